# Optimizing an MI355X kernel written in HIP

```python
import math
import jax, jax.numpy as jnp
from jax import lax
import numpy as np

D_MODEL = 1024
BATCH = 8
SEQ = 4096
DEPTH = 2

CHUNK = 64
N_MIXERS = 2
N_SSD_LAYERS = (DEPTH + 1) // 2
N_ATT_LAYERS = DEPTH // 2

SSD_EXPAND = 2
D_INNER = SSD_EXPAND * D_MODEL
SSD_HEAD_DIM = 64
SSD_HEADS = D_INNER // SSD_HEAD_DIM
SSD_GROUPS = 4
SSD_HEADS_PER_GROUP = SSD_HEADS // SSD_GROUPS
SSD_STATE = 128
SSD_CONV = 4
SSD_CONV_DIM = D_INNER + 2 * SSD_GROUPS * SSD_STATE
SSD_IN_DIM = 2 * D_INNER + 2 * SSD_GROUPS * SSD_STATE + SSD_HEADS

ATT_HEADS = 16
ATT_HEAD_DIM = D_MODEL // ATT_HEADS
LEFT_CHUNKS = 8
BAND = (LEFT_CHUNKS + 1) * CHUNK
MAX_REL = 128

N_EXPERTS = 16
N_EXPERT_GROUPS = 4
EXPERTS_PER_GROUP = N_EXPERTS // N_EXPERT_GROUPS
TOP_K = 2
D_FF_EXPERT = 512

DEEPNORM_ALPHA = (2.0 * DEPTH) ** 0.25
DEEPNORM_BETA = (8.0 * DEPTH) ** -0.25
LN_EPS = 1e-5
RMS_EPS = 1e-5

kernel_name = "hybrid_ssd_chunkattn_groupmoe_deepnorm"


def layer_norm(x, g, b):
    xf = x.astype(jnp.float32)
    mu = jnp.mean(xf, axis=-1, keepdims=True)
    var = jnp.mean(jnp.square(xf - mu), axis=-1, keepdims=True)
    out = (xf - mu) * lax.rsqrt(var + LN_EPS) * g.astype(jnp.float32) + b.astype(jnp.float32)
    return out.astype(x.dtype)


def causal_depthwise_conv(u, w, b):
    k_w = w.shape[0]
    s = u.shape[1]
    up = jnp.pad(u, ((0, 0), (k_w - 1, 0), (0, 0)))
    return sum(up[:, k:k + s] * w[k] for k in range(k_w)) + b


def ssd_mixer(x, w_in, conv_w, conv_b, dt_bias, a_log, d_skip, norm_w, w_out):
    bsz, s, _ = x.shape
    nc = s // CHUNK
    g, hg, p, n = SSD_GROUPS, SSD_HEADS_PER_GROUP, SSD_HEAD_DIM, SSD_STATE
    f32 = jnp.float32
    zxbcdt = x @ w_in
    z, xbc, dt = jnp.split(zxbcdt, [D_INNER, D_INNER + SSD_CONV_DIM], axis=-1)
    xbc = jax.nn.silu(causal_depthwise_conv(xbc, conv_w, conv_b))
    xs, bm, cm = jnp.split(xbc, [D_INNER, D_INNER + g * n], axis=-1)
    xs = xs.astype(f32).reshape(bsz, nc, CHUNK, g, hg, p)
    bm = bm.astype(f32).reshape(bsz, nc, CHUNK, g, n)
    cm = cm.astype(f32).reshape(bsz, nc, CHUNK, g, n)
    dt = jax.nn.softplus(dt.astype(f32) + dt_bias.astype(f32)).reshape(bsz, nc, CHUNK, g, hg)
    a = -jnp.exp(a_log.astype(f32)).reshape(g, hg)
    da = dt * a
    causal = jnp.tril(jnp.ones((CHUNK, CHUNK), dtype=bool))

    def step(h, inp):
        xc, bc, cc, dtc, dac = inp
        cum = jnp.cumsum(dac, axis=1)
        seg = cum[:, :, None] - cum[:, None, :]
        decay = jnp.exp(jnp.where(causal[None, :, :, None, None], seg, -jnp.inf))
        cb = jnp.einsum('bign,bjgn->bijg', cc, bc)
        w_ij = cb[..., None] * decay * dtc[:, None]
        y = jnp.einsum('bijgh,bjghp->bighp', w_ij, xc)
        y = y + jnp.einsum('bign,bghpn->bighp', cc, h) * jnp.exp(cum)[..., None]
        last = cum[:, -1]
        wj = jnp.exp(last[:, None] - cum) * dtc
        h = h * jnp.exp(last)[..., None, None] + jnp.einsum('bjgn,bjgh,bjghp->bghpn', bc, wj, xc)
        return h, y

    h0 = jnp.zeros((bsz, g, hg, p, n), f32)
    inputs = tuple(jnp.moveaxis(t, 1, 0) for t in (xs, bm, cm, dt, da))
    _, ys = lax.scan(step, h0, inputs)
    ys = jnp.moveaxis(ys, 0, 1)
    y = ys + d_skip.astype(f32).reshape(g, hg)[..., None] * xs
    y = y.reshape(bsz, s, D_INNER) * jax.nn.silu(z.astype(f32))
    yg = y.reshape(bsz, s, g, D_INNER // g)
    yg = yg * lax.rsqrt(jnp.mean(jnp.square(yg), axis=-1, keepdims=True) + RMS_EPS)
    y = yg.reshape(bsz, s, D_INNER) * norm_w.astype(f32)
    return y.astype(x.dtype) @ w_out


def chunked_attention(x, w_qkv, b_qkv, rel_table, w_o, b_o):
    bsz, s, _ = x.shape
    nc = s // CHUNK
    pad = LEFT_CHUNKS * CHUNK
    qkv = x @ w_qkv + b_qkv
    q, k, v = jnp.split(qkv, 3, axis=-1)
    q = q.reshape(bsz, s, ATT_HEADS, ATT_HEAD_DIM) * (ATT_HEAD_DIM ** -0.5)
    k = k.reshape(bsz, s, ATT_HEADS, ATT_HEAD_DIM)
    v = v.reshape(bsz, s, ATT_HEADS, ATT_HEAD_DIM)
    k_pad = jnp.pad(k, ((0, 0), (pad, 0), (0, 0), (0, 0)))
    v_pad = jnp.pad(v, ((0, 0), (pad, 0), (0, 0), (0, 0)))
    q_chunks = jnp.moveaxis(q.reshape(bsz, nc, CHUNK, ATT_HEADS, ATT_HEAD_DIM), 1, 0)
    qi = jnp.arange(CHUNK)
    kj = jnp.arange(BAND)
    dist = qi[:, None] + pad - kj[None, :]
    rel_idx = jnp.clip(dist, -MAX_REL, MAX_REL) + MAX_REL
    bias = jnp.transpose(rel_table[rel_idx], (2, 0, 1)).astype(jnp.float32)

    def one_chunk(args):
        qc, c = args
        start = c * CHUNK
        kb = lax.dynamic_slice_in_dim(k_pad, start, BAND, axis=1)
        vb = lax.dynamic_slice_in_dim(v_pad, start, BAND, axis=1)
        key_pos = start - pad + kj
        sc = jnp.einsum('bqhd,bkhd->bhqk', qc, kb).astype(jnp.float32) + bias
        sc = jnp.where((key_pos >= 0)[None, None, None, :], sc, -jnp.inf)
        pr = jax.nn.softmax(sc, axis=-1).astype(vb.dtype)
        return jnp.einsum('bhqk,bkhd->bqhd', pr, vb)

    out = lax.map(one_chunk, (q_chunks, jnp.arange(nc)))
    out = jnp.moveaxis(out, 0, 1).reshape(bsz, s, D_MODEL)
    return out @ w_o + b_o


def group_limited_moe(x, router_w, router_bias, w_gate, w_up, w_down):
    bsz, s, dm = x.shape
    t = x.reshape(-1, dm)
    scores = jax.nn.softmax((t @ router_w).astype(jnp.float32), axis=-1)
    sel = scores + router_bias.astype(jnp.float32)
    grp_top = lax.top_k(sel.reshape(-1, N_EXPERT_GROUPS, EXPERTS_PER_GROUP), TOP_K)[0]
    grp = jnp.argmax(jnp.sum(grp_top, axis=-1), axis=-1)
    expert_group = jnp.arange(N_EXPERTS) // EXPERTS_PER_GROUP
    masked = jnp.where(expert_group[None, :] == grp[:, None], sel, -jnp.inf)
    _, idx = lax.top_k(masked, TOP_K)
    gate = jnp.take_along_axis(scores, idx, axis=-1)
    gate = gate / jnp.sum(gate, axis=-1, keepdims=True)
    combine = jnp.sum(jax.nn.one_hot(idx, N_EXPERTS, dtype=jnp.float32) * gate[..., None], axis=1)
    out = jnp.zeros_like(t)
    for e in range(N_EXPERTS):
        h = jax.nn.silu(t @ w_gate[e]) * (t @ w_up[e])
        out = out + combine[:, e:e + 1].astype(t.dtype) * (h @ w_down[e])
    return out.reshape(bsz, s, dm)


def setup_inputs(seed: int = 0) -> dict:
    key = jax.random.key(seed)
    keys = jax.random.split(key, 24)
    f32 = jnp.float32

    def nrm(k, shape, scale):
        return jax.random.normal(k, shape, f32) * scale

    dt0 = jnp.exp(jax.random.uniform(keys[4], (N_SSD_LAYERS, SSD_HEADS), f32)
                  * (math.log(0.1) - math.log(1e-3)) + math.log(1e-3))
    ssm_dt_bias = dt0 + jnp.log(-jnp.expm1(-dt0))
    att_w_qkv = nrm(keys[9], (N_ATT_LAYERS, D_MODEL, 3 * D_MODEL), D_MODEL ** -0.5)
    att_w_qkv = att_w_qkv.at[..., 2 * D_MODEL:].multiply(DEEPNORM_BETA)
    return {
        "x": nrm(keys[0], (BATCH, SEQ, D_MODEL), 1.0),
        "ssm_w_in": nrm(keys[1], (N_SSD_LAYERS, D_MODEL, SSD_IN_DIM), D_MODEL ** -0.5),
        "ssm_conv_w": nrm(keys[2], (N_SSD_LAYERS, SSD_CONV, SSD_CONV_DIM), SSD_CONV ** -0.5),
        "ssm_conv_b": nrm(keys[3], (N_SSD_LAYERS, SSD_CONV_DIM), 0.02),
        "ssm_dt_bias": ssm_dt_bias,
        "ssm_a_log": jnp.log(jax.random.uniform(keys[5], (N_SSD_LAYERS, SSD_HEADS), f32, 1.0, 16.0)),
        "ssm_d": 1.0 + nrm(keys[6], (N_SSD_LAYERS, SSD_HEADS), 0.02),
        "ssm_norm_w": 1.0 + nrm(keys[7], (N_SSD_LAYERS, D_INNER), 0.02),
        "ssm_w_out": nrm(keys[8], (N_SSD_LAYERS, D_INNER, D_MODEL), D_INNER ** -0.5 * DEEPNORM_BETA),
        "att_w_qkv": att_w_qkv,
        "att_b_qkv": nrm(keys[10], (N_ATT_LAYERS, 3 * D_MODEL), 0.02),
        "att_rel_bias": nrm(keys[11], (N_ATT_LAYERS, 2 * MAX_REL + 1, ATT_HEADS), 0.5),
        "att_w_o": nrm(keys[12], (N_ATT_LAYERS, D_MODEL, D_MODEL), D_MODEL ** -0.5 * DEEPNORM_BETA),
        "att_b_o": nrm(keys[13], (N_ATT_LAYERS, D_MODEL), 0.02),
        "router_w": nrm(keys[14], (D_MODEL, N_EXPERTS), D_MODEL ** -0.5),
        "router_bias": nrm(keys[15], (N_EXPERTS,), 0.01),
        "moe_w_gate": nrm(keys[16], (DEPTH, N_EXPERTS, D_MODEL, D_FF_EXPERT), D_MODEL ** -0.5 * DEEPNORM_BETA),
        "moe_w_up": nrm(keys[17], (DEPTH, N_EXPERTS, D_MODEL, D_FF_EXPERT), D_MODEL ** -0.5 * DEEPNORM_BETA),
        "moe_w_down": nrm(keys[18], (DEPTH, N_EXPERTS, D_FF_EXPERT, D_MODEL), D_FF_EXPERT ** -0.5 * DEEPNORM_BETA),
        "ln_mix_g": 1.0 + nrm(keys[19], (DEPTH, D_MODEL), 0.02),
        "ln_mix_b": nrm(keys[20], (DEPTH, D_MODEL), 0.02),
        "ln_ffn_g": 1.0 + nrm(keys[21], (DEPTH, D_MODEL), 0.02),
        "ln_ffn_b": nrm(keys[22], (DEPTH, D_MODEL), 0.02),
    }


def reference(x, ssm_w_in, ssm_conv_w, ssm_conv_b, ssm_dt_bias, ssm_a_log, ssm_d,
              ssm_norm_w, ssm_w_out, att_w_qkv, att_b_qkv, att_rel_bias, att_w_o, att_b_o,
              router_w, router_bias, moe_w_gate, moe_w_up, moe_w_down,
              ln_mix_g, ln_mix_b, ln_ffn_g, ln_ffn_b):
    for i in range(DEPTH):
        j = i // N_MIXERS
        if i % N_MIXERS == 0:
            mix = ssd_mixer(x, ssm_w_in[j], ssm_conv_w[j], ssm_conv_b[j], ssm_dt_bias[j],
                            ssm_a_log[j], ssm_d[j], ssm_norm_w[j], ssm_w_out[j])
        else:
            mix = chunked_attention(x, att_w_qkv[j], att_b_qkv[j], att_rel_bias[j],
                                    att_w_o[j], att_b_o[j])
        x = layer_norm(DEEPNORM_ALPHA * x + mix, ln_mix_g[i], ln_mix_b[i])
        ffn = group_limited_moe(x, router_w, router_bias, moe_w_gate[i], moe_w_up[i], moe_w_down[i])
        x = layer_norm(DEEPNORM_ALPHA * x + ffn, ln_ffn_g[i], ln_ffn_b[i])
    return x
```

```cpp
#include <hip/hip_runtime.h>
#include <cstdio>
#include <cstdint>

#ifndef MK_N_LAUNCHES
#define MK_N_LAUNCHES 1
#endif
#ifndef NAIVE_SCAN
#define NAIVE_SCAN 1
#endif
#ifndef NAIVE_ATTN
#define NAIVE_ATTN 1
#endif

#define LAS __attribute__((address_space(3)))
#define GAS __attribute__((address_space(1)))
typedef unsigned short bf16;
typedef short bf16x8 __attribute__((ext_vector_type(8)));
typedef float f32x4 __attribute__((ext_vector_type(4)));
typedef float f32x2 __attribute__((ext_vector_type(2)));
typedef unsigned u32x4 __attribute__((ext_vector_type(4)));
typedef unsigned u32x2 __attribute__((ext_vector_type(2)));
typedef GAS unsigned gu32;

constexpr int NB = 8, SEQ = 4096, D = 1024, T = NB * SEQ;
constexpr int DI = 2048, NH = 32, HP = 64, NG = 4, NS = 128, CONVD = 3072, INP = 5152, NZX = 5120;
constexpr int AH = 16, AD = 64, LEFTC = 8, MAXREL = 128;
constexpr int NE = 16, DFF = 512;
constexpr float ALPHA = 1.4142135623730951f;
constexpr float LN_EPS = 1e-5f, RMS_EPS = 1e-5f;
constexpr int NPHASE = 16;
constexpr int MAXTILES = 272;

constexpr size_t MiB = 1u << 20;
constexpr size_t WS_CTL = 0, CTL_ZERO_BYTES = 1 * MiB;
constexpr size_t WS_WIN = 1 * MiB;
constexpr size_t WS_WOUT = 12 * MiB;
constexpr size_t WS_XB = 16 * MiB;
constexpr size_t WS_WGU0 = 16 * MiB, WS_WD0 = 48 * MiB, WS_WQKV = 64 * MiB, WS_WO = 70 * MiB, WS_WGU1 = 72 * MiB, WS_WD1 = 104 * MiB;
constexpr size_t WS_Z = 120 * MiB;
constexpr size_t WS_XBC = 248 * MiB;
constexpr size_t WS_DTRAW = 440 * MiB;
constexpr size_t WS_SSQ = 444 * MiB;
constexpr size_t WS_MIX1 = 248 * MiB;
constexpr size_t WS_X1B = 324 * MiB;
constexpr size_t WS_H0 = 120 * MiB;
constexpr size_t WS_Y20 = 188 * MiB;
constexpr size_t WS_X2B = 120 * MiB;
constexpr size_t WS_QKV = 188 * MiB;
constexpr size_t WS_AO = 380 * MiB;
constexpr size_t WS_MIX2 = 188 * MiB;
constexpr size_t WS_X3B = 256 * MiB;
constexpr size_t WS_H1 = 320 * MiB;
constexpr size_t WS_Y21 = 120 * MiB;
constexpr size_t WS_LIST = 500 * MiB;
constexpr size_t WS_INFO = 504 * MiB;
constexpr size_t WS_END = 512 * MiB;
constexpr int CW_TMO = 0;
constexpr int CW_CNT = 1024;
constexpr int CW_BAR = 4096;

constexpr int RING_BYTES = 131072;
constexpr int LDSCTL_OFF = RING_BYTES, MISC_OFF = LDSCTL_OFF + 320;
constexpr int TOKL_OFF = LDSCTL_OFF + 1024;
constexpr int MOE_OFF = TOKL_OFF + 6 * 1024;
constexpr int LDS_BYTES = 147456;

#define RLX_AGENT __ATOMIC_RELAXED, __HIP_MEMORY_SCOPE_AGENT
#define LDS_WAIT() asm volatile("s_waitcnt lgkmcnt(0)" ::: "memory")
#define VM_WAIT() asm volatile("s_waitcnt vmcnt(0)" ::: "memory")

__device__ __forceinline__ unsigned f2bf(float f) { unsigned u = __builtin_bit_cast(unsigned, f); return (u + 0x7fffu + ((u >> 16) & 1u)) >> 16; }
__device__ __forceinline__ unsigned pk2(float lo, float hi) { return f2bf(lo) | (f2bf(hi) << 16); }
__device__ __forceinline__ float bf2f(unsigned short b) { return __builtin_bit_cast(float, ((unsigned)b) << 16); }
__device__ __forceinline__ float bflo(unsigned w) { return __builtin_bit_cast(float, w << 16); }
__device__ __forceinline__ float bfhi(unsigned w) { return __builtin_bit_cast(float, w & 0xffff0000u); }
__device__ __forceinline__ float silu_f(float v) { return v / (1.f + __expf(-v)); }
__device__ __forceinline__ float wave_sum(float v) {
#pragma unroll
    for (int o = 1; o < 64; o <<= 1) v += __shfl_xor(v, o);
    return v;
}

namespace pg8 {
constexpr int BM = 256, BK = 64, HALF = 128, HTB = HALF * BK * 2, STAGE_BYTES = 8 * HTB;
__device__ __forceinline__ int lds_byte(int r, int c) { const int st = (r >> 4) * 2 + (c >> 5), rr = r & 15, cc = c & 31, ob = rr * 64 + cc * 2; return st * 1024 + (ob ^ (((ob >> 9) & 1) << 5)); }
__device__ __forceinline__ void stage_rc(int b, int& R, int& C) { const int st = b / 1024, sb = b % 1024, swz = sb ^ (((sb >> 9) & 1) << 5); R = (st >> 1) * 16 + swz / 64; C = (st & 1) * 32 + (swz % 64) / 2; }
__device__ __forceinline__ int perm32(int rho) { const int n = rho >> 4, i = rho & 15; return 8 * (i >> 2) + 4 * n + (i & 3); }
__device__ __forceinline__ unsigned cvt_pk_bf16(float lo, float hi) { unsigned r; asm volatile("v_cvt_pk_bf16_f32 %0, %1, %2" : "=v"(r) : "v"(lo), "v"(hi)); return r; }

struct Unit { int pm, pn, bt, e; };

template <class Epi, class Sched>
__device__ __forceinline__ void gemm_phase(LAS unsigned char* lds, const bf16* A, const bf16* Bt, int K, const Sched& S, const Epi& E) {
    int tid = threadIdx.x; asm volatile("" : "+v"(tid));
    const int wid = __builtin_amdgcn_readfirstlane(tid >> 6), lane = tid & 63, wr = wid >> 2, wc = wid & 3, fr = lane & 15, fq = lane >> 4;
    const int nt = K / BK;
    int Rr[2], Cc[2]; unsigned voffB[2];
#pragma unroll
    for (int i = 0; i < 2; ++i) { stage_rc(tid * 16 + i * 8192, Rr[i], Cc[i]); const int Rb = (Rr[i] & ~31) + perm32(Rr[i] & 31); voffB[i] = (unsigned)(Rb * K + Cc[i]) * 2u; }
    const size_t kstep = (size_t)(BK * 2);
    const size_t hstep = (size_t)HALF * K * 2;
    const size_t tstep = 2 * hstep;
    const unsigned ldsw = (unsigned)wid * 1024u;
    const int aoff = lds_byte(wr * 64 + fr, fq * 8), boff = lds_byte(wc * 32 + fr, fq * 8);
#define PG8_SA(b, h) (((b) * 2 + (h)) * HTB)
#define PG8_SB(b, h) ((4 + (b) * 2 + (h)) * HTB)
#define PG8_STAGE(bufoff, gbase, voff) do { _Pragma("unroll") for (int _i = 0; _i < 2; ++_i) \
        __builtin_amdgcn_global_load_lds((const unsigned*)((const char*)(gbase) + (voff)[_i]), (LAS unsigned*)(lds + (bufoff) + ldsw + _i * 8192), 16, 0, 0); } while (0)
#define PG8_LDA(dst, b, h) do { _Pragma("unroll") for (int m = 0; m < 4; ++m) _Pragma("unroll") for (int k = 0; k < 2; ++k) dst[m][k] = *(const LAS bf16x8*)(lds + PG8_SA(b, h) + aoff + m * 2048 + k * 1024); } while (0)
#define PG8_LDB(dst, b, h) do { _Pragma("unroll") for (int n = 0; n < 2; ++n) _Pragma("unroll") for (int k = 0; k < 2; ++k) dst[n][k] = *(const LAS bf16x8*)(lds + PG8_SB(b, h) + boff + n * 2048 + k * 1024); } while (0)
#define PG8_MMA(ai, bj, At, Bt_) do { __builtin_amdgcn_s_setprio(1); _Pragma("unroll") for (int m = 0; m < 4; ++m) _Pragma("unroll") for (int n = 0; n < 2; ++n) _Pragma("unroll") for (int k = 0; k < 2; ++k) \
        acc[ai][bj][m][n] = __builtin_amdgcn_mfma_f32_16x16x32_bf16(Bt_[n][k], At[m][k], acc[ai][bj][m][n], 0, 0, 0); __builtin_amdgcn_s_setprio(0); } while (0)
#define PG8_WAIT_V(n) asm volatile("s_waitcnt vmcnt(" #n ")" ::: "memory")
#define PG8_WAIT_L(n) asm volatile("s_waitcnt lgkmcnt(" #n ")" ::: "memory")
#define PG8_BAR __builtin_amdgcn_s_barrier()
#define PG8_SCHED __builtin_amdgcn_sched_barrier(0)
    Unit cur, nxt; int ui = 0;
    if (!S.next(0, cur)) return;
    f32x4 acc[2][2][4][2];
#pragma unroll
    for (int a = 0; a < 2; ++a)
#pragma unroll
        for (int b = 0; b < 2; ++b)
#pragma unroll
            for (int m = 0; m < 4; ++m)
#pragma unroll
                for (int n = 0; n < 2; ++n) acc[a][b][m][n] = (f32x4){0.f, 0.f, 0.f, 0.f};
    bf16x8 At[4][2], B0[2][2], B1[2][2];
    unsigned vA0[2], vA1[2];
#pragma unroll
    for (int i = 0; i < 2; ++i) { vA0[i] = S.a_off(0, cur, 0, Rr[i], Cc[i]); vA1[i] = S.a_off(0, cur, 1, Rr[i], Cc[i]); }
    const char* Ab = (const char*)A;
    const char* cB = (const char*)Bt + (size_t)cur.bt * tstep;
    PG8_STAGE(PG8_SB(0, 0), cB, voffB); PG8_STAGE(PG8_SB(0, 1), cB + hstep, voffB); PG8_STAGE(PG8_SA(0, 0), Ab, vA0); PG8_STAGE(PG8_SA(0, 1), Ab, vA1);
    if (wr == 1) PG8_BAR;
    PG8_WAIT_V(2); PG8_BAR;
    PG8_STAGE(PG8_SB(1, 0), cB + kstep, voffB); PG8_STAGE(PG8_SA(1, 0), Ab + kstep, vA0); PG8_STAGE(PG8_SB(1, 1), cB + hstep + kstep, voffB);
    PG8_WAIT_V(6); PG8_BAR;
    for (;;) {
        const bool has_next = S.next(ui + 1, nxt);
        const char* nB = has_next ? (const char*)Bt + (size_t)nxt.bt * tstep : cB;
        for (int t = 0; t < nt; t += 2) {
            const bool last = (t == nt - 2);
            const char* a1 = Ab + (size_t)(t + 1) * kstep;
            const char* a2 = last ? Ab : Ab + (size_t)(t + 2) * kstep; const char* b2 = last ? nB : cB + (size_t)(t + 2) * kstep;
            const char* a3 = a2 + kstep; const char* b3 = b2 + kstep;
            unsigned v20[2], v21[2];
#pragma unroll
            for (int i = 0; i < 2; ++i) { v20[i] = vA0[i]; v21[i] = vA1[i]; }
            if (last && has_next) {
#pragma unroll
                for (int i = 0; i < 2; ++i) { v20[i] = S.a_off(ui + 1, nxt, 0, Rr[i], Cc[i]); v21[i] = S.a_off(ui + 1, nxt, 1, Rr[i], Cc[i]); } }
            PG8_LDB(B0, 0, 0); PG8_LDB(B1, 0, 1); PG8_SCHED; PG8_LDA(At, 0, 0); PG8_STAGE(PG8_SA(1, 1), a1, vA1);
            PG8_WAIT_V(8); PG8_WAIT_L(0); PG8_BAR; PG8_MMA(0, 0, At, B0); PG8_MMA(0, 1, At, B1); PG8_BAR; PG8_SCHED;
            PG8_LDA(At, 0, 1); PG8_STAGE(PG8_SB(0, 0), b2, voffB); PG8_STAGE(PG8_SB(0, 1), b2 + hstep, voffB); PG8_STAGE(PG8_SA(0, 0), a2, v20);
            PG8_WAIT_V(8); PG8_WAIT_L(0); PG8_BAR; PG8_MMA(1, 0, At, B0); PG8_MMA(1, 1, At, B1); PG8_BAR; PG8_SCHED;
            PG8_LDB(B0, 1, 0); PG8_LDB(B1, 1, 1); PG8_SCHED; PG8_LDA(At, 1, 0); PG8_STAGE(PG8_SA(0, 1), a2, v21);
            PG8_WAIT_V(8); PG8_WAIT_L(0); PG8_BAR; PG8_MMA(0, 0, At, B0); PG8_MMA(0, 1, At, B1); PG8_BAR; PG8_SCHED;
            PG8_LDA(At, 1, 1); PG8_STAGE(PG8_SB(1, 0), b3, voffB); PG8_STAGE(PG8_SB(1, 1), b3 + hstep, voffB); PG8_STAGE(PG8_SA(1, 0), a3, v20);
            PG8_WAIT_V(8); PG8_WAIT_L(0); PG8_BAR; PG8_MMA(1, 0, At, B0); PG8_MMA(1, 1, At, B1); PG8_BAR; PG8_SCHED;
        }
        if (wr == 0) PG8_BAR;
        E(acc, cur, wr, wc, fr, fq);
        if (!has_next) break;
#pragma unroll
        for (int a = 0; a < 2; ++a)
#pragma unroll
            for (int b = 0; b < 2; ++b)
#pragma unroll
                for (int m = 0; m < 4; ++m)
#pragma unroll
                    for (int n = 0; n < 2; ++n) acc[a][b][m][n] = (f32x4){0.f, 0.f, 0.f, 0.f};
        cur = nxt; cB = nB; ++ui;
#pragma unroll
        for (int i = 0; i < 2; ++i) { vA0[i] = S.a_off(ui, cur, 0, Rr[i], Cc[i]); vA1[i] = S.a_off(ui, cur, 1, Rr[i], Cc[i]); }
        if (wr == 1) PG8_BAR;
    }
    PG8_WAIT_V(0);
    PG8_BAR;
#undef PG8_SA
#undef PG8_SB
#undef PG8_STAGE
#undef PG8_LDA
#undef PG8_LDB
#undef PG8_MMA
#undef PG8_WAIT_V
#undef PG8_WAIT_L
#undef PG8_BAR
#undef PG8_SCHED
}

struct DenseOrder {
    int nM, nN, nwg, G, c, lda;
    __device__ void init(int M, int N, int G_, int c_, int lda_) { nM = M / BM; nN = N / BM; nwg = nM * nN; G = G_; c = c_; lda = lda_; }
    __device__ __forceinline__ bool next(int i, Unit& u) const {
        const long L = (long)i * G + c; if (L >= nwg) return false;
        int wgid = (int)L; { const int q = nwg / 8, r = nwg % 8, xcd = wgid % 8, off = wgid / 8; wgid = (xcd < r ? xcd * (q + 1) : r * (q + 1) + (xcd - r) * q) + off; }
        const int nig = 8 * nN, gid = wgid / nig, fm = gid * 8, gsz = (nM - fm) < 8 ? (nM - fm) : 8;
        u.pm = fm + ((wgid % nig) % gsz); u.pn = (wgid % nig) / gsz; u.bt = u.pn; u.e = 0; return true;
    }
    __device__ __forceinline__ unsigned a_off(int, const Unit& u, int h, int R, int C) const { return (unsigned)((u.pm * BM + h * HALF + R) * lda + C) * 2u; }
};
template <bool GATHER> struct MoeOrder {
    const LAS int* ts;
    const LAS int* tokL;
    int G, c, lda;
    __device__ __forceinline__ bool next(int i, Unit& u) const {
        const int L = i * G + c; const int ntile = __builtin_amdgcn_readfirstlane(ts[16]);
        if (L >= ntile * 4) return false;
        const int rt = L >> 2; int e = 0;
#pragma unroll
        for (int j = 1; j < 16; ++j) e += (rt >= ts[j]) ? 1 : 0;
        e = __builtin_amdgcn_readfirstlane(e);
        u.pm = rt; u.pn = L & 3; u.e = e; u.bt = e * 4 + (L & 3); return true;
    }
    __device__ __forceinline__ unsigned a_off(int ui, const Unit& u, int h, int R, int C) const {
        if (GATHER) { const int tok = tokL[ui * 256 + h * HALF + R]; return (unsigned)(tok * lda + C) * 2u; }
        return (unsigned)((u.pm * BM + h * HALF + R) * lda + C) * 2u;
    }
};

struct EpiPlain {
    bf16* O; int ldc; const float* bias; int scale_cols; float scale0;
    __device__ __forceinline__ void operator()(const f32x4 (&acc)[2][2][4][2], const Unit& u, int wr, int wc, int fr, int fq) const {
        const int row0 = u.pm * BM + wr * 64 + fr, col0 = u.pn * BM + wc * 32 + 8 * fq;
        const float sc = (u.pn * BM < scale_cols) ? scale0 : 1.f;
        f32x4 bv[2][2];
#pragma unroll
        for (int bj = 0; bj < 2; ++bj)
#pragma unroll
            for (int n = 0; n < 2; ++n) bv[bj][n] = bias ? *(const f32x4*)(bias + col0 + bj * HALF + 4 * n) : (f32x4){0.f, 0.f, 0.f, 0.f};
#pragma unroll
        for (int ai = 0; ai < 2; ++ai)
#pragma unroll
            for (int m = 0; m < 4; ++m) { bf16* rowp = O + (size_t)(row0 + ai * HALF + m * 16) * ldc + col0;
#pragma unroll
                for (int bj = 0; bj < 2; ++bj) { f32x4 v0 = (acc[ai][bj][m][0] + bv[bj][0]) * sc, v1 = (acc[ai][bj][m][1] + bv[bj][1]) * sc;
                    u32x4 w; w.x = cvt_pk_bf16(v0[0], v0[1]); w.y = cvt_pk_bf16(v0[2], v0[3]); w.z = cvt_pk_bf16(v1[0], v1[1]); w.w = cvt_pk_bf16(v1[2], v1[3]);
                    *(u32x4*)(rowp + bj * HALF) = w; } }
    }
};
struct EpiInProj {
    bf16* Z; bf16* XBC;
    __device__ __forceinline__ void operator()(const f32x4 (&acc)[2][2][4][2], const Unit& u, int wr, int wc, int fr, int fq) const {
        const int row0 = u.pm * BM + wr * 64 + fr; int colt = u.pn * BM; bf16* base; int ldc;
        if (colt < DI) { base = Z; ldc = DI; } else { base = XBC; ldc = CONVD; colt -= DI; }
        const int col0 = colt + wc * 32 + 8 * fq;
#pragma unroll
        for (int ai = 0; ai < 2; ++ai)
#pragma unroll
            for (int m = 0; m < 4; ++m) { bf16* rowp = base + (size_t)(row0 + ai * HALF + m * 16) * ldc + col0;
#pragma unroll
                for (int bj = 0; bj < 2; ++bj) { const f32x4 v0 = acc[ai][bj][m][0], v1 = acc[ai][bj][m][1];
                    u32x4 w; w.x = cvt_pk_bf16(v0[0], v0[1]); w.y = cvt_pk_bf16(v0[2], v0[3]); w.z = cvt_pk_bf16(v1[0], v1[1]); w.w = cvt_pk_bf16(v1[2], v1[3]);
                    *(u32x4*)(rowp + bj * HALF) = w; } }
    }
};
struct EpiGateUp {
    bf16* Hh;
    __device__ __forceinline__ void operator()(const f32x4 (&acc)[2][2][4][2], const Unit& u, int wr, int wc, int fr, int fq) const {
        const int row0 = u.pm * BM + wr * 64 + fr, col0 = (u.pn * BM + wc * 32 + 8 * fq) >> 1;
#pragma unroll
        for (int ai = 0; ai < 2; ++ai)
#pragma unroll
            for (int m = 0; m < 4; ++m) { bf16* rowp = Hh + (size_t)(row0 + ai * HALF + m * 16) * DFF + col0;
#pragma unroll
                for (int bj = 0; bj < 2; ++bj) { const f32x4 g = acc[ai][bj][m][0], up = acc[ai][bj][m][1];
                    u32x2 w; w.x = cvt_pk_bf16(silu_f(g[0]) * up[0], silu_f(g[1]) * up[1]); w.y = cvt_pk_bf16(silu_f(g[2]) * up[2], silu_f(g[3]) * up[3]);
                    *(u32x2*)(rowp + bj * (HALF / 2)) = w; } }
    }
};
}

#define XB_TMO      128
#define XB_XCNT(j)  (256  + 64 * (j))
#define XB_XSUB(j)  (1280 + 64 * (j))
#define XB_XGEN(j)  (2304 + 64 * (j))
#define XB_TOP      3328
#define XB_TOPGEN   3392
#define XCD_BAR_WORDS 3456
#define XB_SPIN_CAP (1u << 18)
__device__ __forceinline__ unsigned xb_ld(unsigned* p)              { return __hip_atomic_load(p, __ATOMIC_RELAXED, __HIP_MEMORY_SCOPE_AGENT); }
__device__ __forceinline__ unsigned xb_add(unsigned* p, unsigned v) { return __hip_atomic_fetch_add(p, v, __ATOMIC_RELAXED, __HIP_MEMORY_SCOPE_AGENT); }
__device__ __forceinline__ unsigned xb_xcc_id() { return (unsigned)__builtin_amdgcn_s_getreg((3 << 11) | 20) & 0xFu; }
#define XB_SPIN(cond, bar) do { unsigned _sp = 0; while (cond) { __builtin_amdgcn_s_sleep(1); \
    if ((++_sp & 255u) == 0u) { if (xb_ld(&(bar)[XB_TMO])) break; if (_sp > XB_SPIN_CAP) { atomicAdd(&(bar)[XB_TMO], 1u); break; } } } } while (0)
struct XcdBarrier { unsigned* bar; unsigned x; volatile LAS unsigned* st; };
__device__ __forceinline__ XcdBarrier xcd_barrier_post(unsigned* bar, volatile LAS unsigned* st) {
    XcdBarrier b; b.bar = bar; b.x = xb_xcc_id(); b.st = st;
    if (threadIdx.x == 0) (void)xb_add(&bar[XB_XCNT(b.x)], 1u);
    return b;
}
__device__ __forceinline__ void xcd_barrier_complete(unsigned* bar, unsigned x, unsigned& nloc, unsigned& nx) {
    const unsigned G = gridDim.x * gridDim.y * gridDim.z;
    unsigned sum, cnt, mine, sp = 0u;
    for (;;) {
        sum = 0u; cnt = 0u; mine = 0u;
#pragma unroll
        for (unsigned j = 0; j < 16; ++j) { const unsigned c = xb_ld(&bar[XB_XCNT(j)]); sum += c; cnt += (c > 0u) ? 1u : 0u; mine = (j == x) ? c : mine; }
        if (sum == G) break;
        __builtin_amdgcn_s_sleep(1);
        if ((++sp & 255u) == 0u) { if (xb_ld(&bar[XB_TMO])) break; if (sp > XB_SPIN_CAP) { atomicAdd(&bar[XB_TMO], 1u); break; } }
    }
    nloc = mine > 0u ? mine : 1u; nx = cnt > 0u ? cnt : 1u;
}
__device__ __forceinline__ void xcd_barrier(const XcdBarrier& b) {
    asm volatile("s_waitcnt vmcnt(0)" ::: "memory");
    __syncthreads();
    if (threadIdx.x == 0) {
        unsigned* bar = b.bar;
        __builtin_amdgcn_s_waitcnt(0);
        unsigned nloc = b.st[0], nx = b.st[1];
        if (nloc == 0u) { xcd_barrier_complete(bar, b.x, nloc, nx); b.st[0] = nloc; b.st[1] = nx; }
        const unsigned old = xb_add(&bar[XB_XSUB(b.x)], 1u);
        const unsigned gen = old / nloc;
        if (old + 1u == (gen + 1u) * nloc) {
            __builtin_amdgcn_fence(__ATOMIC_RELEASE, "agent");
            asm volatile("s_waitcnt vmcnt(0)" ::: "memory");
            const unsigned og = xb_add(&bar[XB_TOP], 1u);
            const unsigned tg = og / nx;
            if (og + 1u == (tg + 1u) * nx) xb_add(&bar[XB_TOPGEN], 1u);
            else XB_SPIN(xb_ld(&bar[XB_TOPGEN]) == tg, bar);
            __builtin_amdgcn_fence(__ATOMIC_ACQUIRE, "agent");
            xb_add(&bar[XB_XGEN(b.x)], 1u);
            asm volatile("s_waitcnt vmcnt(0)" ::: "memory");
        } else {
            XB_SPIN(xb_ld(&bar[XB_XGEN(b.x)]) == gen, bar);
            __builtin_amdgcn_fence(__ATOMIC_ACQUIRE, "agent");
            asm volatile("s_waitcnt vmcnt(0)" ::: "memory");
        }
    }
    __syncthreads();
}

struct Args { const float* in[23]; float* out; unsigned char* ws; int ph_lo, ph_hi; };

struct Frame {
    LAS unsigned char* lds;
    int tid, lane, wave, vcu, G;
};

__device__ __forceinline__ void transpose_item(const float* W, int K, int N, bf16* WT, int row_off, int mode, const float* kscale, LAS float* scr, int item, int lane) {
    const int nblk = N / 32, kb = item / nblk, nb = item % nblk, k0 = 64 * kb, n0 = 32 * nb;
#pragma unroll 8
    for (int i = 0; i < 32; ++i) { const int kk = 2 * i + (lane >> 5); scr[kk * 33 + (lane & 31)] = W[(size_t)(k0 + kk) * N + n0 + (lane & 31)]; }
    LDS_WAIT(); asm volatile("" ::: "memory");
    const int c = lane & 7;
    float ks[8];
#pragma unroll
    for (int q = 0; q < 8; ++q) ks[q] = kscale ? kscale[k0 + 8 * c + q] : 1.f;
#pragma unroll
    for (int j = 0; j < 4; ++j) { const int n = (lane >> 3) + 8 * j; const LAS float* s = scr + (8 * c) * 33 + n;
        u32x4 o; o.x = pk2(s[0 * 33] * ks[0], s[1 * 33] * ks[1]); o.y = pk2(s[2 * 33] * ks[2], s[3 * 33] * ks[3]); o.z = pk2(s[4 * 33] * ks[4], s[5 * 33] * ks[5]); o.w = pk2(s[6 * 33] * ks[6], s[7 * 33] * ks[7]);
        const int ng = n0 + n; const int dr = (mode == 0) ? ng : (8 * (ng >> 2) + (ng & 3) + (mode == 2 ? 4 : 0));
        *(GAS u32x4*)(WT + (size_t)(row_off + dr) * K + k0 + 8 * c) = o; }
    LDS_WAIT(); asm volatile("" ::: "memory");
}

__device__ __forceinline__ void ln_row(f32x4 (&v)[4], const float* g, const float* b, int lane) {
    float s = 0.f;
#pragma unroll
    for (int j = 0; j < 4; ++j) s += (v[j].x + v[j].y) + (v[j].z + v[j].w);
    const float mean = wave_sum(s) * (1.f / D); float s2 = 0.f;
#pragma unroll
    for (int j = 0; j < 4; ++j) { v[j] = v[j] - mean; s2 += (v[j].x * v[j].x + v[j].y * v[j].y) + (v[j].z * v[j].z + v[j].w * v[j].w); }
    const float rstd = 1.f / sqrtf(wave_sum(s2) * (1.f / D) + LN_EPS);
#pragma unroll
    for (int j = 0; j < 4; ++j) { const f32x4 gg = *(const f32x4*)(g + 4 * lane + 256 * j), bb = *(const f32x4*)(b + 4 * lane + 256 * j); v[j] = v[j] * rstd * gg + bb; }
}
__device__ __forceinline__ f32x4 ld_bf16x4(const bf16* p) { const u32x2 w = *(const u32x2*)p; return (f32x4){bflo(w.x), bfhi(w.x), bflo(w.y), bfhi(w.y)}; }
__device__ __forceinline__ void st_bf16x4(bf16* p, f32x4 v) { u32x2 w; w.x = pk2(v.x, v.y); w.y = pk2(v.z, v.w); *(u32x2*)p = w; }

__global__ void __launch_bounds__(512, 2) fwd_kernel(Args args) {
    extern __shared__ __attribute__((aligned(16))) unsigned char lds_raw[];
    Frame F;
    F.lds = (LAS unsigned char*)lds_raw;
    F.tid = threadIdx.x; F.lane = F.tid & 63; F.wave = __builtin_amdgcn_readfirstlane(F.tid >> 6);
    F.G = gridDim.x; { const int bx = blockIdx.x; F.vcu = (F.G % 8 == 0) ? (bx % 8) * (F.G / 8) + bx / 8 : bx; }
    unsigned char* ws = args.ws;
    gu32* ctl = (gu32*)(ws + WS_CTL);
    volatile LAS unsigned* MISC = (volatile LAS unsigned*)(F.lds + MISC_OFF);
    for (int u = F.tid; u < (LDS_BYTES - LDSCTL_OFF) / 4; u += 512) ((LAS unsigned*)(F.lds + LDSCTL_OFF))[u] = 0u;
    __syncthreads();
    XcdBarrier bar; bar.bar = (unsigned*)(ctl + CW_BAR); bar.x = 0; bar.st = nullptr;
    if (MK_N_LAUNCHES == 1) bar = xcd_barrier_post((unsigned*)(ctl + CW_BAR), MISC + 8);
    const int lo = args.ph_lo, hi = args.ph_hi;
#ifndef PH_MASK
#define PH_MASK 0xffff
#endif
#define IN(k) (((PH_MASK >> (k)) & 1) && lo <= (k) && (k) < hi)
#define SEAM(k) do { if (IN(k) && IN((k) + 1)) xcd_barrier(bar); } while (0)
#define PH_LOCALS \
    int tid = threadIdx.x; asm volatile("" : "+v"(tid)); const int lane = tid & 63, wave = __builtin_amdgcn_readfirstlane(tid >> 6); \
    unsigned char* ws = args.ws; asm volatile("" : "+s"(ws)); \
    const int gw = F.vcu * 8 + wave, NGW = F.G * 8; (void)lane; (void)gw; (void)NGW; \
    const float* x_in = args.in[0]; (void)x_in; \
    bf16* Wt_in = (bf16*)(ws + WS_WIN); bf16* Wt_out = (bf16*)(ws + WS_WOUT); (void)Wt_in; (void)Wt_out; \
    bf16* XB = (bf16*)(ws + WS_XB); bf16* Zb = (bf16*)(ws + WS_Z); bf16* XBC = (bf16*)(ws + WS_XBC); (void)XB; (void)Zb; (void)XBC; \
    float* DTRAW = (float*)(ws + WS_DTRAW); float* SSQ = (float*)(ws + WS_SSQ); (void)DTRAW; (void)SSQ; \
    int* LIST = (int*)(ws + WS_LIST); unsigned* INFO = (unsigned*)(ws + WS_INFO); (void)LIST; (void)INFO;

    if (IN(0)) { PH_LOCALS
        LAS float* scr = (LAS float*)(F.lds + wave * 16384);
        constexpr int I_IN = (D / 64) * (INP / 32), I_OUT = (DI / 64) * (D / 32);
        for (int it = gw; it < I_IN + I_OUT; it += NGW) {
            if (it < I_IN) transpose_item(args.in[1], D, INP, Wt_in, 0, 0, nullptr, scr, it, lane);
            else transpose_item(args.in[8], DI, D, Wt_out, 0, 0, args.in[7], scr, it - I_IN, lane);
        }
        const size_t n8 = (size_t)T * D / 8;
        for (size_t i = (size_t)blockIdx.x * 512 + tid; i < n8; i += (size_t)F.G * 512) {
            const f32x4 a = *(const f32x4*)(x_in + i * 8), b = *(const f32x4*)(x_in + i * 8 + 4);
            u32x4 o; o.x = pk2(a.x, a.y); o.y = pk2(a.z, a.w); o.z = pk2(b.x, b.y); o.w = pk2(b.z, b.w);
            *(u32x4*)(XB + i * 8) = o;
        }
    }
    SEAM(0);

    if (IN(1)) { PH_LOCALS
        pg8::DenseOrder S; S.init(T, NZX, F.G, (int)blockIdx.x, D);
        pg8::EpiInProj E{Zb, XBC};
        pg8::gemm_phase<pg8::EpiInProj, pg8::DenseOrder>(F.lds, XB, Wt_in, D, S, E);
        for (int tile = gw; tile < T / 16; tile += NGW) {
            const int t0 = tile * 16, r = lane & 15, q = lane >> 4;
            const bf16* xp = XB + (size_t)(t0 + r) * D + 8 * q;
            const bf16* w0 = Wt_in + (size_t)(NZX + r) * D + 8 * q; const bf16* w1 = w0 + (size_t)16 * D;
            f32x4 a0 = {0.f, 0.f, 0.f, 0.f}, a1 = {0.f, 0.f, 0.f, 0.f};
#pragma unroll 4
            for (int k0 = 0; k0 < D; k0 += 32) {
                const bf16x8 xv = *(const bf16x8*)(xp + k0), wa = *(const bf16x8*)(w0 + k0), wb = *(const bf16x8*)(w1 + k0);
                a0 = __builtin_amdgcn_mfma_f32_16x16x32_bf16(wa, xv, a0, 0, 0, 0);
                a1 = __builtin_amdgcn_mfma_f32_16x16x32_bf16(wb, xv, a1, 0, 0, 0);
            }
            float* o = DTRAW + (size_t)(t0 + r) * NH + 4 * q;
            *(f32x4*)o = a0; *(f32x4*)(o + 16) = a1;
        }
    }
    SEAM(1);

    if (IN(2)) { PH_LOCALS
#if NAIVE_SCAN
        const float* conv_w = args.in[2]; const float* conv_b = args.in[3]; const float* dt_bias = args.in[4]; const float* a_log = args.in[5]; const float* dsk = args.in[6];
        for (int item = blockIdx.x; item < NB * NH; item += F.G) {
            if (wave >= 2) continue;
            LAS float* sB = (LAS float*)(F.lds + wave * 8192); LAS float* sC = sB + 128; LAS float* cwl = sC + 128;
            const int b = item / NH, h = item % NH, g = h / 8, pp = 32 * wave + (lane & 31), nh = lane >> 5;
            int col[5]; col[0] = h * HP + pp; col[1] = DI + g * NS + lane; col[2] = col[1] + 64; col[3] = DI + NG * NS + g * NS + lane; col[4] = col[3] + 64;
            float hist[5][3];
#pragma unroll
            for (int c = 0; c < 5; ++c) { cwl[(c * 5 + 4) * 64 + lane] = conv_b[col[c]];
#pragma unroll
                for (int k = 0; k < 4; ++k) cwl[(c * 5 + k) * 64 + lane] = conv_w[k * CONVD + col[c]];
#pragma unroll
                for (int k = 0; k < 3; ++k) hist[c][k] = 0.f; }
            LDS_WAIT();
            const float dtb = dt_bias[h], av = -__expf(a_log[h]), dh = dsk[h];
            float hst[64];
#pragma unroll
            for (int n = 0; n < 64; ++n) hst[n] = 0.f;
            for (int t = 0; t < SEQ; ++t) {
                const size_t row = (size_t)b * SEQ + t;
                float v[5];
#pragma unroll
                for (int c = 0; c < 5; ++c) { const float cur = bf2f(XBC[row * CONVD + col[c]]);
                    float a = cwl[(c * 5 + 4) * 64 + lane] + cwl[(c * 5) * 64 + lane] * hist[c][0] + cwl[(c * 5 + 1) * 64 + lane] * hist[c][1] + cwl[(c * 5 + 2) * 64 + lane] * hist[c][2] + cwl[(c * 5 + 3) * 64 + lane] * cur;
                    hist[c][0] = hist[c][1]; hist[c][1] = hist[c][2]; hist[c][2] = cur; v[c] = silu_f(a); }
                const float raw = DTRAW[row * NH + h] + dtb;
                const float dtv = raw > 20.f ? raw : log1pf(__expf(raw));
                const float dA = __expf(dtv * av);
                sB[lane] = v[1]; sB[lane + 64] = v[2]; sC[lane] = v[3]; sC[lane + 64] = v[4];
                LDS_WAIT(); asm volatile("" ::: "memory");
                const float xd = dtv * v[0]; float y = 0.f;
#pragma unroll
                for (int n = 0; n < 64; n += 4) { const f32x4 bb = *(const LAS f32x4*)(sB + 64 * nh + n), cc = *(const LAS f32x4*)(sC + 64 * nh + n);
                    hst[n] = hst[n] * dA + xd * bb.x; y += cc.x * hst[n];
                    hst[n + 1] = hst[n + 1] * dA + xd * bb.y; y += cc.y * hst[n + 1];
                    hst[n + 2] = hst[n + 2] * dA + xd * bb.z; y += cc.z * hst[n + 2];
                    hst[n + 3] = hst[n + 3] * dA + xd * bb.w; y += cc.w * hst[n + 3]; }
                LDS_WAIT(); asm volatile("" ::: "memory");
                y += __shfl_xor(y, 32);
                y += dh * v[0];
                const float zv = bf2f(Zb[row * DI + h * HP + pp]);
                const float yg = y * silu_f(zv);
                float sq = (lane < 32) ? yg * yg : 0.f; sq = wave_sum(sq);
                if (lane < 32) Zb[row * DI + h * HP + pp] = (bf16)f2bf(yg);
                if (lane == 0) SSQ[row * 64 + h * 2 + wave] = sq;
            }
        }
#endif
    }
    SEAM(2);

    if (IN(3)) { PH_LOCALS
        for (int m = gw; m < T; m += NGW) {
            float p = SSQ[(size_t)m * 64 + lane];
            p += __shfl_xor(p, 1); p += __shfl_xor(p, 2); p += __shfl_xor(p, 4); p += __shfl_xor(p, 8);
            bf16* yr = Zb + (size_t)m * DI;
#pragma unroll
            for (int j = 0; j < 4; ++j) { const float ss = __shfl(p, 16 * j); const float rs = 1.f / sqrtf(ss * (1.f / 512.f) + RMS_EPS);
                u32x4 w = *(const u32x4*)(yr + j * 512 + lane * 8);
                w.x = pk2(bflo(w.x) * rs, bfhi(w.x) * rs); w.y = pk2(bflo(w.y) * rs, bfhi(w.y) * rs); w.z = pk2(bflo(w.z) * rs, bfhi(w.z) * rs); w.w = pk2(bflo(w.w) * rs, bfhi(w.w) * rs);
                *(u32x4*)(yr + j * 512 + lane * 8) = w; }
        }
        LAS float* scr = (LAS float*)(F.lds + wave * 16384);
        constexpr int I_QKV = (D / 64) * (3 * D / 32), I_O = (D / 64) * (D / 32), I_G = (D / 64) * (DFF / 32), I_D = (DFF / 64) * (D / 32);
        constexpr int I_MOE = 2 * NE * (2 * I_G + I_D);
        for (int it = gw; it < I_QKV + I_O + I_MOE; it += NGW) {
            int r = it;
            if (r < I_QKV) { transpose_item(args.in[9], D, 3 * D, (bf16*)(ws + WS_WQKV), 0, 0, nullptr, scr, r, lane); continue; } r -= I_QKV;
            if (r < I_O) { transpose_item(args.in[12], D, D, (bf16*)(ws + WS_WO), 0, 0, nullptr, scr, r, lane); continue; } r -= I_O;
            const int le = r / (2 * I_G + I_D), L = le / NE, e = le % NE; r -= le * (2 * I_G + I_D);
            bf16* wgu = (bf16*)(ws + (L ? WS_WGU1 : WS_WGU0)) + (size_t)e * 1024 * D; bf16* wd = (bf16*)(ws + (L ? WS_WD1 : WS_WD0)) + (size_t)e * D * DFF;
            if (r < I_G) { transpose_item(args.in[16] + (size_t)le * D * DFF, D, DFF, wgu, 0, 1, nullptr, scr, r, lane); continue; } r -= I_G;
            if (r < I_G) { transpose_item(args.in[17] + (size_t)le * D * DFF, D, DFF, wgu, 0, 2, nullptr, scr, r, lane); continue; } r -= I_G;
            transpose_item(args.in[18] + (size_t)le * DFF * D, DFF, D, wd, 0, 0, nullptr, scr, r, lane);
        }
    }
    SEAM(3);

    if (IN(4)) { PH_LOCALS
        pg8::DenseOrder S; S.init(T, D, F.G, (int)blockIdx.x, DI);
        pg8::EpiPlain E{(bf16*)(ws + WS_MIX1), D, nullptr, 0, 1.f};
        pg8::gemm_phase<pg8::EpiPlain, pg8::DenseOrder>(F.lds, Zb, Wt_out, DI, S, E);
    }
    SEAM(4);

#pragma unroll
    for (int L = 0; L < 2; ++L) {
        if (L == 1) {
            if (IN(9)) { PH_LOCALS
                pg8::DenseOrder S; S.init(T, 3 * D, F.G, (int)blockIdx.x, D);
                pg8::EpiPlain E{(bf16*)(ws + WS_QKV), 3 * D, args.in[10], D, 0.125f};
                pg8::gemm_phase<pg8::EpiPlain, pg8::DenseOrder>(F.lds, (const bf16*)(ws + WS_X2B), (const bf16*)(ws + WS_WQKV), D, S, E);
            }
            SEAM(9);
            if (IN(10)) { PH_LOCALS
#if NAIVE_ATTN
                const bf16* QKV = (const bf16*)(ws + WS_QKV); bf16* AO = (bf16*)(ws + WS_AO); const float* rel = args.in[11];
                for (int idx = blockIdx.x * 512 + tid; idx < NB * AH * SEQ; idx += F.G * 512) {
                    const int s = idx % SEQ, bh = idx / SEQ, hh = bh % AH, b = bh / AH, c = s / 64;
                    const bf16* qp = QKV + ((size_t)b * SEQ + s) * (3 * D) + hh * AD;
                    float q[AD], o[AD];
#pragma unroll
                    for (int d = 0; d < AD; ++d) { q[d] = bf2f(qp[d]); o[d] = 0.f; }
                    float mx = -1e30f, l = 0.f;
                    const int k0 = (c - LEFTC) * 64 < 0 ? 0 : (c - LEFTC) * 64, k1 = c * 64 + 64;
                    for (int kp = k0; kp < k1; ++kp) {
                        const bf16* kr = QKV + ((size_t)b * SEQ + kp) * (3 * D) + D + hh * AD; const bf16* vr = kr + D;
                        float sc = 0.f;
#pragma unroll
                        for (int d = 0; d < AD; d += 2) { const unsigned w = *(const unsigned*)(kr + d); sc += q[d] * bflo(w) + q[d + 1] * bfhi(w); }
                        int dist = s - kp; dist = dist < -MAXREL ? -MAXREL : (dist > MAXREL ? MAXREL : dist);
                        sc += rel[(dist + MAXREL) * AH + hh];
                        const float mn = fmaxf(mx, sc), f = __expf(mx - mn), p = __expf(sc - mn);
                        l = l * f + p; mx = mn;
#pragma unroll
                        for (int d = 0; d < AD; d += 2) { const unsigned w = *(const unsigned*)(vr + d); o[d] = o[d] * f + p * bflo(w); o[d + 1] = o[d + 1] * f + p * bfhi(w); }
                    }
                    const float il = 1.f / l; bf16* op = AO + ((size_t)b * SEQ + s) * D + hh * AD;
#pragma unroll
                    for (int d = 0; d < AD; d += 2) *(unsigned*)(op + d) = pk2(o[d] * il, o[d + 1] * il);
                }
#endif
            }
            SEAM(10);
            if (IN(11)) { PH_LOCALS
                pg8::DenseOrder S; S.init(T, D, F.G, (int)blockIdx.x, D);
                pg8::EpiPlain E{(bf16*)(ws + WS_MIX2), D, args.in[13], 0, 1.f};
                pg8::gemm_phase<pg8::EpiPlain, pg8::DenseOrder>(F.lds, (const bf16*)(ws + WS_AO), (const bf16*)(ws + WS_WO), D, S, E);
            }
            SEAM(11);
        }
        const int pb = L ? 12 : 5;
#define LAYER_LOCALS \
        const bf16* MIX = (const bf16*)(ws + (L ? WS_MIX2 : WS_MIX1)); (void)MIX; \
        bf16* XN = (bf16*)(ws + (L ? WS_X3B : WS_X1B)); (void)XN;            \
        bf16* HB = (bf16*)(ws + (L ? WS_H1 : WS_H0)); (void)HB; \
        bf16* Y2 = (bf16*)(ws + (L ? WS_Y21 : WS_Y20)); (void)Y2; \
        gu32* gcnt = (gu32*)(ws + WS_CTL) + CW_CNT + 64 * L; (void)gcnt; \
        LAS int* tokL = (LAS int*)(F.lds + TOKL_OFF); (void)tokL; \
        LAS int* mo = (LAS int*)(F.lds + MOE_OFF); (void)mo;

        if (IN(pb)) { PH_LOCALS LAYER_LOCALS
            const float* lg = args.in[19] + L * D; const float* lb = args.in[20] + L * D;
            const float* rw = args.in[14]; const float* rbias = args.in[15];
            LAS float* rwl = (LAS float*)F.lds;
            LAS int* lcnt = (LAS int*)(F.lds + 65536);
            LAS int* rec = (LAS int*)(F.lds + 65536 + 256);
            for (int i = tid; i < D * NE / 4; i += 512) ((LAS f32x4*)rwl)[i] = ((const f32x4*)rw)[i];
            if (tid < 32) lcnt[tid] = 0;
            __syncthreads();
            int li = 0;
            for (int m = gw; m < T; m += NGW, ++li) {
                f32x4 v[4];
#pragma unroll
                for (int j = 0; j < 4; ++j) {
                    const f32x4 mx = ld_bf16x4(MIX + (size_t)m * D + 4 * lane + 256 * j);
                    f32x4 xr;
                    if (L == 0) xr = *(const f32x4*)(x_in + (size_t)m * D + 4 * lane + 256 * j);
                    else xr = ld_bf16x4((const bf16*)(ws + WS_X2B) + (size_t)m * D + 4 * lane + 256 * j);
                    v[j] = xr * ALPHA + mx;
                }
                ln_row(v, lg, lb, lane);
#pragma unroll
                for (int j = 0; j < 4; ++j) st_bf16x4(XN + (size_t)m * D + 4 * lane + 256 * j, v[j]);
                float lgt[NE];
#pragma unroll
                for (int e = 0; e < NE; ++e) lgt[e] = 0.f;
#pragma unroll
                for (int j = 0; j < 4; ++j)
#pragma unroll
                    for (int q = 0; q < 4; ++q) { const LAS f32x4* wr_ = (const LAS f32x4*)(rwl + (size_t)(4 * lane + 256 * j + q) * NE); const float xv = v[j][q];
#pragma unroll
                        for (int e4 = 0; e4 < 4; ++e4) { const f32x4 w = wr_[e4]; lgt[4 * e4] += xv * w.x; lgt[4 * e4 + 1] += xv * w.y; lgt[4 * e4 + 2] += xv * w.z; lgt[4 * e4 + 3] += xv * w.w; } }
#pragma unroll
                for (int e = 0; e < NE; ++e) lgt[e] = wave_sum(lgt[e]);
                float mxl = lgt[0];
#pragma unroll
                for (int e = 1; e < NE; ++e) mxl = fmaxf(mxl, lgt[e]);
                float sc[NE], sel[NE], den = 0.f;
#pragma unroll
                for (int e = 0; e < NE; ++e) { sc[e] = __expf(lgt[e] - mxl); den += sc[e]; }
                const float iden = 1.f / den;
#pragma unroll
                for (int e = 0; e < NE; ++e) { sc[e] *= iden; sel[e] = sc[e] + rbias[e]; }
                int bg = 0; float bgs = -1e30f;
#pragma unroll
                for (int g = 0; g < 4; ++g) { const float a = sel[4 * g], b2 = sel[4 * g + 1], c2 = sel[4 * g + 2], d2 = sel[4 * g + 3];
                    const float tot = a + b2 + c2 + d2, mn1 = fminf(fminf(a, b2), fminf(c2, d2));
                    float hi1 = fmaxf(fmaxf(a, b2), fmaxf(c2, d2));
                    const float m01 = fminf(a, b2), m23 = fminf(c2, d2), M01 = fmaxf(a, b2), M23 = fmaxf(c2, d2);
                    const float second = fmaxf(fminf(M01, M23), fmaxf(m01, m23));
                    (void)tot; (void)mn1;
                    const float gs = hi1 + second;
                    if (gs > bgs) { bgs = gs; bg = g; } }
                float s0 = 0.f, s1 = 0.f, s2 = 0.f, s3 = 0.f, p0 = 0.f, p1 = 0.f, p2 = 0.f, p3 = 0.f;
#pragma unroll
                for (int g = 0; g < 4; ++g) if (g == bg) { s0 = sel[4 * g]; s1 = sel[4 * g + 1]; s2 = sel[4 * g + 2]; s3 = sel[4 * g + 3]; p0 = sc[4 * g]; p1 = sc[4 * g + 1]; p2 = sc[4 * g + 2]; p3 = sc[4 * g + 3]; }
                int i1 = 0; float b1 = s0, q1 = p0;
                if (s1 > b1) { b1 = s1; i1 = 1; q1 = p1; } if (s2 > b1) { b1 = s2; i1 = 2; q1 = p2; } if (s3 > b1) { b1 = s3; i1 = 3; q1 = p3; }
                int i2 = -1; float b2v = -1e30f, q2 = 0.f;
                if (i1 != 0 && s0 > b2v) { b2v = s0; i2 = 0; q2 = p0; } if (i1 != 1 && s1 > b2v) { b2v = s1; i2 = 1; q2 = p1; }
                if (i1 != 2 && s2 > b2v) { b2v = s2; i2 = 2; q2 = p2; } if (i1 != 3 && s3 > b2v) { b2v = s3; i2 = 3; q2 = p3; }
                const int e1 = 4 * bg + i1, e2 = 4 * bg + i2; const float gsum = q1 + q2, g1 = q1 / gsum, g2 = q2 / gsum;
                if (lane == 0) {
                    const int r1 = atomicAdd((int*)(lcnt + e1), 1), r2 = atomicAdd((int*)(lcnt + e2), 1);
                    LAS int* rc = rec + (wave * 32 + li) * 8; rc[0] = e1; rc[1] = r1; rc[2] = e2; rc[3] = r2; rc[4] = __builtin_bit_cast(int, g1); rc[5] = __builtin_bit_cast(int, g2);
                }
            }
            __syncthreads();
            if (tid < NE) lcnt[16 + tid] = (int)__hip_atomic_fetch_add(gcnt + tid, (unsigned)lcnt[tid], RLX_AGENT);
            __syncthreads();
            li = 0;
            for (int m = gw; m < T; m += NGW, ++li) {
                if (lane == 0) {
                    const LAS int* rc = rec + (wave * 32 + li) * 8;
                    const int e1 = rc[0], e2 = rc[2], sl1 = lcnt[16 + e1] + rc[1], sl2 = lcnt[16 + e2] + rc[3];
                    LIST[(size_t)e1 * T + sl1] = m; LIST[(size_t)e2 * T + sl2] = m;
                    u32x4 w0; w0.x = (unsigned)e1; w0.y = (unsigned)sl1; w0.z = (unsigned)e2; w0.w = (unsigned)sl2;
                    *(u32x4*)(INFO + (size_t)m * 8) = w0; INFO[(size_t)m * 8 + 4] = (unsigned)rc[4]; INFO[(size_t)m * 8 + 5] = (unsigned)rc[5];
                }
            }
        }
        SEAM(pb);

        if (IN(pb + 1) || IN(pb + 2) || IN(pb + 3)) { PH_LOCALS LAYER_LOCALS
            __syncthreads();
            if (tid == 0) { int acc_ = 0; for (int e = 0; e < NE; ++e) { const int c = (int)__hip_atomic_load(gcnt + e, RLX_AGENT); mo[e] = acc_; mo[32 + e] = c; acc_ += (c + 255) >> 8; } mo[16] = acc_; }
            __syncthreads();
        }
        if (IN(pb + 1)) { PH_LOCALS LAYER_LOCALS
            pg8::MoeOrder<true> S{mo, tokL, F.G, F.vcu, D};
            { pg8::Unit u; for (int ui = 0; ui < 6 && S.next(ui, u); ++ui) { if (tid < 256) { const int r = (u.pm - mo[u.e]) * 256 + tid, c = mo[32 + u.e]; tokL[ui * 256 + tid] = LIST[(size_t)u.e * T + (r < c ? r : c - 1)]; } } }
            __syncthreads();
            pg8::EpiGateUp E{HB};
            pg8::gemm_phase<pg8::EpiGateUp, pg8::MoeOrder<true>>(F.lds, XN, (const bf16*)(ws + (L ? WS_WGU1 : WS_WGU0)), D, S, E);
        }
        SEAM(pb + 1);
        if (IN(pb + 2)) { PH_LOCALS LAYER_LOCALS
            pg8::MoeOrder<false> S{mo, tokL, F.G, F.vcu, DFF};
            pg8::EpiPlain E{Y2, D, nullptr, 0, 1.f};
            pg8::gemm_phase<pg8::EpiPlain, pg8::MoeOrder<false>>(F.lds, HB, (const bf16*)(ws + (L ? WS_WD1 : WS_WD0)), DFF, S, E);
        }
        SEAM(pb + 2);
        if (IN(pb + 3)) { PH_LOCALS LAYER_LOCALS
            const float* lg = args.in[21] + L * D; const float* lb = args.in[22] + L * D;
            for (int m = gw; m < T; m += NGW) {
                const u32x4 w0 = *(const u32x4*)(INFO + (size_t)m * 8); const float g1 = __builtin_bit_cast(float, INFO[(size_t)m * 8 + 4]), g2 = __builtin_bit_cast(float, INFO[(size_t)m * 8 + 5]);
                const size_t r1 = (size_t)mo[w0.x] * 256 + w0.y, r2 = (size_t)mo[w0.z] * 256 + w0.w;
                f32x4 v[4];
#pragma unroll
                for (int j = 0; j < 4; ++j) { const int co = 4 * lane + 256 * j;
                    v[j] = ld_bf16x4(XN + (size_t)m * D + co) * ALPHA + ld_bf16x4(Y2 + r1 * D + co) * g1 + ld_bf16x4(Y2 + r2 * D + co) * g2; }
                ln_row(v, lg, lb, lane);
                if (L == 0) {
#pragma unroll
                    for (int j = 0; j < 4; ++j) st_bf16x4((bf16*)(ws + WS_X2B) + (size_t)m * D + 4 * lane + 256 * j, v[j]);
                } else {
#pragma unroll
                    for (int j = 0; j < 4; ++j) *(f32x4*)(args.out + (size_t)m * D + 4 * lane + 256 * j) = v[j];
                }
            }
        }
        if (L == 0) SEAM(8);
    }
#undef IN
#undef SEAM
}

extern "C" void kernel_launch(void* const* d_in, const int* in_sizes, int n_in, void* d_out, int out_size, void* d_ws, size_t ws_size, hipStream_t stream) {
    static int grid = 0;
    if (grid == 0) {
        if (n_in != 23 || in_sizes[0] != T * D || out_size != T * D || ws_size < WS_END) { fprintf(stderr, "kernel_launch: unexpected shapes / workspace (n_in %d, ws %zu); nothing launched\n", n_in, ws_size); grid = -1; return; }
        int dev = 0, cus = 0, per_cu = 0;
        if (hipGetDevice(&dev) != hipSuccess || hipDeviceGetAttribute(&cus, hipDeviceAttributeMultiprocessorCount, dev) != hipSuccess) { grid = -1; return; }
        if (hipFuncSetAttribute((const void*)fwd_kernel, hipFuncAttributeMaxDynamicSharedMemorySize, LDS_BYTES) != hipSuccess) { fprintf(stderr, "kernel_launch: hipFuncSetAttribute failed\n"); grid = -1; return; }
        if (hipOccupancyMaxActiveBlocksPerMultiprocessor(&per_cu, (const void*)fwd_kernel, 512, LDS_BYTES) != hipSuccess || per_cu < 1) fprintf(stderr, "kernel_launch: occupancy query reports %d\n", per_cu);
        (void)hipGetLastError();
        grid = cus;
    }
    if (grid < 0) return;
    if (hipMemsetAsync((char*)d_ws + WS_CTL, 0, CTL_ZERO_BYTES, stream) != hipSuccess) return;
    Args a{};
    for (int i = 0; i < 23; ++i) a.in[i] = (const float*)d_in[i];
    a.out = (float*)d_out; a.ws = (unsigned char*)d_ws;
    if (MK_N_LAUNCHES == 1) { a.ph_lo = 0; a.ph_hi = NPHASE; hipLaunchKernelGGL(fwd_kernel, dim3(grid), dim3(512), LDS_BYTES, stream, a); }
    else for (int p = 0; p < NPHASE; ++p) { a.ph_lo = p; a.ph_hi = p + 1; hipLaunchKernelGGL(fwd_kernel, dim3(grid), dim3(512), LDS_BYTES, stream, a); }
}
```

```cpp
#include <hip/hip_runtime.h>
#include <cstdio>
#include <cstdint>

#ifndef MK_N_LAUNCHES
#define MK_N_LAUNCHES 1
#endif
#ifndef NAIVE_SCAN
#define NAIVE_SCAN 0
#endif
#ifndef NAIVE_ATTN
#define NAIVE_ATTN 1
#endif

#define LAS __attribute__((address_space(3)))
#define GAS __attribute__((address_space(1)))
typedef unsigned short bf16;
typedef short bf16x8 __attribute__((ext_vector_type(8)));
typedef float f32x4 __attribute__((ext_vector_type(4)));
typedef float f32x2 __attribute__((ext_vector_type(2)));
typedef unsigned u32x4 __attribute__((ext_vector_type(4)));
typedef unsigned u32x2 __attribute__((ext_vector_type(2)));
typedef GAS unsigned gu32;

constexpr int NB = 8, SEQ = 4096, D = 1024, T = NB * SEQ;
constexpr int DI = 2048, NH = 32, HP = 64, NG = 4, NS = 128, CONVD = 3072, INP = 5152, NZX = 5120;
constexpr int AH = 16, AD = 64, LEFTC = 8, MAXREL = 128;
constexpr int NE = 16, DFF = 512;
constexpr float ALPHA = 1.4142135623730951f;
constexpr float LN_EPS = 1e-5f, RMS_EPS = 1e-5f;
constexpr int NPHASE = 16;
constexpr int MAXTILES = 272;

constexpr size_t MiB = 1u << 20;
constexpr size_t WS_CTL = 0, CTL_ZERO_BYTES = 1 * MiB;
constexpr size_t WS_WIN = 1 * MiB;
constexpr size_t WS_WOUT = 12 * MiB;
constexpr size_t WS_XB = 16 * MiB;
constexpr size_t WS_WGU0 = 16 * MiB, WS_WD0 = 48 * MiB, WS_WQKV = 64 * MiB, WS_WO = 70 * MiB, WS_WGU1 = 72 * MiB, WS_WD1 = 104 * MiB;
constexpr size_t WS_Z = 120 * MiB;
constexpr size_t WS_XBC = 248 * MiB;
constexpr size_t WS_DTRAW = 440 * MiB;
constexpr size_t WS_SSQ = 444 * MiB;
constexpr size_t WS_MIX1 = 248 * MiB;
constexpr size_t WS_X1B = 324 * MiB;
constexpr size_t WS_H0 = 120 * MiB;
constexpr size_t WS_Y20 = 188 * MiB;
constexpr size_t WS_X2B = 120 * MiB;
constexpr size_t WS_QKV = 188 * MiB;
constexpr size_t WS_AO = 380 * MiB;
constexpr size_t WS_MIX2 = 188 * MiB;
constexpr size_t WS_X3B = 256 * MiB;
constexpr size_t WS_H1 = 320 * MiB;
constexpr size_t WS_Y21 = 120 * MiB;
constexpr size_t WS_LIST = 500 * MiB;
constexpr size_t WS_INFO = 504 * MiB;
constexpr size_t WS_END = 512 * MiB;
constexpr int CW_TMO = 0;
constexpr int CW_CNT = 1024;
constexpr int CW_BAR = 4096;

constexpr int RING_BYTES = 131072;
constexpr int LDSCTL_OFF = RING_BYTES, MISC_OFF = LDSCTL_OFF + 320;
constexpr int TOKL_OFF = LDSCTL_OFF + 1024;
constexpr int MOE_OFF = TOKL_OFF + 6 * 1024;
constexpr int LDS_BYTES = 147456;

#define RLX_AGENT __ATOMIC_RELAXED, __HIP_MEMORY_SCOPE_AGENT
#define LDS_WAIT() asm volatile("s_waitcnt lgkmcnt(0)" ::: "memory")
#define VM_WAIT() asm volatile("s_waitcnt vmcnt(0)" ::: "memory")

__device__ __forceinline__ unsigned f2bf(float f) { unsigned u = __builtin_bit_cast(unsigned, f); return (u + 0x7fffu + ((u >> 16) & 1u)) >> 16; }
__device__ __forceinline__ unsigned pk2(float lo, float hi) { return f2bf(lo) | (f2bf(hi) << 16); }
__device__ __forceinline__ float bf2f(unsigned short b) { return __builtin_bit_cast(float, ((unsigned)b) << 16); }
__device__ __forceinline__ float bflo(unsigned w) { return __builtin_bit_cast(float, w << 16); }
__device__ __forceinline__ float bfhi(unsigned w) { return __builtin_bit_cast(float, w & 0xffff0000u); }
__device__ __forceinline__ float silu_f(float v) { return v / (1.f + __expf(-v)); }
__device__ __forceinline__ float wave_sum(float v) {
#pragma unroll
    for (int o = 1; o < 64; o <<= 1) v += __shfl_xor(v, o);
    return v;
}

namespace pg8 {
constexpr int BM = 256, BK = 64, HALF = 128, HTB = HALF * BK * 2, STAGE_BYTES = 8 * HTB;
__device__ __forceinline__ int lds_byte(int r, int c) { const int st = (r >> 4) * 2 + (c >> 5), rr = r & 15, cc = c & 31, ob = rr * 64 + cc * 2; return st * 1024 + (ob ^ (((ob >> 9) & 1) << 5)); }
__device__ __forceinline__ void stage_rc(int b, int& R, int& C) { const int st = b / 1024, sb = b % 1024, swz = sb ^ (((sb >> 9) & 1) << 5); R = (st >> 1) * 16 + swz / 64; C = (st & 1) * 32 + (swz % 64) / 2; }
__device__ __forceinline__ int perm32(int rho) { const int n = rho >> 4, i = rho & 15; return 8 * (i >> 2) + 4 * n + (i & 3); }
__device__ __forceinline__ unsigned cvt_pk_bf16(float lo, float hi) { unsigned r; asm volatile("v_cvt_pk_bf16_f32 %0, %1, %2" : "=v"(r) : "v"(lo), "v"(hi)); return r; }

struct Unit { int pm, pn, bt, e; };

template <class Epi, class Sched>
__device__ __forceinline__ void gemm_phase(LAS unsigned char* lds, const bf16* A, const bf16* Bt, int K, const Sched& S, const Epi& E) {
    int tid = threadIdx.x; asm volatile("" : "+v"(tid));
    const int wid = __builtin_amdgcn_readfirstlane(tid >> 6), lane = tid & 63, wr = wid >> 2, wc = wid & 3, fr = lane & 15, fq = lane >> 4;
    const int nt = K / BK;
    int Rr[2], Cc[2]; unsigned voffB[2];
#pragma unroll
    for (int i = 0; i < 2; ++i) { stage_rc(tid * 16 + i * 8192, Rr[i], Cc[i]); const int Rb = (Rr[i] & ~31) + perm32(Rr[i] & 31); voffB[i] = (unsigned)(Rb * K + Cc[i]) * 2u; }
    const size_t kstep = (size_t)(BK * 2);
    const size_t hstep = (size_t)HALF * K * 2;
    const size_t tstep = 2 * hstep;
    const unsigned ldsw = (unsigned)wid * 1024u;
    const int aoff = lds_byte(wr * 64 + fr, fq * 8), boff = lds_byte(wc * 32 + fr, fq * 8);
#define PG8_SA(b, h) (((b) * 2 + (h)) * HTB)
#define PG8_SB(b, h) ((4 + (b) * 2 + (h)) * HTB)
#define PG8_STAGE(bufoff, gbase, voff) do { _Pragma("unroll") for (int _i = 0; _i < 2; ++_i) \
        __builtin_amdgcn_global_load_lds((const unsigned*)((const char*)(gbase) + (voff)[_i]), (LAS unsigned*)(lds + (bufoff) + ldsw + _i * 8192), 16, 0, 0); } while (0)
#define PG8_LDA(dst, b, h) do { _Pragma("unroll") for (int m = 0; m < 4; ++m) _Pragma("unroll") for (int k = 0; k < 2; ++k) dst[m][k] = *(const LAS bf16x8*)(lds + PG8_SA(b, h) + aoff + m * 2048 + k * 1024); } while (0)
#define PG8_LDB(dst, b, h) do { _Pragma("unroll") for (int n = 0; n < 2; ++n) _Pragma("unroll") for (int k = 0; k < 2; ++k) dst[n][k] = *(const LAS bf16x8*)(lds + PG8_SB(b, h) + boff + n * 2048 + k * 1024); } while (0)
#define PG8_MMA(ai, bj, At, Bt_) do { __builtin_amdgcn_s_setprio(1); _Pragma("unroll") for (int m = 0; m < 4; ++m) _Pragma("unroll") for (int n = 0; n < 2; ++n) _Pragma("unroll") for (int k = 0; k < 2; ++k) \
        acc[ai][bj][m][n] = __builtin_amdgcn_mfma_f32_16x16x32_bf16(Bt_[n][k], At[m][k], acc[ai][bj][m][n], 0, 0, 0); __builtin_amdgcn_s_setprio(0); } while (0)
#define PG8_WAIT_V(n) asm volatile("s_waitcnt vmcnt(" #n ")" ::: "memory")
#define PG8_WAIT_L(n) asm volatile("s_waitcnt lgkmcnt(" #n ")" ::: "memory")
#define PG8_BAR __builtin_amdgcn_s_barrier()
#define PG8_SCHED __builtin_amdgcn_sched_barrier(0)
    Unit cur, nxt; int ui = 0;
    if (!S.next(0, cur)) return;
    f32x4 acc[2][2][4][2];
#pragma unroll
    for (int a = 0; a < 2; ++a)
#pragma unroll
        for (int b = 0; b < 2; ++b)
#pragma unroll
            for (int m = 0; m < 4; ++m)
#pragma unroll
                for (int n = 0; n < 2; ++n) acc[a][b][m][n] = (f32x4){0.f, 0.f, 0.f, 0.f};
    bf16x8 At[4][2], B0[2][2], B1[2][2];
    unsigned vA0[2], vA1[2];
#pragma unroll
    for (int i = 0; i < 2; ++i) { vA0[i] = S.a_off(0, cur, 0, Rr[i], Cc[i]); vA1[i] = S.a_off(0, cur, 1, Rr[i], Cc[i]); }
    const char* Ab = (const char*)A;
    const char* cB = (const char*)Bt + (size_t)cur.bt * tstep;
    PG8_STAGE(PG8_SB(0, 0), cB, voffB); PG8_STAGE(PG8_SB(0, 1), cB + hstep, voffB); PG8_STAGE(PG8_SA(0, 0), Ab, vA0); PG8_STAGE(PG8_SA(0, 1), Ab, vA1);
    if (wr == 1) PG8_BAR;
    PG8_WAIT_V(2); PG8_BAR;
    PG8_STAGE(PG8_SB(1, 0), cB + kstep, voffB); PG8_STAGE(PG8_SA(1, 0), Ab + kstep, vA0); PG8_STAGE(PG8_SB(1, 1), cB + hstep + kstep, voffB);
    PG8_WAIT_V(6); PG8_BAR;
    for (;;) {
        const bool has_next = S.next(ui + 1, nxt);
        const char* nB = has_next ? (const char*)Bt + (size_t)nxt.bt * tstep : cB;
        for (int t = 0; t < nt; t += 2) {
            const bool last = (t == nt - 2);
            const char* a1 = Ab + (size_t)(t + 1) * kstep;
            const char* a2 = last ? Ab : Ab + (size_t)(t + 2) * kstep; const char* b2 = last ? nB : cB + (size_t)(t + 2) * kstep;
            const char* a3 = a2 + kstep; const char* b3 = b2 + kstep;
            unsigned v20[2], v21[2];
#pragma unroll
            for (int i = 0; i < 2; ++i) { v20[i] = vA0[i]; v21[i] = vA1[i]; }
            if (last && has_next) {
#pragma unroll
                for (int i = 0; i < 2; ++i) { v20[i] = S.a_off(ui + 1, nxt, 0, Rr[i], Cc[i]); v21[i] = S.a_off(ui + 1, nxt, 1, Rr[i], Cc[i]); } }
            PG8_LDB(B0, 0, 0); PG8_LDB(B1, 0, 1); PG8_SCHED; PG8_LDA(At, 0, 0); PG8_STAGE(PG8_SA(1, 1), a1, vA1);
            PG8_WAIT_V(8); PG8_WAIT_L(0); PG8_BAR; PG8_MMA(0, 0, At, B0); PG8_MMA(0, 1, At, B1); PG8_BAR; PG8_SCHED;
            PG8_LDA(At, 0, 1); PG8_STAGE(PG8_SB(0, 0), b2, voffB); PG8_STAGE(PG8_SB(0, 1), b2 + hstep, voffB); PG8_STAGE(PG8_SA(0, 0), a2, v20);
            PG8_WAIT_V(8); PG8_WAIT_L(0); PG8_BAR; PG8_MMA(1, 0, At, B0); PG8_MMA(1, 1, At, B1); PG8_BAR; PG8_SCHED;
            PG8_LDB(B0, 1, 0); PG8_LDB(B1, 1, 1); PG8_SCHED; PG8_LDA(At, 1, 0); PG8_STAGE(PG8_SA(0, 1), a2, v21);
            PG8_WAIT_V(8); PG8_WAIT_L(0); PG8_BAR; PG8_MMA(0, 0, At, B0); PG8_MMA(0, 1, At, B1); PG8_BAR; PG8_SCHED;
            PG8_LDA(At, 1, 1); PG8_STAGE(PG8_SB(1, 0), b3, voffB); PG8_STAGE(PG8_SB(1, 1), b3 + hstep, voffB); PG8_STAGE(PG8_SA(1, 0), a3, v20);
            PG8_WAIT_V(8); PG8_WAIT_L(0); PG8_BAR; PG8_MMA(1, 0, At, B0); PG8_MMA(1, 1, At, B1); PG8_BAR; PG8_SCHED;
        }
        if (wr == 0) PG8_BAR;
        E(acc, cur, wr, wc, fr, fq);
        if (!has_next) break;
#pragma unroll
        for (int a = 0; a < 2; ++a)
#pragma unroll
            for (int b = 0; b < 2; ++b)
#pragma unroll
                for (int m = 0; m < 4; ++m)
#pragma unroll
                    for (int n = 0; n < 2; ++n) acc[a][b][m][n] = (f32x4){0.f, 0.f, 0.f, 0.f};
        cur = nxt; cB = nB; ++ui;
#pragma unroll
        for (int i = 0; i < 2; ++i) { vA0[i] = S.a_off(ui, cur, 0, Rr[i], Cc[i]); vA1[i] = S.a_off(ui, cur, 1, Rr[i], Cc[i]); }
        if (wr == 1) PG8_BAR;
    }
    PG8_WAIT_V(0);
    PG8_BAR;
#undef PG8_SA
#undef PG8_SB
#undef PG8_STAGE
#undef PG8_LDA
#undef PG8_LDB
#undef PG8_MMA
#undef PG8_WAIT_V
#undef PG8_WAIT_L
#undef PG8_BAR
#undef PG8_SCHED
}

struct DenseOrder {
    int nM, nN, nwg, G, c, lda;
    __device__ void init(int M, int N, int G_, int c_, int lda_) { nM = M / BM; nN = N / BM; nwg = nM * nN; G = G_; c = c_; lda = lda_; }
    __device__ __forceinline__ bool next(int i, Unit& u) const {
        const long L = (long)i * G + c; if (L >= nwg) return false;
        int wgid = (int)L; { const int q = nwg / 8, r = nwg % 8, xcd = wgid % 8, off = wgid / 8; wgid = (xcd < r ? xcd * (q + 1) : r * (q + 1) + (xcd - r) * q) + off; }
        const int nig = 8 * nN, gid = wgid / nig, fm = gid * 8, gsz = (nM - fm) < 8 ? (nM - fm) : 8;
        u.pm = fm + ((wgid % nig) % gsz); u.pn = (wgid % nig) / gsz; u.bt = u.pn; u.e = 0; return true;
    }
    __device__ __forceinline__ unsigned a_off(int, const Unit& u, int h, int R, int C) const { return (unsigned)((u.pm * BM + h * HALF + R) * lda + C) * 2u; }
};
template <bool GATHER> struct MoeOrder {
    const LAS int* ts;
    const LAS int* tokL;
    int G, c, lda;
    __device__ __forceinline__ bool next(int i, Unit& u) const {
        const int L = i * G + c; const int ntile = __builtin_amdgcn_readfirstlane(ts[16]);
        if (L >= ntile * 4) return false;
        const int rt = L >> 2; int e = 0;
#pragma unroll
        for (int j = 1; j < 16; ++j) e += (rt >= ts[j]) ? 1 : 0;
        e = __builtin_amdgcn_readfirstlane(e);
        u.pm = rt; u.pn = L & 3; u.e = e; u.bt = e * 4 + (L & 3); return true;
    }
    __device__ __forceinline__ unsigned a_off(int ui, const Unit& u, int h, int R, int C) const {
        if (GATHER) { const int tok = tokL[ui * 256 + h * HALF + R]; return (unsigned)(tok * lda + C) * 2u; }
        return (unsigned)((u.pm * BM + h * HALF + R) * lda + C) * 2u;
    }
};

struct EpiPlain {
    bf16* O; int ldc; const float* bias; int scale_cols; float scale0;
    __device__ __forceinline__ void operator()(const f32x4 (&acc)[2][2][4][2], const Unit& u, int wr, int wc, int fr, int fq) const {
        const int row0 = u.pm * BM + wr * 64 + fr, col0 = u.pn * BM + wc * 32 + 8 * fq;
        const float sc = (u.pn * BM < scale_cols) ? scale0 : 1.f;
        f32x4 bv[2][2];
#pragma unroll
        for (int bj = 0; bj < 2; ++bj)
#pragma unroll
            for (int n = 0; n < 2; ++n) bv[bj][n] = bias ? *(const f32x4*)(bias + col0 + bj * HALF + 4 * n) : (f32x4){0.f, 0.f, 0.f, 0.f};
#pragma unroll
        for (int ai = 0; ai < 2; ++ai)
#pragma unroll
            for (int m = 0; m < 4; ++m) { bf16* rowp = O + (size_t)(row0 + ai * HALF + m * 16) * ldc + col0;
#pragma unroll
                for (int bj = 0; bj < 2; ++bj) { f32x4 v0 = (acc[ai][bj][m][0] + bv[bj][0]) * sc, v1 = (acc[ai][bj][m][1] + bv[bj][1]) * sc;
                    u32x4 w; w.x = cvt_pk_bf16(v0[0], v0[1]); w.y = cvt_pk_bf16(v0[2], v0[3]); w.z = cvt_pk_bf16(v1[0], v1[1]); w.w = cvt_pk_bf16(v1[2], v1[3]);
                    *(u32x4*)(rowp + bj * HALF) = w; } }
    }
};
struct EpiInProj {
    bf16* Z; bf16* XBC;
    __device__ __forceinline__ void operator()(const f32x4 (&acc)[2][2][4][2], const Unit& u, int wr, int wc, int fr, int fq) const {
        const int row0 = u.pm * BM + wr * 64 + fr; int colt = u.pn * BM; bf16* base; int ldc;
        if (colt < DI) { base = Z; ldc = DI; } else { base = XBC; ldc = CONVD; colt -= DI; }
        const int col0 = colt + wc * 32 + 8 * fq;
#pragma unroll
        for (int ai = 0; ai < 2; ++ai)
#pragma unroll
            for (int m = 0; m < 4; ++m) { bf16* rowp = base + (size_t)(row0 + ai * HALF + m * 16) * ldc + col0;
#pragma unroll
                for (int bj = 0; bj < 2; ++bj) { const f32x4 v0 = acc[ai][bj][m][0], v1 = acc[ai][bj][m][1];
                    u32x4 w; w.x = cvt_pk_bf16(v0[0], v0[1]); w.y = cvt_pk_bf16(v0[2], v0[3]); w.z = cvt_pk_bf16(v1[0], v1[1]); w.w = cvt_pk_bf16(v1[2], v1[3]);
                    *(u32x4*)(rowp + bj * HALF) = w; } }
    }
};
struct EpiGateUp {
    bf16* Hh;
    __device__ __forceinline__ void operator()(const f32x4 (&acc)[2][2][4][2], const Unit& u, int wr, int wc, int fr, int fq) const {
        const int row0 = u.pm * BM + wr * 64 + fr, col0 = (u.pn * BM + wc * 32 + 8 * fq) >> 1;
#pragma unroll
        for (int ai = 0; ai < 2; ++ai)
#pragma unroll
            for (int m = 0; m < 4; ++m) { bf16* rowp = Hh + (size_t)(row0 + ai * HALF + m * 16) * DFF + col0;
#pragma unroll
                for (int bj = 0; bj < 2; ++bj) { const f32x4 g = acc[ai][bj][m][0], up = acc[ai][bj][m][1];
                    u32x2 w; w.x = cvt_pk_bf16(silu_f(g[0]) * up[0], silu_f(g[1]) * up[1]); w.y = cvt_pk_bf16(silu_f(g[2]) * up[2], silu_f(g[3]) * up[3]);
                    *(u32x2*)(rowp + bj * (HALF / 2)) = w; } }
    }
};
}

#define XB_TMO      128
#define XB_XCNT(j)  (256  + 64 * (j))
#define XB_XSUB(j)  (1280 + 64 * (j))
#define XB_XGEN(j)  (2304 + 64 * (j))
#define XB_TOP      3328
#define XB_TOPGEN   3392
#define XCD_BAR_WORDS 3456
#define XB_SPIN_CAP (1u << 18)
__device__ __forceinline__ unsigned xb_ld(unsigned* p)              { return __hip_atomic_load(p, __ATOMIC_RELAXED, __HIP_MEMORY_SCOPE_AGENT); }
__device__ __forceinline__ unsigned xb_add(unsigned* p, unsigned v) { return __hip_atomic_fetch_add(p, v, __ATOMIC_RELAXED, __HIP_MEMORY_SCOPE_AGENT); }
__device__ __forceinline__ unsigned xb_xcc_id() { return (unsigned)__builtin_amdgcn_s_getreg((3 << 11) | 20) & 0xFu; }
#define XB_SPIN(cond, bar) do { unsigned _sp = 0; while (cond) { __builtin_amdgcn_s_sleep(1); \
    if ((++_sp & 255u) == 0u) { if (xb_ld(&(bar)[XB_TMO])) break; if (_sp > XB_SPIN_CAP) { atomicAdd(&(bar)[XB_TMO], 1u); break; } } } } while (0)
struct XcdBarrier { unsigned* bar; unsigned x; volatile LAS unsigned* st; };
__device__ __forceinline__ XcdBarrier xcd_barrier_post(unsigned* bar, volatile LAS unsigned* st) {
    XcdBarrier b; b.bar = bar; b.x = xb_xcc_id(); b.st = st;
    if (threadIdx.x == 0) (void)xb_add(&bar[XB_XCNT(b.x)], 1u);
    return b;
}
__device__ __forceinline__ void xcd_barrier_complete(unsigned* bar, unsigned x, unsigned& nloc, unsigned& nx) {
    const unsigned G = gridDim.x * gridDim.y * gridDim.z;
    unsigned sum, cnt, mine, sp = 0u;
    for (;;) {
        sum = 0u; cnt = 0u; mine = 0u;
#pragma unroll
        for (unsigned j = 0; j < 16; ++j) { const unsigned c = xb_ld(&bar[XB_XCNT(j)]); sum += c; cnt += (c > 0u) ? 1u : 0u; mine = (j == x) ? c : mine; }
        if (sum == G) break;
        __builtin_amdgcn_s_sleep(1);
        if ((++sp & 255u) == 0u) { if (xb_ld(&bar[XB_TMO])) break; if (sp > XB_SPIN_CAP) { atomicAdd(&bar[XB_TMO], 1u); break; } }
    }
    nloc = mine > 0u ? mine : 1u; nx = cnt > 0u ? cnt : 1u;
}
__device__ __forceinline__ void xcd_barrier(const XcdBarrier& b) {
    asm volatile("s_waitcnt vmcnt(0)" ::: "memory");
    __syncthreads();
    if (threadIdx.x == 0) {
        unsigned* bar = b.bar;
        __builtin_amdgcn_s_waitcnt(0);
        unsigned nloc = b.st[0], nx = b.st[1];
        if (nloc == 0u) { xcd_barrier_complete(bar, b.x, nloc, nx); b.st[0] = nloc; b.st[1] = nx; }
        const unsigned old = xb_add(&bar[XB_XSUB(b.x)], 1u);
        const unsigned gen = old / nloc;
        if (old + 1u == (gen + 1u) * nloc) {
            __builtin_amdgcn_fence(__ATOMIC_RELEASE, "agent");
            asm volatile("s_waitcnt vmcnt(0)" ::: "memory");
            const unsigned og = xb_add(&bar[XB_TOP], 1u);
            const unsigned tg = og / nx;
            if (og + 1u == (tg + 1u) * nx) xb_add(&bar[XB_TOPGEN], 1u);
            else XB_SPIN(xb_ld(&bar[XB_TOPGEN]) == tg, bar);
            __builtin_amdgcn_fence(__ATOMIC_ACQUIRE, "agent");
            xb_add(&bar[XB_XGEN(b.x)], 1u);
            asm volatile("s_waitcnt vmcnt(0)" ::: "memory");
        } else {
            XB_SPIN(xb_ld(&bar[XB_XGEN(b.x)]) == gen, bar);
            __builtin_amdgcn_fence(__ATOMIC_ACQUIRE, "agent");
            asm volatile("s_waitcnt vmcnt(0)" ::: "memory");
        }
    }
    __syncthreads();
}

struct Args { const float* in[23]; float* out; unsigned char* ws; int ph_lo, ph_hi; };

struct Frame {
    LAS unsigned char* lds;
    int tid, lane, wave, vcu, G;
};

__device__ __forceinline__ void transpose_item(const float* W, int K, int N, bf16* WT, int row_off, int mode, const float* kscale, LAS float* scr, int item, int lane) {
    const int nblk = N / 32, kb = item / nblk, nb = item % nblk, k0 = 64 * kb, n0 = 32 * nb;
#pragma unroll 8
    for (int i = 0; i < 32; ++i) { const int kk = 2 * i + (lane >> 5); scr[kk * 33 + (lane & 31)] = W[(size_t)(k0 + kk) * N + n0 + (lane & 31)]; }
    LDS_WAIT(); asm volatile("" ::: "memory");
    const int c = lane & 7;
    float ks[8];
#pragma unroll
    for (int q = 0; q < 8; ++q) ks[q] = kscale ? kscale[k0 + 8 * c + q] : 1.f;
#pragma unroll
    for (int j = 0; j < 4; ++j) { const int n = (lane >> 3) + 8 * j; const LAS float* s = scr + (8 * c) * 33 + n;
        u32x4 o; o.x = pk2(s[0 * 33] * ks[0], s[1 * 33] * ks[1]); o.y = pk2(s[2 * 33] * ks[2], s[3 * 33] * ks[3]); o.z = pk2(s[4 * 33] * ks[4], s[5 * 33] * ks[5]); o.w = pk2(s[6 * 33] * ks[6], s[7 * 33] * ks[7]);
        const int ng = n0 + n; const int dr = (mode == 0) ? ng : (8 * (ng >> 2) + (ng & 3) + (mode == 2 ? 4 : 0));
        *(GAS u32x4*)(WT + (size_t)(row_off + dr) * K + k0 + 8 * c) = o; }
    LDS_WAIT(); asm volatile("" ::: "memory");
}

__device__ __forceinline__ void ln_row(f32x4 (&v)[4], const float* g, const float* b, int lane) {
    float s = 0.f;
#pragma unroll
    for (int j = 0; j < 4; ++j) s += (v[j].x + v[j].y) + (v[j].z + v[j].w);
    const float mean = wave_sum(s) * (1.f / D); float s2 = 0.f;
#pragma unroll
    for (int j = 0; j < 4; ++j) { v[j] = v[j] - mean; s2 += (v[j].x * v[j].x + v[j].y * v[j].y) + (v[j].z * v[j].z + v[j].w * v[j].w); }
    const float rstd = 1.f / sqrtf(wave_sum(s2) * (1.f / D) + LN_EPS);
#pragma unroll
    for (int j = 0; j < 4; ++j) { const f32x4 gg = *(const f32x4*)(g + 4 * lane + 256 * j), bb = *(const f32x4*)(b + 4 * lane + 256 * j); v[j] = v[j] * rstd * gg + bb; }
}
__device__ __forceinline__ f32x4 ld_bf16x4(const bf16* p) { const u32x2 w = *(const u32x2*)p; return (f32x4){bflo(w.x), bfhi(w.x), bflo(w.y), bfhi(w.y)}; }
__device__ __forceinline__ void st_bf16x4(bf16* p, f32x4 v) { u32x2 w; w.x = pk2(v.x, v.y); w.y = pk2(v.z, v.w); *(u32x2*)p = w; }

__global__ void __launch_bounds__(512, 2) fwd_kernel(Args args) {
    extern __shared__ __attribute__((aligned(16))) unsigned char lds_raw[];
    Frame F;
    F.lds = (LAS unsigned char*)lds_raw;
    F.tid = threadIdx.x; F.lane = F.tid & 63; F.wave = __builtin_amdgcn_readfirstlane(F.tid >> 6);
    F.G = gridDim.x; { const int bx = blockIdx.x; F.vcu = (F.G % 8 == 0) ? (bx % 8) * (F.G / 8) + bx / 8 : bx; }
    unsigned char* ws = args.ws;
    gu32* ctl = (gu32*)(ws + WS_CTL);
    volatile LAS unsigned* MISC = (volatile LAS unsigned*)(F.lds + MISC_OFF);
    for (int u = F.tid; u < (LDS_BYTES - LDSCTL_OFF) / 4; u += 512) ((LAS unsigned*)(F.lds + LDSCTL_OFF))[u] = 0u;
    __syncthreads();
    XcdBarrier bar; bar.bar = (unsigned*)(ctl + CW_BAR); bar.x = 0; bar.st = nullptr;
    if (MK_N_LAUNCHES == 1) bar = xcd_barrier_post((unsigned*)(ctl + CW_BAR), MISC + 8);
    const int lo = args.ph_lo, hi = args.ph_hi;
#ifndef PH_MASK
#define PH_MASK 0xffff
#endif
#define IN(k) (((PH_MASK >> (k)) & 1) && lo <= (k) && (k) < hi)
#define SEAM(k) do { if (IN(k) && IN((k) + 1)) xcd_barrier(bar); } while (0)
#define PH_LOCALS \
    int tid = threadIdx.x; asm volatile("" : "+v"(tid)); const int lane = tid & 63, wave = __builtin_amdgcn_readfirstlane(tid >> 6); \
    unsigned char* ws = args.ws; asm volatile("" : "+s"(ws)); \
    const int gw = F.vcu * 8 + wave, NGW = F.G * 8; (void)lane; (void)gw; (void)NGW; \
    const float* x_in = args.in[0]; (void)x_in; \
    bf16* Wt_in = (bf16*)(ws + WS_WIN); bf16* Wt_out = (bf16*)(ws + WS_WOUT); (void)Wt_in; (void)Wt_out; \
    bf16* XB = (bf16*)(ws + WS_XB); bf16* Zb = (bf16*)(ws + WS_Z); bf16* XBC = (bf16*)(ws + WS_XBC); (void)XB; (void)Zb; (void)XBC; \
    float* DTRAW = (float*)(ws + WS_DTRAW); float* SSQ = (float*)(ws + WS_SSQ); (void)DTRAW; (void)SSQ; \
    int* LIST = (int*)(ws + WS_LIST); unsigned* INFO = (unsigned*)(ws + WS_INFO); (void)LIST; (void)INFO;

    if (IN(0)) { PH_LOCALS
        LAS float* scr = (LAS float*)(F.lds + wave * 16384);
        constexpr int I_IN = (D / 64) * (INP / 32), I_OUT = (DI / 64) * (D / 32);
        for (int it = gw; it < I_IN + I_OUT; it += NGW) {
            if (it < I_IN) transpose_item(args.in[1], D, INP, Wt_in, 0, 0, nullptr, scr, it, lane);
            else transpose_item(args.in[8], DI, D, Wt_out, 0, 0, args.in[7], scr, it - I_IN, lane);
        }
        const size_t n8 = (size_t)T * D / 8;
        for (size_t i = (size_t)blockIdx.x * 512 + tid; i < n8; i += (size_t)F.G * 512) {
            const f32x4 a = *(const f32x4*)(x_in + i * 8), b = *(const f32x4*)(x_in + i * 8 + 4);
            u32x4 o; o.x = pk2(a.x, a.y); o.y = pk2(a.z, a.w); o.z = pk2(b.x, b.y); o.w = pk2(b.z, b.w);
            *(u32x4*)(XB + i * 8) = o;
        }
    }
    SEAM(0);

    if (IN(1)) { PH_LOCALS
        pg8::DenseOrder S; S.init(T, NZX, F.G, (int)blockIdx.x, D);
        pg8::EpiInProj E{Zb, XBC};
        pg8::gemm_phase<pg8::EpiInProj, pg8::DenseOrder>(F.lds, XB, Wt_in, D, S, E);
        for (int tile = gw; tile < T / 16; tile += NGW) {
            const int t0 = tile * 16, r = lane & 15, q = lane >> 4;
            const bf16* xp = XB + (size_t)(t0 + r) * D + 8 * q;
            const bf16* w0 = Wt_in + (size_t)(NZX + r) * D + 8 * q; const bf16* w1 = w0 + (size_t)16 * D;
            f32x4 a0 = {0.f, 0.f, 0.f, 0.f}, a1 = {0.f, 0.f, 0.f, 0.f};
#pragma unroll 4
            for (int k0 = 0; k0 < D; k0 += 32) {
                const bf16x8 xv = *(const bf16x8*)(xp + k0), wa = *(const bf16x8*)(w0 + k0), wb = *(const bf16x8*)(w1 + k0);
                a0 = __builtin_amdgcn_mfma_f32_16x16x32_bf16(wa, xv, a0, 0, 0, 0);
                a1 = __builtin_amdgcn_mfma_f32_16x16x32_bf16(wb, xv, a1, 0, 0, 0);
            }
            float* o = DTRAW + (size_t)(t0 + r) * NH + 4 * q;
            *(f32x4*)o = a0; *(f32x4*)(o + 16) = a1;
        }
    }
    SEAM(1);

    if (IN(2)) { PH_LOCALS
#if NAIVE_SCAN
        const float* conv_w = args.in[2]; const float* conv_b = args.in[3]; const float* dt_bias = args.in[4]; const float* a_log = args.in[5]; const float* dsk = args.in[6];
        for (int item = blockIdx.x; item < NB * NH; item += F.G) {
            if (wave >= 2) continue;
            LAS float* sB = (LAS float*)(F.lds + wave * 8192); LAS float* sC = sB + 128; LAS float* cwl = sC + 128;
            const int b = item / NH, h = item % NH, g = h / 8, pp = 32 * wave + (lane & 31), nh = lane >> 5;
            int col[5]; col[0] = h * HP + pp; col[1] = DI + g * NS + lane; col[2] = col[1] + 64; col[3] = DI + NG * NS + g * NS + lane; col[4] = col[3] + 64;
            float hist[5][3];
#pragma unroll
            for (int c = 0; c < 5; ++c) { cwl[(c * 5 + 4) * 64 + lane] = conv_b[col[c]];
#pragma unroll
                for (int k = 0; k < 4; ++k) cwl[(c * 5 + k) * 64 + lane] = conv_w[k * CONVD + col[c]];
#pragma unroll
                for (int k = 0; k < 3; ++k) hist[c][k] = 0.f; }
            LDS_WAIT();
            const float dtb = dt_bias[h], av = -__expf(a_log[h]), dh = dsk[h];
            float hst[64];
#pragma unroll
            for (int n = 0; n < 64; ++n) hst[n] = 0.f;
            for (int t = 0; t < SEQ; ++t) {
                const size_t row = (size_t)b * SEQ + t;
                float v[5];
#pragma unroll
                for (int c = 0; c < 5; ++c) { const float cur = bf2f(XBC[row * CONVD + col[c]]);
                    float a = cwl[(c * 5 + 4) * 64 + lane] + cwl[(c * 5) * 64 + lane] * hist[c][0] + cwl[(c * 5 + 1) * 64 + lane] * hist[c][1] + cwl[(c * 5 + 2) * 64 + lane] * hist[c][2] + cwl[(c * 5 + 3) * 64 + lane] * cur;
                    hist[c][0] = hist[c][1]; hist[c][1] = hist[c][2]; hist[c][2] = cur; v[c] = silu_f(a); }
                const float raw = DTRAW[row * NH + h] + dtb;
                const float dtv = raw > 20.f ? raw : log1pf(__expf(raw));
                const float dA = __expf(dtv * av);
                sB[lane] = v[1]; sB[lane + 64] = v[2]; sC[lane] = v[3]; sC[lane + 64] = v[4];
                LDS_WAIT(); asm volatile("" ::: "memory");
                const float xd = dtv * v[0]; float y = 0.f;
#pragma unroll
                for (int n = 0; n < 64; n += 4) { const f32x4 bb = *(const LAS f32x4*)(sB + 64 * nh + n), cc = *(const LAS f32x4*)(sC + 64 * nh + n);
                    hst[n] = hst[n] * dA + xd * bb.x; y += cc.x * hst[n];
                    hst[n + 1] = hst[n + 1] * dA + xd * bb.y; y += cc.y * hst[n + 1];
                    hst[n + 2] = hst[n + 2] * dA + xd * bb.z; y += cc.z * hst[n + 2];
                    hst[n + 3] = hst[n + 3] * dA + xd * bb.w; y += cc.w * hst[n + 3]; }
                LDS_WAIT(); asm volatile("" ::: "memory");
                y += __shfl_xor(y, 32);
                y += dh * v[0];
                const float zv = bf2f(Zb[row * DI + h * HP + pp]);
                const float yg = y * silu_f(zv);
                float sq = (lane < 32) ? yg * yg : 0.f; sq = wave_sum(sq);
                if (lane < 32) Zb[row * DI + h * HP + pp] = (bf16)f2bf(yg);
                if (lane == 0) SSQ[row * 64 + h * 2 + wave] = sq;
            }
        }
#else
        const float* conv_w = args.in[2]; const float* conv_b = args.in[3]; const float* dt_bias = args.in[4]; const float* a_log = args.in[5]; const float* dsk = args.in[6];
        typedef short v4i16 __attribute__((ext_vector_type(4)));
        constexpr int SXB = 144, SBB = 272;
        constexpr int XS_OFF = 0, XW_OFF = 9216, BM_OFF = 18432, CM_OFF = 35840, WM_OFF = 53248, HB_OFF = 62464, VEC_OFF = 97280, CW_OFF = 98304;
        LAS unsigned char* Lb = F.lds;
        LAS float* cumL = (LAS float*)(Lb + VEC_OFF);
        LAS float* dtL = cumL + 128;
        LAS float* cwl = (LAS float*)(Lb + CW_OFF);
        const int r16 = lane & 15, q4 = lane >> 4;
#define TR8(dst, base_off, stride, k0, c0) do { const LAS unsigned char* _a = Lb + (base_off) + ((k0) + 8 * q4 + (r16 >> 2)) * (stride) + ((c0) + 4 * (lane & 3)) * 2; \
        const v4i16 _lo = __builtin_amdgcn_ds_read_tr16_b64_v4i16((LAS v4i16*)_a), _hi = __builtin_amdgcn_ds_read_tr16_b64_v4i16((LAS v4i16*)(_a + 4 * (stride))); \
        dst = (bf16x8){_lo[0], _lo[1], _lo[2], _lo[3], _hi[0], _hi[1], _hi[2], _hi[3]}; } while (0)
        for (int item = blockIdx.x; item < NB * NH; item += F.G) {
            const int b = item / NH, h = item % NH, g = h >> 3;
            __syncthreads();
            for (int i = tid; i < 5 * 320; i += 512) { const int k = i / 320, cl = i % 320; const int gc = cl < 64 ? h * HP + cl : (cl < 192 ? DI + g * NS + (cl - 64) : DI + NG * NS + g * NS + (cl - 192)); cwl[i] = k < 4 ? conv_w[k * CONVD + gc] : conv_b[gc]; }
            for (int i = tid; i < SBB * 64 / 4; i += 512) ((LAS unsigned*)(Lb + HB_OFF))[i] = 0u;
            const float dtb = dt_bias[h], av = -__expf(a_log[h]), dh = dsk[h];
            const bool stg = tid < 320; const int cc = tid % 40, rg = (tid / 40) & 7;
            const int gcol = cc < 8 ? h * HP + 8 * cc : (cc < 24 ? DI + g * NS + 8 * (cc - 8) : DI + NG * NS + g * NS + 8 * (cc - 24));
            const int t_off = cc < 8 ? XS_OFF : (cc < 24 ? BM_OFF : CM_OFF), t_str = cc < 8 ? SXB : SBB, t_col = (cc < 8 ? cc : (cc < 24 ? cc - 8 : cc - 24)) * 16;
            const size_t row0 = (size_t)b * SEQ;
            f32x4 hacc[4];
#pragma unroll
            for (int i = 0; i < 4; ++i) hacc[i] = (f32x4){0.f, 0.f, 0.f, 0.f};
            u32x4 raw[11]; float dtr = 0.f;
#define SC_LOAD(c) do { if (stg) { _Pragma("unroll") for (int q = 0; q < 11; ++q) { const int rr = (c) * 64 + 8 * rg - 3 + q; const int rc = rr < 0 ? 0 : rr; \
                raw[q] = *(const u32x4*)(XBC + (row0 + rc) * CONVD + gcol); if (rr < 0) raw[q] = (u32x4){0u, 0u, 0u, 0u}; } } \
            if (wave == 7) dtr = DTRAW[(row0 + (c) * 64 + lane) * NH + h]; } while (0)
#define SC_CUMDT(c) do { if (wave == 7) { const float rw_ = dtr + dtb; const float dtv = rw_ > 20.f ? rw_ : log1pf(__expf(rw_)); float xx = dtv * av; \
                _Pragma("unroll") for (int o = 1; o < 64; o <<= 1) { const float vv = __shfl_up(xx, o); if (lane >= o) xx += vv; } \
                cumL[((c) & 1) * 64 + lane] = xx; dtL[((c) & 1) * 64 + lane] = dtv; } } while (0)
#define SC_STAGE(c) do { if (stg) { const int pr_ = ((c) & 1) * 64; const float cl_ = cumL[pr_ + 63]; \
                _Pragma("unroll") for (int hf = 0; hf < 2; ++hf) { \
                f32x4 wq[5]; _Pragma("unroll") for (int k = 0; k < 5; ++k) wq[k] = *(const LAS f32x4*)(cwl + k * 320 + 8 * cc + 4 * hf); \
                _Pragma("unroll") for (int jj = 0; jj < 8; ++jj) { const int j = 8 * rg + jj; f32x4 aq = wq[4]; \
                    _Pragma("unroll") for (int k = 0; k < 4; ++k) { const u32x4 rq = raw[jj + k]; const unsigned r0_ = hf ? rq.z : rq.x, r1_ = hf ? rq.w : rq.y; \
                        aq += wq[k] * (f32x4){bflo(r0_), bfhi(r0_), bflo(r1_), bfhi(r1_)}; } \
                    _Pragma("unroll") for (int e = 0; e < 4; ++e) aq[e] = silu_f(aq[e]); \
                    u32x2 o_; o_.x = pk2(aq[0], aq[1]); o_.y = pk2(aq[2], aq[3]); \
                    *(LAS u32x2*)(Lb + t_off + j * t_str + t_col + 8 * hf) = o_; \
                    if (cc < 8) { const float wj = __expf(cl_ - cumL[pr_ + j]) * dtL[pr_ + j]; \
                        o_.x = pk2(aq[0] * wj, aq[1] * wj); o_.y = pk2(aq[2] * wj, aq[3] * wj); \
                        *(LAS u32x2*)(Lb + XW_OFF + j * SXB + t_col + 8 * hf) = o_; } } \
                asm volatile("" ::: "memory"); } } } while (0)
            SC_LOAD(0); SC_CUMDT(0);
            __syncthreads();
            SC_STAGE(0);
            __syncthreads();
            const int ti = wave & 3, wh = wave >> 2;
            for (int c = 0; c < SEQ / 64; ++c) {
                const int pr = (c & 1) * 64; const int hb_cur = HB_OFF + (c & 1) * (SBB * 64), hb_nxt = HB_OFF + ((c & 1) ^ 1) * (SBB * 64);
                if (c + 1 < SEQ / 64) SC_LOAD(c + 1);
                const int irow = 16 * ti + r16;
                u32x2 zreg[2];
#pragma unroll
                for (int tt = 0; tt < 2; ++tt) zreg[tt] = *(const u32x2*)(Zb + (row0 + c * 64 + irow) * DI + h * HP + 16 * (2 * wh + tt) + 4 * q4);
                bf16x8 cf[4];
#pragma unroll
                for (int ks = 0; ks < 4; ++ks) cf[ks] = *(const LAS bf16x8*)(Lb + CM_OFF + irow * SBB + (32 * ks + 8 * q4) * 2);
                const float ci = cumL[pr + irow];
#pragma unroll
                for (int tt = 0; tt < 2; ++tt) { const int tj = 2 * wh + tt; f32x4 ga = {0.f, 0.f, 0.f, 0.f};
#pragma unroll
                    for (int ks = 0; ks < 4; ++ks) { const bf16x8 bfr = *(const LAS bf16x8*)(Lb + BM_OFF + (16 * tj + r16) * SBB + (32 * ks + 8 * q4) * 2); ga = __builtin_amdgcn_mfma_f32_16x16x32_bf16(bfr, cf[ks], ga, 0, 0, 0); }
                    const int j0 = 16 * tj + 4 * q4; const f32x4 cj = *(const LAS f32x4*)(cumL + pr + j0), dj = *(const LAS f32x4*)(dtL + pr + j0);
                    float wv[4];
#pragma unroll
                    for (int r = 0; r < 4; ++r) { const int j = j0 + r; float v = ga[r] * __expf(ci - cj[r]) * dj[r]; v = (j <= irow) ? v : 0.f; if (j == irow) v += dh; wv[r] = v; }
                    u32x2 w_; w_.x = pk2(wv[0], wv[1]); w_.y = pk2(wv[2], wv[3]);
                    *(LAS u32x2*)(Lb + WM_OFF + irow * SXB + j0 * 2) = w_; }
                __syncthreads();
                { bf16x8 wf[2];
#pragma unroll
                  for (int ks = 0; ks < 2; ++ks) wf[ks] = *(const LAS bf16x8*)(Lb + WM_OFF + irow * SXB + (32 * ks + 8 * q4) * 2);
                  const float ec = __expf(ci); float ssq = 0.f;
#pragma unroll
                  for (int tt = 0; tt < 2; ++tt) { const int tp = 2 * wh + tt; f32x4 yd = {0.f, 0.f, 0.f, 0.f}, yo = {0.f, 0.f, 0.f, 0.f};
#pragma unroll
                      for (int ks = 0; ks < 2; ++ks) { bf16x8 xa; TR8(xa, XS_OFF, SXB, 32 * ks, 16 * tp); yd = __builtin_amdgcn_mfma_f32_16x16x32_bf16(xa, wf[ks], yd, 0, 0, 0); }
#pragma unroll
                      for (int ks = 0; ks < 4; ++ks) { const bf16x8 ha = *(const LAS bf16x8*)(Lb + hb_cur + (16 * tp + r16) * SBB + (32 * ks + 8 * q4) * 2); yo = __builtin_amdgcn_mfma_f32_16x16x32_bf16(ha, cf[ks], yo, 0, 0, 0); }
                      const float z0 = bflo(zreg[tt].x), z1 = bfhi(zreg[tt].x), z2 = bflo(zreg[tt].y), z3 = bfhi(zreg[tt].y);
                      const float y0 = (yd[0] + ec * yo[0]) * silu_f(z0), y1 = (yd[1] + ec * yo[1]) * silu_f(z1), y2 = (yd[2] + ec * yo[2]) * silu_f(z2), y3 = (yd[3] + ec * yo[3]) * silu_f(z3);
                      ssq += (y0 * y0 + y1 * y1) + (y2 * y2 + y3 * y3);
                      u32x2 o_; o_.x = pk2(y0, y1); o_.y = pk2(y2, y3);
                      *(u32x2*)(Zb + (row0 + c * 64 + irow) * DI + h * HP + 16 * tp + 4 * q4) = o_; }
                  ssq += __shfl_xor(ssq, 16); ssq += __shfl_xor(ssq, 32);
                  if (q4 == 0) SSQ[(row0 + c * 64 + irow) * 64 + h * 2 + wh] = ssq; }
                { const float eL = __expf(cumL[pr + 63]);
#pragma unroll
                  for (int tp = 0; tp < 4; ++tp) hacc[tp] = hacc[tp] * eL;
#pragma unroll
                  for (int ks = 0; ks < 2; ++ks) { bf16x8 ba; TR8(ba, BM_OFF, SBB, 32 * ks, 16 * wave);
#pragma unroll
                      for (int tp = 0; tp < 4; ++tp) { bf16x8 xb; TR8(xb, XW_OFF, SXB, 32 * ks, 16 * tp); hacc[tp] = __builtin_amdgcn_mfma_f32_16x16x32_bf16(ba, xb, hacc[tp], 0, 0, 0); } }
#pragma unroll
                  for (int tp = 0; tp < 4; ++tp) { u32x2 o_; o_.x = pk2(hacc[tp][0], hacc[tp][1]); o_.y = pk2(hacc[tp][2], hacc[tp][3]);
                      *(LAS u32x2*)(Lb + hb_nxt + (16 * tp + r16) * SBB + (16 * wave + 4 * q4) * 2) = o_; } }
                if (c + 1 < SEQ / 64) SC_CUMDT(c + 1);
                __syncthreads();
                if (c + 1 < SEQ / 64) SC_STAGE(c + 1);
                __syncthreads();
            }
        }
#undef TR8
#undef SC_LOAD
#undef SC_CUMDT
#undef SC_STAGE
#endif
    }
    SEAM(2);

    if (IN(3)) { PH_LOCALS
        for (int m = gw; m < T; m += NGW) {
            float p = SSQ[(size_t)m * 64 + lane];
            p += __shfl_xor(p, 1); p += __shfl_xor(p, 2); p += __shfl_xor(p, 4); p += __shfl_xor(p, 8);
            bf16* yr = Zb + (size_t)m * DI;
#pragma unroll
            for (int j = 0; j < 4; ++j) { const float ss = __shfl(p, 16 * j); const float rs = 1.f / sqrtf(ss * (1.f / 512.f) + RMS_EPS);
                u32x4 w = *(const u32x4*)(yr + j * 512 + lane * 8);
                w.x = pk2(bflo(w.x) * rs, bfhi(w.x) * rs); w.y = pk2(bflo(w.y) * rs, bfhi(w.y) * rs); w.z = pk2(bflo(w.z) * rs, bfhi(w.z) * rs); w.w = pk2(bflo(w.w) * rs, bfhi(w.w) * rs);
                *(u32x4*)(yr + j * 512 + lane * 8) = w; }
        }
        LAS float* scr = (LAS float*)(F.lds + wave * 16384);
        constexpr int I_QKV = (D / 64) * (3 * D / 32), I_O = (D / 64) * (D / 32), I_G = (D / 64) * (DFF / 32), I_D = (DFF / 64) * (D / 32);
        constexpr int I_MOE = 2 * NE * (2 * I_G + I_D);
        for (int it = gw; it < I_QKV + I_O + I_MOE; it += NGW) {
            int r = it;
            if (r < I_QKV) { transpose_item(args.in[9], D, 3 * D, (bf16*)(ws + WS_WQKV), 0, 0, nullptr, scr, r, lane); continue; } r -= I_QKV;
            if (r < I_O) { transpose_item(args.in[12], D, D, (bf16*)(ws + WS_WO), 0, 0, nullptr, scr, r, lane); continue; } r -= I_O;
            const int le = r / (2 * I_G + I_D), L = le / NE, e = le % NE; r -= le * (2 * I_G + I_D);
            bf16* wgu = (bf16*)(ws + (L ? WS_WGU1 : WS_WGU0)) + (size_t)e * 1024 * D; bf16* wd = (bf16*)(ws + (L ? WS_WD1 : WS_WD0)) + (size_t)e * D * DFF;
            if (r < I_G) { transpose_item(args.in[16] + (size_t)le * D * DFF, D, DFF, wgu, 0, 1, nullptr, scr, r, lane); continue; } r -= I_G;
            if (r < I_G) { transpose_item(args.in[17] + (size_t)le * D * DFF, D, DFF, wgu, 0, 2, nullptr, scr, r, lane); continue; } r -= I_G;
            transpose_item(args.in[18] + (size_t)le * DFF * D, DFF, D, wd, 0, 0, nullptr, scr, r, lane);
        }
    }
    SEAM(3);

    if (IN(4)) { PH_LOCALS
        pg8::DenseOrder S; S.init(T, D, F.G, (int)blockIdx.x, DI);
        pg8::EpiPlain E{(bf16*)(ws + WS_MIX1), D, nullptr, 0, 1.f};
        pg8::gemm_phase<pg8::EpiPlain, pg8::DenseOrder>(F.lds, Zb, Wt_out, DI, S, E);
    }
    SEAM(4);

#pragma unroll
    for (int L = 0; L < 2; ++L) {
        if (L == 1) {
            if (IN(9)) { PH_LOCALS
                pg8::DenseOrder S; S.init(T, 3 * D, F.G, (int)blockIdx.x, D);
                pg8::EpiPlain E{(bf16*)(ws + WS_QKV), 3 * D, args.in[10], D, 0.125f};
                pg8::gemm_phase<pg8::EpiPlain, pg8::DenseOrder>(F.lds, (const bf16*)(ws + WS_X2B), (const bf16*)(ws + WS_WQKV), D, S, E);
            }
            SEAM(9);
            if (IN(10)) { PH_LOCALS
#if NAIVE_ATTN
                const bf16* QKV = (const bf16*)(ws + WS_QKV); bf16* AO = (bf16*)(ws + WS_AO); const float* rel = args.in[11];
                for (int idx = blockIdx.x * 512 + tid; idx < NB * AH * SEQ; idx += F.G * 512) {
                    const int s = idx % SEQ, bh = idx / SEQ, hh = bh % AH, b = bh / AH, c = s / 64;
                    const bf16* qp = QKV + ((size_t)b * SEQ + s) * (3 * D) + hh * AD;
                    float q[AD], o[AD];
#pragma unroll
                    for (int d = 0; d < AD; ++d) { q[d] = bf2f(qp[d]); o[d] = 0.f; }
                    float mx = -1e30f, l = 0.f;
                    const int k0 = (c - LEFTC) * 64 < 0 ? 0 : (c - LEFTC) * 64, k1 = c * 64 + 64;
                    for (int kp = k0; kp < k1; ++kp) {
                        const bf16* kr = QKV + ((size_t)b * SEQ + kp) * (3 * D) + D + hh * AD; const bf16* vr = kr + D;
                        float sc = 0.f;
#pragma unroll
                        for (int d = 0; d < AD; d += 2) { const unsigned w = *(const unsigned*)(kr + d); sc += q[d] * bflo(w) + q[d + 1] * bfhi(w); }
                        int dist = s - kp; dist = dist < -MAXREL ? -MAXREL : (dist > MAXREL ? MAXREL : dist);
                        sc += rel[(dist + MAXREL) * AH + hh];
                        const float mn = fmaxf(mx, sc), f = __expf(mx - mn), p = __expf(sc - mn);
                        l = l * f + p; mx = mn;
#pragma unroll
                        for (int d = 0; d < AD; d += 2) { const unsigned w = *(const unsigned*)(vr + d); o[d] = o[d] * f + p * bflo(w); o[d + 1] = o[d + 1] * f + p * bfhi(w); }
                    }
                    const float il = 1.f / l; bf16* op = AO + ((size_t)b * SEQ + s) * D + hh * AD;
#pragma unroll
                    for (int d = 0; d < AD; d += 2) *(unsigned*)(op + d) = pk2(o[d] * il, o[d + 1] * il);
                }
#endif
            }
            SEAM(10);
            if (IN(11)) { PH_LOCALS
                pg8::DenseOrder S; S.init(T, D, F.G, (int)blockIdx.x, D);
                pg8::EpiPlain E{(bf16*)(ws + WS_MIX2), D, args.in[13], 0, 1.f};
                pg8::gemm_phase<pg8::EpiPlain, pg8::DenseOrder>(F.lds, (const bf16*)(ws + WS_AO), (const bf16*)(ws + WS_WO), D, S, E);
            }
            SEAM(11);
        }
        const int pb = L ? 12 : 5;
#define LAYER_LOCALS \
        const bf16* MIX = (const bf16*)(ws + (L ? WS_MIX2 : WS_MIX1)); (void)MIX; \
        bf16* XN = (bf16*)(ws + (L ? WS_X3B : WS_X1B)); (void)XN;            \
        bf16* HB = (bf16*)(ws + (L ? WS_H1 : WS_H0)); (void)HB; \
        bf16* Y2 = (bf16*)(ws + (L ? WS_Y21 : WS_Y20)); (void)Y2; \
        gu32* gcnt = (gu32*)(ws + WS_CTL) + CW_CNT + 64 * L; (void)gcnt; \
        LAS int* tokL = (LAS int*)(F.lds + TOKL_OFF); (void)tokL; \
        LAS int* mo = (LAS int*)(F.lds + MOE_OFF); (void)mo;

        if (IN(pb)) { PH_LOCALS LAYER_LOCALS
            const float* lg = args.in[19] + L * D; const float* lb = args.in[20] + L * D;
            const float* rw = args.in[14]; const float* rbias = args.in[15];
            LAS float* rwl = (LAS float*)F.lds;
            LAS int* lcnt = (LAS int*)(F.lds + 65536);
            LAS int* rec = (LAS int*)(F.lds + 65536 + 256);
            for (int i = tid; i < D * NE / 4; i += 512) ((LAS f32x4*)rwl)[i] = ((const f32x4*)rw)[i];
            if (tid < 32) lcnt[tid] = 0;
            __syncthreads();
            int li = 0;
            for (int m = gw; m < T; m += NGW, ++li) {
                f32x4 v[4];
#pragma unroll
                for (int j = 0; j < 4; ++j) {
                    const f32x4 mx = ld_bf16x4(MIX + (size_t)m * D + 4 * lane + 256 * j);
                    f32x4 xr;
                    if (L == 0) xr = *(const f32x4*)(x_in + (size_t)m * D + 4 * lane + 256 * j);
                    else xr = ld_bf16x4((const bf16*)(ws + WS_X2B) + (size_t)m * D + 4 * lane + 256 * j);
                    v[j] = xr * ALPHA + mx;
                }
                ln_row(v, lg, lb, lane);
#pragma unroll
                for (int j = 0; j < 4; ++j) st_bf16x4(XN + (size_t)m * D + 4 * lane + 256 * j, v[j]);
                float lgt[NE];
#pragma unroll
                for (int e = 0; e < NE; ++e) lgt[e] = 0.f;
#pragma unroll
                for (int j = 0; j < 4; ++j)
#pragma unroll
                    for (int q = 0; q < 4; ++q) { const LAS f32x4* wr_ = (const LAS f32x4*)(rwl + (size_t)(4 * lane + 256 * j + q) * NE); const float xv = v[j][q];
#pragma unroll
                        for (int e4 = 0; e4 < 4; ++e4) { const f32x4 w = wr_[e4]; lgt[4 * e4] += xv * w.x; lgt[4 * e4 + 1] += xv * w.y; lgt[4 * e4 + 2] += xv * w.z; lgt[4 * e4 + 3] += xv * w.w; } }
#pragma unroll
                for (int e = 0; e < NE; ++e) lgt[e] = wave_sum(lgt[e]);
                float mxl = lgt[0];
#pragma unroll
                for (int e = 1; e < NE; ++e) mxl = fmaxf(mxl, lgt[e]);
                float sc[NE], sel[NE], den = 0.f;
#pragma unroll
                for (int e = 0; e < NE; ++e) { sc[e] = __expf(lgt[e] - mxl); den += sc[e]; }
                const float iden = 1.f / den;
#pragma unroll
                for (int e = 0; e < NE; ++e) { sc[e] *= iden; sel[e] = sc[e] + rbias[e]; }
                int bg = 0; float bgs = -1e30f;
#pragma unroll
                for (int g = 0; g < 4; ++g) { const float a = sel[4 * g], b2 = sel[4 * g + 1], c2 = sel[4 * g + 2], d2 = sel[4 * g + 3];
                    const float tot = a + b2 + c2 + d2, mn1 = fminf(fminf(a, b2), fminf(c2, d2));
                    float hi1 = fmaxf(fmaxf(a, b2), fmaxf(c2, d2));
                    const float m01 = fminf(a, b2), m23 = fminf(c2, d2), M01 = fmaxf(a, b2), M23 = fmaxf(c2, d2);
                    const float second = fmaxf(fminf(M01, M23), fmaxf(m01, m23));
                    (void)tot; (void)mn1;
                    const float gs = hi1 + second;
                    if (gs > bgs) { bgs = gs; bg = g; } }
                float s0 = 0.f, s1 = 0.f, s2 = 0.f, s3 = 0.f, p0 = 0.f, p1 = 0.f, p2 = 0.f, p3 = 0.f;
#pragma unroll
                for (int g = 0; g < 4; ++g) if (g == bg) { s0 = sel[4 * g]; s1 = sel[4 * g + 1]; s2 = sel[4 * g + 2]; s3 = sel[4 * g + 3]; p0 = sc[4 * g]; p1 = sc[4 * g + 1]; p2 = sc[4 * g + 2]; p3 = sc[4 * g + 3]; }
                int i1 = 0; float b1 = s0, q1 = p0;
                if (s1 > b1) { b1 = s1; i1 = 1; q1 = p1; } if (s2 > b1) { b1 = s2; i1 = 2; q1 = p2; } if (s3 > b1) { b1 = s3; i1 = 3; q1 = p3; }
                int i2 = -1; float b2v = -1e30f, q2 = 0.f;
                if (i1 != 0 && s0 > b2v) { b2v = s0; i2 = 0; q2 = p0; } if (i1 != 1 && s1 > b2v) { b2v = s1; i2 = 1; q2 = p1; }
                if (i1 != 2 && s2 > b2v) { b2v = s2; i2 = 2; q2 = p2; } if (i1 != 3 && s3 > b2v) { b2v = s3; i2 = 3; q2 = p3; }
                const int e1 = 4 * bg + i1, e2 = 4 * bg + i2; const float gsum = q1 + q2, g1 = q1 / gsum, g2 = q2 / gsum;
                if (lane == 0) {
                    const int r1 = atomicAdd((int*)(lcnt + e1), 1), r2 = atomicAdd((int*)(lcnt + e2), 1);
                    LAS int* rc = rec + (wave * 32 + li) * 8; rc[0] = e1; rc[1] = r1; rc[2] = e2; rc[3] = r2; rc[4] = __builtin_bit_cast(int, g1); rc[5] = __builtin_bit_cast(int, g2);
                }
            }
            __syncthreads();
            if (tid < NE) lcnt[16 + tid] = (int)__hip_atomic_fetch_add(gcnt + tid, (unsigned)lcnt[tid], RLX_AGENT);
            __syncthreads();
            li = 0;
            for (int m = gw; m < T; m += NGW, ++li) {
                if (lane == 0) {
                    const LAS int* rc = rec + (wave * 32 + li) * 8;
                    const int e1 = rc[0], e2 = rc[2], sl1 = lcnt[16 + e1] + rc[1], sl2 = lcnt[16 + e2] + rc[3];
                    LIST[(size_t)e1 * T + sl1] = m; LIST[(size_t)e2 * T + sl2] = m;
                    u32x4 w0; w0.x = (unsigned)e1; w0.y = (unsigned)sl1; w0.z = (unsigned)e2; w0.w = (unsigned)sl2;
                    *(u32x4*)(INFO + (size_t)m * 8) = w0; INFO[(size_t)m * 8 + 4] = (unsigned)rc[4]; INFO[(size_t)m * 8 + 5] = (unsigned)rc[5];
                }
            }
        }
        SEAM(pb);

        if (IN(pb + 1) || IN(pb + 2) || IN(pb + 3)) { PH_LOCALS LAYER_LOCALS
            __syncthreads();
            if (tid == 0) { int acc_ = 0; for (int e = 0; e < NE; ++e) { const int c = (int)__hip_atomic_load(gcnt + e, RLX_AGENT); mo[e] = acc_; mo[32 + e] = c; acc_ += (c + 255) >> 8; } mo[16] = acc_; }
            __syncthreads();
        }
        if (IN(pb + 1)) { PH_LOCALS LAYER_LOCALS
            pg8::MoeOrder<true> S{mo, tokL, F.G, F.vcu, D};
            { pg8::Unit u; for (int ui = 0; ui < 6 && S.next(ui, u); ++ui) { if (tid < 256) { const int r = (u.pm - mo[u.e]) * 256 + tid, c = mo[32 + u.e]; tokL[ui * 256 + tid] = LIST[(size_t)u.e * T + (r < c ? r : c - 1)]; } } }
            __syncthreads();
            pg8::EpiGateUp E{HB};
            pg8::gemm_phase<pg8::EpiGateUp, pg8::MoeOrder<true>>(F.lds, XN, (const bf16*)(ws + (L ? WS_WGU1 : WS_WGU0)), D, S, E);
        }
        SEAM(pb + 1);
        if (IN(pb + 2)) { PH_LOCALS LAYER_LOCALS
            pg8::MoeOrder<false> S{mo, tokL, F.G, F.vcu, DFF};
            pg8::EpiPlain E{Y2, D, nullptr, 0, 1.f};
            pg8::gemm_phase<pg8::EpiPlain, pg8::MoeOrder<false>>(F.lds, HB, (const bf16*)(ws + (L ? WS_WD1 : WS_WD0)), DFF, S, E);
        }
        SEAM(pb + 2);
        if (IN(pb + 3)) { PH_LOCALS LAYER_LOCALS
            const float* lg = args.in[21] + L * D; const float* lb = args.in[22] + L * D;
            for (int m = gw; m < T; m += NGW) {
                const u32x4 w0 = *(const u32x4*)(INFO + (size_t)m * 8); const float g1 = __builtin_bit_cast(float, INFO[(size_t)m * 8 + 4]), g2 = __builtin_bit_cast(float, INFO[(size_t)m * 8 + 5]);
                const size_t r1 = (size_t)mo[w0.x] * 256 + w0.y, r2 = (size_t)mo[w0.z] * 256 + w0.w;
                f32x4 v[4];
#pragma unroll
                for (int j = 0; j < 4; ++j) { const int co = 4 * lane + 256 * j;
                    v[j] = ld_bf16x4(XN + (size_t)m * D + co) * ALPHA + ld_bf16x4(Y2 + r1 * D + co) * g1 + ld_bf16x4(Y2 + r2 * D + co) * g2; }
                ln_row(v, lg, lb, lane);
                if (L == 0) {
#pragma unroll
                    for (int j = 0; j < 4; ++j) st_bf16x4((bf16*)(ws + WS_X2B) + (size_t)m * D + 4 * lane + 256 * j, v[j]);
                } else {
#pragma unroll
                    for (int j = 0; j < 4; ++j) *(f32x4*)(args.out + (size_t)m * D + 4 * lane + 256 * j) = v[j];
                }
            }
        }
        if (L == 0) SEAM(8);
    }
#undef IN
#undef SEAM
}

extern "C" void kernel_launch(void* const* d_in, const int* in_sizes, int n_in, void* d_out, int out_size, void* d_ws, size_t ws_size, hipStream_t stream) {
    static int grid = 0;
    if (grid == 0) {
        if (n_in != 23 || in_sizes[0] != T * D || out_size != T * D || ws_size < WS_END) { fprintf(stderr, "kernel_launch: unexpected shapes / workspace (n_in %d, ws %zu); nothing launched\n", n_in, ws_size); grid = -1; return; }
        int dev = 0, cus = 0, per_cu = 0;
        if (hipGetDevice(&dev) != hipSuccess || hipDeviceGetAttribute(&cus, hipDeviceAttributeMultiprocessorCount, dev) != hipSuccess) { grid = -1; return; }
        if (hipFuncSetAttribute((const void*)fwd_kernel, hipFuncAttributeMaxDynamicSharedMemorySize, LDS_BYTES) != hipSuccess) { fprintf(stderr, "kernel_launch: hipFuncSetAttribute failed\n"); grid = -1; return; }
        if (hipOccupancyMaxActiveBlocksPerMultiprocessor(&per_cu, (const void*)fwd_kernel, 512, LDS_BYTES) != hipSuccess || per_cu < 1) fprintf(stderr, "kernel_launch: occupancy query reports %d\n", per_cu);
        (void)hipGetLastError();
        grid = cus;
    }
    if (grid < 0) return;
    if (hipMemsetAsync((char*)d_ws + WS_CTL, 0, CTL_ZERO_BYTES, stream) != hipSuccess) return;
    Args a{};
    for (int i = 0; i < 23; ++i) a.in[i] = (const float*)d_in[i];
    a.out = (float*)d_out; a.ws = (unsigned char*)d_ws;
    if (MK_N_LAUNCHES == 1) { a.ph_lo = 0; a.ph_hi = NPHASE; hipLaunchKernelGGL(fwd_kernel, dim3(grid), dim3(512), LDS_BYTES, stream, a); }
    else for (int p = 0; p < NPHASE; ++p) { a.ph_lo = p; a.ph_hi = p + 1; hipLaunchKernelGGL(fwd_kernel, dim3(grid), dim3(512), LDS_BYTES, stream, a); }
}
```

```cpp
#include <hip/hip_runtime.h>
#include <cstdio>
#include <cstdint>

#ifndef MK_N_LAUNCHES
#define MK_N_LAUNCHES 1
#endif
#ifndef NAIVE_SCAN
#define NAIVE_SCAN 0
#endif
#ifndef NAIVE_ATTN
#define NAIVE_ATTN 0
#endif

#define LAS __attribute__((address_space(3)))
#define GAS __attribute__((address_space(1)))
typedef unsigned short bf16;
typedef short bf16x8 __attribute__((ext_vector_type(8)));
typedef float f32x4 __attribute__((ext_vector_type(4)));
typedef float f32x2 __attribute__((ext_vector_type(2)));
typedef unsigned u32x4 __attribute__((ext_vector_type(4)));
typedef unsigned u32x2 __attribute__((ext_vector_type(2)));
typedef GAS unsigned gu32;

constexpr int NB = 8, SEQ = 4096, D = 1024, T = NB * SEQ;
constexpr int DI = 2048, NH = 32, HP = 64, NG = 4, NS = 128, CONVD = 3072, INP = 5152, NZX = 5120;
constexpr int AH = 16, AD = 64, LEFTC = 8, MAXREL = 128;
constexpr int NE = 16, DFF = 512;
constexpr float ALPHA = 1.4142135623730951f;
constexpr float LN_EPS = 1e-5f, RMS_EPS = 1e-5f;
constexpr int NPHASE = 16;
constexpr int MAXTILES = 272;

constexpr size_t MiB = 1u << 20;
constexpr size_t WS_CTL = 0, CTL_ZERO_BYTES = 1 * MiB;
constexpr size_t WS_WIN = 1 * MiB;
constexpr size_t WS_WOUT = 12 * MiB;
constexpr size_t WS_XB = 16 * MiB;
constexpr size_t WS_WGU0 = 16 * MiB, WS_WD0 = 48 * MiB, WS_WQKV = 64 * MiB, WS_WO = 70 * MiB, WS_WGU1 = 72 * MiB, WS_WD1 = 104 * MiB;
constexpr size_t WS_Z = 120 * MiB;
constexpr size_t WS_XBC = 248 * MiB;
constexpr size_t WS_DTRAW = 440 * MiB;
constexpr size_t WS_SSQ = 444 * MiB;
constexpr size_t WS_MIX1 = 248 * MiB;
constexpr size_t WS_X1B = 324 * MiB;
constexpr size_t WS_H0 = 120 * MiB;
constexpr size_t WS_Y20 = 188 * MiB;
constexpr size_t WS_X2B = 120 * MiB;
constexpr size_t WS_QKV = 188 * MiB;
constexpr size_t WS_AO = 380 * MiB;
constexpr size_t WS_MIX2 = 188 * MiB;
constexpr size_t WS_X3B = 256 * MiB;
constexpr size_t WS_H1 = 320 * MiB;
constexpr size_t WS_Y21 = 120 * MiB;
constexpr size_t WS_LIST = 500 * MiB;
constexpr size_t WS_INFO = 504 * MiB;
constexpr size_t WS_END = 512 * MiB;
constexpr int CW_TMO = 0;
constexpr int CW_CNT = 1024;
constexpr int CW_BAR = 4096;

constexpr int RING_BYTES = 131072;
constexpr int LDSCTL_OFF = RING_BYTES, MISC_OFF = LDSCTL_OFF + 320;
constexpr int TOKL_OFF = LDSCTL_OFF + 1024;
constexpr int MOE_OFF = TOKL_OFF + 6 * 1024;
constexpr int LDS_BYTES = 147456;

#define RLX_AGENT __ATOMIC_RELAXED, __HIP_MEMORY_SCOPE_AGENT
#define LDS_WAIT() asm volatile("s_waitcnt lgkmcnt(0)" ::: "memory")
#define VM_WAIT() asm volatile("s_waitcnt vmcnt(0)" ::: "memory")

__device__ __forceinline__ unsigned f2bf(float f) { unsigned u = __builtin_bit_cast(unsigned, f); return (u + 0x7fffu + ((u >> 16) & 1u)) >> 16; }
__device__ __forceinline__ unsigned pk2(float lo, float hi) { return f2bf(lo) | (f2bf(hi) << 16); }
__device__ __forceinline__ float bf2f(unsigned short b) { return __builtin_bit_cast(float, ((unsigned)b) << 16); }
__device__ __forceinline__ float bflo(unsigned w) { return __builtin_bit_cast(float, w << 16); }
__device__ __forceinline__ float bfhi(unsigned w) { return __builtin_bit_cast(float, w & 0xffff0000u); }
__device__ __forceinline__ float silu_f(float v) { return v / (1.f + __expf(-v)); }
__device__ __forceinline__ float wave_sum(float v) {
#pragma unroll
    for (int o = 1; o < 64; o <<= 1) v += __shfl_xor(v, o);
    return v;
}

namespace pg8 {
constexpr int BM = 256, BK = 64, HALF = 128, HTB = HALF * BK * 2, STAGE_BYTES = 8 * HTB;
__device__ __forceinline__ int lds_byte(int r, int c) { const int st = (r >> 4) * 2 + (c >> 5), rr = r & 15, cc = c & 31, ob = rr * 64 + cc * 2; return st * 1024 + (ob ^ (((ob >> 9) & 1) << 5)); }
__device__ __forceinline__ void stage_rc(int b, int& R, int& C) { const int st = b / 1024, sb = b % 1024, swz = sb ^ (((sb >> 9) & 1) << 5); R = (st >> 1) * 16 + swz / 64; C = (st & 1) * 32 + (swz % 64) / 2; }
__device__ __forceinline__ int perm32(int rho) { const int n = rho >> 4, i = rho & 15; return 8 * (i >> 2) + 4 * n + (i & 3); }
__device__ __forceinline__ unsigned cvt_pk_bf16(float lo, float hi) { unsigned r; asm volatile("v_cvt_pk_bf16_f32 %0, %1, %2" : "=v"(r) : "v"(lo), "v"(hi)); return r; }

struct Unit { int pm, pn, bt, e; };

template <class Epi, class Sched>
__device__ __forceinline__ void gemm_phase(LAS unsigned char* lds, const bf16* A, const bf16* Bt, int K, const Sched& S, const Epi& E) {
    int tid = threadIdx.x; asm volatile("" : "+v"(tid));
    const int wid = __builtin_amdgcn_readfirstlane(tid >> 6), lane = tid & 63, wr = wid >> 2, wc = wid & 3, fr = lane & 15, fq = lane >> 4;
    const int nt = K / BK;
    int Rr[2], Cc[2]; unsigned voffB[2];
#pragma unroll
    for (int i = 0; i < 2; ++i) { stage_rc(tid * 16 + i * 8192, Rr[i], Cc[i]); const int Rb = (Rr[i] & ~31) + perm32(Rr[i] & 31); voffB[i] = (unsigned)(Rb * K + Cc[i]) * 2u; }
    const size_t kstep = (size_t)(BK * 2);
    const size_t hstep = (size_t)HALF * K * 2;
    const size_t tstep = 2 * hstep;
    const unsigned ldsw = (unsigned)wid * 1024u;
    const int aoff = lds_byte(wr * 64 + fr, fq * 8), boff = lds_byte(wc * 32 + fr, fq * 8);
#define PG8_SA(b, h) (((b) * 2 + (h)) * HTB)
#define PG8_SB(b, h) ((4 + (b) * 2 + (h)) * HTB)
#define PG8_STAGE(bufoff, gbase, voff) do { _Pragma("unroll") for (int _i = 0; _i < 2; ++_i) \
        __builtin_amdgcn_global_load_lds((const unsigned*)((const char*)(gbase) + (voff)[_i]), (LAS unsigned*)(lds + (bufoff) + ldsw + _i * 8192), 16, 0, 0); } while (0)
#define PG8_LDA(dst, b, h) do { _Pragma("unroll") for (int m = 0; m < 4; ++m) _Pragma("unroll") for (int k = 0; k < 2; ++k) dst[m][k] = *(const LAS bf16x8*)(lds + PG8_SA(b, h) + aoff + m * 2048 + k * 1024); } while (0)
#define PG8_LDB(dst, b, h) do { _Pragma("unroll") for (int n = 0; n < 2; ++n) _Pragma("unroll") for (int k = 0; k < 2; ++k) dst[n][k] = *(const LAS bf16x8*)(lds + PG8_SB(b, h) + boff + n * 2048 + k * 1024); } while (0)
#define PG8_MMA(ai, bj, At, Bt_) do { __builtin_amdgcn_s_setprio(1); _Pragma("unroll") for (int m = 0; m < 4; ++m) _Pragma("unroll") for (int n = 0; n < 2; ++n) _Pragma("unroll") for (int k = 0; k < 2; ++k) \
        acc[ai][bj][m][n] = __builtin_amdgcn_mfma_f32_16x16x32_bf16(Bt_[n][k], At[m][k], acc[ai][bj][m][n], 0, 0, 0); __builtin_amdgcn_s_setprio(0); } while (0)
#define PG8_WAIT_V(n) asm volatile("s_waitcnt vmcnt(" #n ")" ::: "memory")
#define PG8_WAIT_L(n) asm volatile("s_waitcnt lgkmcnt(" #n ")" ::: "memory")
#define PG8_BAR __builtin_amdgcn_s_barrier()
#define PG8_SCHED __builtin_amdgcn_sched_barrier(0)
    Unit cur, nxt; int ui = 0;
    if (!S.next(0, cur)) return;
    f32x4 acc[2][2][4][2];
#pragma unroll
    for (int a = 0; a < 2; ++a)
#pragma unroll
        for (int b = 0; b < 2; ++b)
#pragma unroll
            for (int m = 0; m < 4; ++m)
#pragma unroll
                for (int n = 0; n < 2; ++n) acc[a][b][m][n] = (f32x4){0.f, 0.f, 0.f, 0.f};
    bf16x8 At[4][2], B0[2][2], B1[2][2];
    unsigned vA0[2], vA1[2];
#pragma unroll
    for (int i = 0; i < 2; ++i) { vA0[i] = S.a_off(0, cur, 0, Rr[i], Cc[i]); vA1[i] = S.a_off(0, cur, 1, Rr[i], Cc[i]); }
    const char* Ab = (const char*)A;
    const char* cB = (const char*)Bt + (size_t)cur.bt * tstep;
    PG8_STAGE(PG8_SB(0, 0), cB, voffB); PG8_STAGE(PG8_SB(0, 1), cB + hstep, voffB); PG8_STAGE(PG8_SA(0, 0), Ab, vA0); PG8_STAGE(PG8_SA(0, 1), Ab, vA1);
    if (wr == 1) PG8_BAR;
    PG8_WAIT_V(2); PG8_BAR;
    PG8_STAGE(PG8_SB(1, 0), cB + kstep, voffB); PG8_STAGE(PG8_SA(1, 0), Ab + kstep, vA0); PG8_STAGE(PG8_SB(1, 1), cB + hstep + kstep, voffB);
    PG8_WAIT_V(6); PG8_BAR;
    for (;;) {
        const bool has_next = S.next(ui + 1, nxt);
        const char* nB = has_next ? (const char*)Bt + (size_t)nxt.bt * tstep : cB;
        for (int t = 0; t < nt; t += 2) {
            const bool last = (t == nt - 2);
            const char* a1 = Ab + (size_t)(t + 1) * kstep;
            const char* a2 = last ? Ab : Ab + (size_t)(t + 2) * kstep; const char* b2 = last ? nB : cB + (size_t)(t + 2) * kstep;
            const char* a3 = a2 + kstep; const char* b3 = b2 + kstep;
            unsigned v20[2], v21[2];
#pragma unroll
            for (int i = 0; i < 2; ++i) { v20[i] = vA0[i]; v21[i] = vA1[i]; }
            if (last && has_next) {
#pragma unroll
                for (int i = 0; i < 2; ++i) { v20[i] = S.a_off(ui + 1, nxt, 0, Rr[i], Cc[i]); v21[i] = S.a_off(ui + 1, nxt, 1, Rr[i], Cc[i]); } }
            PG8_LDB(B0, 0, 0); PG8_LDB(B1, 0, 1); PG8_SCHED; PG8_LDA(At, 0, 0); PG8_STAGE(PG8_SA(1, 1), a1, vA1);
            PG8_WAIT_V(8); PG8_WAIT_L(0); PG8_BAR; PG8_MMA(0, 0, At, B0); PG8_MMA(0, 1, At, B1); PG8_BAR; PG8_SCHED;
            PG8_LDA(At, 0, 1); PG8_STAGE(PG8_SB(0, 0), b2, voffB); PG8_STAGE(PG8_SB(0, 1), b2 + hstep, voffB); PG8_STAGE(PG8_SA(0, 0), a2, v20);
            PG8_WAIT_V(8); PG8_WAIT_L(0); PG8_BAR; PG8_MMA(1, 0, At, B0); PG8_MMA(1, 1, At, B1); PG8_BAR; PG8_SCHED;
            PG8_LDB(B0, 1, 0); PG8_LDB(B1, 1, 1); PG8_SCHED; PG8_LDA(At, 1, 0); PG8_STAGE(PG8_SA(0, 1), a2, v21);
            PG8_WAIT_V(8); PG8_WAIT_L(0); PG8_BAR; PG8_MMA(0, 0, At, B0); PG8_MMA(0, 1, At, B1); PG8_BAR; PG8_SCHED;
            PG8_LDA(At, 1, 1); PG8_STAGE(PG8_SB(1, 0), b3, voffB); PG8_STAGE(PG8_SB(1, 1), b3 + hstep, voffB); PG8_STAGE(PG8_SA(1, 0), a3, v20);
            PG8_WAIT_V(8); PG8_WAIT_L(0); PG8_BAR; PG8_MMA(1, 0, At, B0); PG8_MMA(1, 1, At, B1); PG8_BAR; PG8_SCHED;
        }
        if (wr == 0) PG8_BAR;
        E(acc, cur, wr, wc, fr, fq);
        if (!has_next) break;
#pragma unroll
        for (int a = 0; a < 2; ++a)
#pragma unroll
            for (int b = 0; b < 2; ++b)
#pragma unroll
                for (int m = 0; m < 4; ++m)
#pragma unroll
                    for (int n = 0; n < 2; ++n) acc[a][b][m][n] = (f32x4){0.f, 0.f, 0.f, 0.f};
        cur = nxt; cB = nB; ++ui;
#pragma unroll
        for (int i = 0; i < 2; ++i) { vA0[i] = S.a_off(ui, cur, 0, Rr[i], Cc[i]); vA1[i] = S.a_off(ui, cur, 1, Rr[i], Cc[i]); }
        if (wr == 1) PG8_BAR;
    }
    PG8_WAIT_V(0);
    PG8_BAR;
#undef PG8_SA
#undef PG8_SB
#undef PG8_STAGE
#undef PG8_LDA
#undef PG8_LDB
#undef PG8_MMA
#undef PG8_WAIT_V
#undef PG8_WAIT_L
#undef PG8_BAR
#undef PG8_SCHED
}

struct DenseOrder {
    int nM, nN, nwg, G, c, lda;
    __device__ void init(int M, int N, int G_, int c_, int lda_) { nM = M / BM; nN = N / BM; nwg = nM * nN; G = G_; c = c_; lda = lda_; }
    __device__ __forceinline__ bool next(int i, Unit& u) const {
        const long L = (long)i * G + c; if (L >= nwg) return false;
        int wgid = (int)L; { const int q = nwg / 8, r = nwg % 8, xcd = wgid % 8, off = wgid / 8; wgid = (xcd < r ? xcd * (q + 1) : r * (q + 1) + (xcd - r) * q) + off; }
        const int nig = 8 * nN, gid = wgid / nig, fm = gid * 8, gsz = (nM - fm) < 8 ? (nM - fm) : 8;
        u.pm = fm + ((wgid % nig) % gsz); u.pn = (wgid % nig) / gsz; u.bt = u.pn; u.e = 0; return true;
    }
    __device__ __forceinline__ unsigned a_off(int, const Unit& u, int h, int R, int C) const { return (unsigned)((u.pm * BM + h * HALF + R) * lda + C) * 2u; }
};
template <bool GATHER> struct MoeOrder {
    const LAS int* ts;
    const LAS int* tokL;
    int G, c, lda;
    __device__ __forceinline__ bool next(int i, Unit& u) const {
        const int L = i * G + c; const int ntile = __builtin_amdgcn_readfirstlane(ts[16]);
        if (L >= ntile * 4) return false;
        const int rt = L >> 2; int e = 0;
#pragma unroll
        for (int j = 1; j < 16; ++j) e += (rt >= ts[j]) ? 1 : 0;
        e = __builtin_amdgcn_readfirstlane(e);
        u.pm = rt; u.pn = L & 3; u.e = e; u.bt = e * 4 + (L & 3); return true;
    }
    __device__ __forceinline__ unsigned a_off(int ui, const Unit& u, int h, int R, int C) const {
        if (GATHER) { const int tok = tokL[ui * 256 + h * HALF + R]; return (unsigned)(tok * lda + C) * 2u; }
        return (unsigned)((u.pm * BM + h * HALF + R) * lda + C) * 2u;
    }
};

struct EpiPlain {
    bf16* O; int ldc; const float* bias; int scale_cols; float scale0;
    __device__ __forceinline__ void operator()(const f32x4 (&acc)[2][2][4][2], const Unit& u, int wr, int wc, int fr, int fq) const {
        const int row0 = u.pm * BM + wr * 64 + fr, col0 = u.pn * BM + wc * 32 + 8 * fq;
        const float sc = (u.pn * BM < scale_cols) ? scale0 : 1.f;
        f32x4 bv[2][2];
#pragma unroll
        for (int bj = 0; bj < 2; ++bj)
#pragma unroll
            for (int n = 0; n < 2; ++n) bv[bj][n] = bias ? *(const f32x4*)(bias + col0 + bj * HALF + 4 * n) : (f32x4){0.f, 0.f, 0.f, 0.f};
#pragma unroll
        for (int ai = 0; ai < 2; ++ai)
#pragma unroll
            for (int m = 0; m < 4; ++m) { bf16* rowp = O + (size_t)(row0 + ai * HALF + m * 16) * ldc + col0;
#pragma unroll
                for (int bj = 0; bj < 2; ++bj) { f32x4 v0 = (acc[ai][bj][m][0] + bv[bj][0]) * sc, v1 = (acc[ai][bj][m][1] + bv[bj][1]) * sc;
                    u32x4 w; w.x = cvt_pk_bf16(v0[0], v0[1]); w.y = cvt_pk_bf16(v0[2], v0[3]); w.z = cvt_pk_bf16(v1[0], v1[1]); w.w = cvt_pk_bf16(v1[2], v1[3]);
                    *(u32x4*)(rowp + bj * HALF) = w; } }
    }
};
struct EpiInProj {
    bf16* Z; bf16* XBC;
    __device__ __forceinline__ void operator()(const f32x4 (&acc)[2][2][4][2], const Unit& u, int wr, int wc, int fr, int fq) const {
        const int row0 = u.pm * BM + wr * 64 + fr; int colt = u.pn * BM; bf16* base; int ldc;
        if (colt < DI) { base = Z; ldc = DI; } else { base = XBC; ldc = CONVD; colt -= DI; }
        const int col0 = colt + wc * 32 + 8 * fq;
#pragma unroll
        for (int ai = 0; ai < 2; ++ai)
#pragma unroll
            for (int m = 0; m < 4; ++m) { bf16* rowp = base + (size_t)(row0 + ai * HALF + m * 16) * ldc + col0;
#pragma unroll
                for (int bj = 0; bj < 2; ++bj) { const f32x4 v0 = acc[ai][bj][m][0], v1 = acc[ai][bj][m][1];
                    u32x4 w; w.x = cvt_pk_bf16(v0[0], v0[1]); w.y = cvt_pk_bf16(v0[2], v0[3]); w.z = cvt_pk_bf16(v1[0], v1[1]); w.w = cvt_pk_bf16(v1[2], v1[3]);
                    *(u32x4*)(rowp + bj * HALF) = w; } }
    }
};
struct EpiGateUp {
    bf16* Hh;
    __device__ __forceinline__ void operator()(const f32x4 (&acc)[2][2][4][2], const Unit& u, int wr, int wc, int fr, int fq) const {
        const int row0 = u.pm * BM + wr * 64 + fr, col0 = (u.pn * BM + wc * 32 + 8 * fq) >> 1;
#pragma unroll
        for (int ai = 0; ai < 2; ++ai)
#pragma unroll
            for (int m = 0; m < 4; ++m) { bf16* rowp = Hh + (size_t)(row0 + ai * HALF + m * 16) * DFF + col0;
#pragma unroll
                for (int bj = 0; bj < 2; ++bj) { const f32x4 g = acc[ai][bj][m][0], up = acc[ai][bj][m][1];
                    u32x2 w; w.x = cvt_pk_bf16(silu_f(g[0]) * up[0], silu_f(g[1]) * up[1]); w.y = cvt_pk_bf16(silu_f(g[2]) * up[2], silu_f(g[3]) * up[3]);
                    *(u32x2*)(rowp + bj * (HALF / 2)) = w; } }
    }
};
}

#define XB_TMO      128
#define XB_XCNT(j)  (256  + 64 * (j))
#define XB_XSUB(j)  (1280 + 64 * (j))
#define XB_XGEN(j)  (2304 + 64 * (j))
#define XB_TOP      3328
#define XB_TOPGEN   3392
#define XCD_BAR_WORDS 3456
#define XB_SPIN_CAP (1u << 18)
__device__ __forceinline__ unsigned xb_ld(unsigned* p)              { return __hip_atomic_load(p, __ATOMIC_RELAXED, __HIP_MEMORY_SCOPE_AGENT); }
__device__ __forceinline__ unsigned xb_add(unsigned* p, unsigned v) { return __hip_atomic_fetch_add(p, v, __ATOMIC_RELAXED, __HIP_MEMORY_SCOPE_AGENT); }
__device__ __forceinline__ unsigned xb_xcc_id() { return (unsigned)__builtin_amdgcn_s_getreg((3 << 11) | 20) & 0xFu; }
#define XB_SPIN(cond, bar) do { unsigned _sp = 0; while (cond) { __builtin_amdgcn_s_sleep(1); \
    if ((++_sp & 255u) == 0u) { if (xb_ld(&(bar)[XB_TMO])) break; if (_sp > XB_SPIN_CAP) { atomicAdd(&(bar)[XB_TMO], 1u); break; } } } } while (0)
struct XcdBarrier { unsigned* bar; unsigned x; volatile LAS unsigned* st; };
__device__ __forceinline__ XcdBarrier xcd_barrier_post(unsigned* bar, volatile LAS unsigned* st) {
    XcdBarrier b; b.bar = bar; b.x = xb_xcc_id(); b.st = st;
    if (threadIdx.x == 0) (void)xb_add(&bar[XB_XCNT(b.x)], 1u);
    return b;
}
__device__ __forceinline__ void xcd_barrier_complete(unsigned* bar, unsigned x, unsigned& nloc, unsigned& nx) {
    const unsigned G = gridDim.x * gridDim.y * gridDim.z;
    unsigned sum, cnt, mine, sp = 0u;
    for (;;) {
        sum = 0u; cnt = 0u; mine = 0u;
#pragma unroll
        for (unsigned j = 0; j < 16; ++j) { const unsigned c = xb_ld(&bar[XB_XCNT(j)]); sum += c; cnt += (c > 0u) ? 1u : 0u; mine = (j == x) ? c : mine; }
        if (sum == G) break;
        __builtin_amdgcn_s_sleep(1);
        if ((++sp & 255u) == 0u) { if (xb_ld(&bar[XB_TMO])) break; if (sp > XB_SPIN_CAP) { atomicAdd(&bar[XB_TMO], 1u); break; } }
    }
    nloc = mine > 0u ? mine : 1u; nx = cnt > 0u ? cnt : 1u;
}
__device__ __forceinline__ void xcd_barrier(const XcdBarrier& b) {
    asm volatile("s_waitcnt vmcnt(0)" ::: "memory");
    __syncthreads();
    if (threadIdx.x == 0) {
        unsigned* bar = b.bar;
        __builtin_amdgcn_s_waitcnt(0);
        unsigned nloc = b.st[0], nx = b.st[1];
        if (nloc == 0u) { xcd_barrier_complete(bar, b.x, nloc, nx); b.st[0] = nloc; b.st[1] = nx; }
        const unsigned old = xb_add(&bar[XB_XSUB(b.x)], 1u);
        const unsigned gen = old / nloc;
        if (old + 1u == (gen + 1u) * nloc) {
            __builtin_amdgcn_fence(__ATOMIC_RELEASE, "agent");
            asm volatile("s_waitcnt vmcnt(0)" ::: "memory");
            const unsigned og = xb_add(&bar[XB_TOP], 1u);
            const unsigned tg = og / nx;
            if (og + 1u == (tg + 1u) * nx) xb_add(&bar[XB_TOPGEN], 1u);
            else XB_SPIN(xb_ld(&bar[XB_TOPGEN]) == tg, bar);
            __builtin_amdgcn_fence(__ATOMIC_ACQUIRE, "agent");
            xb_add(&bar[XB_XGEN(b.x)], 1u);
            asm volatile("s_waitcnt vmcnt(0)" ::: "memory");
        } else {
            XB_SPIN(xb_ld(&bar[XB_XGEN(b.x)]) == gen, bar);
            __builtin_amdgcn_fence(__ATOMIC_ACQUIRE, "agent");
            asm volatile("s_waitcnt vmcnt(0)" ::: "memory");
        }
    }
    __syncthreads();
}

struct Args { const float* in[23]; float* out; unsigned char* ws; int ph_lo, ph_hi; };

struct Frame {
    LAS unsigned char* lds;
    int tid, lane, wave, vcu, G;
};

__device__ __forceinline__ void transpose_item(const float* W, int K, int N, bf16* WT, int row_off, int mode, const float* kscale, LAS float* scr, int item, int lane) {
    const int nblk = N / 32, kb = item / nblk, nb = item % nblk, k0 = 64 * kb, n0 = 32 * nb;
#pragma unroll 8
    for (int i = 0; i < 32; ++i) { const int kk = 2 * i + (lane >> 5); scr[kk * 33 + (lane & 31)] = W[(size_t)(k0 + kk) * N + n0 + (lane & 31)]; }
    LDS_WAIT(); asm volatile("" ::: "memory");
    const int c = lane & 7;
    float ks[8];
#pragma unroll
    for (int q = 0; q < 8; ++q) ks[q] = kscale ? kscale[k0 + 8 * c + q] : 1.f;
#pragma unroll
    for (int j = 0; j < 4; ++j) { const int n = (lane >> 3) + 8 * j; const LAS float* s = scr + (8 * c) * 33 + n;
        u32x4 o; o.x = pk2(s[0 * 33] * ks[0], s[1 * 33] * ks[1]); o.y = pk2(s[2 * 33] * ks[2], s[3 * 33] * ks[3]); o.z = pk2(s[4 * 33] * ks[4], s[5 * 33] * ks[5]); o.w = pk2(s[6 * 33] * ks[6], s[7 * 33] * ks[7]);
        const int ng = n0 + n; const int dr = (mode == 0) ? ng : (8 * (ng >> 2) + (ng & 3) + (mode == 2 ? 4 : 0));
        *(GAS u32x4*)(WT + (size_t)(row_off + dr) * K + k0 + 8 * c) = o; }
    LDS_WAIT(); asm volatile("" ::: "memory");
}

__device__ __forceinline__ void ln_row(f32x4 (&v)[4], const float* g, const float* b, int lane) {
    float s = 0.f;
#pragma unroll
    for (int j = 0; j < 4; ++j) s += (v[j].x + v[j].y) + (v[j].z + v[j].w);
    const float mean = wave_sum(s) * (1.f / D); float s2 = 0.f;
#pragma unroll
    for (int j = 0; j < 4; ++j) { v[j] = v[j] - mean; s2 += (v[j].x * v[j].x + v[j].y * v[j].y) + (v[j].z * v[j].z + v[j].w * v[j].w); }
    const float rstd = 1.f / sqrtf(wave_sum(s2) * (1.f / D) + LN_EPS);
#pragma unroll
    for (int j = 0; j < 4; ++j) { const f32x4 gg = *(const f32x4*)(g + 4 * lane + 256 * j), bb = *(const f32x4*)(b + 4 * lane + 256 * j); v[j] = v[j] * rstd * gg + bb; }
}
__device__ __forceinline__ f32x4 ld_bf16x4(const bf16* p) { const u32x2 w = *(const u32x2*)p; return (f32x4){bflo(w.x), bfhi(w.x), bflo(w.y), bfhi(w.y)}; }
__device__ __forceinline__ void st_bf16x4(bf16* p, f32x4 v) { u32x2 w; w.x = pk2(v.x, v.y); w.y = pk2(v.z, v.w); *(u32x2*)p = w; }

__global__ void __launch_bounds__(512, 2) fwd_kernel(Args args) {
    extern __shared__ __attribute__((aligned(16))) unsigned char lds_raw[];
    Frame F;
    F.lds = (LAS unsigned char*)lds_raw;
    F.tid = threadIdx.x; F.lane = F.tid & 63; F.wave = __builtin_amdgcn_readfirstlane(F.tid >> 6);
    F.G = gridDim.x; { const int bx = blockIdx.x; F.vcu = (F.G % 8 == 0) ? (bx % 8) * (F.G / 8) + bx / 8 : bx; }
    unsigned char* ws = args.ws;
    gu32* ctl = (gu32*)(ws + WS_CTL);
    volatile LAS unsigned* MISC = (volatile LAS unsigned*)(F.lds + MISC_OFF);
    for (int u = F.tid; u < (LDS_BYTES - LDSCTL_OFF) / 4; u += 512) ((LAS unsigned*)(F.lds + LDSCTL_OFF))[u] = 0u;
    __syncthreads();
    XcdBarrier bar; bar.bar = (unsigned*)(ctl + CW_BAR); bar.x = 0; bar.st = nullptr;
    if (MK_N_LAUNCHES == 1) bar = xcd_barrier_post((unsigned*)(ctl + CW_BAR), MISC + 8);
    const int lo = args.ph_lo, hi = args.ph_hi;
#ifndef PH_MASK
#define PH_MASK 0xffff
#endif
#define IN(k) (((PH_MASK >> (k)) & 1) && lo <= (k) && (k) < hi)
#define SEAM(k) do { if (IN(k) && IN((k) + 1)) xcd_barrier(bar); } while (0)
#define PH_LOCALS \
    int tid = threadIdx.x; asm volatile("" : "+v"(tid)); const int lane = tid & 63, wave = __builtin_amdgcn_readfirstlane(tid >> 6); \
    unsigned char* ws = args.ws; asm volatile("" : "+s"(ws)); \
    const int gw = F.vcu * 8 + wave, NGW = F.G * 8; (void)lane; (void)gw; (void)NGW; \
    const float* x_in = args.in[0]; (void)x_in; \
    bf16* Wt_in = (bf16*)(ws + WS_WIN); bf16* Wt_out = (bf16*)(ws + WS_WOUT); (void)Wt_in; (void)Wt_out; \
    bf16* XB = (bf16*)(ws + WS_XB); bf16* Zb = (bf16*)(ws + WS_Z); bf16* XBC = (bf16*)(ws + WS_XBC); (void)XB; (void)Zb; (void)XBC; \
    float* DTRAW = (float*)(ws + WS_DTRAW); float* SSQ = (float*)(ws + WS_SSQ); (void)DTRAW; (void)SSQ; \
    int* LIST = (int*)(ws + WS_LIST); unsigned* INFO = (unsigned*)(ws + WS_INFO); (void)LIST; (void)INFO;

    if (IN(0)) { PH_LOCALS
        LAS float* scr = (LAS float*)(F.lds + wave * 16384);
        constexpr int I_IN = (D / 64) * (INP / 32), I_OUT = (DI / 64) * (D / 32);
        for (int it = gw; it < I_IN + I_OUT; it += NGW) {
            if (it < I_IN) transpose_item(args.in[1], D, INP, Wt_in, 0, 0, nullptr, scr, it, lane);
            else transpose_item(args.in[8], DI, D, Wt_out, 0, 0, args.in[7], scr, it - I_IN, lane);
        }
        const size_t n8 = (size_t)T * D / 8;
        for (size_t i = (size_t)blockIdx.x * 512 + tid; i < n8; i += (size_t)F.G * 512) {
            const f32x4 a = *(const f32x4*)(x_in + i * 8), b = *(const f32x4*)(x_in + i * 8 + 4);
            u32x4 o; o.x = pk2(a.x, a.y); o.y = pk2(a.z, a.w); o.z = pk2(b.x, b.y); o.w = pk2(b.z, b.w);
            *(u32x4*)(XB + i * 8) = o;
        }
    }
    SEAM(0);

    if (IN(1)) { PH_LOCALS
        pg8::DenseOrder S; S.init(T, NZX, F.G, (int)blockIdx.x, D);
        pg8::EpiInProj E{Zb, XBC};
        pg8::gemm_phase<pg8::EpiInProj, pg8::DenseOrder>(F.lds, XB, Wt_in, D, S, E);
        for (int tile = gw; tile < T / 16; tile += NGW) {
            const int t0 = tile * 16, r = lane & 15, q = lane >> 4;
            const bf16* xp = XB + (size_t)(t0 + r) * D + 8 * q;
            const bf16* w0 = Wt_in + (size_t)(NZX + r) * D + 8 * q; const bf16* w1 = w0 + (size_t)16 * D;
            f32x4 a0 = {0.f, 0.f, 0.f, 0.f}, a1 = {0.f, 0.f, 0.f, 0.f};
#pragma unroll 4
            for (int k0 = 0; k0 < D; k0 += 32) {
                const bf16x8 xv = *(const bf16x8*)(xp + k0), wa = *(const bf16x8*)(w0 + k0), wb = *(const bf16x8*)(w1 + k0);
                a0 = __builtin_amdgcn_mfma_f32_16x16x32_bf16(wa, xv, a0, 0, 0, 0);
                a1 = __builtin_amdgcn_mfma_f32_16x16x32_bf16(wb, xv, a1, 0, 0, 0);
            }
            float* o = DTRAW + (size_t)(t0 + r) * NH + 4 * q;
            *(f32x4*)o = a0; *(f32x4*)(o + 16) = a1;
        }
    }
    SEAM(1);

    if (IN(2)) { PH_LOCALS
#if NAIVE_SCAN
        const float* conv_w = args.in[2]; const float* conv_b = args.in[3]; const float* dt_bias = args.in[4]; const float* a_log = args.in[5]; const float* dsk = args.in[6];
        for (int item = blockIdx.x; item < NB * NH; item += F.G) {
            if (wave >= 2) continue;
            LAS float* sB = (LAS float*)(F.lds + wave * 8192); LAS float* sC = sB + 128; LAS float* cwl = sC + 128;
            const int b = item / NH, h = item % NH, g = h / 8, pp = 32 * wave + (lane & 31), nh = lane >> 5;
            int col[5]; col[0] = h * HP + pp; col[1] = DI + g * NS + lane; col[2] = col[1] + 64; col[3] = DI + NG * NS + g * NS + lane; col[4] = col[3] + 64;
            float hist[5][3];
#pragma unroll
            for (int c = 0; c < 5; ++c) { cwl[(c * 5 + 4) * 64 + lane] = conv_b[col[c]];
#pragma unroll
                for (int k = 0; k < 4; ++k) cwl[(c * 5 + k) * 64 + lane] = conv_w[k * CONVD + col[c]];
#pragma unroll
                for (int k = 0; k < 3; ++k) hist[c][k] = 0.f; }
            LDS_WAIT();
            const float dtb = dt_bias[h], av = -__expf(a_log[h]), dh = dsk[h];
            float hst[64];
#pragma unroll
            for (int n = 0; n < 64; ++n) hst[n] = 0.f;
            for (int t = 0; t < SEQ; ++t) {
                const size_t row = (size_t)b * SEQ + t;
                float v[5];
#pragma unroll
                for (int c = 0; c < 5; ++c) { const float cur = bf2f(XBC[row * CONVD + col[c]]);
                    float a = cwl[(c * 5 + 4) * 64 + lane] + cwl[(c * 5) * 64 + lane] * hist[c][0] + cwl[(c * 5 + 1) * 64 + lane] * hist[c][1] + cwl[(c * 5 + 2) * 64 + lane] * hist[c][2] + cwl[(c * 5 + 3) * 64 + lane] * cur;
                    hist[c][0] = hist[c][1]; hist[c][1] = hist[c][2]; hist[c][2] = cur; v[c] = silu_f(a); }
                const float raw = DTRAW[row * NH + h] + dtb;
                const float dtv = raw > 20.f ? raw : log1pf(__expf(raw));
                const float dA = __expf(dtv * av);
                sB[lane] = v[1]; sB[lane + 64] = v[2]; sC[lane] = v[3]; sC[lane + 64] = v[4];
                LDS_WAIT(); asm volatile("" ::: "memory");
                const float xd = dtv * v[0]; float y = 0.f;
#pragma unroll
                for (int n = 0; n < 64; n += 4) { const f32x4 bb = *(const LAS f32x4*)(sB + 64 * nh + n), cc = *(const LAS f32x4*)(sC + 64 * nh + n);
                    hst[n] = hst[n] * dA + xd * bb.x; y += cc.x * hst[n];
                    hst[n + 1] = hst[n + 1] * dA + xd * bb.y; y += cc.y * hst[n + 1];
                    hst[n + 2] = hst[n + 2] * dA + xd * bb.z; y += cc.z * hst[n + 2];
                    hst[n + 3] = hst[n + 3] * dA + xd * bb.w; y += cc.w * hst[n + 3]; }
                LDS_WAIT(); asm volatile("" ::: "memory");
                y += __shfl_xor(y, 32);
                y += dh * v[0];
                const float zv = bf2f(Zb[row * DI + h * HP + pp]);
                const float yg = y * silu_f(zv);
                float sq = (lane < 32) ? yg * yg : 0.f; sq = wave_sum(sq);
                if (lane < 32) Zb[row * DI + h * HP + pp] = (bf16)f2bf(yg);
                if (lane == 0) SSQ[row * 64 + h * 2 + wave] = sq;
            }
        }
#else
        const float* conv_w = args.in[2]; const float* conv_b = args.in[3]; const float* dt_bias = args.in[4]; const float* a_log = args.in[5]; const float* dsk = args.in[6];
        typedef short v4i16 __attribute__((ext_vector_type(4)));
        constexpr int SXB = 144, SBB = 272;
        constexpr int XS_OFF = 0, XW_OFF = 9216, BM_OFF = 18432, CM_OFF = 35840, WM_OFF = 53248, HB_OFF = 62464, VEC_OFF = 97280, CW_OFF = 98304;
        LAS unsigned char* Lb = F.lds;
        LAS float* cumL = (LAS float*)(Lb + VEC_OFF);
        LAS float* dtL = cumL + 128;
        LAS float* cwl = (LAS float*)(Lb + CW_OFF);
        const int r16 = lane & 15, q4 = lane >> 4;
#define TR8(dst, base_off, stride, k0, c0) do { const LAS unsigned char* _a = Lb + (base_off) + ((k0) + 8 * q4 + (r16 >> 2)) * (stride) + ((c0) + 4 * (lane & 3)) * 2; \
        const v4i16 _lo = __builtin_amdgcn_ds_read_tr16_b64_v4i16((LAS v4i16*)_a), _hi = __builtin_amdgcn_ds_read_tr16_b64_v4i16((LAS v4i16*)(_a + 4 * (stride))); \
        dst = (bf16x8){_lo[0], _lo[1], _lo[2], _lo[3], _hi[0], _hi[1], _hi[2], _hi[3]}; } while (0)
        for (int item = blockIdx.x; item < NB * NH; item += F.G) {
            const int b = item / NH, h = item % NH, g = h >> 3;
            __syncthreads();
            for (int i = tid; i < 5 * 320; i += 512) { const int k = i / 320, cl = i % 320; const int gc = cl < 64 ? h * HP + cl : (cl < 192 ? DI + g * NS + (cl - 64) : DI + NG * NS + g * NS + (cl - 192)); cwl[i] = k < 4 ? conv_w[k * CONVD + gc] : conv_b[gc]; }
            for (int i = tid; i < SBB * 64 / 4; i += 512) ((LAS unsigned*)(Lb + HB_OFF))[i] = 0u;
            const float dtb = dt_bias[h], av = -__expf(a_log[h]), dh = dsk[h];
            const bool stg = tid < 320; const int cc = tid % 40, rg = (tid / 40) & 7;
            const int gcol = cc < 8 ? h * HP + 8 * cc : (cc < 24 ? DI + g * NS + 8 * (cc - 8) : DI + NG * NS + g * NS + 8 * (cc - 24));
            const int t_off = cc < 8 ? XS_OFF : (cc < 24 ? BM_OFF : CM_OFF), t_str = cc < 8 ? SXB : SBB, t_col = (cc < 8 ? cc : (cc < 24 ? cc - 8 : cc - 24)) * 16;
            const size_t row0 = (size_t)b * SEQ;
            f32x4 hacc[4];
#pragma unroll
            for (int i = 0; i < 4; ++i) hacc[i] = (f32x4){0.f, 0.f, 0.f, 0.f};
            u32x4 raw[11]; float dtr = 0.f;
#define SC_LOAD(c) do { if (stg) { _Pragma("unroll") for (int q = 0; q < 11; ++q) { const int rr = (c) * 64 + 8 * rg - 3 + q; const int rc = rr < 0 ? 0 : rr; \
                raw[q] = *(const u32x4*)(XBC + (row0 + rc) * CONVD + gcol); if (rr < 0) raw[q] = (u32x4){0u, 0u, 0u, 0u}; } } \
            if (wave == 7) dtr = DTRAW[(row0 + (c) * 64 + lane) * NH + h]; } while (0)
#define SC_CUMDT(c) do { if (wave == 7) { const float rw_ = dtr + dtb; const float dtv = rw_ > 20.f ? rw_ : log1pf(__expf(rw_)); float xx = dtv * av; \
                _Pragma("unroll") for (int o = 1; o < 64; o <<= 1) { const float vv = __shfl_up(xx, o); if (lane >= o) xx += vv; } \
                cumL[((c) & 1) * 64 + lane] = xx; dtL[((c) & 1) * 64 + lane] = dtv; } } while (0)
#define SC_STAGE(c) do { if (stg) { const int pr_ = ((c) & 1) * 64; const float cl_ = cumL[pr_ + 63]; \
                _Pragma("unroll") for (int hf = 0; hf < 2; ++hf) { \
                f32x4 wq[5]; _Pragma("unroll") for (int k = 0; k < 5; ++k) wq[k] = *(const LAS f32x4*)(cwl + k * 320 + 8 * cc + 4 * hf); \
                _Pragma("unroll") for (int jj = 0; jj < 8; ++jj) { const int j = 8 * rg + jj; f32x4 aq = wq[4]; \
                    _Pragma("unroll") for (int k = 0; k < 4; ++k) { const u32x4 rq = raw[jj + k]; const unsigned r0_ = hf ? rq.z : rq.x, r1_ = hf ? rq.w : rq.y; \
                        aq += wq[k] * (f32x4){bflo(r0_), bfhi(r0_), bflo(r1_), bfhi(r1_)}; } \
                    _Pragma("unroll") for (int e = 0; e < 4; ++e) aq[e] = silu_f(aq[e]); \
                    u32x2 o_; o_.x = pk2(aq[0], aq[1]); o_.y = pk2(aq[2], aq[3]); \
                    *(LAS u32x2*)(Lb + t_off + j * t_str + t_col + 8 * hf) = o_; \
                    if (cc < 8) { const float wj = __expf(cl_ - cumL[pr_ + j]) * dtL[pr_ + j]; \
                        o_.x = pk2(aq[0] * wj, aq[1] * wj); o_.y = pk2(aq[2] * wj, aq[3] * wj); \
                        *(LAS u32x2*)(Lb + XW_OFF + j * SXB + t_col + 8 * hf) = o_; } } \
                asm volatile("" ::: "memory"); } } } while (0)
            SC_LOAD(0); SC_CUMDT(0);
            __syncthreads();
            SC_STAGE(0);
            __syncthreads();
            const int ti = wave & 3, wh = wave >> 2;
            for (int c = 0; c < SEQ / 64; ++c) {
                const int pr = (c & 1) * 64; const int hb_cur = HB_OFF + (c & 1) * (SBB * 64), hb_nxt = HB_OFF + ((c & 1) ^ 1) * (SBB * 64);
                if (c + 1 < SEQ / 64) SC_LOAD(c + 1);
                const int irow = 16 * ti + r16;
                u32x2 zreg[2];
#pragma unroll
                for (int tt = 0; tt < 2; ++tt) zreg[tt] = *(const u32x2*)(Zb + (row0 + c * 64 + irow) * DI + h * HP + 16 * (2 * wh + tt) + 4 * q4);
                bf16x8 cf[4];
#pragma unroll
                for (int ks = 0; ks < 4; ++ks) cf[ks] = *(const LAS bf16x8*)(Lb + CM_OFF + irow * SBB + (32 * ks + 8 * q4) * 2);
                const float ci = cumL[pr + irow];
#pragma unroll
                for (int tt = 0; tt < 2; ++tt) { const int tj = 2 * wh + tt; f32x4 ga = {0.f, 0.f, 0.f, 0.f};
#pragma unroll
                    for (int ks = 0; ks < 4; ++ks) { const bf16x8 bfr = *(const LAS bf16x8*)(Lb + BM_OFF + (16 * tj + r16) * SBB + (32 * ks + 8 * q4) * 2); ga = __builtin_amdgcn_mfma_f32_16x16x32_bf16(bfr, cf[ks], ga, 0, 0, 0); }
                    const int j0 = 16 * tj + 4 * q4; const f32x4 cj = *(const LAS f32x4*)(cumL + pr + j0), dj = *(const LAS f32x4*)(dtL + pr + j0);
                    float wv[4];
#pragma unroll
                    for (int r = 0; r < 4; ++r) { const int j = j0 + r; float v = ga[r] * __expf(ci - cj[r]) * dj[r]; v = (j <= irow) ? v : 0.f; if (j == irow) v += dh; wv[r] = v; }
                    u32x2 w_; w_.x = pk2(wv[0], wv[1]); w_.y = pk2(wv[2], wv[3]);
                    *(LAS u32x2*)(Lb + WM_OFF + irow * SXB + j0 * 2) = w_; }
                __syncthreads();
                { bf16x8 wf[2];
#pragma unroll
                  for (int ks = 0; ks < 2; ++ks) wf[ks] = *(const LAS bf16x8*)(Lb + WM_OFF + irow * SXB + (32 * ks + 8 * q4) * 2);
                  const float ec = __expf(ci); float ssq = 0.f;
#pragma unroll
                  for (int tt = 0; tt < 2; ++tt) { const int tp = 2 * wh + tt; f32x4 yd = {0.f, 0.f, 0.f, 0.f}, yo = {0.f, 0.f, 0.f, 0.f};
#pragma unroll
                      for (int ks = 0; ks < 2; ++ks) { bf16x8 xa; TR8(xa, XS_OFF, SXB, 32 * ks, 16 * tp); yd = __builtin_amdgcn_mfma_f32_16x16x32_bf16(xa, wf[ks], yd, 0, 0, 0); }
#pragma unroll
                      for (int ks = 0; ks < 4; ++ks) { const bf16x8 ha = *(const LAS bf16x8*)(Lb + hb_cur + (16 * tp + r16) * SBB + (32 * ks + 8 * q4) * 2); yo = __builtin_amdgcn_mfma_f32_16x16x32_bf16(ha, cf[ks], yo, 0, 0, 0); }
                      const float z0 = bflo(zreg[tt].x), z1 = bfhi(zreg[tt].x), z2 = bflo(zreg[tt].y), z3 = bfhi(zreg[tt].y);
                      const float y0 = (yd[0] + ec * yo[0]) * silu_f(z0), y1 = (yd[1] + ec * yo[1]) * silu_f(z1), y2 = (yd[2] + ec * yo[2]) * silu_f(z2), y3 = (yd[3] + ec * yo[3]) * silu_f(z3);
                      ssq += (y0 * y0 + y1 * y1) + (y2 * y2 + y3 * y3);
                      u32x2 o_; o_.x = pk2(y0, y1); o_.y = pk2(y2, y3);
                      *(u32x2*)(Zb + (row0 + c * 64 + irow) * DI + h * HP + 16 * tp + 4 * q4) = o_; }
                  ssq += __shfl_xor(ssq, 16); ssq += __shfl_xor(ssq, 32);
                  if (q4 == 0) SSQ[(row0 + c * 64 + irow) * 64 + h * 2 + wh] = ssq; }
                { const float eL = __expf(cumL[pr + 63]);
#pragma unroll
                  for (int tp = 0; tp < 4; ++tp) hacc[tp] = hacc[tp] * eL;
#pragma unroll
                  for (int ks = 0; ks < 2; ++ks) { bf16x8 ba; TR8(ba, BM_OFF, SBB, 32 * ks, 16 * wave);
#pragma unroll
                      for (int tp = 0; tp < 4; ++tp) { bf16x8 xb; TR8(xb, XW_OFF, SXB, 32 * ks, 16 * tp); hacc[tp] = __builtin_amdgcn_mfma_f32_16x16x32_bf16(ba, xb, hacc[tp], 0, 0, 0); } }
#pragma unroll
                  for (int tp = 0; tp < 4; ++tp) { u32x2 o_; o_.x = pk2(hacc[tp][0], hacc[tp][1]); o_.y = pk2(hacc[tp][2], hacc[tp][3]);
                      *(LAS u32x2*)(Lb + hb_nxt + (16 * tp + r16) * SBB + (16 * wave + 4 * q4) * 2) = o_; } }
                if (c + 1 < SEQ / 64) SC_CUMDT(c + 1);
                __syncthreads();
                if (c + 1 < SEQ / 64) SC_STAGE(c + 1);
                __syncthreads();
            }
        }
#undef TR8
#undef SC_LOAD
#undef SC_CUMDT
#undef SC_STAGE
#endif
    }
    SEAM(2);

    if (IN(3)) { PH_LOCALS
        for (int m = gw; m < T; m += NGW) {
            float p = SSQ[(size_t)m * 64 + lane];
            p += __shfl_xor(p, 1); p += __shfl_xor(p, 2); p += __shfl_xor(p, 4); p += __shfl_xor(p, 8);
            bf16* yr = Zb + (size_t)m * DI;
#pragma unroll
            for (int j = 0; j < 4; ++j) { const float ss = __shfl(p, 16 * j); const float rs = 1.f / sqrtf(ss * (1.f / 512.f) + RMS_EPS);
                u32x4 w = *(const u32x4*)(yr + j * 512 + lane * 8);
                w.x = pk2(bflo(w.x) * rs, bfhi(w.x) * rs); w.y = pk2(bflo(w.y) * rs, bfhi(w.y) * rs); w.z = pk2(bflo(w.z) * rs, bfhi(w.z) * rs); w.w = pk2(bflo(w.w) * rs, bfhi(w.w) * rs);
                *(u32x4*)(yr + j * 512 + lane * 8) = w; }
        }
        LAS float* scr = (LAS float*)(F.lds + wave * 16384);
        constexpr int I_QKV = (D / 64) * (3 * D / 32), I_O = (D / 64) * (D / 32), I_G = (D / 64) * (DFF / 32), I_D = (DFF / 64) * (D / 32);
        constexpr int I_MOE = 2 * NE * (2 * I_G + I_D);
        for (int it = gw; it < I_QKV + I_O + I_MOE; it += NGW) {
            int r = it;
            if (r < I_QKV) { transpose_item(args.in[9], D, 3 * D, (bf16*)(ws + WS_WQKV), 0, 0, nullptr, scr, r, lane); continue; } r -= I_QKV;
            if (r < I_O) { transpose_item(args.in[12], D, D, (bf16*)(ws + WS_WO), 0, 0, nullptr, scr, r, lane); continue; } r -= I_O;
            const int le = r / (2 * I_G + I_D), L = le / NE, e = le % NE; r -= le * (2 * I_G + I_D);
            bf16* wgu = (bf16*)(ws + (L ? WS_WGU1 : WS_WGU0)) + (size_t)e * 1024 * D; bf16* wd = (bf16*)(ws + (L ? WS_WD1 : WS_WD0)) + (size_t)e * D * DFF;
            if (r < I_G) { transpose_item(args.in[16] + (size_t)le * D * DFF, D, DFF, wgu, 0, 1, nullptr, scr, r, lane); continue; } r -= I_G;
            if (r < I_G) { transpose_item(args.in[17] + (size_t)le * D * DFF, D, DFF, wgu, 0, 2, nullptr, scr, r, lane); continue; } r -= I_G;
            transpose_item(args.in[18] + (size_t)le * DFF * D, DFF, D, wd, 0, 0, nullptr, scr, r, lane);
        }
    }
    SEAM(3);

    if (IN(4)) { PH_LOCALS
        pg8::DenseOrder S; S.init(T, D, F.G, (int)blockIdx.x, DI);
        pg8::EpiPlain E{(bf16*)(ws + WS_MIX1), D, nullptr, 0, 1.f};
        pg8::gemm_phase<pg8::EpiPlain, pg8::DenseOrder>(F.lds, Zb, Wt_out, DI, S, E);
    }
    SEAM(4);

#pragma unroll
    for (int L = 0; L < 2; ++L) {
        if (L == 1) {
            if (IN(9)) { PH_LOCALS
                pg8::DenseOrder S; S.init(T, 3 * D, F.G, (int)blockIdx.x, D);
                pg8::EpiPlain E{(bf16*)(ws + WS_QKV), 3 * D, args.in[10], D, 0.125f};
                pg8::gemm_phase<pg8::EpiPlain, pg8::DenseOrder>(F.lds, (const bf16*)(ws + WS_X2B), (const bf16*)(ws + WS_WQKV), D, S, E);
            }
            SEAM(9);
            if (IN(10)) { PH_LOCALS
#if NAIVE_ATTN
                const bf16* QKV = (const bf16*)(ws + WS_QKV); bf16* AO = (bf16*)(ws + WS_AO); const float* rel = args.in[11];
                for (int idx = blockIdx.x * 512 + tid; idx < NB * AH * SEQ; idx += F.G * 512) {
                    const int s = idx % SEQ, bh = idx / SEQ, hh = bh % AH, b = bh / AH, c = s / 64;
                    const bf16* qp = QKV + ((size_t)b * SEQ + s) * (3 * D) + hh * AD;
                    float q[AD], o[AD];
#pragma unroll
                    for (int d = 0; d < AD; ++d) { q[d] = bf2f(qp[d]); o[d] = 0.f; }
                    float mx = -1e30f, l = 0.f;
                    const int k0 = (c - LEFTC) * 64 < 0 ? 0 : (c - LEFTC) * 64, k1 = c * 64 + 64;
                    for (int kp = k0; kp < k1; ++kp) {
                        const bf16* kr = QKV + ((size_t)b * SEQ + kp) * (3 * D) + D + hh * AD; const bf16* vr = kr + D;
                        float sc = 0.f;
#pragma unroll
                        for (int d = 0; d < AD; d += 2) { const unsigned w = *(const unsigned*)(kr + d); sc += q[d] * bflo(w) + q[d + 1] * bfhi(w); }
                        int dist = s - kp; dist = dist < -MAXREL ? -MAXREL : (dist > MAXREL ? MAXREL : dist);
                        sc += rel[(dist + MAXREL) * AH + hh];
                        const float mn = fmaxf(mx, sc), f = __expf(mx - mn), p = __expf(sc - mn);
                        l = l * f + p; mx = mn;
#pragma unroll
                        for (int d = 0; d < AD; d += 2) { const unsigned w = *(const unsigned*)(vr + d); o[d] = o[d] * f + p * bflo(w); o[d + 1] = o[d + 1] * f + p * bfhi(w); }
                    }
                    const float il = 1.f / l; bf16* op = AO + ((size_t)b * SEQ + s) * D + hh * AD;
#pragma unroll
                    for (int d = 0; d < AD; d += 2) *(unsigned*)(op + d) = pk2(o[d] * il, o[d + 1] * il);
                }
#else
                const bf16* QKV = (const bf16*)(ws + WS_QKV); bf16* AO = (bf16*)(ws + WS_AO); const float* rel = args.in[11];
                typedef short v4i16 __attribute__((ext_vector_type(4)));
                constexpr int SKB = 144, KB_OFF = 0, VB_OFF = 18432, TB_OFF = 36864; constexpr float LOG2E = 1.4426950408889634f;
                LAS unsigned char* Lb = F.lds; LAS float* tb = (LAS float*)(Lb + TB_OFF);
                const int r16 = lane & 15, q4 = lane >> 4, wq = wave >> 2;
                const int NU = NB * AH * (SEQ / 128), per = (NU + F.G - 1) / F.G;
                int hprev = -1;
                for (int ui = 0; ui < per; ++ui) {
                    const int u = F.vcu * per + ui; if (u >= NU) break;
                    const int bh = u >> 5, cp = u & 31, b = bh >> 4, hh = bh & 15, c0 = 2 * cp;
                    __syncthreads();
                    if (hh != hprev) { for (int i = tid; i < 2 * MAXREL + 1; i += 512) tb[i] = rel[i * AH + hh] * LOG2E; hprev = hh; }
                    const int cw = c0 + wq, qrow = 64 * cw + 16 * (wave & 3) + r16;
                    const size_t tok0 = (size_t)b * SEQ;
                    bf16x8 qf[2];
#pragma unroll
                    for (int ds = 0; ds < 2; ++ds) qf[ds] = *(const bf16x8*)(QKV + (tok0 + qrow) * (3 * D) + hh * AD + 32 * ds + 8 * q4);
                    f32x4 oacc[4];
#pragma unroll
                    for (int i = 0; i < 4; ++i) oacc[i] = (f32x4){0.f, 0.f, 0.f, 0.f};
                    float mrun = -1e30f, lrun = 0.f;
                    const int kt_lo = c0 < 8 ? 8 - c0 : 0;
                    const int kr = tid >> 3, pc = tid & 7;
                    const bf16* kvp = QKV + (tok0 + kr) * (3 * D) + D + hh * AD + 8 * pc;
                    u32x4 kreg, vreg;
                    { const size_t co = (size_t)(c0 - 8 + kt_lo) * 64 * (3 * D); kreg = *(const u32x4*)(kvp + co); vreg = *(const u32x4*)(kvp + co + D); }
                    *(LAS u32x4*)(Lb + KB_OFF + (kt_lo & 1) * 9216 + kr * SKB + pc * 16) = kreg; *(LAS u32x4*)(Lb + VB_OFF + (kt_lo & 1) * 9216 + kr * SKB + pc * 16) = vreg;
                    __syncthreads();
                    for (int kt = kt_lo; kt < 10; ++kt) {
                        const int chunk = c0 - 8 + kt;
                        if (kt + 1 < 10) { const size_t co = (size_t)(chunk + 1) * 64 * (3 * D); kreg = *(const u32x4*)(kvp + co); vreg = *(const u32x4*)(kvp + co + D); }
                        if (kt >= wq && kt <= wq + 8) {
                            const LAS unsigned char* Kb = Lb + KB_OFF + (kt & 1) * 9216; const LAS unsigned char* Vb = Lb + VB_OFF + (kt & 1) * 9216;
                            f32x4 sc[4];
#pragma unroll
                            for (int t = 0; t < 4; ++t) { sc[t] = (f32x4){0.f, 0.f, 0.f, 0.f};
#pragma unroll
                                for (int ds = 0; ds < 2; ++ds) { const bf16x8 kf = *(const LAS bf16x8*)(Kb + (16 * t + r16) * SKB + (32 * ds + 8 * q4) * 2); sc[t] = __builtin_amdgcn_mfma_f32_16x16x32_bf16(kf, qf[ds], sc[t], 0, 0, 0); } }
                            if (cw - chunk >= 3) { const float bc = tb[2 * MAXREL];
#pragma unroll
                                for (int t = 0; t < 4; ++t) sc[t] = sc[t] * LOG2E + bc;
                            } else {
#pragma unroll
                                for (int t = 0; t < 4; ++t)
#pragma unroll
                                    for (int r = 0; r < 4; ++r) { int dist = qrow - (64 * chunk + 16 * t + 4 * q4 + r); dist = dist < -MAXREL ? -MAXREL : (dist > MAXREL ? MAXREL : dist); sc[t][r] = sc[t][r] * LOG2E + tb[dist + MAXREL]; }
                            }
                            float mx = fmaxf(fmaxf(sc[0][0], sc[0][1]), fmaxf(sc[0][2], sc[0][3]));
#pragma unroll
                            for (int t = 1; t < 4; ++t) mx = fmaxf(mx, fmaxf(fmaxf(sc[t][0], sc[t][1]), fmaxf(sc[t][2], sc[t][3])));
                            mx = fmaxf(mx, __shfl_xor(mx, 16)); mx = fmaxf(mx, __shfl_xor(mx, 32));
                            const float mnew = fmaxf(mrun, mx), alpha = __builtin_amdgcn_exp2f(mrun - mnew); mrun = mnew;
                            float ls = 0.f;
#pragma unroll
                            for (int t = 0; t < 4; ++t)
#pragma unroll
                                for (int r = 0; r < 4; ++r) { sc[t][r] = __builtin_amdgcn_exp2f(sc[t][r] - mnew); ls += sc[t][r]; }
                            lrun = lrun * alpha + ls;
#pragma unroll
                            for (int i = 0; i < 4; ++i) oacc[i] = oacc[i] * alpha;
                            bf16x8 pb[2];
#pragma unroll
                            for (int kk = 0; kk < 2; ++kk) { u32x4 w_; w_.x = pk2(sc[2 * kk][0], sc[2 * kk][1]); w_.y = pk2(sc[2 * kk][2], sc[2 * kk][3]); w_.z = pk2(sc[2 * kk + 1][0], sc[2 * kk + 1][1]); w_.w = pk2(sc[2 * kk + 1][2], sc[2 * kk + 1][3]); pb[kk] = __builtin_bit_cast(bf16x8, w_); }
#pragma unroll
                            for (int dt = 0; dt < 4; ++dt)
#pragma unroll
                                for (int kk = 0; kk < 2; ++kk) { const LAS unsigned char* va_ = Vb + (32 * kk + 4 * q4 + (r16 >> 2)) * SKB + (16 * dt + 4 * (lane & 3)) * 2;
                                    const v4i16 lo_ = __builtin_amdgcn_ds_read_tr16_b64_v4i16((LAS v4i16*)va_), hi_ = __builtin_amdgcn_ds_read_tr16_b64_v4i16((LAS v4i16*)(va_ + 16 * SKB));
                                    const bf16x8 vf = (bf16x8){lo_[0], lo_[1], lo_[2], lo_[3], hi_[0], hi_[1], hi_[2], hi_[3]};
                                    oacc[dt] = __builtin_amdgcn_mfma_f32_16x16x32_bf16(vf, pb[kk], oacc[dt], 0, 0, 0); }
                        }
                        if (kt + 1 < 10) { *(LAS u32x4*)(Lb + KB_OFF + ((kt + 1) & 1) * 9216 + kr * SKB + pc * 16) = kreg; *(LAS u32x4*)(Lb + VB_OFF + ((kt + 1) & 1) * 9216 + kr * SKB + pc * 16) = vreg; }
                        __syncthreads();
                    }
                    lrun += __shfl_xor(lrun, 16); lrun += __shfl_xor(lrun, 32);
                    const float il = 1.f / lrun; bf16* op = AO + (tok0 + qrow) * D + hh * AD + 4 * q4;
#pragma unroll
                    for (int dt = 0; dt < 4; ++dt) { u32x2 o_; o_.x = pk2(oacc[dt][0] * il, oacc[dt][1] * il); o_.y = pk2(oacc[dt][2] * il, oacc[dt][3] * il); *(u32x2*)(op + 16 * dt) = o_; }
                }
#endif
            }
            SEAM(10);
            if (IN(11)) { PH_LOCALS
                pg8::DenseOrder S; S.init(T, D, F.G, (int)blockIdx.x, D);
                pg8::EpiPlain E{(bf16*)(ws + WS_MIX2), D, args.in[13], 0, 1.f};
                pg8::gemm_phase<pg8::EpiPlain, pg8::DenseOrder>(F.lds, (const bf16*)(ws + WS_AO), (const bf16*)(ws + WS_WO), D, S, E);
            }
            SEAM(11);
        }
        const int pb = L ? 12 : 5;
#define LAYER_LOCALS \
        const bf16* MIX = (const bf16*)(ws + (L ? WS_MIX2 : WS_MIX1)); (void)MIX; \
        bf16* XN = (bf16*)(ws + (L ? WS_X3B : WS_X1B)); (void)XN;            \
        bf16* HB = (bf16*)(ws + (L ? WS_H1 : WS_H0)); (void)HB; \
        bf16* Y2 = (bf16*)(ws + (L ? WS_Y21 : WS_Y20)); (void)Y2; \
        gu32* gcnt = (gu32*)(ws + WS_CTL) + CW_CNT + 64 * L; (void)gcnt; \
        LAS int* tokL = (LAS int*)(F.lds + TOKL_OFF); (void)tokL; \
        LAS int* mo = (LAS int*)(F.lds + MOE_OFF); (void)mo;

        if (IN(pb)) { PH_LOCALS LAYER_LOCALS
            const float* lg = args.in[19] + L * D; const float* lb = args.in[20] + L * D;
            const float* rw = args.in[14]; const float* rbias = args.in[15];
            LAS float* rwl = (LAS float*)F.lds;
            LAS int* lcnt = (LAS int*)(F.lds + 65536);
            LAS int* rec = (LAS int*)(F.lds + 65536 + 256);
            for (int i = tid; i < D * NE / 4; i += 512) ((LAS f32x4*)rwl)[i] = ((const f32x4*)rw)[i];
            if (tid < 32) lcnt[tid] = 0;
            __syncthreads();
            int li = 0;
            for (int m = gw; m < T; m += NGW, ++li) {
                f32x4 v[4];
#pragma unroll
                for (int j = 0; j < 4; ++j) {
                    const f32x4 mx = ld_bf16x4(MIX + (size_t)m * D + 4 * lane + 256 * j);
                    f32x4 xr;
                    if (L == 0) xr = *(const f32x4*)(x_in + (size_t)m * D + 4 * lane + 256 * j);
                    else xr = ld_bf16x4((const bf16*)(ws + WS_X2B) + (size_t)m * D + 4 * lane + 256 * j);
                    v[j] = xr * ALPHA + mx;
                }
                ln_row(v, lg, lb, lane);
#pragma unroll
                for (int j = 0; j < 4; ++j) st_bf16x4(XN + (size_t)m * D + 4 * lane + 256 * j, v[j]);
                float lgt[NE];
#pragma unroll
                for (int e = 0; e < NE; ++e) lgt[e] = 0.f;
#pragma unroll
                for (int j = 0; j < 4; ++j)
#pragma unroll
                    for (int q = 0; q < 4; ++q) { const LAS f32x4* wr_ = (const LAS f32x4*)(rwl + (size_t)(4 * lane + 256 * j + q) * NE); const float xv = v[j][q];
#pragma unroll
                        for (int e4 = 0; e4 < 4; ++e4) { const f32x4 w = wr_[e4]; lgt[4 * e4] += xv * w.x; lgt[4 * e4 + 1] += xv * w.y; lgt[4 * e4 + 2] += xv * w.z; lgt[4 * e4 + 3] += xv * w.w; } }
#pragma unroll
                for (int e = 0; e < NE; ++e) lgt[e] = wave_sum(lgt[e]);
                float mxl = lgt[0];
#pragma unroll
                for (int e = 1; e < NE; ++e) mxl = fmaxf(mxl, lgt[e]);
                float sc[NE], sel[NE], den = 0.f;
#pragma unroll
                for (int e = 0; e < NE; ++e) { sc[e] = __expf(lgt[e] - mxl); den += sc[e]; }
                const float iden = 1.f / den;
#pragma unroll
                for (int e = 0; e < NE; ++e) { sc[e] *= iden; sel[e] = sc[e] + rbias[e]; }
                int bg = 0; float bgs = -1e30f;
#pragma unroll
                for (int g = 0; g < 4; ++g) { const float a = sel[4 * g], b2 = sel[4 * g + 1], c2 = sel[4 * g + 2], d2 = sel[4 * g + 3];
                    const float tot = a + b2 + c2 + d2, mn1 = fminf(fminf(a, b2), fminf(c2, d2));
                    float hi1 = fmaxf(fmaxf(a, b2), fmaxf(c2, d2));
                    const float m01 = fminf(a, b2), m23 = fminf(c2, d2), M01 = fmaxf(a, b2), M23 = fmaxf(c2, d2);
                    const float second = fmaxf(fminf(M01, M23), fmaxf(m01, m23));
                    (void)tot; (void)mn1;
                    const float gs = hi1 + second;
                    if (gs > bgs) { bgs = gs; bg = g; } }
                float s0 = 0.f, s1 = 0.f, s2 = 0.f, s3 = 0.f, p0 = 0.f, p1 = 0.f, p2 = 0.f, p3 = 0.f;
#pragma unroll
                for (int g = 0; g < 4; ++g) if (g == bg) { s0 = sel[4 * g]; s1 = sel[4 * g + 1]; s2 = sel[4 * g + 2]; s3 = sel[4 * g + 3]; p0 = sc[4 * g]; p1 = sc[4 * g + 1]; p2 = sc[4 * g + 2]; p3 = sc[4 * g + 3]; }
                int i1 = 0; float b1 = s0, q1 = p0;
                if (s1 > b1) { b1 = s1; i1 = 1; q1 = p1; } if (s2 > b1) { b1 = s2; i1 = 2; q1 = p2; } if (s3 > b1) { b1 = s3; i1 = 3; q1 = p3; }
                int i2 = -1; float b2v = -1e30f, q2 = 0.f;
                if (i1 != 0 && s0 > b2v) { b2v = s0; i2 = 0; q2 = p0; } if (i1 != 1 && s1 > b2v) { b2v = s1; i2 = 1; q2 = p1; }
                if (i1 != 2 && s2 > b2v) { b2v = s2; i2 = 2; q2 = p2; } if (i1 != 3 && s3 > b2v) { b2v = s3; i2 = 3; q2 = p3; }
                const int e1 = 4 * bg + i1, e2 = 4 * bg + i2; const float gsum = q1 + q2, g1 = q1 / gsum, g2 = q2 / gsum;
                if (lane == 0) {
                    const int r1 = atomicAdd((int*)(lcnt + e1), 1), r2 = atomicAdd((int*)(lcnt + e2), 1);
                    LAS int* rc = rec + (wave * 32 + li) * 8; rc[0] = e1; rc[1] = r1; rc[2] = e2; rc[3] = r2; rc[4] = __builtin_bit_cast(int, g1); rc[5] = __builtin_bit_cast(int, g2);
                }
            }
            __syncthreads();
            if (tid < NE) lcnt[16 + tid] = (int)__hip_atomic_fetch_add(gcnt + tid, (unsigned)lcnt[tid], RLX_AGENT);
            __syncthreads();
            li = 0;
            for (int m = gw; m < T; m += NGW, ++li) {
                if (lane == 0) {
                    const LAS int* rc = rec + (wave * 32 + li) * 8;
                    const int e1 = rc[0], e2 = rc[2], sl1 = lcnt[16 + e1] + rc[1], sl2 = lcnt[16 + e2] + rc[3];
                    LIST[(size_t)e1 * T + sl1] = m; LIST[(size_t)e2 * T + sl2] = m;
                    u32x4 w0; w0.x = (unsigned)e1; w0.y = (unsigned)sl1; w0.z = (unsigned)e2; w0.w = (unsigned)sl2;
                    *(u32x4*)(INFO + (size_t)m * 8) = w0; INFO[(size_t)m * 8 + 4] = (unsigned)rc[4]; INFO[(size_t)m * 8 + 5] = (unsigned)rc[5];
                }
            }
        }
        SEAM(pb);

        if (IN(pb + 1) || IN(pb + 2) || IN(pb + 3)) { PH_LOCALS LAYER_LOCALS
            __syncthreads();
            if (tid == 0) { int acc_ = 0; for (int e = 0; e < NE; ++e) { const int c = (int)__hip_atomic_load(gcnt + e, RLX_AGENT); mo[e] = acc_; mo[32 + e] = c; acc_ += (c + 255) >> 8; } mo[16] = acc_; }
            __syncthreads();
        }
        if (IN(pb + 1)) { PH_LOCALS LAYER_LOCALS
            pg8::MoeOrder<true> S{mo, tokL, F.G, F.vcu, D};
            { pg8::Unit u; for (int ui = 0; ui < 6 && S.next(ui, u); ++ui) { if (tid < 256) { const int r = (u.pm - mo[u.e]) * 256 + tid, c = mo[32 + u.e]; tokL[ui * 256 + tid] = LIST[(size_t)u.e * T + (r < c ? r : c - 1)]; } } }
            __syncthreads();
            pg8::EpiGateUp E{HB};
            pg8::gemm_phase<pg8::EpiGateUp, pg8::MoeOrder<true>>(F.lds, XN, (const bf16*)(ws + (L ? WS_WGU1 : WS_WGU0)), D, S, E);
        }
        SEAM(pb + 1);
        if (IN(pb + 2)) { PH_LOCALS LAYER_LOCALS
            pg8::MoeOrder<false> S{mo, tokL, F.G, F.vcu, DFF};
            pg8::EpiPlain E{Y2, D, nullptr, 0, 1.f};
            pg8::gemm_phase<pg8::EpiPlain, pg8::MoeOrder<false>>(F.lds, HB, (const bf16*)(ws + (L ? WS_WD1 : WS_WD0)), DFF, S, E);
        }
        SEAM(pb + 2);
        if (IN(pb + 3)) { PH_LOCALS LAYER_LOCALS
            const float* lg = args.in[21] + L * D; const float* lb = args.in[22] + L * D;
            for (int m = gw; m < T; m += NGW) {
                const u32x4 w0 = *(const u32x4*)(INFO + (size_t)m * 8); const float g1 = __builtin_bit_cast(float, INFO[(size_t)m * 8 + 4]), g2 = __builtin_bit_cast(float, INFO[(size_t)m * 8 + 5]);
                const size_t r1 = (size_t)mo[w0.x] * 256 + w0.y, r2 = (size_t)mo[w0.z] * 256 + w0.w;
                f32x4 v[4];
#pragma unroll
                for (int j = 0; j < 4; ++j) { const int co = 4 * lane + 256 * j;
                    v[j] = ld_bf16x4(XN + (size_t)m * D + co) * ALPHA + ld_bf16x4(Y2 + r1 * D + co) * g1 + ld_bf16x4(Y2 + r2 * D + co) * g2; }
                ln_row(v, lg, lb, lane);
                if (L == 0) {
#pragma unroll
                    for (int j = 0; j < 4; ++j) st_bf16x4((bf16*)(ws + WS_X2B) + (size_t)m * D + 4 * lane + 256 * j, v[j]);
                } else {
#pragma unroll
                    for (int j = 0; j < 4; ++j) *(f32x4*)(args.out + (size_t)m * D + 4 * lane + 256 * j) = v[j];
                }
            }
        }
        if (L == 0) SEAM(8);
    }
#undef IN
#undef SEAM
}

extern "C" void kernel_launch(void* const* d_in, const int* in_sizes, int n_in, void* d_out, int out_size, void* d_ws, size_t ws_size, hipStream_t stream) {
    static int grid = 0;
    if (grid == 0) {
        if (n_in != 23 || in_sizes[0] != T * D || out_size != T * D || ws_size < WS_END) { fprintf(stderr, "kernel_launch: unexpected shapes / workspace (n_in %d, ws %zu); nothing launched\n", n_in, ws_size); grid = -1; return; }
        int dev = 0, cus = 0, per_cu = 0;
        if (hipGetDevice(&dev) != hipSuccess || hipDeviceGetAttribute(&cus, hipDeviceAttributeMultiprocessorCount, dev) != hipSuccess) { grid = -1; return; }
        if (hipFuncSetAttribute((const void*)fwd_kernel, hipFuncAttributeMaxDynamicSharedMemorySize, LDS_BYTES) != hipSuccess) { fprintf(stderr, "kernel_launch: hipFuncSetAttribute failed\n"); grid = -1; return; }
        if (hipOccupancyMaxActiveBlocksPerMultiprocessor(&per_cu, (const void*)fwd_kernel, 512, LDS_BYTES) != hipSuccess || per_cu < 1) fprintf(stderr, "kernel_launch: occupancy query reports %d\n", per_cu);
        (void)hipGetLastError();
        grid = cus;
    }
    if (grid < 0) return;
    if (hipMemsetAsync((char*)d_ws + WS_CTL, 0, CTL_ZERO_BYTES, stream) != hipSuccess) return;
    Args a{};
    for (int i = 0; i < 23; ++i) a.in[i] = (const float*)d_in[i];
    a.out = (float*)d_out; a.ws = (unsigned char*)d_ws;
    if (MK_N_LAUNCHES == 1) { a.ph_lo = 0; a.ph_hi = NPHASE; hipLaunchKernelGGL(fwd_kernel, dim3(grid), dim3(512), LDS_BYTES, stream, a); }
    else for (int p = 0; p < NPHASE; ++p) { a.ph_lo = p; a.ph_hi = p + 1; hipLaunchKernelGGL(fwd_kernel, dim3(grid), dim3(512), LDS_BYTES, stream, a); }
}
```

```cpp
#include <hip/hip_runtime.h>
#include <cstdio>
#include <cstdint>

#ifndef MK_N_LAUNCHES
#define MK_N_LAUNCHES 1
#endif
#ifndef NAIVE_SCAN
#define NAIVE_SCAN 0
#endif
#ifndef NAIVE_ATTN
#define NAIVE_ATTN 0
#endif

#define LAS __attribute__((address_space(3)))
#define GAS __attribute__((address_space(1)))
typedef unsigned short bf16;
typedef short bf16x8 __attribute__((ext_vector_type(8)));
typedef float f32x4 __attribute__((ext_vector_type(4)));
typedef float f32x2 __attribute__((ext_vector_type(2)));
typedef unsigned u32x4 __attribute__((ext_vector_type(4)));
typedef unsigned u32x2 __attribute__((ext_vector_type(2)));
typedef GAS unsigned gu32;

constexpr int NB = 8, SEQ = 4096, D = 1024, T = NB * SEQ;
constexpr int DI = 2048, NH = 32, HP = 64, NG = 4, NS = 128, CONVD = 3072, INP = 5152, NZX = 5120;
constexpr int AH = 16, AD = 64, LEFTC = 8, MAXREL = 128;
constexpr int NE = 16, DFF = 512;
constexpr float ALPHA = 1.4142135623730951f;
constexpr float LN_EPS = 1e-5f, RMS_EPS = 1e-5f;
constexpr int NPHASE = 17;
constexpr int MAXTILES = 272;

constexpr size_t MiB = 1u << 20;
constexpr size_t WS_CTL = 0, CTL_ZERO_BYTES = 1 * MiB;
constexpr size_t WS_WIN = 1 * MiB;
constexpr size_t WS_WOUT = 12 * MiB;
constexpr size_t WS_XB = 16 * MiB;
constexpr size_t WS_BCACT = 16 * MiB;
constexpr size_t WS_WGU0 = 16 * MiB, WS_WD0 = 48 * MiB, WS_WQKV = 64 * MiB, WS_WO = 70 * MiB, WS_WGU1 = 72 * MiB, WS_WD1 = 104 * MiB;
constexpr size_t WS_Z = 120 * MiB;
constexpr size_t WS_XBC = 248 * MiB;
constexpr size_t WS_DTRAW = 440 * MiB;
constexpr size_t WS_SSQ = 444 * MiB;
constexpr size_t WS_MIX1 = 248 * MiB;
constexpr size_t WS_X1B = 324 * MiB;
constexpr size_t WS_H0 = 120 * MiB;
constexpr size_t WS_Y20 = 188 * MiB;
constexpr size_t WS_X2B = 120 * MiB;
constexpr size_t WS_QKV = 188 * MiB;
constexpr size_t WS_AO = 380 * MiB;
constexpr size_t WS_MIX2 = 188 * MiB;
constexpr size_t WS_X3B = 256 * MiB;
constexpr size_t WS_H1 = 320 * MiB;
constexpr size_t WS_Y21 = 120 * MiB;
constexpr size_t WS_LIST = 500 * MiB;
constexpr size_t WS_INFO = 504 * MiB;
constexpr size_t WS_END = 512 * MiB;
constexpr int CW_TMO = 0;
constexpr int CW_CNT = 1024;
constexpr int CW_BAR = 4096;

constexpr int RING_BYTES = 131072;
constexpr int LDSCTL_OFF = RING_BYTES, MISC_OFF = LDSCTL_OFF + 320;
constexpr int TOKL_OFF = LDSCTL_OFF + 1024;
constexpr int MOE_OFF = TOKL_OFF + 6 * 1024;
constexpr int LDS_BYTES = 147456;

#define RLX_AGENT __ATOMIC_RELAXED, __HIP_MEMORY_SCOPE_AGENT
#define LDS_WAIT() asm volatile("s_waitcnt lgkmcnt(0)" ::: "memory")
#define VM_WAIT() asm volatile("s_waitcnt vmcnt(0)" ::: "memory")

__device__ __forceinline__ unsigned f2bf(float f) { unsigned u = __builtin_bit_cast(unsigned, f); return (u + 0x7fffu + ((u >> 16) & 1u)) >> 16; }
__device__ __forceinline__ unsigned pk2(float lo, float hi) { return f2bf(lo) | (f2bf(hi) << 16); }
__device__ __forceinline__ float bf2f(unsigned short b) { return __builtin_bit_cast(float, ((unsigned)b) << 16); }
__device__ __forceinline__ float bflo(unsigned w) { return __builtin_bit_cast(float, w << 16); }
__device__ __forceinline__ float bfhi(unsigned w) { return __builtin_bit_cast(float, w & 0xffff0000u); }
__device__ __forceinline__ float silu_f(float v) { return v / (1.f + __expf(-v)); }
__device__ __forceinline__ float wave_sum(float v) {
#pragma unroll
    for (int o = 1; o < 64; o <<= 1) v += __shfl_xor(v, o);
    return v;
}

namespace pg8 {
constexpr int BM = 256, BK = 64, HALF = 128, HTB = HALF * BK * 2, STAGE_BYTES = 8 * HTB;
__device__ __forceinline__ int lds_byte(int r, int c) { const int st = (r >> 4) * 2 + (c >> 5), rr = r & 15, cc = c & 31, ob = rr * 64 + cc * 2; return st * 1024 + (ob ^ (((ob >> 9) & 1) << 5)); }
__device__ __forceinline__ void stage_rc(int b, int& R, int& C) { const int st = b / 1024, sb = b % 1024, swz = sb ^ (((sb >> 9) & 1) << 5); R = (st >> 1) * 16 + swz / 64; C = (st & 1) * 32 + (swz % 64) / 2; }
__device__ __forceinline__ int perm32(int rho) { const int n = rho >> 4, i = rho & 15; return 8 * (i >> 2) + 4 * n + (i & 3); }
__device__ __forceinline__ unsigned cvt_pk_bf16(float lo, float hi) { unsigned r; asm volatile("v_cvt_pk_bf16_f32 %0, %1, %2" : "=v"(r) : "v"(lo), "v"(hi)); return r; }

struct Unit { int pm, pn, bt, e; };

template <class Epi, class Sched>
__device__ __forceinline__ void gemm_phase(LAS unsigned char* lds, const bf16* A, const bf16* Bt, int K, const Sched& S, const Epi& E) {
    int tid = threadIdx.x; asm volatile("" : "+v"(tid));
    const int wid = __builtin_amdgcn_readfirstlane(tid >> 6), lane = tid & 63, wr = wid >> 2, wc = wid & 3, fr = lane & 15, fq = lane >> 4;
    const int nt = K / BK;
    int Rr[2], Cc[2]; unsigned voffB[2];
#pragma unroll
    for (int i = 0; i < 2; ++i) { stage_rc(tid * 16 + i * 8192, Rr[i], Cc[i]); const int Rb = (Rr[i] & ~31) + perm32(Rr[i] & 31); voffB[i] = (unsigned)(Rb * K + Cc[i]) * 2u; }
    const size_t kstep = (size_t)(BK * 2);
    const size_t hstep = (size_t)HALF * K * 2;
    const size_t tstep = 2 * hstep;
    const unsigned ldsw = (unsigned)wid * 1024u;
    const int aoff = lds_byte(wr * 64 + fr, fq * 8), boff = lds_byte(wc * 32 + fr, fq * 8);
#define PG8_SA(b, h) (((b) * 2 + (h)) * HTB)
#define PG8_SB(b, h) ((4 + (b) * 2 + (h)) * HTB)
#define PG8_STAGE(bufoff, gbase, voff) do { _Pragma("unroll") for (int _i = 0; _i < 2; ++_i) \
        __builtin_amdgcn_global_load_lds((const unsigned*)((const char*)(gbase) + (voff)[_i]), (LAS unsigned*)(lds + (bufoff) + ldsw + _i * 8192), 16, 0, 0); } while (0)
#define PG8_LDA(dst, b, h) do { _Pragma("unroll") for (int m = 0; m < 4; ++m) _Pragma("unroll") for (int k = 0; k < 2; ++k) dst[m][k] = *(const LAS bf16x8*)(lds + PG8_SA(b, h) + aoff + m * 2048 + k * 1024); } while (0)
#define PG8_LDB(dst, b, h) do { _Pragma("unroll") for (int n = 0; n < 2; ++n) _Pragma("unroll") for (int k = 0; k < 2; ++k) dst[n][k] = *(const LAS bf16x8*)(lds + PG8_SB(b, h) + boff + n * 2048 + k * 1024); } while (0)
#define PG8_MMA(ai, bj, At, Bt_) do { __builtin_amdgcn_s_setprio(1); _Pragma("unroll") for (int m = 0; m < 4; ++m) _Pragma("unroll") for (int n = 0; n < 2; ++n) _Pragma("unroll") for (int k = 0; k < 2; ++k) \
        acc[ai][bj][m][n] = __builtin_amdgcn_mfma_f32_16x16x32_bf16(Bt_[n][k], At[m][k], acc[ai][bj][m][n], 0, 0, 0); __builtin_amdgcn_s_setprio(0); } while (0)
#define PG8_WAIT_V(n) asm volatile("s_waitcnt vmcnt(" #n ")" ::: "memory")
#define PG8_WAIT_L(n) asm volatile("s_waitcnt lgkmcnt(" #n ")" ::: "memory")
#define PG8_BAR __builtin_amdgcn_s_barrier()
#define PG8_SCHED __builtin_amdgcn_sched_barrier(0)
    Unit cur, nxt; int ui = 0;
    if (!S.next(0, cur)) return;
    f32x4 acc[2][2][4][2];
#pragma unroll
    for (int a = 0; a < 2; ++a)
#pragma unroll
        for (int b = 0; b < 2; ++b)
#pragma unroll
            for (int m = 0; m < 4; ++m)
#pragma unroll
                for (int n = 0; n < 2; ++n) acc[a][b][m][n] = (f32x4){0.f, 0.f, 0.f, 0.f};
    bf16x8 At[4][2], B0[2][2], B1[2][2];
    unsigned vA0[2], vA1[2];
#pragma unroll
    for (int i = 0; i < 2; ++i) { vA0[i] = S.a_off(0, cur, 0, Rr[i], Cc[i]); vA1[i] = S.a_off(0, cur, 1, Rr[i], Cc[i]); }
    const char* Ab = (const char*)A;
    const char* cB = (const char*)Bt + (size_t)cur.bt * tstep;
    PG8_STAGE(PG8_SB(0, 0), cB, voffB); PG8_STAGE(PG8_SB(0, 1), cB + hstep, voffB); PG8_STAGE(PG8_SA(0, 0), Ab, vA0); PG8_STAGE(PG8_SA(0, 1), Ab, vA1);
    if (wr == 1) PG8_BAR;
    PG8_WAIT_V(2); PG8_BAR;
    PG8_STAGE(PG8_SB(1, 0), cB + kstep, voffB); PG8_STAGE(PG8_SA(1, 0), Ab + kstep, vA0); PG8_STAGE(PG8_SB(1, 1), cB + hstep + kstep, voffB);
    PG8_WAIT_V(6); PG8_BAR;
    for (;;) {
        const bool has_next = S.next(ui + 1, nxt);
        const char* nB = has_next ? (const char*)Bt + (size_t)nxt.bt * tstep : cB;
        for (int t = 0; t < nt; t += 2) {
            const bool last = (t == nt - 2);
            const char* a1 = Ab + (size_t)(t + 1) * kstep;
            const char* a2 = last ? Ab : Ab + (size_t)(t + 2) * kstep; const char* b2 = last ? nB : cB + (size_t)(t + 2) * kstep;
            const char* a3 = a2 + kstep; const char* b3 = b2 + kstep;
            unsigned v20[2], v21[2];
#pragma unroll
            for (int i = 0; i < 2; ++i) { v20[i] = vA0[i]; v21[i] = vA1[i]; }
            if (last && has_next) {
#pragma unroll
                for (int i = 0; i < 2; ++i) { v20[i] = S.a_off(ui + 1, nxt, 0, Rr[i], Cc[i]); v21[i] = S.a_off(ui + 1, nxt, 1, Rr[i], Cc[i]); } }
            PG8_LDB(B0, 0, 0); PG8_LDB(B1, 0, 1); PG8_SCHED; PG8_LDA(At, 0, 0); PG8_STAGE(PG8_SA(1, 1), a1, vA1);
            PG8_WAIT_V(8); PG8_WAIT_L(0); PG8_BAR; PG8_MMA(0, 0, At, B0); PG8_MMA(0, 1, At, B1); PG8_BAR; PG8_SCHED;
            PG8_LDA(At, 0, 1); PG8_STAGE(PG8_SB(0, 0), b2, voffB); PG8_STAGE(PG8_SB(0, 1), b2 + hstep, voffB); PG8_STAGE(PG8_SA(0, 0), a2, v20);
            PG8_WAIT_V(8); PG8_WAIT_L(0); PG8_BAR; PG8_MMA(1, 0, At, B0); PG8_MMA(1, 1, At, B1); PG8_BAR; PG8_SCHED;
            PG8_LDB(B0, 1, 0); PG8_LDB(B1, 1, 1); PG8_SCHED; PG8_LDA(At, 1, 0); PG8_STAGE(PG8_SA(0, 1), a2, v21);
            PG8_WAIT_V(8); PG8_WAIT_L(0); PG8_BAR; PG8_MMA(0, 0, At, B0); PG8_MMA(0, 1, At, B1); PG8_BAR; PG8_SCHED;
            PG8_LDA(At, 1, 1); PG8_STAGE(PG8_SB(1, 0), b3, voffB); PG8_STAGE(PG8_SB(1, 1), b3 + hstep, voffB); PG8_STAGE(PG8_SA(1, 0), a3, v20);
            PG8_WAIT_V(8); PG8_WAIT_L(0); PG8_BAR; PG8_MMA(1, 0, At, B0); PG8_MMA(1, 1, At, B1); PG8_BAR; PG8_SCHED;
        }
        if (wr == 0) PG8_BAR;
        E(acc, cur, wr, wc, fr, fq);
        if (!has_next) break;
#pragma unroll
        for (int a = 0; a < 2; ++a)
#pragma unroll
            for (int b = 0; b < 2; ++b)
#pragma unroll
                for (int m = 0; m < 4; ++m)
#pragma unroll
                    for (int n = 0; n < 2; ++n) acc[a][b][m][n] = (f32x4){0.f, 0.f, 0.f, 0.f};
        cur = nxt; cB = nB; ++ui;
#pragma unroll
        for (int i = 0; i < 2; ++i) { vA0[i] = S.a_off(ui, cur, 0, Rr[i], Cc[i]); vA1[i] = S.a_off(ui, cur, 1, Rr[i], Cc[i]); }
        if (wr == 1) PG8_BAR;
    }
    PG8_WAIT_V(0);
    PG8_BAR;
#undef PG8_SA
#undef PG8_SB
#undef PG8_STAGE
#undef PG8_LDA
#undef PG8_LDB
#undef PG8_MMA
#undef PG8_WAIT_V
#undef PG8_WAIT_L
#undef PG8_BAR
#undef PG8_SCHED
}

struct DenseOrder {
    int nM, nN, nwg, G, c, lda;
    __device__ void init(int M, int N, int G_, int c_, int lda_) { nM = M / BM; nN = N / BM; nwg = nM * nN; G = G_; c = c_; lda = lda_; }
    __device__ __forceinline__ bool next(int i, Unit& u) const {
        const long L = (long)i * G + c; if (L >= nwg) return false;
        int wgid = (int)L; { const int q = nwg / 8, r = nwg % 8, xcd = wgid % 8, off = wgid / 8; wgid = (xcd < r ? xcd * (q + 1) : r * (q + 1) + (xcd - r) * q) + off; }
        const int nig = 8 * nN, gid = wgid / nig, fm = gid * 8, gsz = (nM - fm) < 8 ? (nM - fm) : 8;
        u.pm = fm + ((wgid % nig) % gsz); u.pn = (wgid % nig) / gsz; u.bt = u.pn; u.e = 0; return true;
    }
    __device__ __forceinline__ unsigned a_off(int, const Unit& u, int h, int R, int C) const { return (unsigned)((u.pm * BM + h * HALF + R) * lda + C) * 2u; }
};
template <bool GATHER> struct MoeOrder {
    const LAS int* ts;
    const LAS int* tokL;
    int G, c, lda;
    __device__ __forceinline__ bool next(int i, Unit& u) const {
        const int L = i * G + c; const int ntile = __builtin_amdgcn_readfirstlane(ts[16]);
        if (L >= ntile * 4) return false;
        const int rt = L >> 2; int e = 0;
#pragma unroll
        for (int j = 1; j < 16; ++j) e += (rt >= ts[j]) ? 1 : 0;
        e = __builtin_amdgcn_readfirstlane(e);
        u.pm = rt; u.pn = L & 3; u.e = e; u.bt = e * 4 + (L & 3); return true;
    }
    __device__ __forceinline__ unsigned a_off(int ui, const Unit& u, int h, int R, int C) const {
        if (GATHER) { const int tok = tokL[ui * 256 + h * HALF + R]; return (unsigned)(tok * lda + C) * 2u; }
        return (unsigned)((u.pm * BM + h * HALF + R) * lda + C) * 2u;
    }
};

struct EpiPlain {
    bf16* O; int ldc; const float* bias; int scale_cols; float scale0;
    __device__ __forceinline__ void operator()(const f32x4 (&acc)[2][2][4][2], const Unit& u, int wr, int wc, int fr, int fq) const {
        const int row0 = u.pm * BM + wr * 64 + fr, col0 = u.pn * BM + wc * 32 + 8 * fq;
        const float sc = (u.pn * BM < scale_cols) ? scale0 : 1.f;
        f32x4 bv[2][2];
#pragma unroll
        for (int bj = 0; bj < 2; ++bj)
#pragma unroll
            for (int n = 0; n < 2; ++n) bv[bj][n] = bias ? *(const f32x4*)(bias + col0 + bj * HALF + 4 * n) : (f32x4){0.f, 0.f, 0.f, 0.f};
#pragma unroll
        for (int ai = 0; ai < 2; ++ai)
#pragma unroll
            for (int m = 0; m < 4; ++m) { bf16* rowp = O + (size_t)(row0 + ai * HALF + m * 16) * ldc + col0;
#pragma unroll
                for (int bj = 0; bj < 2; ++bj) { f32x4 v0 = (acc[ai][bj][m][0] + bv[bj][0]) * sc, v1 = (acc[ai][bj][m][1] + bv[bj][1]) * sc;
                    u32x4 w; w.x = cvt_pk_bf16(v0[0], v0[1]); w.y = cvt_pk_bf16(v0[2], v0[3]); w.z = cvt_pk_bf16(v1[0], v1[1]); w.w = cvt_pk_bf16(v1[2], v1[3]);
                    *(u32x4*)(rowp + bj * HALF) = w; } }
    }
};
struct EpiInProj {
    bf16* Z; bf16* XBC;
    __device__ __forceinline__ void operator()(const f32x4 (&acc)[2][2][4][2], const Unit& u, int wr, int wc, int fr, int fq) const {
        const int row0 = u.pm * BM + wr * 64 + fr; int colt = u.pn * BM; bf16* base; int ldc;
        if (colt < DI) { base = Z; ldc = DI; } else { base = XBC; ldc = CONVD; colt -= DI; }
        const int col0 = colt + wc * 32 + 8 * fq;
#pragma unroll
        for (int ai = 0; ai < 2; ++ai)
#pragma unroll
            for (int m = 0; m < 4; ++m) { bf16* rowp = base + (size_t)(row0 + ai * HALF + m * 16) * ldc + col0;
#pragma unroll
                for (int bj = 0; bj < 2; ++bj) { const f32x4 v0 = acc[ai][bj][m][0], v1 = acc[ai][bj][m][1];
                    u32x4 w; w.x = cvt_pk_bf16(v0[0], v0[1]); w.y = cvt_pk_bf16(v0[2], v0[3]); w.z = cvt_pk_bf16(v1[0], v1[1]); w.w = cvt_pk_bf16(v1[2], v1[3]);
                    *(u32x4*)(rowp + bj * HALF) = w; } }
    }
};
struct EpiGateUp {
    bf16* Hh;
    __device__ __forceinline__ void operator()(const f32x4 (&acc)[2][2][4][2], const Unit& u, int wr, int wc, int fr, int fq) const {
        const int row0 = u.pm * BM + wr * 64 + fr, col0 = (u.pn * BM + wc * 32 + 8 * fq) >> 1;
#pragma unroll
        for (int ai = 0; ai < 2; ++ai)
#pragma unroll
            for (int m = 0; m < 4; ++m) { bf16* rowp = Hh + (size_t)(row0 + ai * HALF + m * 16) * DFF + col0;
#pragma unroll
                for (int bj = 0; bj < 2; ++bj) { const f32x4 g = acc[ai][bj][m][0], up = acc[ai][bj][m][1];
                    u32x2 w; w.x = cvt_pk_bf16(silu_f(g[0]) * up[0], silu_f(g[1]) * up[1]); w.y = cvt_pk_bf16(silu_f(g[2]) * up[2], silu_f(g[3]) * up[3]);
                    *(u32x2*)(rowp + bj * (HALF / 2)) = w; } }
    }
};
}

#define XB_TMO      128
#define XB_XCNT(j)  (256  + 64 * (j))
#define XB_XSUB(j)  (1280 + 64 * (j))
#define XB_XGEN(j)  (2304 + 64 * (j))
#define XB_TOP      3328
#define XB_TOPGEN   3392
#define XCD_BAR_WORDS 3456
#define XB_SPIN_CAP (1u << 18)
__device__ __forceinline__ unsigned xb_ld(unsigned* p)              { return __hip_atomic_load(p, __ATOMIC_RELAXED, __HIP_MEMORY_SCOPE_AGENT); }
__device__ __forceinline__ unsigned xb_add(unsigned* p, unsigned v) { return __hip_atomic_fetch_add(p, v, __ATOMIC_RELAXED, __HIP_MEMORY_SCOPE_AGENT); }
__device__ __forceinline__ unsigned xb_xcc_id() { return (unsigned)__builtin_amdgcn_s_getreg((3 << 11) | 20) & 0xFu; }
#define XB_SPIN(cond, bar) do { unsigned _sp = 0; while (cond) { __builtin_amdgcn_s_sleep(1); \
    if ((++_sp & 255u) == 0u) { if (xb_ld(&(bar)[XB_TMO])) break; if (_sp > XB_SPIN_CAP) { atomicAdd(&(bar)[XB_TMO], 1u); break; } } } } while (0)
struct XcdBarrier { unsigned* bar; unsigned x; volatile LAS unsigned* st; };
__device__ __forceinline__ XcdBarrier xcd_barrier_post(unsigned* bar, volatile LAS unsigned* st) {
    XcdBarrier b; b.bar = bar; b.x = xb_xcc_id(); b.st = st;
    if (threadIdx.x == 0) (void)xb_add(&bar[XB_XCNT(b.x)], 1u);
    return b;
}
__device__ __forceinline__ void xcd_barrier_complete(unsigned* bar, unsigned x, unsigned& nloc, unsigned& nx) {
    const unsigned G = gridDim.x * gridDim.y * gridDim.z;
    unsigned sum, cnt, mine, sp = 0u;
    for (;;) {
        sum = 0u; cnt = 0u; mine = 0u;
#pragma unroll
        for (unsigned j = 0; j < 16; ++j) { const unsigned c = xb_ld(&bar[XB_XCNT(j)]); sum += c; cnt += (c > 0u) ? 1u : 0u; mine = (j == x) ? c : mine; }
        if (sum == G) break;
        __builtin_amdgcn_s_sleep(1);
        if ((++sp & 255u) == 0u) { if (xb_ld(&bar[XB_TMO])) break; if (sp > XB_SPIN_CAP) { atomicAdd(&bar[XB_TMO], 1u); break; } }
    }
    nloc = mine > 0u ? mine : 1u; nx = cnt > 0u ? cnt : 1u;
}
__device__ __forceinline__ void xcd_barrier(const XcdBarrier& b) {
    asm volatile("s_waitcnt vmcnt(0)" ::: "memory");
    __syncthreads();
    if (threadIdx.x == 0) {
        unsigned* bar = b.bar;
        __builtin_amdgcn_s_waitcnt(0);
        unsigned nloc = b.st[0], nx = b.st[1];
        if (nloc == 0u) { xcd_barrier_complete(bar, b.x, nloc, nx); b.st[0] = nloc; b.st[1] = nx; }
        const unsigned old = xb_add(&bar[XB_XSUB(b.x)], 1u);
        const unsigned gen = old / nloc;
        if (old + 1u == (gen + 1u) * nloc) {
            __builtin_amdgcn_fence(__ATOMIC_RELEASE, "agent");
            asm volatile("s_waitcnt vmcnt(0)" ::: "memory");
            const unsigned og = xb_add(&bar[XB_TOP], 1u);
            const unsigned tg = og / nx;
            if (og + 1u == (tg + 1u) * nx) xb_add(&bar[XB_TOPGEN], 1u);
            else XB_SPIN(xb_ld(&bar[XB_TOPGEN]) == tg, bar);
            __builtin_amdgcn_fence(__ATOMIC_ACQUIRE, "agent");
            xb_add(&bar[XB_XGEN(b.x)], 1u);
            asm volatile("s_waitcnt vmcnt(0)" ::: "memory");
        } else {
            XB_SPIN(xb_ld(&bar[XB_XGEN(b.x)]) == gen, bar);
            __builtin_amdgcn_fence(__ATOMIC_ACQUIRE, "agent");
            asm volatile("s_waitcnt vmcnt(0)" ::: "memory");
        }
    }
    __syncthreads();
}

struct Args { const float* in[23]; float* out; unsigned char* ws; int ph_lo, ph_hi; };

struct Frame {
    LAS unsigned char* lds;
    int tid, lane, wave, vcu, G;
};

__device__ __forceinline__ void transpose_item(const float* W, int K, int N, bf16* WT, int row_off, int mode, const float* kscale, LAS float* scr, int item, int lane) {
    const int nblk = N / 32, kb = item / nblk, nb = item % nblk, k0 = 64 * kb, n0 = 32 * nb;
#pragma unroll 8
    for (int i = 0; i < 32; ++i) { const int kk = 2 * i + (lane >> 5); scr[kk * 33 + (lane & 31)] = W[(size_t)(k0 + kk) * N + n0 + (lane & 31)]; }
    LDS_WAIT(); asm volatile("" ::: "memory");
    const int c = lane & 7;
    float ks[8];
#pragma unroll
    for (int q = 0; q < 8; ++q) ks[q] = kscale ? kscale[k0 + 8 * c + q] : 1.f;
#pragma unroll
    for (int j = 0; j < 4; ++j) { const int n = (lane >> 3) + 8 * j; const LAS float* s = scr + (8 * c) * 33 + n;
        u32x4 o; o.x = pk2(s[0 * 33] * ks[0], s[1 * 33] * ks[1]); o.y = pk2(s[2 * 33] * ks[2], s[3 * 33] * ks[3]); o.z = pk2(s[4 * 33] * ks[4], s[5 * 33] * ks[5]); o.w = pk2(s[6 * 33] * ks[6], s[7 * 33] * ks[7]);
        const int ng = n0 + n; const int dr = (mode == 0) ? ng : (8 * (ng >> 2) + (ng & 3) + (mode == 2 ? 4 : 0));
        *(GAS u32x4*)(WT + (size_t)(row_off + dr) * K + k0 + 8 * c) = o; }
    LDS_WAIT(); asm volatile("" ::: "memory");
}

__device__ __forceinline__ void ln_row(f32x4 (&v)[4], const float* g, const float* b, int lane) {
    float s = 0.f;
#pragma unroll
    for (int j = 0; j < 4; ++j) s += (v[j].x + v[j].y) + (v[j].z + v[j].w);
    const float mean = wave_sum(s) * (1.f / D); float s2 = 0.f;
#pragma unroll
    for (int j = 0; j < 4; ++j) { v[j] = v[j] - mean; s2 += (v[j].x * v[j].x + v[j].y * v[j].y) + (v[j].z * v[j].z + v[j].w * v[j].w); }
    const float rstd = 1.f / sqrtf(wave_sum(s2) * (1.f / D) + LN_EPS);
#pragma unroll
    for (int j = 0; j < 4; ++j) { const f32x4 gg = *(const f32x4*)(g + 4 * lane + 256 * j), bb = *(const f32x4*)(b + 4 * lane + 256 * j); v[j] = v[j] * rstd * gg + bb; }
}
__device__ __forceinline__ f32x4 ld_bf16x4(const bf16* p) { const u32x2 w = *(const u32x2*)p; return (f32x4){bflo(w.x), bfhi(w.x), bflo(w.y), bfhi(w.y)}; }
__device__ __forceinline__ void st_bf16x4(bf16* p, f32x4 v) { u32x2 w; w.x = pk2(v.x, v.y); w.y = pk2(v.z, v.w); *(u32x2*)p = w; }

#ifndef PH_MASK
#define PH_MASK 0x1ffff
#endif
#define IN(k) (((PH_MASK >> (k)) & 1) && lo <= (k) && (k) < hi)
#define SEAM(k) do { if (IN(k) && IN((k) + 1)) xcd_barrier(bar); } while (0)
#define PH_LOCALS \
    int tid = threadIdx.x; asm volatile("" : "+v"(tid)); const int lane = tid & 63, wave = __builtin_amdgcn_readfirstlane(tid >> 6); \
    unsigned char* ws = args.ws; asm volatile("" : "+s"(ws)); \
    const int gw = F.vcu * 8 + wave, NGW = F.G * 8; (void)lane; (void)gw; (void)NGW; \
    const float* x_in = args.in[0]; (void)x_in; \
    bf16* Wt_in = (bf16*)(ws + WS_WIN); bf16* Wt_out = (bf16*)(ws + WS_WOUT); (void)Wt_in; (void)Wt_out; \
    bf16* XB = (bf16*)(ws + WS_XB); bf16* Zb = (bf16*)(ws + WS_Z); bf16* XBC = (bf16*)(ws + WS_XBC); (void)XB; (void)Zb; (void)XBC; \
    float* DTRAW = (float*)(ws + WS_DTRAW); float* SSQ = (float*)(ws + WS_SSQ); (void)DTRAW; (void)SSQ; \
    int* LIST = (int*)(ws + WS_LIST); unsigned* INFO = (unsigned*)(ws + WS_INFO); (void)LIST; (void)INFO;


template <int L>
__device__ __forceinline__ void layer_tail(const Args& args, const Frame& F, const XcdBarrier& bar, const int lo, const int hi) {
    const int pb = L ? 13 : 6;
#define LAYER_LOCALS \
    const bf16* MIX = (const bf16*)(ws + (L ? WS_MIX2 : WS_MIX1)); (void)MIX; \
    bf16* XN = (bf16*)(ws + (L ? WS_X3B : WS_X1B)); (void)XN;            \
    bf16* HB = (bf16*)(ws + (L ? WS_H1 : WS_H0)); (void)HB; \
    bf16* Y2 = (bf16*)(ws + (L ? WS_Y21 : WS_Y20)); (void)Y2; \
    gu32* gcnt = (gu32*)(ws + WS_CTL) + CW_CNT + 64 * L; (void)gcnt; \
    LAS int* tokL = (LAS int*)(F.lds + TOKL_OFF); (void)tokL; \
    LAS int* mo = (LAS int*)(F.lds + MOE_OFF); (void)mo;

    if (IN(pb)) { PH_LOCALS LAYER_LOCALS
        const float* lg = args.in[19] + L * D; const float* lb = args.in[20] + L * D;
        const float* rw = args.in[14]; const float* rbias = args.in[15];
        LAS float* rwl = (LAS float*)F.lds;
        LAS int* lcnt = (LAS int*)(F.lds + 65536);
        LAS int* rec = (LAS int*)(F.lds + 65536 + 256);
        for (int i = tid; i < D * NE; i += 512) rwl[(i & 15) * D + (i >> 4)] = rw[i];
        if (tid < 32) lcnt[tid] = 0;
        __syncthreads();
        int li = 0;
        f32x4 nx[4]; u32x2 nm[4];
#define RT_LOAD(mm) do { _Pragma("unroll") for (int j = 0; j < 4; ++j) { nm[j] = *(const u32x2*)(MIX + (size_t)(mm) * D + 4 * lane + 256 * j); \
            if (L == 0) nx[j] = *(const f32x4*)(x_in + (size_t)(mm) * D + 4 * lane + 256 * j); \
            else { const u32x2 t_ = *(const u32x2*)((const bf16*)(ws + WS_X2B) + (size_t)(mm) * D + 4 * lane + 256 * j); nx[j] = (f32x4){bflo(t_.x), bfhi(t_.x), bflo(t_.y), bfhi(t_.y)}; } } } while (0)
        if (gw < T) RT_LOAD(gw);
        for (int m = gw; m < T && li < 32; m += NGW, ++li) {
            f32x4 v[4];
#pragma unroll
            for (int j = 0; j < 4; ++j) v[j] = nx[j] * ALPHA + (f32x4){bflo(nm[j].x), bfhi(nm[j].x), bflo(nm[j].y), bfhi(nm[j].y)};
            if (m + NGW < T) RT_LOAD(m + NGW);
            ln_row(v, lg, lb, lane);
#pragma unroll
            for (int j = 0; j < 4; ++j) st_bf16x4(XN + (size_t)m * D + 4 * lane + 256 * j, v[j]);
            float lgt[NE];
#pragma unroll
            for (int e = 0; e < NE; ++e) { float a_ = 0.f;
#pragma unroll
                for (int j = 0; j < 4; ++j) { const f32x4 w = *(const LAS f32x4*)(rwl + e * D + 256 * j + 4 * lane); a_ += (v[j].x * w.x + v[j].y * w.y) + (v[j].z * w.z + v[j].w * w.w); }
                lgt[e] = a_; }
            { float t8[8], t4[4], t2[2], t1;
#pragma unroll
              for (int e = 0; e < 8; ++e) { const bool up = (lane & 32) != 0; const float snd = up ? lgt[e] : lgt[e + 8], kp = up ? lgt[e + 8] : lgt[e]; t8[e] = kp + __shfl_xor(snd, 32); }
#pragma unroll
              for (int e = 0; e < 4; ++e) { const bool up = (lane & 16) != 0; const float snd = up ? t8[e] : t8[e + 4], kp = up ? t8[e + 4] : t8[e]; t4[e] = kp + __shfl_xor(snd, 16); }
#pragma unroll
              for (int e = 0; e < 2; ++e) { const bool up = (lane & 8) != 0; const float snd = up ? t4[e] : t4[e + 2], kp = up ? t4[e + 2] : t4[e]; t2[e] = kp + __shfl_xor(snd, 8); }
              { const bool up = (lane & 4) != 0; const float snd = up ? t2[0] : t2[1], kp = up ? t2[1] : t2[0]; t1 = kp + __shfl_xor(snd, 4); }
              t1 += __shfl_xor(t1, 2); t1 += __shfl_xor(t1, 1);
#pragma unroll
              for (int e = 0; e < NE; ++e) lgt[e] = __builtin_bit_cast(float, __builtin_amdgcn_readlane(__builtin_bit_cast(int, t1), 4 * e)); }
            float mxl = lgt[0];
#pragma unroll
            for (int e = 1; e < NE; ++e) mxl = fmaxf(mxl, lgt[e]);
            float sc[NE], sel[NE], den = 0.f;
#pragma unroll
            for (int e = 0; e < NE; ++e) { sc[e] = __expf(lgt[e] - mxl); den += sc[e]; }
            const float iden = 1.f / den;
#pragma unroll
            for (int e = 0; e < NE; ++e) { sc[e] *= iden; sel[e] = sc[e] + rbias[e]; }
            int bg = 0; float bgs = -1e30f;
#pragma unroll
            for (int g = 0; g < 4; ++g) { const float a = sel[4 * g], b2 = sel[4 * g + 1], c2 = sel[4 * g + 2], d2 = sel[4 * g + 3];
                const float tot = a + b2 + c2 + d2, mn1 = fminf(fminf(a, b2), fminf(c2, d2));
                float hi1 = fmaxf(fmaxf(a, b2), fmaxf(c2, d2));
                const float m01 = fminf(a, b2), m23 = fminf(c2, d2), M01 = fmaxf(a, b2), M23 = fmaxf(c2, d2);
                const float second = fmaxf(fminf(M01, M23), fmaxf(m01, m23));
                (void)tot; (void)mn1;
                const float gs = hi1 + second;
                if (gs > bgs) { bgs = gs; bg = g; } }
            float s0 = 0.f, s1 = 0.f, s2 = 0.f, s3 = 0.f, p0 = 0.f, p1 = 0.f, p2 = 0.f, p3 = 0.f;
#pragma unroll
            for (int g = 0; g < 4; ++g) if (g == bg) { s0 = sel[4 * g]; s1 = sel[4 * g + 1]; s2 = sel[4 * g + 2]; s3 = sel[4 * g + 3]; p0 = sc[4 * g]; p1 = sc[4 * g + 1]; p2 = sc[4 * g + 2]; p3 = sc[4 * g + 3]; }
            int i1 = 0; float b1 = s0, q1 = p0;
            if (s1 > b1) { b1 = s1; i1 = 1; q1 = p1; } if (s2 > b1) { b1 = s2; i1 = 2; q1 = p2; } if (s3 > b1) { b1 = s3; i1 = 3; q1 = p3; }
            int i2 = -1; float b2v = -1e30f, q2 = 0.f;
            if (i1 != 0 && s0 > b2v) { b2v = s0; i2 = 0; q2 = p0; } if (i1 != 1 && s1 > b2v) { b2v = s1; i2 = 1; q2 = p1; }
            if (i1 != 2 && s2 > b2v) { b2v = s2; i2 = 2; q2 = p2; } if (i1 != 3 && s3 > b2v) { b2v = s3; i2 = 3; q2 = p3; }
            const int e1 = 4 * bg + i1, e2 = 4 * bg + i2; const float gsum = q1 + q2, g1 = q1 / gsum, g2 = q2 / gsum;
            if (lane == 0) {
                const int r1 = atomicAdd((int*)(lcnt + e1), 1), r2 = atomicAdd((int*)(lcnt + e2), 1);
                LAS int* rc = rec + (wave * 32 + li) * 8; rc[0] = e1; rc[1] = r1; rc[2] = e2; rc[3] = r2; rc[4] = __builtin_bit_cast(int, g1); rc[5] = __builtin_bit_cast(int, g2);
            }
        }
        __syncthreads();
        if (tid < NE) lcnt[16 + tid] = (int)__hip_atomic_fetch_add(gcnt + tid, (unsigned)lcnt[tid], RLX_AGENT);
        __syncthreads();
        li = 0;
        for (int m = gw; m < T; m += NGW, ++li) {
            if (lane == 0) {
                const LAS int* rc = rec + (wave * 32 + li) * 8;
                const int e1 = rc[0], e2 = rc[2], sl1 = lcnt[16 + e1] + rc[1], sl2 = lcnt[16 + e2] + rc[3];
                LIST[(size_t)e1 * T + sl1] = m; LIST[(size_t)e2 * T + sl2] = m;
                u32x4 w0; w0.x = (unsigned)e1; w0.y = (unsigned)sl1; w0.z = (unsigned)e2; w0.w = (unsigned)sl2;
                *(u32x4*)(INFO + (size_t)m * 8) = w0; INFO[(size_t)m * 8 + 4] = (unsigned)rc[4]; INFO[(size_t)m * 8 + 5] = (unsigned)rc[5];
            }
        }
    }
    SEAM(pb);

    if (IN(pb + 1) || IN(pb + 2) || IN(pb + 3)) { PH_LOCALS LAYER_LOCALS
        __syncthreads();
        if (tid == 0) { int acc_ = 0; for (int e = 0; e < NE; ++e) { const int c = (int)__hip_atomic_load(gcnt + e, RLX_AGENT); mo[e] = acc_; mo[32 + e] = c; acc_ += (c + 255) >> 8; } mo[16] = acc_; }
        __syncthreads();
    }
    if (IN(pb + 1)) { PH_LOCALS LAYER_LOCALS
        pg8::MoeOrder<true> S{mo, tokL, F.G, F.vcu, D};
        { pg8::Unit u; for (int ui = 0; ui < 6 && S.next(ui, u); ++ui) { if (tid < 256) { const int r = (u.pm - mo[u.e]) * 256 + tid, c = mo[32 + u.e]; tokL[ui * 256 + tid] = LIST[(size_t)u.e * T + (r < c ? r : c - 1)]; } } }
        __syncthreads();
        pg8::EpiGateUp E{HB};
        pg8::gemm_phase<pg8::EpiGateUp, pg8::MoeOrder<true>>(F.lds, XN, (const bf16*)(ws + (L ? WS_WGU1 : WS_WGU0)), D, S, E);
    }
    SEAM(pb + 1);
    if (IN(pb + 2)) { PH_LOCALS LAYER_LOCALS
        pg8::MoeOrder<false> S{mo, tokL, F.G, F.vcu, DFF};
        pg8::EpiPlain E{Y2, D, nullptr, 0, 1.f};
        pg8::gemm_phase<pg8::EpiPlain, pg8::MoeOrder<false>>(F.lds, HB, (const bf16*)(ws + (L ? WS_WD1 : WS_WD0)), DFF, S, E);
    }
    SEAM(pb + 2);
    if (IN(pb + 3)) { PH_LOCALS LAYER_LOCALS
        const float* lg = args.in[21] + L * D; const float* lb = args.in[22] + L * D;
        for (int m = gw; m < T; m += NGW) {
            const u32x4 w0 = *(const u32x4*)(INFO + (size_t)m * 8); const float g1 = __builtin_bit_cast(float, INFO[(size_t)m * 8 + 4]), g2 = __builtin_bit_cast(float, INFO[(size_t)m * 8 + 5]);
            const size_t r1 = (size_t)mo[w0.x] * 256 + w0.y, r2 = (size_t)mo[w0.z] * 256 + w0.w;
            f32x4 v[4];
#pragma unroll
            for (int j = 0; j < 4; ++j) { const int co = 4 * lane + 256 * j;
                v[j] = ld_bf16x4(XN + (size_t)m * D + co) * ALPHA + ld_bf16x4(Y2 + r1 * D + co) * g1 + ld_bf16x4(Y2 + r2 * D + co) * g2; }
            ln_row(v, lg, lb, lane);
            if (L == 0) {
#pragma unroll
                for (int j = 0; j < 4; ++j) st_bf16x4((bf16*)(ws + WS_X2B) + (size_t)m * D + 4 * lane + 256 * j, v[j]);
            } else {
#pragma unroll
                for (int j = 0; j < 4; ++j) *(f32x4*)(args.out + (size_t)m * D + 4 * lane + 256 * j) = v[j];
            }
        }
    }
}

__global__ void __launch_bounds__(512, 2) fwd_kernel(Args args) {
    extern __shared__ __attribute__((aligned(16))) unsigned char lds_raw[];
    Frame F;
    F.lds = (LAS unsigned char*)lds_raw;
    F.tid = threadIdx.x; F.lane = F.tid & 63; F.wave = __builtin_amdgcn_readfirstlane(F.tid >> 6);
    F.G = gridDim.x; { const int bx = blockIdx.x; F.vcu = (F.G % 8 == 0) ? (bx % 8) * (F.G / 8) + bx / 8 : bx; }
    unsigned char* ws = args.ws;
    gu32* ctl = (gu32*)(ws + WS_CTL);
    volatile LAS unsigned* MISC = (volatile LAS unsigned*)(F.lds + MISC_OFF);
    for (int u = F.tid; u < (LDS_BYTES - LDSCTL_OFF) / 4; u += 512) ((LAS unsigned*)(F.lds + LDSCTL_OFF))[u] = 0u;
    __syncthreads();
    XcdBarrier bar; bar.bar = (unsigned*)(ctl + CW_BAR); bar.x = 0; bar.st = nullptr;
    if (MK_N_LAUNCHES == 1) bar = xcd_barrier_post((unsigned*)(ctl + CW_BAR), MISC + 8);
    const int lo = args.ph_lo, hi = args.ph_hi;
    if (IN(0)) { PH_LOCALS
        LAS float* scr = (LAS float*)(F.lds + wave * 16384);
        constexpr int I_IN = (D / 64) * (INP / 32), I_OUT = (DI / 64) * (D / 32);
        for (int it = gw; it < I_IN + I_OUT; it += NGW) {
            if (it < I_IN) transpose_item(args.in[1], D, INP, Wt_in, 0, 0, nullptr, scr, it, lane);
            else transpose_item(args.in[8], DI, D, Wt_out, 0, 0, args.in[7], scr, it - I_IN, lane);
        }
        const size_t n8 = (size_t)T * D / 8;
        for (size_t i = (size_t)blockIdx.x * 512 + tid; i < n8; i += (size_t)F.G * 512) {
            const f32x4 a = *(const f32x4*)(x_in + i * 8), b = *(const f32x4*)(x_in + i * 8 + 4);
            u32x4 o; o.x = pk2(a.x, a.y); o.y = pk2(a.z, a.w); o.z = pk2(b.x, b.y); o.w = pk2(b.z, b.w);
            *(u32x4*)(XB + i * 8) = o;
        }
    }
    SEAM(0);

    if (IN(1)) { PH_LOCALS
        pg8::DenseOrder S; S.init(T, NZX, F.G, (int)blockIdx.x, D);
        pg8::EpiInProj E{Zb, XBC};
        pg8::gemm_phase<pg8::EpiInProj, pg8::DenseOrder>(F.lds, XB, Wt_in, D, S, E);
        for (int tile = gw; tile < T / 16; tile += NGW) {
            const int t0 = tile * 16, r = lane & 15, q = lane >> 4;
            const bf16* xp = XB + (size_t)(t0 + r) * D + 8 * q;
            const bf16* w0 = Wt_in + (size_t)(NZX + r) * D + 8 * q; const bf16* w1 = w0 + (size_t)16 * D;
            f32x4 a0 = {0.f, 0.f, 0.f, 0.f}, a1 = {0.f, 0.f, 0.f, 0.f};
#pragma unroll 4
            for (int k0 = 0; k0 < D; k0 += 32) {
                const bf16x8 xv = *(const bf16x8*)(xp + k0), wa = *(const bf16x8*)(w0 + k0), wb = *(const bf16x8*)(w1 + k0);
                a0 = __builtin_amdgcn_mfma_f32_16x16x32_bf16(wa, xv, a0, 0, 0, 0);
                a1 = __builtin_amdgcn_mfma_f32_16x16x32_bf16(wb, xv, a1, 0, 0, 0);
            }
            float* o = DTRAW + (size_t)(t0 + r) * NH + 4 * q;
            *(f32x4*)o = a0; *(f32x4*)(o + 16) = a1;
        }
    }
    SEAM(1);

    if (IN(2)) { PH_LOCALS
        const float* conv_w = args.in[2]; const float* conv_b = args.in[3];
        bf16* BCACT = (bf16*)(ws + WS_BCACT);
        for (int it = blockIdx.x * 512 + tid; it < (T / 8) * 128; it += F.G * 512) {
            const int ch = it & 127, seg = it >> 7, r0 = seg * 8, s0 = r0 & (SEQ - 1), col = DI + 8 * ch;
            u32x4 rw[11];
#pragma unroll
            for (int q = 0; q < 11; ++q) { const int sr = s0 - 3 + q; const int rc = sr < 0 ? 0 : sr; rw[q] = *(const u32x4*)(XBC + (size_t)(r0 - s0 + rc) * CONVD + col); if (sr < 0) rw[q] = (u32x4){0u, 0u, 0u, 0u}; }
#pragma unroll
            for (int hf = 0; hf < 2; ++hf) {
                f32x4 wq[5];
#pragma unroll
                for (int k = 0; k < 4; ++k) wq[k] = *(const f32x4*)(conv_w + k * CONVD + col + 4 * hf);
                wq[4] = *(const f32x4*)(conv_b + col + 4 * hf);
#pragma unroll
                for (int jj = 0; jj < 8; ++jj) { f32x4 aq = wq[4];
#pragma unroll
                    for (int k = 0; k < 4; ++k) { const u32x4 rq = rw[jj + k]; const unsigned a0 = hf ? rq.z : rq.x, a1 = hf ? rq.w : rq.y; aq += wq[k] * (f32x4){bflo(a0), bfhi(a0), bflo(a1), bfhi(a1)}; }
#pragma unroll
                    for (int e = 0; e < 4; ++e) aq[e] = silu_f(aq[e]);
                    u32x2 o_; o_.x = pk2(aq[0], aq[1]); o_.y = pk2(aq[2], aq[3]);
                    *(u32x2*)(BCACT + (size_t)(r0 + jj) * 1024 + 8 * ch + 4 * hf) = o_; }
            }
        }
    }
    SEAM(2);

    if (IN(3)) { PH_LOCALS
#if NAIVE_SCAN
        const float* conv_w = args.in[2]; const float* conv_b = args.in[3]; const float* dt_bias = args.in[4]; const float* a_log = args.in[5]; const float* dsk = args.in[6];
        for (int item = blockIdx.x; item < NB * NH; item += F.G) {
            if (wave >= 2) continue;
            LAS float* sB = (LAS float*)(F.lds + wave * 8192); LAS float* sC = sB + 128; LAS float* cwl = sC + 128;
            const int b = item / NH, h = item % NH, g = h / 8, pp = 32 * wave + (lane & 31), nh = lane >> 5;
            int col[5]; col[0] = h * HP + pp; col[1] = DI + g * NS + lane; col[2] = col[1] + 64; col[3] = DI + NG * NS + g * NS + lane; col[4] = col[3] + 64;
            float hist[5][3];
#pragma unroll
            for (int c = 0; c < 5; ++c) { cwl[(c * 5 + 4) * 64 + lane] = conv_b[col[c]];
#pragma unroll
                for (int k = 0; k < 4; ++k) cwl[(c * 5 + k) * 64 + lane] = conv_w[k * CONVD + col[c]];
#pragma unroll
                for (int k = 0; k < 3; ++k) hist[c][k] = 0.f; }
            LDS_WAIT();
            const float dtb = dt_bias[h], av = -__expf(a_log[h]), dh = dsk[h];
            float hst[64];
#pragma unroll
            for (int n = 0; n < 64; ++n) hst[n] = 0.f;
            for (int t = 0; t < SEQ; ++t) {
                const size_t row = (size_t)b * SEQ + t;
                float v[5];
#pragma unroll
                for (int c = 0; c < 5; ++c) { const float cur = bf2f(XBC[row * CONVD + col[c]]);
                    float a = cwl[(c * 5 + 4) * 64 + lane] + cwl[(c * 5) * 64 + lane] * hist[c][0] + cwl[(c * 5 + 1) * 64 + lane] * hist[c][1] + cwl[(c * 5 + 2) * 64 + lane] * hist[c][2] + cwl[(c * 5 + 3) * 64 + lane] * cur;
                    hist[c][0] = hist[c][1]; hist[c][1] = hist[c][2]; hist[c][2] = cur; v[c] = silu_f(a); }
                const float raw = DTRAW[row * NH + h] + dtb;
                const float dtv = raw > 20.f ? raw : log1pf(__expf(raw));
                const float dA = __expf(dtv * av);
                sB[lane] = v[1]; sB[lane + 64] = v[2]; sC[lane] = v[3]; sC[lane + 64] = v[4];
                LDS_WAIT(); asm volatile("" ::: "memory");
                const float xd = dtv * v[0]; float y = 0.f;
#pragma unroll
                for (int n = 0; n < 64; n += 4) { const f32x4 bb = *(const LAS f32x4*)(sB + 64 * nh + n), cc = *(const LAS f32x4*)(sC + 64 * nh + n);
                    hst[n] = hst[n] * dA + xd * bb.x; y += cc.x * hst[n];
                    hst[n + 1] = hst[n + 1] * dA + xd * bb.y; y += cc.y * hst[n + 1];
                    hst[n + 2] = hst[n + 2] * dA + xd * bb.z; y += cc.z * hst[n + 2];
                    hst[n + 3] = hst[n + 3] * dA + xd * bb.w; y += cc.w * hst[n + 3]; }
                LDS_WAIT(); asm volatile("" ::: "memory");
                y += __shfl_xor(y, 32);
                y += dh * v[0];
                const float zv = bf2f(Zb[row * DI + h * HP + pp]);
                const float yg = y * silu_f(zv);
                float sq = (lane < 32) ? yg * yg : 0.f; sq = wave_sum(sq);
                if (lane < 32) Zb[row * DI + h * HP + pp] = (bf16)f2bf(yg);
                if (lane == 0) SSQ[row * 64 + h * 2 + wave] = sq;
            }
        }
#else
        const float* conv_w = args.in[2]; const float* conv_b = args.in[3]; const float* dt_bias = args.in[4]; const float* a_log = args.in[5]; const float* dsk = args.in[6];
        typedef short v4i16 __attribute__((ext_vector_type(4)));
        constexpr int SXB = 144, SBB = 272;
        constexpr int XS_OFF = 0, XW_OFF = 9216, BM_OFF = 18432, CM_OFF = 35840, WM_OFF = 53248, HB_OFF = 62464, VEC_OFF = 97280, CW_OFF = 98304;
        LAS unsigned char* Lb = F.lds;
        LAS float* cumL = (LAS float*)(Lb + VEC_OFF);
        LAS float* dtL = cumL + 128;
        LAS float* cwl = (LAS float*)(Lb + CW_OFF);
        const int r16 = lane & 15, q4 = lane >> 4;
#define TR8(dst, base_off, stride, k0, c0) do { const LAS unsigned char* _a = Lb + (base_off) + ((k0) + 8 * q4 + (r16 >> 2)) * (stride) + ((c0) + 4 * (lane & 3)) * 2; \
        const v4i16 _lo = __builtin_amdgcn_ds_read_tr16_b64_v4i16((LAS v4i16*)_a), _hi = __builtin_amdgcn_ds_read_tr16_b64_v4i16((LAS v4i16*)(_a + 4 * (stride))); \
        dst = (bf16x8){_lo[0], _lo[1], _lo[2], _lo[3], _hi[0], _hi[1], _hi[2], _hi[3]}; } while (0)
        for (int item = blockIdx.x; item < NB * NH; item += F.G) {
            const int b = item / NH, h = item % NH, g = h >> 3;
            __syncthreads();
            for (int i = tid; i < 5 * 64; i += 512) { const int k = i >> 6, cl = i & 63; cwl[i] = k < 4 ? conv_w[k * CONVD + h * HP + cl] : conv_b[h * HP + cl]; }
            for (int i = tid; i < SBB * 64 / 4; i += 512) ((LAS unsigned*)(Lb + HB_OFF))[i] = 0u;
            const float dtb = dt_bias[h], av = -__expf(a_log[h]), dh = dsk[h];
            const int sj = tid >> 3, sxc = tid & 7;
            const bf16* BCACT = (const bf16*)(ws + WS_BCACT);
            const size_t row0 = (size_t)b * SEQ;
            f32x4 hacc[4];
#pragma unroll
            for (int i = 0; i < 4; ++i) hacc[i] = (f32x4){0.f, 0.f, 0.f, 0.f};
            u32x4 xraw[4], braw[2], craw[2]; float dtr = 0.f;
#define SC_LOAD(c) do { _Pragma("unroll") for (int k = 0; k < 4; ++k) { const int rr = (c) * 64 + sj - 3 + k; const int rc = rr < 0 ? 0 : rr; \
                xraw[k] = *(const u32x4*)(XBC + (row0 + rc) * CONVD + h * HP + 8 * sxc); if (rr < 0) xraw[k] = (u32x4){0u, 0u, 0u, 0u}; } \
            _Pragma("unroll") for (int i = 0; i < 2; ++i) { const int idx = tid + 512 * i; const bf16* bp_ = BCACT + (row0 + (c) * 64 + (idx >> 4)) * 1024 + g * NS + 8 * (idx & 15); \
                braw[i] = *(const u32x4*)bp_; craw[i] = *(const u32x4*)(bp_ + 512); } \
            if (wave == 7) dtr = DTRAW[(row0 + (c) * 64 + lane) * NH + h]; } while (0)
#define SC_CUMDT(c) do { if (wave == 7) { const float rw_ = dtr + dtb; const float dtv = rw_ > 20.f ? rw_ : log1pf(__expf(rw_)); float xx = dtv * av; \
                _Pragma("unroll") for (int o = 1; o < 64; o <<= 1) { const float vv = __shfl_up(xx, o); if (lane >= o) xx += vv; } \
                cumL[((c) & 1) * 64 + lane] = xx; dtL[((c) & 1) * 64 + lane] = dtv; } } while (0)
#define SC_STAGE(c) do { const int pr_ = ((c) & 1) * 64; const float wj = __expf(cumL[pr_ + 63] - cumL[pr_ + sj]) * dtL[pr_ + sj]; \
                _Pragma("unroll") for (int hf = 0; hf < 2; ++hf) { f32x4 aq = *(const LAS f32x4*)(cwl + 4 * 64 + 8 * sxc + 4 * hf); \
                    _Pragma("unroll") for (int k = 0; k < 4; ++k) { const f32x4 wq = *(const LAS f32x4*)(cwl + k * 64 + 8 * sxc + 4 * hf); const unsigned r0_ = hf ? xraw[k].z : xraw[k].x, r1_ = hf ? xraw[k].w : xraw[k].y; \
                        aq += wq * (f32x4){bflo(r0_), bfhi(r0_), bflo(r1_), bfhi(r1_)}; } \
                    _Pragma("unroll") for (int e = 0; e < 4; ++e) aq[e] = silu_f(aq[e]); \
                    u32x2 o_; o_.x = pk2(aq[0], aq[1]); o_.y = pk2(aq[2], aq[3]); \
                    *(LAS u32x2*)(Lb + XS_OFF + sj * SXB + 16 * sxc + 8 * hf) = o_; \
                    o_.x = pk2(aq[0] * wj, aq[1] * wj); o_.y = pk2(aq[2] * wj, aq[3] * wj); \
                    *(LAS u32x2*)(Lb + XW_OFF + sj * SXB + 16 * sxc + 8 * hf) = o_; } \
                _Pragma("unroll") for (int i = 0; i < 2; ++i) { const int idx = tid + 512 * i; \
                    *(LAS u32x4*)(Lb + BM_OFF + (idx >> 4) * SBB + 16 * (idx & 15)) = braw[i]; *(LAS u32x4*)(Lb + CM_OFF + (idx >> 4) * SBB + 16 * (idx & 15)) = craw[i]; } } while (0)
            SC_LOAD(0); SC_CUMDT(0);
            __syncthreads();
            SC_STAGE(0);
            __syncthreads();
            const int ti = wave & 3, wh = wave >> 2;
            for (int c = 0; c < SEQ / 64; ++c) {
                const int pr = (c & 1) * 64; const int hb_cur = HB_OFF + (c & 1) * (SBB * 64), hb_nxt = HB_OFF + ((c & 1) ^ 1) * (SBB * 64);
                if (c + 1 < SEQ / 64) SC_LOAD(c + 1);
                const int irow = 16 * ti + r16;
                u32x2 zreg[2];
#pragma unroll
                for (int tt = 0; tt < 2; ++tt) zreg[tt] = *(const u32x2*)(Zb + (row0 + c * 64 + irow) * DI + h * HP + 16 * (2 * wh + tt) + 4 * q4);
                bf16x8 cf[4];
#pragma unroll
                for (int ks = 0; ks < 4; ++ks) cf[ks] = *(const LAS bf16x8*)(Lb + CM_OFF + irow * SBB + (32 * ks + 8 * q4) * 2);
                const float ci = cumL[pr + irow];
#pragma unroll
                for (int tt = 0; tt < 2; ++tt) { const int tj = 2 * wh + tt; f32x4 ga = {0.f, 0.f, 0.f, 0.f};
#pragma unroll
                    for (int ks = 0; ks < 4; ++ks) { const bf16x8 bfr = *(const LAS bf16x8*)(Lb + BM_OFF + (16 * tj + r16) * SBB + (32 * ks + 8 * q4) * 2); ga = __builtin_amdgcn_mfma_f32_16x16x32_bf16(bfr, cf[ks], ga, 0, 0, 0); }
                    const int j0 = 16 * tj + 4 * q4; const f32x4 cj = *(const LAS f32x4*)(cumL + pr + j0), dj = *(const LAS f32x4*)(dtL + pr + j0);
                    float wv[4];
#pragma unroll
                    for (int r = 0; r < 4; ++r) { const int j = j0 + r; float v = ga[r] * __expf(ci - cj[r]) * dj[r]; v = (j <= irow) ? v : 0.f; if (j == irow) v += dh; wv[r] = v; }
                    u32x2 w_; w_.x = pk2(wv[0], wv[1]); w_.y = pk2(wv[2], wv[3]);
                    *(LAS u32x2*)(Lb + WM_OFF + irow * SXB + j0 * 2) = w_; }
                __syncthreads();
                { bf16x8 wf[2];
#pragma unroll
                  for (int ks = 0; ks < 2; ++ks) wf[ks] = *(const LAS bf16x8*)(Lb + WM_OFF + irow * SXB + (32 * ks + 8 * q4) * 2);
                  const float ec = __expf(ci); float ssq = 0.f;
#pragma unroll
                  for (int tt = 0; tt < 2; ++tt) { const int tp = 2 * wh + tt; f32x4 yd = {0.f, 0.f, 0.f, 0.f}, yo = {0.f, 0.f, 0.f, 0.f};
#pragma unroll
                      for (int ks = 0; ks < 2; ++ks) { bf16x8 xa; TR8(xa, XS_OFF, SXB, 32 * ks, 16 * tp); yd = __builtin_amdgcn_mfma_f32_16x16x32_bf16(xa, wf[ks], yd, 0, 0, 0); }
#pragma unroll
                      for (int ks = 0; ks < 4; ++ks) { const bf16x8 ha = *(const LAS bf16x8*)(Lb + hb_cur + (16 * tp + r16) * SBB + (32 * ks + 8 * q4) * 2); yo = __builtin_amdgcn_mfma_f32_16x16x32_bf16(ha, cf[ks], yo, 0, 0, 0); }
                      const float z0 = bflo(zreg[tt].x), z1 = bfhi(zreg[tt].x), z2 = bflo(zreg[tt].y), z3 = bfhi(zreg[tt].y);
                      const float y0 = (yd[0] + ec * yo[0]) * silu_f(z0), y1 = (yd[1] + ec * yo[1]) * silu_f(z1), y2 = (yd[2] + ec * yo[2]) * silu_f(z2), y3 = (yd[3] + ec * yo[3]) * silu_f(z3);
                      ssq += (y0 * y0 + y1 * y1) + (y2 * y2 + y3 * y3);
                      u32x2 o_; o_.x = pk2(y0, y1); o_.y = pk2(y2, y3);
                      *(u32x2*)(Zb + (row0 + c * 64 + irow) * DI + h * HP + 16 * tp + 4 * q4) = o_; }
                  ssq += __shfl_xor(ssq, 16); ssq += __shfl_xor(ssq, 32);
                  if (q4 == 0) SSQ[(row0 + c * 64 + irow) * 64 + h * 2 + wh] = ssq; }
                { const float eL = __expf(cumL[pr + 63]);
#pragma unroll
                  for (int tp = 0; tp < 4; ++tp) hacc[tp] = hacc[tp] * eL;
#pragma unroll
                  for (int ks = 0; ks < 2; ++ks) { bf16x8 ba; TR8(ba, BM_OFF, SBB, 32 * ks, 16 * wave);
#pragma unroll
                      for (int tp = 0; tp < 4; ++tp) { bf16x8 xb; TR8(xb, XW_OFF, SXB, 32 * ks, 16 * tp); hacc[tp] = __builtin_amdgcn_mfma_f32_16x16x32_bf16(ba, xb, hacc[tp], 0, 0, 0); } }
#pragma unroll
                  for (int tp = 0; tp < 4; ++tp) { u32x2 o_; o_.x = pk2(hacc[tp][0], hacc[tp][1]); o_.y = pk2(hacc[tp][2], hacc[tp][3]);
                      *(LAS u32x2*)(Lb + hb_nxt + (16 * tp + r16) * SBB + (16 * wave + 4 * q4) * 2) = o_; } }
                if (c + 1 < SEQ / 64) SC_CUMDT(c + 1);
                __syncthreads();
                if (c + 1 < SEQ / 64) SC_STAGE(c + 1);
                __syncthreads();
            }
        }
#undef TR8
#undef SC_LOAD
#undef SC_CUMDT
#undef SC_STAGE
#endif
    }
    SEAM(3);

    if (IN(4)) { PH_LOCALS
        for (int m = gw; m < T; m += NGW) {
            float p = SSQ[(size_t)m * 64 + lane];
            p += __shfl_xor(p, 1); p += __shfl_xor(p, 2); p += __shfl_xor(p, 4); p += __shfl_xor(p, 8);
            bf16* yr = Zb + (size_t)m * DI;
#pragma unroll
            for (int j = 0; j < 4; ++j) { const float ss = __shfl(p, 16 * j); const float rs = 1.f / sqrtf(ss * (1.f / 512.f) + RMS_EPS);
                u32x4 w = *(const u32x4*)(yr + j * 512 + lane * 8);
                w.x = pk2(bflo(w.x) * rs, bfhi(w.x) * rs); w.y = pk2(bflo(w.y) * rs, bfhi(w.y) * rs); w.z = pk2(bflo(w.z) * rs, bfhi(w.z) * rs); w.w = pk2(bflo(w.w) * rs, bfhi(w.w) * rs);
                *(u32x4*)(yr + j * 512 + lane * 8) = w; }
        }
        LAS float* scr = (LAS float*)(F.lds + wave * 16384);
        constexpr int I_QKV = (D / 64) * (3 * D / 32), I_O = (D / 64) * (D / 32), I_G = (D / 64) * (DFF / 32), I_D = (DFF / 64) * (D / 32);
        constexpr int I_MOE = 2 * NE * (2 * I_G + I_D);
        for (int it = gw; it < I_QKV + I_O + I_MOE; it += NGW) {
            int r = it;
            if (r < I_QKV) { transpose_item(args.in[9], D, 3 * D, (bf16*)(ws + WS_WQKV), 0, 0, nullptr, scr, r, lane); continue; } r -= I_QKV;
            if (r < I_O) { transpose_item(args.in[12], D, D, (bf16*)(ws + WS_WO), 0, 0, nullptr, scr, r, lane); continue; } r -= I_O;
            const int le = r / (2 * I_G + I_D), L = le / NE, e = le % NE; r -= le * (2 * I_G + I_D);
            bf16* wgu = (bf16*)(ws + (L ? WS_WGU1 : WS_WGU0)) + (size_t)e * 1024 * D; bf16* wd = (bf16*)(ws + (L ? WS_WD1 : WS_WD0)) + (size_t)e * D * DFF;
            if (r < I_G) { transpose_item(args.in[16] + (size_t)le * D * DFF, D, DFF, wgu, 0, 1, nullptr, scr, r, lane); continue; } r -= I_G;
            if (r < I_G) { transpose_item(args.in[17] + (size_t)le * D * DFF, D, DFF, wgu, 0, 2, nullptr, scr, r, lane); continue; } r -= I_G;
            transpose_item(args.in[18] + (size_t)le * DFF * D, DFF, D, wd, 0, 0, nullptr, scr, r, lane);
        }
    }
    SEAM(4);

    if (IN(5)) { PH_LOCALS
        pg8::DenseOrder S; S.init(T, D, F.G, (int)blockIdx.x, DI);
        pg8::EpiPlain E{(bf16*)(ws + WS_MIX1), D, nullptr, 0, 1.f};
        pg8::gemm_phase<pg8::EpiPlain, pg8::DenseOrder>(F.lds, Zb, Wt_out, DI, S, E);
    }
    SEAM(5);

    layer_tail<0>(args, F, bar, lo, hi);
    SEAM(9);

    if (IN(10)) { PH_LOCALS
        pg8::DenseOrder S; S.init(T, 3 * D, F.G, (int)blockIdx.x, D);
        pg8::EpiPlain E{(bf16*)(ws + WS_QKV), 3 * D, args.in[10], D, 0.125f};
        pg8::gemm_phase<pg8::EpiPlain, pg8::DenseOrder>(F.lds, (const bf16*)(ws + WS_X2B), (const bf16*)(ws + WS_WQKV), D, S, E);
    }
    SEAM(10);
    if (IN(11)) { PH_LOCALS
#if NAIVE_ATTN
        const bf16* QKV = (const bf16*)(ws + WS_QKV); bf16* AO = (bf16*)(ws + WS_AO); const float* rel = args.in[11];
        for (int idx = blockIdx.x * 512 + tid; idx < NB * AH * SEQ; idx += F.G * 512) {
            const int s = idx % SEQ, bh = idx / SEQ, hh = bh % AH, b = bh / AH, c = s / 64;
            const bf16* qp = QKV + ((size_t)b * SEQ + s) * (3 * D) + hh * AD;
            float q[AD], o[AD];
#pragma unroll
            for (int d = 0; d < AD; ++d) { q[d] = bf2f(qp[d]); o[d] = 0.f; }
            float mx = -1e30f, l = 0.f;
            const int k0 = (c - LEFTC) * 64 < 0 ? 0 : (c - LEFTC) * 64, k1 = c * 64 + 64;
            for (int kp = k0; kp < k1; ++kp) {
                const bf16* kr = QKV + ((size_t)b * SEQ + kp) * (3 * D) + D + hh * AD; const bf16* vr = kr + D;
                float sc = 0.f;
#pragma unroll
                for (int d = 0; d < AD; d += 2) { const unsigned w = *(const unsigned*)(kr + d); sc += q[d] * bflo(w) + q[d + 1] * bfhi(w); }
                int dist = s - kp; dist = dist < -MAXREL ? -MAXREL : (dist > MAXREL ? MAXREL : dist);
                sc += rel[(dist + MAXREL) * AH + hh];
                const float mn = fmaxf(mx, sc), f = __expf(mx - mn), p = __expf(sc - mn);
                l = l * f + p; mx = mn;
#pragma unroll
                for (int d = 0; d < AD; d += 2) { const unsigned w = *(const unsigned*)(vr + d); o[d] = o[d] * f + p * bflo(w); o[d + 1] = o[d + 1] * f + p * bfhi(w); }
            }
            const float il = 1.f / l; bf16* op = AO + ((size_t)b * SEQ + s) * D + hh * AD;
#pragma unroll
            for (int d = 0; d < AD; d += 2) *(unsigned*)(op + d) = pk2(o[d] * il, o[d + 1] * il);
        }
#else
        const bf16* QKV = (const bf16*)(ws + WS_QKV); bf16* AO = (bf16*)(ws + WS_AO); const float* rel = args.in[11];
        typedef short v4i16 __attribute__((ext_vector_type(4)));
        constexpr int SKB = 144, KB_OFF = 0, VB_OFF = 18432, TB_OFF = 36864; constexpr float LOG2E = 1.4426950408889634f;
        LAS unsigned char* Lb = F.lds; LAS float* tb = (LAS float*)(Lb + TB_OFF);
        const int r16 = lane & 15, q4 = lane >> 4, wq = wave >> 2;
        const int NU = NB * AH * (SEQ / 128), per = (NU + F.G - 1) / F.G;
        int hprev = -1;
        for (int ui = 0; ui < per; ++ui) {
            const int u = F.vcu * per + ui; if (u >= NU) break;
            const int bh = u >> 5, cp = u & 31, b = bh >> 4, hh = bh & 15, c0 = 2 * cp;
            __syncthreads();
            if (hh != hprev) { for (int i = tid; i < 2 * MAXREL + 1; i += 512) tb[i] = rel[i * AH + hh] * LOG2E; hprev = hh; }
            const int cw = c0 + wq, qrow = 64 * cw + 16 * (wave & 3) + r16;
            const size_t tok0 = (size_t)b * SEQ;
            bf16x8 qf[2];
#pragma unroll
            for (int ds = 0; ds < 2; ++ds) qf[ds] = *(const bf16x8*)(QKV + (tok0 + qrow) * (3 * D) + hh * AD + 32 * ds + 8 * q4);
            f32x4 oacc[4];
#pragma unroll
            for (int i = 0; i < 4; ++i) oacc[i] = (f32x4){0.f, 0.f, 0.f, 0.f};
            float mrun = -1e30f, lrun = 0.f;
            const int kt_lo = c0 < 8 ? 8 - c0 : 0;
            const int kr = tid >> 3, pc = tid & 7;
            const bf16* kvp = QKV + (tok0 + kr) * (3 * D) + D + hh * AD + 8 * pc;
            u32x4 kreg, vreg;
            { const size_t co = (size_t)(c0 - 8 + kt_lo) * 64 * (3 * D); kreg = *(const u32x4*)(kvp + co); vreg = *(const u32x4*)(kvp + co + D); }
            *(LAS u32x4*)(Lb + KB_OFF + (kt_lo & 1) * 9216 + kr * SKB + pc * 16) = kreg; *(LAS u32x4*)(Lb + VB_OFF + (kt_lo & 1) * 9216 + kr * SKB + pc * 16) = vreg;
            __syncthreads();
            for (int kt = kt_lo; kt < 10; ++kt) {
                const int chunk = c0 - 8 + kt;
                if (kt + 1 < 10) { const size_t co = (size_t)(chunk + 1) * 64 * (3 * D); kreg = *(const u32x4*)(kvp + co); vreg = *(const u32x4*)(kvp + co + D); }
                if (kt >= wq && kt <= wq + 8) {
                    const LAS unsigned char* Kb = Lb + KB_OFF + (kt & 1) * 9216; const LAS unsigned char* Vb = Lb + VB_OFF + (kt & 1) * 9216;
                    f32x4 sc[4];
#pragma unroll
                    for (int t = 0; t < 4; ++t) { sc[t] = (f32x4){0.f, 0.f, 0.f, 0.f};
#pragma unroll
                        for (int ds = 0; ds < 2; ++ds) { const bf16x8 kf = *(const LAS bf16x8*)(Kb + (16 * t + r16) * SKB + (32 * ds + 8 * q4) * 2); sc[t] = __builtin_amdgcn_mfma_f32_16x16x32_bf16(kf, qf[ds], sc[t], 0, 0, 0); } }
                    if (cw - chunk >= 3) { const float bc = tb[2 * MAXREL];
#pragma unroll
                        for (int t = 0; t < 4; ++t) sc[t] = sc[t] * LOG2E + bc;
                    } else {
#pragma unroll
                        for (int t = 0; t < 4; ++t)
#pragma unroll
                            for (int r = 0; r < 4; ++r) { int dist = qrow - (64 * chunk + 16 * t + 4 * q4 + r); dist = dist < -MAXREL ? -MAXREL : (dist > MAXREL ? MAXREL : dist); sc[t][r] = sc[t][r] * LOG2E + tb[dist + MAXREL]; }
                    }
                    float mx = fmaxf(fmaxf(sc[0][0], sc[0][1]), fmaxf(sc[0][2], sc[0][3]));
#pragma unroll
                    for (int t = 1; t < 4; ++t) mx = fmaxf(mx, fmaxf(fmaxf(sc[t][0], sc[t][1]), fmaxf(sc[t][2], sc[t][3])));
                    mx = fmaxf(mx, __shfl_xor(mx, 16)); mx = fmaxf(mx, __shfl_xor(mx, 32));
                    const float mnew = fmaxf(mrun, mx), alpha = __builtin_amdgcn_exp2f(mrun - mnew); mrun = mnew;
                    float ls = 0.f;
#pragma unroll
                    for (int t = 0; t < 4; ++t)
#pragma unroll
                        for (int r = 0; r < 4; ++r) { sc[t][r] = __builtin_amdgcn_exp2f(sc[t][r] - mnew); ls += sc[t][r]; }
                    lrun = lrun * alpha + ls;
#pragma unroll
                    for (int i = 0; i < 4; ++i) oacc[i] = oacc[i] * alpha;
                    bf16x8 pb[2];
#pragma unroll
                    for (int kk = 0; kk < 2; ++kk) { u32x4 w_; w_.x = pk2(sc[2 * kk][0], sc[2 * kk][1]); w_.y = pk2(sc[2 * kk][2], sc[2 * kk][3]); w_.z = pk2(sc[2 * kk + 1][0], sc[2 * kk + 1][1]); w_.w = pk2(sc[2 * kk + 1][2], sc[2 * kk + 1][3]); pb[kk] = __builtin_bit_cast(bf16x8, w_); }
#pragma unroll
                    for (int dt = 0; dt < 4; ++dt)
#pragma unroll
                        for (int kk = 0; kk < 2; ++kk) { const LAS unsigned char* va_ = Vb + (32 * kk + 4 * q4 + (r16 >> 2)) * SKB + (16 * dt + 4 * (lane & 3)) * 2;
                            const v4i16 lo_ = __builtin_amdgcn_ds_read_tr16_b64_v4i16((LAS v4i16*)va_), hi_ = __builtin_amdgcn_ds_read_tr16_b64_v4i16((LAS v4i16*)(va_ + 16 * SKB));
                            const bf16x8 vf = (bf16x8){lo_[0], lo_[1], lo_[2], lo_[3], hi_[0], hi_[1], hi_[2], hi_[3]};
                            oacc[dt] = __builtin_amdgcn_mfma_f32_16x16x32_bf16(vf, pb[kk], oacc[dt], 0, 0, 0); }
                }
                if (kt + 1 < 10) { *(LAS u32x4*)(Lb + KB_OFF + ((kt + 1) & 1) * 9216 + kr * SKB + pc * 16) = kreg; *(LAS u32x4*)(Lb + VB_OFF + ((kt + 1) & 1) * 9216 + kr * SKB + pc * 16) = vreg; }
                __syncthreads();
            }
            lrun += __shfl_xor(lrun, 16); lrun += __shfl_xor(lrun, 32);
            const float il = 1.f / lrun; bf16* op = AO + (tok0 + qrow) * D + hh * AD + 4 * q4;
#pragma unroll
            for (int dt = 0; dt < 4; ++dt) { u32x2 o_; o_.x = pk2(oacc[dt][0] * il, oacc[dt][1] * il); o_.y = pk2(oacc[dt][2] * il, oacc[dt][3] * il); *(u32x2*)(op + 16 * dt) = o_; }
        }
#endif
    }
    SEAM(11);
    if (IN(12)) { PH_LOCALS
        pg8::DenseOrder S; S.init(T, D, F.G, (int)blockIdx.x, D);
        pg8::EpiPlain E{(bf16*)(ws + WS_MIX2), D, args.in[13], 0, 1.f};
        pg8::gemm_phase<pg8::EpiPlain, pg8::DenseOrder>(F.lds, (const bf16*)(ws + WS_AO), (const bf16*)(ws + WS_WO), D, S, E);
    }
    SEAM(12);
    layer_tail<1>(args, F, bar, lo, hi);
#undef IN
#undef SEAM
}

extern "C" void kernel_launch(void* const* d_in, const int* in_sizes, int n_in, void* d_out, int out_size, void* d_ws, size_t ws_size, hipStream_t stream) {
    static int grid = 0;
    if (grid == 0) {
        if (n_in != 23 || in_sizes[0] != T * D || out_size != T * D || ws_size < WS_END) { fprintf(stderr, "kernel_launch: unexpected shapes / workspace (n_in %d, ws %zu); nothing launched\n", n_in, ws_size); grid = -1; return; }
        int dev = 0, cus = 0, per_cu = 0;
        if (hipGetDevice(&dev) != hipSuccess || hipDeviceGetAttribute(&cus, hipDeviceAttributeMultiprocessorCount, dev) != hipSuccess) { grid = -1; return; }
        if (hipFuncSetAttribute((const void*)fwd_kernel, hipFuncAttributeMaxDynamicSharedMemorySize, LDS_BYTES) != hipSuccess) { fprintf(stderr, "kernel_launch: hipFuncSetAttribute failed\n"); grid = -1; return; }
        if (hipOccupancyMaxActiveBlocksPerMultiprocessor(&per_cu, (const void*)fwd_kernel, 512, LDS_BYTES) != hipSuccess || per_cu < 1) fprintf(stderr, "kernel_launch: occupancy query reports %d\n", per_cu);
        (void)hipGetLastError();
        grid = cus;
    }
    if (grid < 0) return;
    if (hipMemsetAsync((char*)d_ws + WS_CTL, 0, CTL_ZERO_BYTES, stream) != hipSuccess) return;
    Args a{};
    for (int i = 0; i < 23; ++i) a.in[i] = (const float*)d_in[i];
    a.out = (float*)d_out; a.ws = (unsigned char*)d_ws;
    if (MK_N_LAUNCHES == 1) { a.ph_lo = 0; a.ph_hi = NPHASE; hipLaunchKernelGGL(fwd_kernel, dim3(grid), dim3(512), LDS_BYTES, stream, a);
#ifdef PROBE_MASK
        for (int p = 0; p < NPHASE; ++p) if ((PROBE_MASK >> p) & 1) { a.ph_lo = p; a.ph_hi = p + 1; hipLaunchKernelGGL(fwd_kernel, dim3(grid), dim3(512), LDS_BYTES, stream, a); }
#endif
    }
    else for (int p = 0; p < NPHASE; ++p) { a.ph_lo = p; a.ph_hi = p + 1; hipLaunchKernelGGL(fwd_kernel, dim3(grid), dim3(512), LDS_BYTES, stream, a); }
}
```

```cpp
#include <hip/hip_runtime.h>
#include <cstdio>
#include <cstdint>

#ifndef MK_N_LAUNCHES
#define MK_N_LAUNCHES 1
#endif
#ifndef NAIVE_SCAN
#define NAIVE_SCAN 0
#endif
#ifndef NAIVE_ATTN
#define NAIVE_ATTN 0
#endif

#define LAS __attribute__((address_space(3)))
#define GAS __attribute__((address_space(1)))
typedef unsigned short bf16;
typedef short bf16x8 __attribute__((ext_vector_type(8)));
typedef float f32x4 __attribute__((ext_vector_type(4)));
typedef float f32x2 __attribute__((ext_vector_type(2)));
typedef unsigned u32x4 __attribute__((ext_vector_type(4)));
typedef unsigned u32x2 __attribute__((ext_vector_type(2)));
typedef GAS unsigned gu32;

constexpr int NB = 8, SEQ = 4096, D = 1024, T = NB * SEQ;
constexpr int DI = 2048, NH = 32, HP = 64, NG = 4, NS = 128, CONVD = 3072, INP = 5152, NZX = 5120;
constexpr int AH = 16, AD = 64, LEFTC = 8, MAXREL = 128;
constexpr int NE = 16, DFF = 512;
constexpr float ALPHA = 1.4142135623730951f;
constexpr float LN_EPS = 1e-5f, RMS_EPS = 1e-5f;
constexpr int NPHASE = 17;
constexpr int MAXTILES = 272;

constexpr size_t MiB = 1u << 20;
constexpr size_t WS_CTL = 0, CTL_ZERO_BYTES = 1 * MiB;
constexpr size_t WS_WIN = 1 * MiB;
constexpr size_t WS_WOUT = 12 * MiB;
constexpr size_t WS_XB = 16 * MiB;
constexpr size_t WS_BCACT = 16 * MiB;
constexpr size_t WS_WGU0 = 16 * MiB, WS_WD0 = 48 * MiB, WS_WQKV = 64 * MiB, WS_WO = 70 * MiB, WS_WGU1 = 72 * MiB, WS_WD1 = 104 * MiB;
constexpr size_t WS_Z = 120 * MiB;
constexpr size_t WS_XBC = 248 * MiB;
constexpr size_t WS_DTRAW = 440 * MiB;
constexpr size_t WS_SSQ = 444 * MiB;
constexpr size_t WS_MIX1 = 248 * MiB;
constexpr size_t WS_X1B = 324 * MiB;
constexpr size_t WS_H0 = 120 * MiB;
constexpr size_t WS_Y20 = 188 * MiB;
constexpr size_t WS_X2B = 120 * MiB;
constexpr size_t WS_QKV = 188 * MiB;
constexpr size_t WS_AO = 380 * MiB;
constexpr size_t WS_MIX2 = 188 * MiB;
constexpr size_t WS_X3B = 256 * MiB;
constexpr size_t WS_H1 = 320 * MiB;
constexpr size_t WS_Y21 = 120 * MiB;
constexpr size_t WS_LIST = 500 * MiB;
constexpr size_t WS_INFO = 504 * MiB;
constexpr size_t WS_END = 512 * MiB;
constexpr int CW_TMO = 0;
constexpr int CW_CNT = 1024;
constexpr int CW_BAR = 4096;

constexpr int RING_BYTES = 131072;
constexpr int LDSCTL_OFF = RING_BYTES, MISC_OFF = LDSCTL_OFF + 320;
constexpr int TOKL_OFF = LDSCTL_OFF + 1024;
constexpr int MOE_OFF = TOKL_OFF + 6 * 1024;
constexpr int LDS_BYTES = 147456;

#define RLX_AGENT __ATOMIC_RELAXED, __HIP_MEMORY_SCOPE_AGENT
#define LDS_WAIT() asm volatile("s_waitcnt lgkmcnt(0)" ::: "memory")
#define VM_WAIT() asm volatile("s_waitcnt vmcnt(0)" ::: "memory")
#define WG_BAR() do { asm volatile("s_waitcnt lgkmcnt(0)" ::: "memory"); __builtin_amdgcn_s_barrier(); asm volatile("" ::: "memory"); } while (0)

__device__ __forceinline__ unsigned f2bf(float f) { unsigned u = __builtin_bit_cast(unsigned, f); return (u + 0x7fffu + ((u >> 16) & 1u)) >> 16; }
__device__ __forceinline__ unsigned pk2(float lo, float hi) { return f2bf(lo) | (f2bf(hi) << 16); }
__device__ __forceinline__ float bf2f(unsigned short b) { return __builtin_bit_cast(float, ((unsigned)b) << 16); }
__device__ __forceinline__ float bflo(unsigned w) { return __builtin_bit_cast(float, w << 16); }
__device__ __forceinline__ float bfhi(unsigned w) { return __builtin_bit_cast(float, w & 0xffff0000u); }
__device__ __forceinline__ float silu_f(float v) { return v * __builtin_amdgcn_rcpf(1.f + __expf(-v)); }
__device__ __forceinline__ float wave_sum(float v) {
#pragma unroll
    for (int o = 1; o < 64; o <<= 1) v += __shfl_xor(v, o);
    return v;
}

namespace pg8 {
constexpr int BM = 256, BK = 64, HALF = 128, HTB = HALF * BK * 2, STAGE_BYTES = 8 * HTB;
__device__ __forceinline__ int lds_byte(int r, int c) { const int st = (r >> 4) * 2 + (c >> 5), rr = r & 15, cc = c & 31, ob = rr * 64 + cc * 2; return st * 1024 + (ob ^ (((ob >> 9) & 1) << 5)); }
__device__ __forceinline__ void stage_rc(int b, int& R, int& C) { const int st = b / 1024, sb = b % 1024, swz = sb ^ (((sb >> 9) & 1) << 5); R = (st >> 1) * 16 + swz / 64; C = (st & 1) * 32 + (swz % 64) / 2; }
__device__ __forceinline__ int perm32(int rho) { const int n = rho >> 4, i = rho & 15; return 8 * (i >> 2) + 4 * n + (i & 3); }
__device__ __forceinline__ unsigned cvt_pk_bf16(float lo, float hi) { unsigned r; asm volatile("v_cvt_pk_bf16_f32 %0, %1, %2" : "=v"(r) : "v"(lo), "v"(hi)); return r; }

struct Unit { int pm, pn, bt, e; };

template <class Epi, class Sched>
__device__ __forceinline__ void gemm_phase(LAS unsigned char* lds, const bf16* A, const bf16* Bt, int K, const Sched& S, const Epi& E) {
    int tid = threadIdx.x; asm volatile("" : "+v"(tid));
    const int wid = __builtin_amdgcn_readfirstlane(tid >> 6), lane = tid & 63, wr = wid >> 2, wc = wid & 3, fr = lane & 15, fq = lane >> 4;
    const int nt = K / BK;
    int Rr[2], Cc[2]; unsigned voffB[2];
#pragma unroll
    for (int i = 0; i < 2; ++i) { stage_rc(tid * 16 + i * 8192, Rr[i], Cc[i]); const int Rb = (Rr[i] & ~31) + perm32(Rr[i] & 31); voffB[i] = (unsigned)(Rb * K + Cc[i]) * 2u; }
    const size_t kstep = (size_t)(BK * 2);
    const size_t hstep = (size_t)HALF * K * 2;
    const size_t tstep = 2 * hstep;
    const unsigned ldsw = (unsigned)wid * 1024u;
    const int aoff = lds_byte(wr * 64 + fr, fq * 8), boff = lds_byte(wc * 32 + fr, fq * 8);
#define PG8_SA(b, h) (((b) * 2 + (h)) * HTB)
#define PG8_SB(b, h) ((4 + (b) * 2 + (h)) * HTB)
#define PG8_STAGE(bufoff, gbase, voff) do { _Pragma("unroll") for (int _i = 0; _i < 2; ++_i) \
        __builtin_amdgcn_global_load_lds((const unsigned*)((const char*)(gbase) + (voff)[_i]), (LAS unsigned*)(lds + (bufoff) + ldsw + _i * 8192), 16, 0, 0); } while (0)
#define PG8_LDA(dst, b, h) do { _Pragma("unroll") for (int m = 0; m < 4; ++m) _Pragma("unroll") for (int k = 0; k < 2; ++k) dst[m][k] = *(const LAS bf16x8*)(lds + PG8_SA(b, h) + aoff + m * 2048 + k * 1024); } while (0)
#define PG8_LDB(dst, b, h) do { _Pragma("unroll") for (int n = 0; n < 2; ++n) _Pragma("unroll") for (int k = 0; k < 2; ++k) dst[n][k] = *(const LAS bf16x8*)(lds + PG8_SB(b, h) + boff + n * 2048 + k * 1024); } while (0)
#define PG8_MMA(ai, bj, At, Bt_) do { __builtin_amdgcn_s_setprio(1); _Pragma("unroll") for (int m = 0; m < 4; ++m) _Pragma("unroll") for (int n = 0; n < 2; ++n) _Pragma("unroll") for (int k = 0; k < 2; ++k) \
        acc[ai][bj][m][n] = __builtin_amdgcn_mfma_f32_16x16x32_bf16(Bt_[n][k], At[m][k], acc[ai][bj][m][n], 0, 0, 0); __builtin_amdgcn_s_setprio(0); } while (0)
#define PG8_WAIT_V(n) asm volatile("s_waitcnt vmcnt(" #n ")" ::: "memory")
#define PG8_WAIT_L(n) asm volatile("s_waitcnt lgkmcnt(" #n ")" ::: "memory")
#define PG8_BAR __builtin_amdgcn_s_barrier()
#define PG8_SCHED __builtin_amdgcn_sched_barrier(0)
    Unit cur, nxt; int ui = 0;
    if (!S.next(0, cur)) return;
    f32x4 acc[2][2][4][2];
#pragma unroll
    for (int a = 0; a < 2; ++a)
#pragma unroll
        for (int b = 0; b < 2; ++b)
#pragma unroll
            for (int m = 0; m < 4; ++m)
#pragma unroll
                for (int n = 0; n < 2; ++n) acc[a][b][m][n] = (f32x4){0.f, 0.f, 0.f, 0.f};
    bf16x8 At[4][2], B0[2][2], B1[2][2];
    unsigned vA0[2], vA1[2];
#pragma unroll
    for (int i = 0; i < 2; ++i) { vA0[i] = S.a_off(0, cur, 0, Rr[i], Cc[i]); vA1[i] = S.a_off(0, cur, 1, Rr[i], Cc[i]); }
    const char* Ab = (const char*)A;
    const char* cB = (const char*)Bt + (size_t)cur.bt * tstep;
    PG8_STAGE(PG8_SB(0, 0), cB, voffB); PG8_STAGE(PG8_SB(0, 1), cB + hstep, voffB); PG8_STAGE(PG8_SA(0, 0), Ab, vA0); PG8_STAGE(PG8_SA(0, 1), Ab, vA1);
    if (wr == 1) PG8_BAR;
    PG8_WAIT_V(2); PG8_BAR;
    PG8_STAGE(PG8_SB(1, 0), cB + kstep, voffB); PG8_STAGE(PG8_SA(1, 0), Ab + kstep, vA0); PG8_STAGE(PG8_SB(1, 1), cB + hstep + kstep, voffB);
    PG8_WAIT_V(6); PG8_BAR;
    for (;;) {
        const bool has_next = S.next(ui + 1, nxt);
        const char* nB = has_next ? (const char*)Bt + (size_t)nxt.bt * tstep : cB;
        for (int t = 0; t < nt; t += 2) {
            const bool last = (t == nt - 2);
            const char* a1 = Ab + (size_t)(t + 1) * kstep;
            const char* a2 = last ? Ab : Ab + (size_t)(t + 2) * kstep; const char* b2 = last ? nB : cB + (size_t)(t + 2) * kstep;
            const char* a3 = a2 + kstep; const char* b3 = b2 + kstep;
            unsigned v20[2], v21[2];
#pragma unroll
            for (int i = 0; i < 2; ++i) { v20[i] = vA0[i]; v21[i] = vA1[i]; }
            if (last && has_next) {
#pragma unroll
                for (int i = 0; i < 2; ++i) { v20[i] = S.a_off(ui + 1, nxt, 0, Rr[i], Cc[i]); v21[i] = S.a_off(ui + 1, nxt, 1, Rr[i], Cc[i]); } }
            PG8_LDB(B0, 0, 0); PG8_LDB(B1, 0, 1); PG8_SCHED; PG8_LDA(At, 0, 0); PG8_STAGE(PG8_SA(1, 1), a1, vA1);
            PG8_WAIT_V(8); PG8_WAIT_L(0); PG8_BAR; PG8_MMA(0, 0, At, B0); PG8_MMA(0, 1, At, B1); PG8_BAR; PG8_SCHED;
            PG8_LDA(At, 0, 1); PG8_STAGE(PG8_SB(0, 0), b2, voffB); PG8_STAGE(PG8_SB(0, 1), b2 + hstep, voffB); PG8_STAGE(PG8_SA(0, 0), a2, v20);
            PG8_WAIT_V(8); PG8_WAIT_L(0); PG8_BAR; PG8_MMA(1, 0, At, B0); PG8_MMA(1, 1, At, B1); PG8_BAR; PG8_SCHED;
            PG8_LDB(B0, 1, 0); PG8_LDB(B1, 1, 1); PG8_SCHED; PG8_LDA(At, 1, 0); PG8_STAGE(PG8_SA(0, 1), a2, v21);
            PG8_WAIT_V(8); PG8_WAIT_L(0); PG8_BAR; PG8_MMA(0, 0, At, B0); PG8_MMA(0, 1, At, B1); PG8_BAR; PG8_SCHED;
            PG8_LDA(At, 1, 1); PG8_STAGE(PG8_SB(1, 0), b3, voffB); PG8_STAGE(PG8_SB(1, 1), b3 + hstep, voffB); PG8_STAGE(PG8_SA(1, 0), a3, v20);
            PG8_WAIT_V(8); PG8_WAIT_L(0); PG8_BAR; PG8_MMA(1, 0, At, B0); PG8_MMA(1, 1, At, B1); PG8_BAR; PG8_SCHED;
        }
        if (wr == 0) PG8_BAR;
        E(acc, cur, wr, wc, fr, fq);
        if (!has_next) break;
#pragma unroll
        for (int a = 0; a < 2; ++a)
#pragma unroll
            for (int b = 0; b < 2; ++b)
#pragma unroll
                for (int m = 0; m < 4; ++m)
#pragma unroll
                    for (int n = 0; n < 2; ++n) acc[a][b][m][n] = (f32x4){0.f, 0.f, 0.f, 0.f};
        cur = nxt; cB = nB; ++ui;
#pragma unroll
        for (int i = 0; i < 2; ++i) { vA0[i] = S.a_off(ui, cur, 0, Rr[i], Cc[i]); vA1[i] = S.a_off(ui, cur, 1, Rr[i], Cc[i]); }
        if (wr == 1) PG8_BAR;
    }
    PG8_WAIT_V(0);
    PG8_BAR;
#undef PG8_SA
#undef PG8_SB
#undef PG8_STAGE
#undef PG8_LDA
#undef PG8_LDB
#undef PG8_MMA
#undef PG8_WAIT_V
#undef PG8_WAIT_L
#undef PG8_BAR
#undef PG8_SCHED
}

struct DenseOrder {
    int nM, nN, nwg, G, c, lda;
    __device__ void init(int M, int N, int G_, int c_, int lda_) { nM = M / BM; nN = N / BM; nwg = nM * nN; G = G_; c = c_; lda = lda_; }
    __device__ __forceinline__ bool next(int i, Unit& u) const {
        const long L = (long)i * G + c; if (L >= nwg) return false;
        int wgid = (int)L; { const int q = nwg / 8, r = nwg % 8, xcd = wgid % 8, off = wgid / 8; wgid = (xcd < r ? xcd * (q + 1) : r * (q + 1) + (xcd - r) * q) + off; }
        const int nig = 8 * nN, gid = wgid / nig, fm = gid * 8, gsz = (nM - fm) < 8 ? (nM - fm) : 8;
        u.pm = fm + ((wgid % nig) % gsz); u.pn = (wgid % nig) / gsz; u.bt = u.pn; u.e = 0; return true;
    }
    __device__ __forceinline__ unsigned a_off(int, const Unit& u, int h, int R, int C) const { return (unsigned)((u.pm * BM + h * HALF + R) * lda + C) * 2u; }
};
template <bool GATHER> struct MoeOrder {
    const LAS int* ts;
    const LAS int* tokL;
    int G, c, lda;
    __device__ __forceinline__ bool next(int i, Unit& u) const {
        const int L = i * G + c; const int ntile = __builtin_amdgcn_readfirstlane(ts[16]);
        if (L >= ntile * 4) return false;
        const int rt = L >> 2; int e = 0;
#pragma unroll
        for (int j = 1; j < 16; ++j) e += (rt >= ts[j]) ? 1 : 0;
        e = __builtin_amdgcn_readfirstlane(e);
        u.pm = rt; u.pn = L & 3; u.e = e; u.bt = e * 4 + (L & 3); return true;
    }
    __device__ __forceinline__ unsigned a_off(int ui, const Unit& u, int h, int R, int C) const {
        if (GATHER) { const int tok = tokL[ui * 256 + h * HALF + R]; return (unsigned)(tok * lda + C) * 2u; }
        return (unsigned)((u.pm * BM + h * HALF + R) * lda + C) * 2u;
    }
};

struct EpiPlain {
    bf16* O; int ldc; const float* bias; int scale_cols; float scale0;
    __device__ __forceinline__ void operator()(const f32x4 (&acc)[2][2][4][2], const Unit& u, int wr, int wc, int fr, int fq) const {
        const int row0 = u.pm * BM + wr * 64 + fr, col0 = u.pn * BM + wc * 32 + 8 * fq;
        const float sc = (u.pn * BM < scale_cols) ? scale0 : 1.f;
        f32x4 bv[2][2];
#pragma unroll
        for (int bj = 0; bj < 2; ++bj)
#pragma unroll
            for (int n = 0; n < 2; ++n) bv[bj][n] = bias ? *(const f32x4*)(bias + col0 + bj * HALF + 4 * n) : (f32x4){0.f, 0.f, 0.f, 0.f};
#pragma unroll
        for (int ai = 0; ai < 2; ++ai)
#pragma unroll
            for (int m = 0; m < 4; ++m) { bf16* rowp = O + (size_t)(row0 + ai * HALF + m * 16) * ldc + col0;
#pragma unroll
                for (int bj = 0; bj < 2; ++bj) { f32x4 v0 = (acc[ai][bj][m][0] + bv[bj][0]) * sc, v1 = (acc[ai][bj][m][1] + bv[bj][1]) * sc;
                    u32x4 w; w.x = cvt_pk_bf16(v0[0], v0[1]); w.y = cvt_pk_bf16(v0[2], v0[3]); w.z = cvt_pk_bf16(v1[0], v1[1]); w.w = cvt_pk_bf16(v1[2], v1[3]);
                    *(u32x4*)(rowp + bj * HALF) = w; } }
    }
};
struct EpiInProj {
    bf16* Z; bf16* XBC;
    __device__ __forceinline__ void operator()(const f32x4 (&acc)[2][2][4][2], const Unit& u, int wr, int wc, int fr, int fq) const {
        const int row0 = u.pm * BM + wr * 64 + fr; int colt = u.pn * BM; bf16* base; int ldc;
        if (colt < DI) { base = Z; ldc = DI; } else { base = XBC; ldc = CONVD; colt -= DI; }
        const int col0 = colt + wc * 32 + 8 * fq;
#pragma unroll
        for (int ai = 0; ai < 2; ++ai)
#pragma unroll
            for (int m = 0; m < 4; ++m) { bf16* rowp = base + (size_t)(row0 + ai * HALF + m * 16) * ldc + col0;
#pragma unroll
                for (int bj = 0; bj < 2; ++bj) { const f32x4 v0 = acc[ai][bj][m][0], v1 = acc[ai][bj][m][1];
                    u32x4 w; w.x = cvt_pk_bf16(v0[0], v0[1]); w.y = cvt_pk_bf16(v0[2], v0[3]); w.z = cvt_pk_bf16(v1[0], v1[1]); w.w = cvt_pk_bf16(v1[2], v1[3]);
                    *(u32x4*)(rowp + bj * HALF) = w; } }
    }
};
struct EpiGateUp {
    bf16* Hh;
    __device__ __forceinline__ void operator()(const f32x4 (&acc)[2][2][4][2], const Unit& u, int wr, int wc, int fr, int fq) const {
        const int row0 = u.pm * BM + wr * 64 + fr, col0 = (u.pn * BM + wc * 32 + 8 * fq) >> 1;
#pragma unroll
        for (int ai = 0; ai < 2; ++ai)
#pragma unroll
            for (int m = 0; m < 4; ++m) { bf16* rowp = Hh + (size_t)(row0 + ai * HALF + m * 16) * DFF + col0;
#pragma unroll
                for (int bj = 0; bj < 2; ++bj) { const f32x4 g = acc[ai][bj][m][0], up = acc[ai][bj][m][1];
                    u32x2 w; w.x = cvt_pk_bf16(silu_f(g[0]) * up[0], silu_f(g[1]) * up[1]); w.y = cvt_pk_bf16(silu_f(g[2]) * up[2], silu_f(g[3]) * up[3]);
                    *(u32x2*)(rowp + bj * (HALF / 2)) = w; } }
    }
};
}

#define XB_TMO      128
#define XB_XCNT(j)  (256  + 64 * (j))
#define XB_XSUB(j)  (1280 + 64 * (j))
#define XB_XGEN(j)  (2304 + 64 * (j))
#define XB_TOP      3328
#define XB_TOPGEN   3392
#define XCD_BAR_WORDS 3456
#define XB_SPIN_CAP (1u << 18)
__device__ __forceinline__ unsigned xb_ld(unsigned* p)              { return __hip_atomic_load(p, __ATOMIC_RELAXED, __HIP_MEMORY_SCOPE_AGENT); }
__device__ __forceinline__ unsigned xb_add(unsigned* p, unsigned v) { return __hip_atomic_fetch_add(p, v, __ATOMIC_RELAXED, __HIP_MEMORY_SCOPE_AGENT); }
__device__ __forceinline__ unsigned xb_xcc_id() { return (unsigned)__builtin_amdgcn_s_getreg((3 << 11) | 20) & 0xFu; }
#define XB_SPIN(cond, bar) do { unsigned _sp = 0; while (cond) { __builtin_amdgcn_s_sleep(1); \
    if ((++_sp & 255u) == 0u) { if (xb_ld(&(bar)[XB_TMO])) break; if (_sp > XB_SPIN_CAP) { atomicAdd(&(bar)[XB_TMO], 1u); break; } } } } while (0)
struct XcdBarrier { unsigned* bar; unsigned x; volatile LAS unsigned* st; };
__device__ __forceinline__ XcdBarrier xcd_barrier_post(unsigned* bar, volatile LAS unsigned* st) {
    XcdBarrier b; b.bar = bar; b.x = xb_xcc_id(); b.st = st;
    if (threadIdx.x == 0) (void)xb_add(&bar[XB_XCNT(b.x)], 1u);
    return b;
}
__device__ __forceinline__ void xcd_barrier_complete(unsigned* bar, unsigned x, unsigned& nloc, unsigned& nx) {
    const unsigned G = gridDim.x * gridDim.y * gridDim.z;
    unsigned sum, cnt, mine, sp = 0u;
    for (;;) {
        sum = 0u; cnt = 0u; mine = 0u;
#pragma unroll
        for (unsigned j = 0; j < 16; ++j) { const unsigned c = xb_ld(&bar[XB_XCNT(j)]); sum += c; cnt += (c > 0u) ? 1u : 0u; mine = (j == x) ? c : mine; }
        if (sum == G) break;
        __builtin_amdgcn_s_sleep(1);
        if ((++sp & 255u) == 0u) { if (xb_ld(&bar[XB_TMO])) break; if (sp > XB_SPIN_CAP) { atomicAdd(&bar[XB_TMO], 1u); break; } }
    }
    nloc = mine > 0u ? mine : 1u; nx = cnt > 0u ? cnt : 1u;
}
__device__ __forceinline__ void xcd_barrier(const XcdBarrier& b) {
    asm volatile("s_waitcnt vmcnt(0)" ::: "memory");
    __syncthreads();
    if (threadIdx.x == 0) {
        unsigned* bar = b.bar;
        __builtin_amdgcn_s_waitcnt(0);
        unsigned nloc = b.st[0], nx = b.st[1];
        if (nloc == 0u) { xcd_barrier_complete(bar, b.x, nloc, nx); b.st[0] = nloc; b.st[1] = nx; }
        const unsigned old = xb_add(&bar[XB_XSUB(b.x)], 1u);
        const unsigned gen = old / nloc;
        if (old + 1u == (gen + 1u) * nloc) {
            __builtin_amdgcn_fence(__ATOMIC_RELEASE, "agent");
            asm volatile("s_waitcnt vmcnt(0)" ::: "memory");
            const unsigned og = xb_add(&bar[XB_TOP], 1u);
            const unsigned tg = og / nx;
            if (og + 1u == (tg + 1u) * nx) xb_add(&bar[XB_TOPGEN], 1u);
            else XB_SPIN(xb_ld(&bar[XB_TOPGEN]) == tg, bar);
            __builtin_amdgcn_fence(__ATOMIC_ACQUIRE, "agent");
            xb_add(&bar[XB_XGEN(b.x)], 1u);
            asm volatile("s_waitcnt vmcnt(0)" ::: "memory");
        } else {
            XB_SPIN(xb_ld(&bar[XB_XGEN(b.x)]) == gen, bar);
            __builtin_amdgcn_fence(__ATOMIC_ACQUIRE, "agent");
            asm volatile("s_waitcnt vmcnt(0)" ::: "memory");
        }
    }
    __syncthreads();
}

struct Args { const float* in[23]; float* out; unsigned char* ws; int ph_lo, ph_hi; };

struct Frame {
    LAS unsigned char* lds;
    int tid, lane, wave, vcu, G;
};

__device__ __forceinline__ void transpose_item(const float* W, int K, int N, bf16* WT, int row_off, int mode, const float* kscale, LAS float* scr, int item, int lane) {
    const int nblk = N / 32, kb = item / nblk, nb = item % nblk, k0 = 64 * kb, n0 = 32 * nb;
#pragma unroll 8
    for (int i = 0; i < 32; ++i) { const int kk = 2 * i + (lane >> 5); scr[kk * 33 + (lane & 31)] = W[(size_t)(k0 + kk) * N + n0 + (lane & 31)]; }
    LDS_WAIT(); asm volatile("" ::: "memory");
    const int c = lane & 7;
    float ks[8];
#pragma unroll
    for (int q = 0; q < 8; ++q) ks[q] = kscale ? kscale[k0 + 8 * c + q] : 1.f;
#pragma unroll
    for (int j = 0; j < 4; ++j) { const int n = (lane >> 3) + 8 * j; const LAS float* s = scr + (8 * c) * 33 + n;
        u32x4 o; o.x = pk2(s[0 * 33] * ks[0], s[1 * 33] * ks[1]); o.y = pk2(s[2 * 33] * ks[2], s[3 * 33] * ks[3]); o.z = pk2(s[4 * 33] * ks[4], s[5 * 33] * ks[5]); o.w = pk2(s[6 * 33] * ks[6], s[7 * 33] * ks[7]);
        const int ng = n0 + n; const int dr = (mode == 0) ? ng : (8 * (ng >> 2) + (ng & 3) + (mode == 2 ? 4 : 0));
        *(GAS u32x4*)(WT + (size_t)(row_off + dr) * K + k0 + 8 * c) = o; }
    LDS_WAIT(); asm volatile("" ::: "memory");
}

__device__ __forceinline__ void ln_row(f32x4 (&v)[4], const float* g, const float* b, int lane) {
    float s = 0.f;
#pragma unroll
    for (int j = 0; j < 4; ++j) s += (v[j].x + v[j].y) + (v[j].z + v[j].w);
    const float mean = wave_sum(s) * (1.f / D); float s2 = 0.f;
#pragma unroll
    for (int j = 0; j < 4; ++j) { v[j] = v[j] - mean; s2 += (v[j].x * v[j].x + v[j].y * v[j].y) + (v[j].z * v[j].z + v[j].w * v[j].w); }
    const float rstd = 1.f / sqrtf(wave_sum(s2) * (1.f / D) + LN_EPS);
#pragma unroll
    for (int j = 0; j < 4; ++j) { const f32x4 gg = *(const f32x4*)(g + 4 * lane + 256 * j), bb = *(const f32x4*)(b + 4 * lane + 256 * j); v[j] = v[j] * rstd * gg + bb; }
}
__device__ __forceinline__ f32x4 ld_bf16x4(const bf16* p) { const u32x2 w = *(const u32x2*)p; return (f32x4){bflo(w.x), bfhi(w.x), bflo(w.y), bfhi(w.y)}; }
__device__ __forceinline__ void st_bf16x4(bf16* p, f32x4 v) { u32x2 w; w.x = pk2(v.x, v.y); w.y = pk2(v.z, v.w); *(u32x2*)p = w; }

#ifndef PH_MASK
#define PH_MASK 0x1ffff
#endif
#define IN(k) (((PH_MASK >> (k)) & 1) && lo <= (k) && (k) < hi)
#define SEAM(k) do { if (IN(k) && IN((k) + 1)) xcd_barrier(bar); } while (0)
#define PH_LOCALS \
    int tid = threadIdx.x; asm volatile("" : "+v"(tid)); const int lane = tid & 63, wave = __builtin_amdgcn_readfirstlane(tid >> 6); \
    size_t ws_z_ = 0; asm volatile("" : "+s"(ws_z_)); unsigned char* ws = args.ws + ws_z_;     \
    const int gw = F.vcu * 8 + wave, NGW = F.G * 8; (void)lane; (void)gw; (void)NGW; \
    const float* x_in = args.in[0]; (void)x_in; \
    bf16* Wt_in = (bf16*)(ws + WS_WIN); bf16* Wt_out = (bf16*)(ws + WS_WOUT); (void)Wt_in; (void)Wt_out; \
    bf16* XB = (bf16*)(ws + WS_XB); bf16* Zb = (bf16*)(ws + WS_Z); bf16* XBC = (bf16*)(ws + WS_XBC); (void)XB; (void)Zb; (void)XBC; \
    float* DTRAW = (float*)(ws + WS_DTRAW); float* SSQ = (float*)(ws + WS_SSQ); (void)DTRAW; (void)SSQ; \
    int* LIST = (int*)(ws + WS_LIST); unsigned* INFO = (unsigned*)(ws + WS_INFO); (void)LIST; (void)INFO;


template <int L>
__device__ __forceinline__ void layer_tail(const Args& args, const Frame& F, const XcdBarrier& bar, const int lo, const int hi) {
    const int pb = L ? 13 : 6;
#define LAYER_LOCALS \
    const bf16* MIX = (const bf16*)(ws + (L ? WS_MIX2 : WS_MIX1)); (void)MIX; \
    bf16* XN = (bf16*)(ws + (L ? WS_X3B : WS_X1B)); (void)XN;            \
    bf16* HB = (bf16*)(ws + (L ? WS_H1 : WS_H0)); (void)HB; \
    bf16* Y2 = (bf16*)(ws + (L ? WS_Y21 : WS_Y20)); (void)Y2; \
    gu32* gcnt = (gu32*)(ws + WS_CTL) + CW_CNT + 64 * L; (void)gcnt; \
    LAS int* tokL = (LAS int*)(F.lds + TOKL_OFF); (void)tokL; \
    LAS int* mo = (LAS int*)(F.lds + MOE_OFF); (void)mo;

    if (IN(pb)) { PH_LOCALS LAYER_LOCALS
        const float* lg = args.in[19] + L * D; const float* lb = args.in[20] + L * D;
        const float* rw = args.in[14]; const float* rbias = args.in[15];
        LAS float* rwl = (LAS float*)F.lds;
        LAS int* lcnt = (LAS int*)(F.lds + 65536);
        LAS int* rec = (LAS int*)(F.lds + 65536 + 256);
        for (int i = tid; i < D * NE; i += 512) rwl[(i & 15) * D + (i >> 4)] = rw[i];
        if (tid < 32) lcnt[tid] = 0;
        __syncthreads();
        int li = 0;
        f32x4 nx[4]; u32x2 nm[4];
#define RT_LOAD(mm) do { _Pragma("unroll") for (int j = 0; j < 4; ++j) { nm[j] = *(const u32x2*)(MIX + (size_t)(mm) * D + 4 * lane + 256 * j); \
            if (L == 0) nx[j] = *(const f32x4*)(x_in + (size_t)(mm) * D + 4 * lane + 256 * j); \
            else { const u32x2 t_ = *(const u32x2*)((const bf16*)(ws + WS_X2B) + (size_t)(mm) * D + 4 * lane + 256 * j); nx[j] = (f32x4){bflo(t_.x), bfhi(t_.x), bflo(t_.y), bfhi(t_.y)}; } } } while (0)
        if (gw < T) RT_LOAD(gw);
        for (int m = gw; m < T && li < 32; m += NGW, ++li) {
            f32x4 v[4];
#pragma unroll
            for (int j = 0; j < 4; ++j) v[j] = nx[j] * ALPHA + (f32x4){bflo(nm[j].x), bfhi(nm[j].x), bflo(nm[j].y), bfhi(nm[j].y)};
            if (m + NGW < T) RT_LOAD(m + NGW);
            ln_row(v, lg, lb, lane);
#pragma unroll
            for (int j = 0; j < 4; ++j) st_bf16x4(XN + (size_t)m * D + 4 * lane + 256 * j, v[j]);
            float lgt[NE];
#pragma unroll
            for (int e = 0; e < NE; ++e) { float a_ = 0.f;
#pragma unroll
                for (int j = 0; j < 4; ++j) { const f32x4 w = *(const LAS f32x4*)(rwl + e * D + 256 * j + 4 * lane); a_ += (v[j].x * w.x + v[j].y * w.y) + (v[j].z * w.z + v[j].w * w.w); }
                lgt[e] = a_; }
            { float t8[8], t4[4], t2[2], t1;
#pragma unroll
              for (int e = 0; e < 8; ++e) { const bool up = (lane & 32) != 0; const float snd = up ? lgt[e] : lgt[e + 8], kp = up ? lgt[e + 8] : lgt[e]; t8[e] = kp + __shfl_xor(snd, 32); }
#pragma unroll
              for (int e = 0; e < 4; ++e) { const bool up = (lane & 16) != 0; const float snd = up ? t8[e] : t8[e + 4], kp = up ? t8[e + 4] : t8[e]; t4[e] = kp + __shfl_xor(snd, 16); }
#pragma unroll
              for (int e = 0; e < 2; ++e) { const bool up = (lane & 8) != 0; const float snd = up ? t4[e] : t4[e + 2], kp = up ? t4[e + 2] : t4[e]; t2[e] = kp + __shfl_xor(snd, 8); }
              { const bool up = (lane & 4) != 0; const float snd = up ? t2[0] : t2[1], kp = up ? t2[1] : t2[0]; t1 = kp + __shfl_xor(snd, 4); }
              t1 += __shfl_xor(t1, 2); t1 += __shfl_xor(t1, 1);
#pragma unroll
              for (int e = 0; e < NE; ++e) lgt[e] = __builtin_bit_cast(float, __builtin_amdgcn_readlane(__builtin_bit_cast(int, t1), 4 * e)); }
            float mxl = lgt[0];
#pragma unroll
            for (int e = 1; e < NE; ++e) mxl = fmaxf(mxl, lgt[e]);
            float sc[NE], sel[NE], den = 0.f;
#pragma unroll
            for (int e = 0; e < NE; ++e) { sc[e] = __expf(lgt[e] - mxl); den += sc[e]; }
            const float iden = 1.f / den;
#pragma unroll
            for (int e = 0; e < NE; ++e) { sc[e] *= iden; sel[e] = sc[e] + rbias[e]; }
            int bg = 0; float bgs = -1e30f;
#pragma unroll
            for (int g = 0; g < 4; ++g) { const float a = sel[4 * g], b2 = sel[4 * g + 1], c2 = sel[4 * g + 2], d2 = sel[4 * g + 3];
                const float tot = a + b2 + c2 + d2, mn1 = fminf(fminf(a, b2), fminf(c2, d2));
                float hi1 = fmaxf(fmaxf(a, b2), fmaxf(c2, d2));
                const float m01 = fminf(a, b2), m23 = fminf(c2, d2), M01 = fmaxf(a, b2), M23 = fmaxf(c2, d2);
                const float second = fmaxf(fminf(M01, M23), fmaxf(m01, m23));
                (void)tot; (void)mn1;
                const float gs = hi1 + second;
                if (gs > bgs) { bgs = gs; bg = g; } }
            float s0 = 0.f, s1 = 0.f, s2 = 0.f, s3 = 0.f, p0 = 0.f, p1 = 0.f, p2 = 0.f, p3 = 0.f;
#pragma unroll
            for (int g = 0; g < 4; ++g) if (g == bg) { s0 = sel[4 * g]; s1 = sel[4 * g + 1]; s2 = sel[4 * g + 2]; s3 = sel[4 * g + 3]; p0 = sc[4 * g]; p1 = sc[4 * g + 1]; p2 = sc[4 * g + 2]; p3 = sc[4 * g + 3]; }
            int i1 = 0; float b1 = s0, q1 = p0;
            if (s1 > b1) { b1 = s1; i1 = 1; q1 = p1; } if (s2 > b1) { b1 = s2; i1 = 2; q1 = p2; } if (s3 > b1) { b1 = s3; i1 = 3; q1 = p3; }
            int i2 = -1; float b2v = -1e30f, q2 = 0.f;
            if (i1 != 0 && s0 > b2v) { b2v = s0; i2 = 0; q2 = p0; } if (i1 != 1 && s1 > b2v) { b2v = s1; i2 = 1; q2 = p1; }
            if (i1 != 2 && s2 > b2v) { b2v = s2; i2 = 2; q2 = p2; } if (i1 != 3 && s3 > b2v) { b2v = s3; i2 = 3; q2 = p3; }
            const int e1 = 4 * bg + i1, e2 = 4 * bg + i2; const float gsum = q1 + q2, g1 = q1 / gsum, g2 = q2 / gsum;
            if (lane == 0) {
                const int r1 = atomicAdd((int*)(lcnt + e1), 1), r2 = atomicAdd((int*)(lcnt + e2), 1);
                LAS int* rc = rec + (wave * 32 + li) * 8; rc[0] = e1; rc[1] = r1; rc[2] = e2; rc[3] = r2; rc[4] = __builtin_bit_cast(int, g1); rc[5] = __builtin_bit_cast(int, g2);
            }
        }
        __syncthreads();
        if (tid < NE) lcnt[16 + tid] = (int)__hip_atomic_fetch_add(gcnt + tid, (unsigned)lcnt[tid], RLX_AGENT);
        __syncthreads();
        li = 0;
        for (int m = gw; m < T; m += NGW, ++li) {
            if (lane == 0) {
                const LAS int* rc = rec + (wave * 32 + li) * 8;
                const int e1 = rc[0], e2 = rc[2], sl1 = lcnt[16 + e1] + rc[1], sl2 = lcnt[16 + e2] + rc[3];
                LIST[(size_t)e1 * T + sl1] = m; LIST[(size_t)e2 * T + sl2] = m;
                u32x4 w0; w0.x = (unsigned)e1; w0.y = (unsigned)sl1; w0.z = (unsigned)e2; w0.w = (unsigned)sl2;
                *(u32x4*)(INFO + (size_t)m * 8) = w0; INFO[(size_t)m * 8 + 4] = (unsigned)rc[4]; INFO[(size_t)m * 8 + 5] = (unsigned)rc[5];
            }
        }
    }
    SEAM(pb);

    if (IN(pb + 1) || IN(pb + 2) || IN(pb + 3)) { PH_LOCALS LAYER_LOCALS
        __syncthreads();
        if (tid == 0) { int acc_ = 0; for (int e = 0; e < NE; ++e) { const int c = (int)__hip_atomic_load(gcnt + e, RLX_AGENT); mo[e] = acc_; mo[32 + e] = c; acc_ += (c + 255) >> 8; } mo[16] = acc_; }
        __syncthreads();
    }
    if (IN(pb + 1)) { PH_LOCALS LAYER_LOCALS
        pg8::MoeOrder<true> S{mo, tokL, F.G, F.vcu, D};
        { pg8::Unit u; for (int ui = 0; ui < 6 && S.next(ui, u); ++ui) { if (tid < 256) { const int r = (u.pm - mo[u.e]) * 256 + tid, c = mo[32 + u.e]; tokL[ui * 256 + tid] = LIST[(size_t)u.e * T + (r < c ? r : c - 1)]; } } }
        __syncthreads();
        pg8::EpiGateUp E{HB};
        pg8::gemm_phase<pg8::EpiGateUp, pg8::MoeOrder<true>>(F.lds, XN, (const bf16*)(ws + (L ? WS_WGU1 : WS_WGU0)), D, S, E);
    }
    SEAM(pb + 1);
    if (IN(pb + 2)) { PH_LOCALS LAYER_LOCALS
        pg8::MoeOrder<false> S{mo, tokL, F.G, F.vcu, DFF};
        pg8::EpiPlain E{Y2, D, nullptr, 0, 1.f};
        pg8::gemm_phase<pg8::EpiPlain, pg8::MoeOrder<false>>(F.lds, HB, (const bf16*)(ws + (L ? WS_WD1 : WS_WD0)), DFF, S, E);
    }
    SEAM(pb + 2);
    if (IN(pb + 3)) { PH_LOCALS LAYER_LOCALS
        const float* lg = args.in[21] + L * D; const float* lb = args.in[22] + L * D;
        for (int m = gw; m < T; m += NGW) {
            const u32x4 w0 = *(const u32x4*)(INFO + (size_t)m * 8); const float g1 = __builtin_bit_cast(float, INFO[(size_t)m * 8 + 4]), g2 = __builtin_bit_cast(float, INFO[(size_t)m * 8 + 5]);
            const size_t r1 = (size_t)mo[w0.x] * 256 + w0.y, r2 = (size_t)mo[w0.z] * 256 + w0.w;
            f32x4 v[4];
#pragma unroll
            for (int j = 0; j < 4; ++j) { const int co = 4 * lane + 256 * j;
                v[j] = ld_bf16x4(XN + (size_t)m * D + co) * ALPHA + ld_bf16x4(Y2 + r1 * D + co) * g1 + ld_bf16x4(Y2 + r2 * D + co) * g2; }
            ln_row(v, lg, lb, lane);
            if (L == 0) {
#pragma unroll
                for (int j = 0; j < 4; ++j) st_bf16x4((bf16*)(ws + WS_X2B) + (size_t)m * D + 4 * lane + 256 * j, v[j]);
            } else {
#pragma unroll
                for (int j = 0; j < 4; ++j) *(f32x4*)(args.out + (size_t)m * D + 4 * lane + 256 * j) = v[j];
            }
        }
    }
}

__global__ void __launch_bounds__(512, 2) fwd_kernel(Args args) {
    extern __shared__ __attribute__((aligned(16))) unsigned char lds_raw[];
    Frame F;
    F.lds = (LAS unsigned char*)lds_raw;
    F.tid = threadIdx.x; F.lane = F.tid & 63; F.wave = __builtin_amdgcn_readfirstlane(F.tid >> 6);
    F.G = gridDim.x; { const int bx = blockIdx.x; F.vcu = (F.G % 8 == 0) ? (bx % 8) * (F.G / 8) + bx / 8 : bx; }
    unsigned char* ws = args.ws;
    gu32* ctl = (gu32*)(ws + WS_CTL);
    volatile LAS unsigned* MISC = (volatile LAS unsigned*)(F.lds + MISC_OFF);
    for (int u = F.tid; u < (LDS_BYTES - LDSCTL_OFF) / 4; u += 512) ((LAS unsigned*)(F.lds + LDSCTL_OFF))[u] = 0u;
    __syncthreads();
    XcdBarrier bar; bar.bar = (unsigned*)(ctl + CW_BAR); bar.x = 0; bar.st = nullptr;
    if (MK_N_LAUNCHES == 1) bar = xcd_barrier_post((unsigned*)(ctl + CW_BAR), MISC + 8);
    const int lo = args.ph_lo, hi = args.ph_hi;
    if (IN(0)) { PH_LOCALS
        LAS float* scr = (LAS float*)(F.lds + wave * 16384);
        constexpr int I_IN = (D / 64) * (INP / 32), I_OUT = (DI / 64) * (D / 32);
        for (int it = gw; it < I_IN + I_OUT; it += NGW) {
            if (it < I_IN) transpose_item(args.in[1], D, INP, Wt_in, 0, 0, nullptr, scr, it, lane);
            else transpose_item(args.in[8], DI, D, Wt_out, 0, 0, args.in[7], scr, it - I_IN, lane);
        }
        const size_t n8 = (size_t)T * D / 8;
        for (size_t i = (size_t)blockIdx.x * 512 + tid; i < n8; i += (size_t)F.G * 512) {
            const f32x4 a = *(const f32x4*)(x_in + i * 8), b = *(const f32x4*)(x_in + i * 8 + 4);
            u32x4 o; o.x = pk2(a.x, a.y); o.y = pk2(a.z, a.w); o.z = pk2(b.x, b.y); o.w = pk2(b.z, b.w);
            *(u32x4*)(XB + i * 8) = o;
        }
    }
    SEAM(0);

    if (IN(1)) { PH_LOCALS
        pg8::DenseOrder S; S.init(T, NZX, F.G, (int)blockIdx.x, D);
        pg8::EpiInProj E{Zb, XBC};
        pg8::gemm_phase<pg8::EpiInProj, pg8::DenseOrder>(F.lds, XB, Wt_in, D, S, E);
        for (int tile = gw; tile < T / 16; tile += NGW) {
            const int t0 = tile * 16, r = lane & 15, q = lane >> 4;
            const bf16* xp = XB + (size_t)(t0 + r) * D + 8 * q;
            const bf16* w0 = Wt_in + (size_t)(NZX + r) * D + 8 * q; const bf16* w1 = w0 + (size_t)16 * D;
            f32x4 a0 = {0.f, 0.f, 0.f, 0.f}, a1 = {0.f, 0.f, 0.f, 0.f};
#pragma unroll 4
            for (int k0 = 0; k0 < D; k0 += 32) {
                const bf16x8 xv = *(const bf16x8*)(xp + k0), wa = *(const bf16x8*)(w0 + k0), wb = *(const bf16x8*)(w1 + k0);
                a0 = __builtin_amdgcn_mfma_f32_16x16x32_bf16(wa, xv, a0, 0, 0, 0);
                a1 = __builtin_amdgcn_mfma_f32_16x16x32_bf16(wb, xv, a1, 0, 0, 0);
            }
            float* o = DTRAW + (size_t)(t0 + r) * NH + 4 * q;
            *(f32x4*)o = a0; *(f32x4*)(o + 16) = a1;
        }
    }
    SEAM(1);

    if (IN(2)) { PH_LOCALS
        const float* conv_w = args.in[2]; const float* conv_b = args.in[3];
        bf16* BCACT = (bf16*)(ws + WS_BCACT);
        for (int it = blockIdx.x * 512 + tid; it < (T / 8) * 128; it += F.G * 512) {
            const int ch = it & 127, seg = it >> 7, r0 = seg * 8, s0 = r0 & (SEQ - 1), col = DI + 8 * ch;
            u32x4 rw[11];
#pragma unroll
            for (int q = 0; q < 11; ++q) { const int sr = s0 - 3 + q; const int rc = sr < 0 ? 0 : sr; rw[q] = *(const u32x4*)(XBC + (size_t)(r0 - s0 + rc) * CONVD + col); if (sr < 0) rw[q] = (u32x4){0u, 0u, 0u, 0u}; }
#pragma unroll
            for (int hf = 0; hf < 2; ++hf) {
                f32x4 wq[5];
#pragma unroll
                for (int k = 0; k < 4; ++k) wq[k] = *(const f32x4*)(conv_w + k * CONVD + col + 4 * hf);
                wq[4] = *(const f32x4*)(conv_b + col + 4 * hf);
#pragma unroll
                for (int jj = 0; jj < 8; ++jj) { f32x4 aq = wq[4];
#pragma unroll
                    for (int k = 0; k < 4; ++k) { const u32x4 rq = rw[jj + k]; const unsigned a0 = hf ? rq.z : rq.x, a1 = hf ? rq.w : rq.y; aq += wq[k] * (f32x4){bflo(a0), bfhi(a0), bflo(a1), bfhi(a1)}; }
#pragma unroll
                    for (int e = 0; e < 4; ++e) aq[e] = silu_f(aq[e]);
                    u32x2 o_; o_.x = pk2(aq[0], aq[1]); o_.y = pk2(aq[2], aq[3]);
                    *(u32x2*)(BCACT + (size_t)(r0 + jj) * 1024 + 8 * ch + 4 * hf) = o_; }
            }
        }
    }
    SEAM(2);

    if (IN(3)) { PH_LOCALS
#if NAIVE_SCAN
        const float* conv_w = args.in[2]; const float* conv_b = args.in[3]; const float* dt_bias = args.in[4]; const float* a_log = args.in[5]; const float* dsk = args.in[6];
        for (int item = blockIdx.x; item < NB * NH; item += F.G) {
            if (wave >= 2) continue;
            LAS float* sB = (LAS float*)(F.lds + wave * 8192); LAS float* sC = sB + 128; LAS float* cwl = sC + 128;
            const int b = item / NH, h = item % NH, g = h / 8, pp = 32 * wave + (lane & 31), nh = lane >> 5;
            int col[5]; col[0] = h * HP + pp; col[1] = DI + g * NS + lane; col[2] = col[1] + 64; col[3] = DI + NG * NS + g * NS + lane; col[4] = col[3] + 64;
            float hist[5][3];
#pragma unroll
            for (int c = 0; c < 5; ++c) { cwl[(c * 5 + 4) * 64 + lane] = conv_b[col[c]];
#pragma unroll
                for (int k = 0; k < 4; ++k) cwl[(c * 5 + k) * 64 + lane] = conv_w[k * CONVD + col[c]];
#pragma unroll
                for (int k = 0; k < 3; ++k) hist[c][k] = 0.f; }
            LDS_WAIT();
            const float dtb = dt_bias[h], av = -__expf(a_log[h]), dh = dsk[h];
            float hst[64];
#pragma unroll
            for (int n = 0; n < 64; ++n) hst[n] = 0.f;
            for (int t = 0; t < SEQ; ++t) {
                const size_t row = (size_t)b * SEQ + t;
                float v[5];
#pragma unroll
                for (int c = 0; c < 5; ++c) { const float cur = bf2f(XBC[row * CONVD + col[c]]);
                    float a = cwl[(c * 5 + 4) * 64 + lane] + cwl[(c * 5) * 64 + lane] * hist[c][0] + cwl[(c * 5 + 1) * 64 + lane] * hist[c][1] + cwl[(c * 5 + 2) * 64 + lane] * hist[c][2] + cwl[(c * 5 + 3) * 64 + lane] * cur;
                    hist[c][0] = hist[c][1]; hist[c][1] = hist[c][2]; hist[c][2] = cur; v[c] = silu_f(a); }
                const float raw = DTRAW[row * NH + h] + dtb;
                const float dtv = raw > 20.f ? raw : log1pf(__expf(raw));
                const float dA = __expf(dtv * av);
                sB[lane] = v[1]; sB[lane + 64] = v[2]; sC[lane] = v[3]; sC[lane + 64] = v[4];
                LDS_WAIT(); asm volatile("" ::: "memory");
                const float xd = dtv * v[0]; float y = 0.f;
#pragma unroll
                for (int n = 0; n < 64; n += 4) { const f32x4 bb = *(const LAS f32x4*)(sB + 64 * nh + n), cc = *(const LAS f32x4*)(sC + 64 * nh + n);
                    hst[n] = hst[n] * dA + xd * bb.x; y += cc.x * hst[n];
                    hst[n + 1] = hst[n + 1] * dA + xd * bb.y; y += cc.y * hst[n + 1];
                    hst[n + 2] = hst[n + 2] * dA + xd * bb.z; y += cc.z * hst[n + 2];
                    hst[n + 3] = hst[n + 3] * dA + xd * bb.w; y += cc.w * hst[n + 3]; }
                LDS_WAIT(); asm volatile("" ::: "memory");
                y += __shfl_xor(y, 32);
                y += dh * v[0];
                const float zv = bf2f(Zb[row * DI + h * HP + pp]);
                const float yg = y * silu_f(zv);
                float sq = (lane < 32) ? yg * yg : 0.f; sq = wave_sum(sq);
                if (lane < 32) Zb[row * DI + h * HP + pp] = (bf16)f2bf(yg);
                if (lane == 0) SSQ[row * 64 + h * 2 + wave] = sq;
            }
        }
#else
        const float* conv_w = args.in[2]; const float* conv_b = args.in[3]; const float* dt_bias = args.in[4]; const float* a_log = args.in[5]; const float* dsk = args.in[6];
        typedef short v4i16 __attribute__((ext_vector_type(4)));
        constexpr int SXB = 144, SBB = 272;
        constexpr int XS_OFF = 0, XW_OFF = 9216, BM_OFF = 18432, CM_OFF = 35840, WM_OFF = 53248, HB_OFF = 62464, VEC_OFF = 97280, CW_OFF = 98304;
        LAS unsigned char* Lb = F.lds;
        LAS float* cumL = (LAS float*)(Lb + VEC_OFF);
        LAS float* dtL = cumL + 128;
        LAS float* cwl = (LAS float*)(Lb + CW_OFF);
        const int r16 = lane & 15, q4 = lane >> 4;
#define TR8(dst, base_off, stride, k0, c0) do { const LAS unsigned char* _a = Lb + (base_off) + ((k0) + 8 * q4 + (r16 >> 2)) * (stride) + ((c0) + 4 * (lane & 3)) * 2; \
        const v4i16 _lo = __builtin_amdgcn_ds_read_tr16_b64_v4i16((LAS v4i16*)_a), _hi = __builtin_amdgcn_ds_read_tr16_b64_v4i16((LAS v4i16*)(_a + 4 * (stride))); \
        dst = (bf16x8){_lo[0], _lo[1], _lo[2], _lo[3], _hi[0], _hi[1], _hi[2], _hi[3]}; } while (0)
        for (int item = blockIdx.x; item < NB * NH; item += F.G) {
            const int b = item / NH, h = item % NH, g = h >> 3;
            __syncthreads();
            for (int i = tid; i < 5 * 64; i += 512) { const int k = i >> 6, cl = i & 63; cwl[i] = k < 4 ? conv_w[k * CONVD + h * HP + cl] : conv_b[h * HP + cl]; }
            for (int i = tid; i < SBB * 64 / 4; i += 512) ((LAS unsigned*)(Lb + HB_OFF))[i] = 0u;
            const float dtb = dt_bias[h], av = -__expf(a_log[h]), dh = dsk[h];
            const int sj = tid >> 3, sxc = tid & 7;
            const bf16* BCACT = (const bf16*)(ws + WS_BCACT);
            const size_t row0 = (size_t)b * SEQ;
            f32x4 hacc[4];
#pragma unroll
            for (int i = 0; i < 4; ++i) hacc[i] = (f32x4){0.f, 0.f, 0.f, 0.f};
            u32x4 xraw[4], braw[2], craw[2]; float dtr = 0.f;
#define SC_LOAD(c) do { _Pragma("unroll") for (int k = 0; k < 4; ++k) { const int rr = (c) * 64 + sj - 3 + k; const int rc = rr < 0 ? 0 : rr; \
                xraw[k] = *(const u32x4*)(XBC + (row0 + rc) * CONVD + h * HP + 8 * sxc); if (rr < 0) xraw[k] = (u32x4){0u, 0u, 0u, 0u}; } \
            _Pragma("unroll") for (int i = 0; i < 2; ++i) { const int idx = tid + 512 * i; const bf16* bp_ = BCACT + (row0 + (c) * 64 + (idx >> 4)) * 1024 + g * NS + 8 * (idx & 15); \
                braw[i] = *(const u32x4*)bp_; craw[i] = *(const u32x4*)(bp_ + 512); } } while (0)
#define SC_CUMDT(c) do { if (wave == 7) { const float rw_ = dtr + dtb; const float dtv = rw_ > 15.f ? rw_ : __logf(1.f + __expf(rw_)); float xx = dtv * av; \
                _Pragma("unroll") for (int o = 1; o < 64; o <<= 1) { const float vv = __shfl_up(xx, o); if (lane >= o) xx += vv; } \
                cumL[((c) & 1) * 64 + lane] = xx; dtL[((c) & 1) * 64 + lane] = dtv; } } while (0)
#define SC_STAGE(c) do { const int pr_ = ((c) & 1) * 64; const float wj = __expf(cumL[pr_ + 63] - cumL[pr_ + sj]) * dtL[pr_ + sj]; \
                _Pragma("unroll") for (int hf = 0; hf < 2; ++hf) { f32x4 aq = *(const LAS f32x4*)(cwl + 4 * 64 + 8 * sxc + 4 * hf); \
                    _Pragma("unroll") for (int k = 0; k < 4; ++k) { const f32x4 wq = *(const LAS f32x4*)(cwl + k * 64 + 8 * sxc + 4 * hf); const unsigned r0_ = hf ? xraw[k].z : xraw[k].x, r1_ = hf ? xraw[k].w : xraw[k].y; \
                        aq += wq * (f32x4){bflo(r0_), bfhi(r0_), bflo(r1_), bfhi(r1_)}; } \
                    _Pragma("unroll") for (int e = 0; e < 4; ++e) aq[e] = silu_f(aq[e]); \
                    u32x2 o_; o_.x = pk2(aq[0], aq[1]); o_.y = pk2(aq[2], aq[3]); \
                    *(LAS u32x2*)(Lb + XS_OFF + sj * SXB + 16 * sxc + 8 * hf) = o_; \
                    o_.x = pk2(aq[0] * wj, aq[1] * wj); o_.y = pk2(aq[2] * wj, aq[3] * wj); \
                    *(LAS u32x2*)(Lb + XW_OFF + sj * SXB + 16 * sxc + 8 * hf) = o_; } \
                _Pragma("unroll") for (int i = 0; i < 2; ++i) { const int idx = tid + 512 * i; \
                    *(LAS u32x4*)(Lb + BM_OFF + (idx >> 4) * SBB + 16 * (idx & 15)) = braw[i]; *(LAS u32x4*)(Lb + CM_OFF + (idx >> 4) * SBB + 16 * (idx & 15)) = craw[i]; } } while (0)
            if (wave == 7) dtr = DTRAW[(row0 + lane) * NH + h];
            SC_LOAD(0); SC_CUMDT(0);
            if (wave == 7) dtr = DTRAW[(row0 + 64 + lane) * NH + h];
            __syncthreads();
            SC_STAGE(0);
            __syncthreads();
            const int ti = wave & 3, wh = wave >> 2;
            for (int c = 0; c < SEQ / 64; ++c) {
                const int pr = (c & 1) * 64; const int hb_cur = HB_OFF + (c & 1) * (SBB * 64), hb_nxt = HB_OFF + ((c & 1) ^ 1) * (SBB * 64);
                if (c + 1 < SEQ / 64) { SC_CUMDT(c + 1); SC_LOAD(c + 1); if (wave == 7 && c + 2 < SEQ / 64) dtr = DTRAW[(row0 + (c + 2) * 64 + lane) * NH + h]; }
                const int irow = 16 * ti + r16;
                u32x2 zreg[2];
#pragma unroll
                for (int tt = 0; tt < 2; ++tt) zreg[tt] = *(const u32x2*)(Zb + (row0 + c * 64 + irow) * DI + h * HP + 16 * (2 * wh + tt) + 4 * q4);
                bf16x8 cf[4];
#pragma unroll
                for (int ks = 0; ks < 4; ++ks) cf[ks] = *(const LAS bf16x8*)(Lb + CM_OFF + irow * SBB + (32 * ks + 8 * q4) * 2);
                const float ci = cumL[pr + irow];
#pragma unroll
                for (int tt = 0; tt < 2; ++tt) { const int tj = 2 * wh + tt; f32x4 ga = {0.f, 0.f, 0.f, 0.f};
#pragma unroll
                    for (int ks = 0; ks < 4; ++ks) { const bf16x8 bfr = *(const LAS bf16x8*)(Lb + BM_OFF + (16 * tj + r16) * SBB + (32 * ks + 8 * q4) * 2); ga = __builtin_amdgcn_mfma_f32_16x16x32_bf16(bfr, cf[ks], ga, 0, 0, 0); }
                    const int j0 = 16 * tj + 4 * q4; const f32x4 cj = *(const LAS f32x4*)(cumL + pr + j0), dj = *(const LAS f32x4*)(dtL + pr + j0);
                    float wv[4];
#pragma unroll
                    for (int r = 0; r < 4; ++r) { const int j = j0 + r; float v = ga[r] * __expf(ci - cj[r]) * dj[r]; v = (j <= irow) ? v : 0.f; if (j == irow) v += dh; wv[r] = v; }
                    u32x2 w_; w_.x = pk2(wv[0], wv[1]); w_.y = pk2(wv[2], wv[3]);
                    *(LAS u32x2*)(Lb + WM_OFF + irow * SXB + j0 * 2) = w_; }
                WG_BAR();
                { bf16x8 wf[2];
#pragma unroll
                  for (int ks = 0; ks < 2; ++ks) wf[ks] = *(const LAS bf16x8*)(Lb + WM_OFF + irow * SXB + (32 * ks + 8 * q4) * 2);
                  const float ec = __expf(ci); float ssq = 0.f;
#pragma unroll
                  for (int tt = 0; tt < 2; ++tt) { const int tp = 2 * wh + tt; f32x4 yd = {0.f, 0.f, 0.f, 0.f}, yo = {0.f, 0.f, 0.f, 0.f};
#pragma unroll
                      for (int ks = 0; ks < 2; ++ks) { bf16x8 xa; TR8(xa, XS_OFF, SXB, 32 * ks, 16 * tp); yd = __builtin_amdgcn_mfma_f32_16x16x32_bf16(xa, wf[ks], yd, 0, 0, 0); }
#pragma unroll
                      for (int ks = 0; ks < 4; ++ks) { const bf16x8 ha = *(const LAS bf16x8*)(Lb + hb_cur + (16 * tp + r16) * SBB + (32 * ks + 8 * q4) * 2); yo = __builtin_amdgcn_mfma_f32_16x16x32_bf16(ha, cf[ks], yo, 0, 0, 0); }
                      const float z0 = bflo(zreg[tt].x), z1 = bfhi(zreg[tt].x), z2 = bflo(zreg[tt].y), z3 = bfhi(zreg[tt].y);
                      const float y0 = (yd[0] + ec * yo[0]) * silu_f(z0), y1 = (yd[1] + ec * yo[1]) * silu_f(z1), y2 = (yd[2] + ec * yo[2]) * silu_f(z2), y3 = (yd[3] + ec * yo[3]) * silu_f(z3);
                      ssq += (y0 * y0 + y1 * y1) + (y2 * y2 + y3 * y3);
                      u32x2 o_; o_.x = pk2(y0, y1); o_.y = pk2(y2, y3);
                      *(u32x2*)(Zb + (row0 + c * 64 + irow) * DI + h * HP + 16 * tp + 4 * q4) = o_; }
                  ssq += __shfl_xor(ssq, 16); ssq += __shfl_xor(ssq, 32);
                  if (q4 == 0) SSQ[(row0 + c * 64 + irow) * 64 + h * 2 + wh] = ssq; }
                { const float eL = __expf(cumL[pr + 63]);
#pragma unroll
                  for (int tp = 0; tp < 4; ++tp) hacc[tp] = hacc[tp] * eL;
#pragma unroll
                  for (int ks = 0; ks < 2; ++ks) { bf16x8 ba; TR8(ba, BM_OFF, SBB, 32 * ks, 16 * wave);
#pragma unroll
                      for (int tp = 0; tp < 4; ++tp) { bf16x8 xb; TR8(xb, XW_OFF, SXB, 32 * ks, 16 * tp); hacc[tp] = __builtin_amdgcn_mfma_f32_16x16x32_bf16(ba, xb, hacc[tp], 0, 0, 0); } }
#pragma unroll
                  for (int tp = 0; tp < 4; ++tp) { u32x2 o_; o_.x = pk2(hacc[tp][0], hacc[tp][1]); o_.y = pk2(hacc[tp][2], hacc[tp][3]);
                      *(LAS u32x2*)(Lb + hb_nxt + (16 * tp + r16) * SBB + (16 * wave + 4 * q4) * 2) = o_; } }
                WG_BAR();
                if (c + 1 < SEQ / 64) SC_STAGE(c + 1);
                WG_BAR();
            }
        }
#undef TR8
#undef SC_LOAD
#undef SC_CUMDT
#undef SC_STAGE
#endif
    }
    SEAM(3);

    if (IN(4)) { PH_LOCALS
        for (int m = gw; m < T; m += NGW) {
            float p = SSQ[(size_t)m * 64 + lane];
            p += __shfl_xor(p, 1); p += __shfl_xor(p, 2); p += __shfl_xor(p, 4); p += __shfl_xor(p, 8);
            bf16* yr = Zb + (size_t)m * DI;
#pragma unroll
            for (int j = 0; j < 4; ++j) { const float ss = __shfl(p, 16 * j); const float rs = 1.f / sqrtf(ss * (1.f / 512.f) + RMS_EPS);
                u32x4 w = *(const u32x4*)(yr + j * 512 + lane * 8);
                w.x = pk2(bflo(w.x) * rs, bfhi(w.x) * rs); w.y = pk2(bflo(w.y) * rs, bfhi(w.y) * rs); w.z = pk2(bflo(w.z) * rs, bfhi(w.z) * rs); w.w = pk2(bflo(w.w) * rs, bfhi(w.w) * rs);
                *(u32x4*)(yr + j * 512 + lane * 8) = w; }
        }
        LAS float* scr = (LAS float*)(F.lds + wave * 16384);
        constexpr int I_QKV = (D / 64) * (3 * D / 32), I_O = (D / 64) * (D / 32), I_G = (D / 64) * (DFF / 32), I_D = (DFF / 64) * (D / 32);
        constexpr int I_MOE = 2 * NE * (2 * I_G + I_D);
        for (int it = gw; it < I_QKV + I_O + I_MOE; it += NGW) {
            int r = it;
            if (r < I_QKV) { transpose_item(args.in[9], D, 3 * D, (bf16*)(ws + WS_WQKV), 0, 0, nullptr, scr, r, lane); continue; } r -= I_QKV;
            if (r < I_O) { transpose_item(args.in[12], D, D, (bf16*)(ws + WS_WO), 0, 0, nullptr, scr, r, lane); continue; } r -= I_O;
            const int le = r / (2 * I_G + I_D), L = le / NE, e = le % NE; r -= le * (2 * I_G + I_D);
            bf16* wgu = (bf16*)(ws + (L ? WS_WGU1 : WS_WGU0)) + (size_t)e * 1024 * D; bf16* wd = (bf16*)(ws + (L ? WS_WD1 : WS_WD0)) + (size_t)e * D * DFF;
            if (r < I_G) { transpose_item(args.in[16] + (size_t)le * D * DFF, D, DFF, wgu, 0, 1, nullptr, scr, r, lane); continue; } r -= I_G;
            if (r < I_G) { transpose_item(args.in[17] + (size_t)le * D * DFF, D, DFF, wgu, 0, 2, nullptr, scr, r, lane); continue; } r -= I_G;
            transpose_item(args.in[18] + (size_t)le * DFF * D, DFF, D, wd, 0, 0, nullptr, scr, r, lane);
        }
    }
    SEAM(4);

    if (IN(5)) { PH_LOCALS
        pg8::DenseOrder S; S.init(T, D, F.G, (int)blockIdx.x, DI);
        pg8::EpiPlain E{(bf16*)(ws + WS_MIX1), D, nullptr, 0, 1.f};
        pg8::gemm_phase<pg8::EpiPlain, pg8::DenseOrder>(F.lds, Zb, Wt_out, DI, S, E);
    }
    SEAM(5);

    layer_tail<0>(args, F, bar, lo, hi);
    SEAM(9);

    if (IN(10)) { PH_LOCALS
        pg8::DenseOrder S; S.init(T, 3 * D, F.G, (int)blockIdx.x, D);
        pg8::EpiPlain E{(bf16*)(ws + WS_QKV), 3 * D, args.in[10], D, 0.125f};
        pg8::gemm_phase<pg8::EpiPlain, pg8::DenseOrder>(F.lds, (const bf16*)(ws + WS_X2B), (const bf16*)(ws + WS_WQKV), D, S, E);
    }
    SEAM(10);
    if (IN(11)) { PH_LOCALS
#if NAIVE_ATTN
        const bf16* QKV = (const bf16*)(ws + WS_QKV); bf16* AO = (bf16*)(ws + WS_AO); const float* rel = args.in[11];
        for (int idx = blockIdx.x * 512 + tid; idx < NB * AH * SEQ; idx += F.G * 512) {
            const int s = idx % SEQ, bh = idx / SEQ, hh = bh % AH, b = bh / AH, c = s / 64;
            const bf16* qp = QKV + ((size_t)b * SEQ + s) * (3 * D) + hh * AD;
            float q[AD], o[AD];
#pragma unroll
            for (int d = 0; d < AD; ++d) { q[d] = bf2f(qp[d]); o[d] = 0.f; }
            float mx = -1e30f, l = 0.f;
            const int k0 = (c - LEFTC) * 64 < 0 ? 0 : (c - LEFTC) * 64, k1 = c * 64 + 64;
            for (int kp = k0; kp < k1; ++kp) {
                const bf16* kr = QKV + ((size_t)b * SEQ + kp) * (3 * D) + D + hh * AD; const bf16* vr = kr + D;
                float sc = 0.f;
#pragma unroll
                for (int d = 0; d < AD; d += 2) { const unsigned w = *(const unsigned*)(kr + d); sc += q[d] * bflo(w) + q[d + 1] * bfhi(w); }
                int dist = s - kp; dist = dist < -MAXREL ? -MAXREL : (dist > MAXREL ? MAXREL : dist);
                sc += rel[(dist + MAXREL) * AH + hh];
                const float mn = fmaxf(mx, sc), f = __expf(mx - mn), p = __expf(sc - mn);
                l = l * f + p; mx = mn;
#pragma unroll
                for (int d = 0; d < AD; d += 2) { const unsigned w = *(const unsigned*)(vr + d); o[d] = o[d] * f + p * bflo(w); o[d + 1] = o[d + 1] * f + p * bfhi(w); }
            }
            const float il = 1.f / l; bf16* op = AO + ((size_t)b * SEQ + s) * D + hh * AD;
#pragma unroll
            for (int d = 0; d < AD; d += 2) *(unsigned*)(op + d) = pk2(o[d] * il, o[d + 1] * il);
        }
#else
        const bf16* QKV = (const bf16*)(ws + WS_QKV); bf16* AO = (bf16*)(ws + WS_AO); const float* rel = args.in[11];
        typedef short v4i16 __attribute__((ext_vector_type(4)));
        constexpr int SKB = 144, KB_OFF = 0, VB_OFF = 18432, TB_OFF = 36864; constexpr float LOG2E = 1.4426950408889634f;
        LAS unsigned char* Lb = F.lds; LAS float* tb = (LAS float*)(Lb + TB_OFF);
        const int r16 = lane & 15, q4 = lane >> 4, wq = wave >> 2;
        const int NU = NB * AH * (SEQ / 128), per = (NU + F.G - 1) / F.G;
        int hprev = -1;
        for (int ui = 0; ui < per; ++ui) {
            const int u = F.vcu * per + ui; if (u >= NU) break;
            const int bh = u >> 5, cp = u & 31, b = bh >> 4, hh = bh & 15, c0 = 2 * cp;
            __syncthreads();
            if (hh != hprev) { for (int i = tid; i < 2 * MAXREL + 1; i += 512) tb[i] = rel[i * AH + hh] * LOG2E; hprev = hh; }
            const int cw = c0 + wq, qrow = 64 * cw + 16 * (wave & 3) + r16;
            const size_t tok0 = (size_t)b * SEQ;
            bf16x8 qf[2];
#pragma unroll
            for (int ds = 0; ds < 2; ++ds) qf[ds] = *(const bf16x8*)(QKV + (tok0 + qrow) * (3 * D) + hh * AD + 32 * ds + 8 * q4);
            f32x4 oacc[4];
#pragma unroll
            for (int i = 0; i < 4; ++i) oacc[i] = (f32x4){0.f, 0.f, 0.f, 0.f};
            float mrun = -1e30f, lrun = 0.f;
            const int kt_lo = c0 < 8 ? 8 - c0 : 0;
            const int kr = tid >> 3, pc = tid & 7;
            const bf16* kvp = QKV + (tok0 + kr) * (3 * D) + D + hh * AD + 8 * pc;
            u32x4 kreg, vreg;
            { const size_t co = (size_t)(c0 - 8 + kt_lo) * 64 * (3 * D); kreg = *(const u32x4*)(kvp + co); vreg = *(const u32x4*)(kvp + co + D); }
            *(LAS u32x4*)(Lb + KB_OFF + (kt_lo & 1) * 9216 + kr * SKB + pc * 16) = kreg; *(LAS u32x4*)(Lb + VB_OFF + (kt_lo & 1) * 9216 + kr * SKB + pc * 16) = vreg;
            __syncthreads();
            for (int kt = kt_lo; kt < 10; ++kt) {
                const int chunk = c0 - 8 + kt;
                if (kt + 1 < 10) { const size_t co = (size_t)(chunk + 1) * 64 * (3 * D); kreg = *(const u32x4*)(kvp + co); vreg = *(const u32x4*)(kvp + co + D); }
                if (kt >= wq && kt <= wq + 8) {
                    const LAS unsigned char* Kb = Lb + KB_OFF + (kt & 1) * 9216; const LAS unsigned char* Vb = Lb + VB_OFF + (kt & 1) * 9216;
                    f32x4 sc[4];
#pragma unroll
                    for (int t = 0; t < 4; ++t) { sc[t] = (f32x4){0.f, 0.f, 0.f, 0.f};
#pragma unroll
                        for (int ds = 0; ds < 2; ++ds) { const bf16x8 kf = *(const LAS bf16x8*)(Kb + (16 * t + r16) * SKB + (32 * ds + 8 * q4) * 2); sc[t] = __builtin_amdgcn_mfma_f32_16x16x32_bf16(kf, qf[ds], sc[t], 0, 0, 0); } }
                    if (cw - chunk >= 3) { const float bc = tb[2 * MAXREL];
#pragma unroll
                        for (int t = 0; t < 4; ++t) sc[t] = sc[t] * LOG2E + bc;
                    } else {
#pragma unroll
                        for (int t = 0; t < 4; ++t)
#pragma unroll
                            for (int r = 0; r < 4; ++r) { int dist = qrow - (64 * chunk + 16 * t + 4 * q4 + r); dist = dist < -MAXREL ? -MAXREL : (dist > MAXREL ? MAXREL : dist); sc[t][r] = sc[t][r] * LOG2E + tb[dist + MAXREL]; }
                    }
                    float mx = fmaxf(fmaxf(sc[0][0], sc[0][1]), fmaxf(sc[0][2], sc[0][3]));
#pragma unroll
                    for (int t = 1; t < 4; ++t) mx = fmaxf(mx, fmaxf(fmaxf(sc[t][0], sc[t][1]), fmaxf(sc[t][2], sc[t][3])));
                    mx = fmaxf(mx, __shfl_xor(mx, 16)); mx = fmaxf(mx, __shfl_xor(mx, 32));
                    const float mnew = fmaxf(mrun, mx), alpha = __builtin_amdgcn_exp2f(mrun - mnew); mrun = mnew;
                    float ls = 0.f;
#pragma unroll
                    for (int t = 0; t < 4; ++t)
#pragma unroll
                        for (int r = 0; r < 4; ++r) { sc[t][r] = __builtin_amdgcn_exp2f(sc[t][r] - mnew); ls += sc[t][r]; }
                    lrun = lrun * alpha + ls;
#pragma unroll
                    for (int i = 0; i < 4; ++i) oacc[i] = oacc[i] * alpha;
                    bf16x8 pb[2];
#pragma unroll
                    for (int kk = 0; kk < 2; ++kk) { u32x4 w_; w_.x = pk2(sc[2 * kk][0], sc[2 * kk][1]); w_.y = pk2(sc[2 * kk][2], sc[2 * kk][3]); w_.z = pk2(sc[2 * kk + 1][0], sc[2 * kk + 1][1]); w_.w = pk2(sc[2 * kk + 1][2], sc[2 * kk + 1][3]); pb[kk] = __builtin_bit_cast(bf16x8, w_); }
#pragma unroll
                    for (int dt = 0; dt < 4; ++dt)
#pragma unroll
                        for (int kk = 0; kk < 2; ++kk) { const LAS unsigned char* va_ = Vb + (32 * kk + 4 * q4 + (r16 >> 2)) * SKB + (16 * dt + 4 * (lane & 3)) * 2;
                            const v4i16 lo_ = __builtin_amdgcn_ds_read_tr16_b64_v4i16((LAS v4i16*)va_), hi_ = __builtin_amdgcn_ds_read_tr16_b64_v4i16((LAS v4i16*)(va_ + 16 * SKB));
                            const bf16x8 vf = (bf16x8){lo_[0], lo_[1], lo_[2], lo_[3], hi_[0], hi_[1], hi_[2], hi_[3]};
                            oacc[dt] = __builtin_amdgcn_mfma_f32_16x16x32_bf16(vf, pb[kk], oacc[dt], 0, 0, 0); }
                }
                if (kt + 1 < 10) { *(LAS u32x4*)(Lb + KB_OFF + ((kt + 1) & 1) * 9216 + kr * SKB + pc * 16) = kreg; *(LAS u32x4*)(Lb + VB_OFF + ((kt + 1) & 1) * 9216 + kr * SKB + pc * 16) = vreg; }
                WG_BAR();
            }
            lrun += __shfl_xor(lrun, 16); lrun += __shfl_xor(lrun, 32);
            const float il = 1.f / lrun; bf16* op = AO + (tok0 + qrow) * D + hh * AD + 4 * q4;
#pragma unroll
            for (int dt = 0; dt < 4; ++dt) { u32x2 o_; o_.x = pk2(oacc[dt][0] * il, oacc[dt][1] * il); o_.y = pk2(oacc[dt][2] * il, oacc[dt][3] * il); *(u32x2*)(op + 16 * dt) = o_; }
        }
#endif
    }
    SEAM(11);
    if (IN(12)) { PH_LOCALS
        pg8::DenseOrder S; S.init(T, D, F.G, (int)blockIdx.x, D);
        pg8::EpiPlain E{(bf16*)(ws + WS_MIX2), D, args.in[13], 0, 1.f};
        pg8::gemm_phase<pg8::EpiPlain, pg8::DenseOrder>(F.lds, (const bf16*)(ws + WS_AO), (const bf16*)(ws + WS_WO), D, S, E);
    }
    SEAM(12);
    layer_tail<1>(args, F, bar, lo, hi);
#undef IN
#undef SEAM
}

extern "C" void kernel_launch(void* const* d_in, const int* in_sizes, int n_in, void* d_out, int out_size, void* d_ws, size_t ws_size, hipStream_t stream) {
    static int grid = 0;
    if (grid == 0) {
        if (n_in != 23 || in_sizes[0] != T * D || out_size != T * D || ws_size < WS_END) { fprintf(stderr, "kernel_launch: unexpected shapes / workspace (n_in %d, ws %zu); nothing launched\n", n_in, ws_size); grid = -1; return; }
        int dev = 0, cus = 0, per_cu = 0;
        if (hipGetDevice(&dev) != hipSuccess || hipDeviceGetAttribute(&cus, hipDeviceAttributeMultiprocessorCount, dev) != hipSuccess) { grid = -1; return; }
        if (hipFuncSetAttribute((const void*)fwd_kernel, hipFuncAttributeMaxDynamicSharedMemorySize, LDS_BYTES) != hipSuccess) { fprintf(stderr, "kernel_launch: hipFuncSetAttribute failed\n"); grid = -1; return; }
        if (hipOccupancyMaxActiveBlocksPerMultiprocessor(&per_cu, (const void*)fwd_kernel, 512, LDS_BYTES) != hipSuccess || per_cu < 1) fprintf(stderr, "kernel_launch: occupancy query reports %d\n", per_cu);
        (void)hipGetLastError();
        grid = cus;
    }
    if (grid < 0) return;
    if (hipMemsetAsync((char*)d_ws + WS_CTL, 0, CTL_ZERO_BYTES, stream) != hipSuccess) return;
    Args a{};
    for (int i = 0; i < 23; ++i) a.in[i] = (const float*)d_in[i];
    a.out = (float*)d_out; a.ws = (unsigned char*)d_ws;
    if (MK_N_LAUNCHES == 1) { a.ph_lo = 0; a.ph_hi = NPHASE; hipLaunchKernelGGL(fwd_kernel, dim3(grid), dim3(512), LDS_BYTES, stream, a);
#ifdef PROBE_MASK
        for (int p = 0; p < NPHASE; ++p) if ((PROBE_MASK >> p) & 1) { a.ph_lo = p; a.ph_hi = p + 1; hipLaunchKernelGGL(fwd_kernel, dim3(grid), dim3(512), LDS_BYTES, stream, a); }
#endif
    }
    else for (int p = 0; p < NPHASE; ++p) { a.ph_lo = p; a.ph_hi = p + 1; hipLaunchKernelGGL(fwd_kernel, dim3(grid), dim3(512), LDS_BYTES, stream, a); }
}
```

```cpp
#include <hip/hip_runtime.h>
#include <cstdio>
#include <cstdint>

#ifndef MK_N_LAUNCHES
#define MK_N_LAUNCHES 1
#endif
#ifndef NAIVE_SCAN
#define NAIVE_SCAN 0
#endif
#ifndef NAIVE_ATTN
#define NAIVE_ATTN 0
#endif

#define LAS __attribute__((address_space(3)))
#define GAS __attribute__((address_space(1)))
typedef unsigned short bf16;
typedef short bf16x8 __attribute__((ext_vector_type(8)));
typedef float f32x4 __attribute__((ext_vector_type(4)));
typedef float f32x2 __attribute__((ext_vector_type(2)));
typedef unsigned u32x4 __attribute__((ext_vector_type(4)));
typedef unsigned u32x2 __attribute__((ext_vector_type(2)));
typedef GAS unsigned gu32;

constexpr int NB = 8, SEQ = 4096, D = 1024, T = NB * SEQ;
constexpr int DI = 2048, NH = 32, HP = 64, NG = 4, NS = 128, CONVD = 3072, INP = 5152, NZX = 5120;
constexpr int AH = 16, AD = 64, LEFTC = 8, MAXREL = 128;
constexpr int NE = 16, DFF = 512;
constexpr float ALPHA = 1.4142135623730951f;
constexpr float LN_EPS = 1e-5f, RMS_EPS = 1e-5f;
constexpr int NPHASE = 17;
constexpr int MAXTILES = 272;

constexpr size_t MiB = 1u << 20;
constexpr size_t WS_CTL = 0, CTL_ZERO_BYTES = 1 * MiB;
constexpr size_t WS_WIN = 1 * MiB;
constexpr size_t WS_WOUT = 12 * MiB;
constexpr size_t WS_XB = 16 * MiB;
constexpr size_t WS_BCACT = 16 * MiB;
constexpr size_t WS_WGU0 = 16 * MiB, WS_WD0 = 48 * MiB, WS_WQKV = 64 * MiB, WS_WO = 70 * MiB, WS_WGU1 = 72 * MiB, WS_WD1 = 104 * MiB;
constexpr size_t WS_Z = 120 * MiB;
constexpr size_t WS_XBC = 248 * MiB;
constexpr size_t WS_DTRAW = 440 * MiB;
constexpr size_t WS_SSQ = 444 * MiB;
constexpr size_t WS_MIX1 = 248 * MiB;
constexpr size_t WS_X1B = 324 * MiB;
constexpr size_t WS_H0 = 120 * MiB;
constexpr size_t WS_Y20 = 188 * MiB;
constexpr size_t WS_X2B = 120 * MiB;
constexpr size_t WS_QKV = 188 * MiB;
constexpr size_t WS_AO = 380 * MiB;
constexpr size_t WS_MIX2 = 188 * MiB;
constexpr size_t WS_X3B = 256 * MiB;
constexpr size_t WS_H1 = 320 * MiB;
constexpr size_t WS_Y21 = 120 * MiB;
constexpr size_t WS_LIST = 500 * MiB;
constexpr size_t WS_INFO = 504 * MiB;
constexpr size_t WS_END = 512 * MiB;
constexpr int CW_TMO = 0;
constexpr int CW_CNT = 1024;
constexpr int CW_BAR = 4096;

constexpr int RING_BYTES = 131072;
constexpr int LDSCTL_OFF = RING_BYTES, MISC_OFF = LDSCTL_OFF + 320;
constexpr int TOKL_OFF = LDSCTL_OFF + 1024;
constexpr int MOE_OFF = TOKL_OFF + 6 * 1024;
constexpr int LDS_BYTES = 147456;

#define RLX_AGENT __ATOMIC_RELAXED, __HIP_MEMORY_SCOPE_AGENT
#define LDS_WAIT() asm volatile("s_waitcnt lgkmcnt(0)" ::: "memory")
#define VM_WAIT() asm volatile("s_waitcnt vmcnt(0)" ::: "memory")
#define WG_BAR() do { asm volatile("s_waitcnt lgkmcnt(0)" ::: "memory"); __builtin_amdgcn_s_barrier(); asm volatile("" ::: "memory"); } while (0)

__device__ __forceinline__ unsigned f2bf(float f) { unsigned u = __builtin_bit_cast(unsigned, f); return (u + 0x7fffu + ((u >> 16) & 1u)) >> 16; }
__device__ __forceinline__ unsigned pk2(float lo, float hi) { return f2bf(lo) | (f2bf(hi) << 16); }
__device__ __forceinline__ float bf2f(unsigned short b) { return __builtin_bit_cast(float, ((unsigned)b) << 16); }
__device__ __forceinline__ float bflo(unsigned w) { return __builtin_bit_cast(float, w << 16); }
__device__ __forceinline__ float bfhi(unsigned w) { return __builtin_bit_cast(float, w & 0xffff0000u); }
__device__ __forceinline__ float silu_f(float v) { return v * __builtin_amdgcn_rcpf(1.f + __expf(-v)); }
template <int CTRL> __device__ __forceinline__ float dpp_mov(float v) { return __builtin_bit_cast(float, __builtin_amdgcn_update_dpp(0, __builtin_bit_cast(int, v), CTRL, 0xF, 0xF, true)); }
__device__ __forceinline__ float wave_sum(float v) {
    v += dpp_mov<0xB1>(v); v += dpp_mov<0x4E>(v); v += dpp_mov<0x141>(v); v += dpp_mov<0x140>(v);
    const int vi = __builtin_bit_cast(int, v);
    return (__builtin_bit_cast(float, __builtin_amdgcn_readlane(vi, 0)) + __builtin_bit_cast(float, __builtin_amdgcn_readlane(vi, 16))) + (__builtin_bit_cast(float, __builtin_amdgcn_readlane(vi, 32)) + __builtin_bit_cast(float, __builtin_amdgcn_readlane(vi, 48)));
}

namespace pg8 {
constexpr int BM = 256, BK = 64, HALF = 128, HTB = HALF * BK * 2, STAGE_BYTES = 8 * HTB;
__device__ __forceinline__ int lds_byte(int r, int c) { const int st = (r >> 4) * 2 + (c >> 5), rr = r & 15, cc = c & 31, ob = rr * 64 + cc * 2; return st * 1024 + (ob ^ (((ob >> 9) & 1) << 5)); }
__device__ __forceinline__ void stage_rc(int b, int& R, int& C) { const int st = b / 1024, sb = b % 1024, swz = sb ^ (((sb >> 9) & 1) << 5); R = (st >> 1) * 16 + swz / 64; C = (st & 1) * 32 + (swz % 64) / 2; }
__device__ __forceinline__ int perm32(int rho) { const int n = rho >> 4, i = rho & 15; return 8 * (i >> 2) + 4 * n + (i & 3); }
__device__ __forceinline__ unsigned cvt_pk_bf16(float lo, float hi) { unsigned r; asm volatile("v_cvt_pk_bf16_f32 %0, %1, %2" : "=v"(r) : "v"(lo), "v"(hi)); return r; }

struct Unit { int pm, pn, bt, e; };

template <class Epi, class Sched>
__device__ __forceinline__ void gemm_phase(LAS unsigned char* lds, const bf16* A, const bf16* Bt, int K, const Sched& S, const Epi& E) {
    int tid = threadIdx.x; asm volatile("" : "+v"(tid));
    const int wid = __builtin_amdgcn_readfirstlane(tid >> 6), lane = tid & 63, wr = wid >> 2, wc = wid & 3, fr = lane & 15, fq = lane >> 4;
    const int nt = K / BK;
    int Rr[2], Cc[2]; unsigned voffB[2];
#pragma unroll
    for (int i = 0; i < 2; ++i) { stage_rc(tid * 16 + i * 8192, Rr[i], Cc[i]); const int Rb = (Rr[i] & ~31) + perm32(Rr[i] & 31); voffB[i] = (unsigned)(Rb * K + Cc[i]) * 2u; }
    const size_t kstep = (size_t)(BK * 2);
    const size_t hstep = (size_t)HALF * K * 2;
    const size_t tstep = 2 * hstep;
    const unsigned ldsw = (unsigned)wid * 1024u;
    const int aoff = lds_byte(wr * 64 + fr, fq * 8), boff = lds_byte(wc * 32 + fr, fq * 8);
#define PG8_SA(b, h) (((b) * 2 + (h)) * HTB)
#define PG8_SB(b, h) ((4 + (b) * 2 + (h)) * HTB)
#define PG8_STAGE(bufoff, gbase, voff) do { _Pragma("unroll") for (int _i = 0; _i < 2; ++_i) \
        __builtin_amdgcn_global_load_lds((const unsigned*)((const char*)(gbase) + (voff)[_i]), (LAS unsigned*)(lds + (bufoff) + ldsw + _i * 8192), 16, 0, 0); } while (0)
#define PG8_LDA(dst, b, h) do { _Pragma("unroll") for (int m = 0; m < 4; ++m) _Pragma("unroll") for (int k = 0; k < 2; ++k) dst[m][k] = *(const LAS bf16x8*)(lds + PG8_SA(b, h) + aoff + m * 2048 + k * 1024); } while (0)
#define PG8_LDB(dst, b, h) do { _Pragma("unroll") for (int n = 0; n < 2; ++n) _Pragma("unroll") for (int k = 0; k < 2; ++k) dst[n][k] = *(const LAS bf16x8*)(lds + PG8_SB(b, h) + boff + n * 2048 + k * 1024); } while (0)
#define PG8_MMA(ai, bj, At, Bt_) do { __builtin_amdgcn_s_setprio(1); _Pragma("unroll") for (int m = 0; m < 4; ++m) _Pragma("unroll") for (int n = 0; n < 2; ++n) _Pragma("unroll") for (int k = 0; k < 2; ++k) \
        acc[ai][bj][m][n] = __builtin_amdgcn_mfma_f32_16x16x32_bf16(Bt_[n][k], At[m][k], acc[ai][bj][m][n], 0, 0, 0); __builtin_amdgcn_s_setprio(0); } while (0)
#define PG8_WAIT_V(n) asm volatile("s_waitcnt vmcnt(" #n ")" ::: "memory")
#define PG8_WAIT_L(n) asm volatile("s_waitcnt lgkmcnt(" #n ")" ::: "memory")
#define PG8_BAR __builtin_amdgcn_s_barrier()
#define PG8_SCHED __builtin_amdgcn_sched_barrier(0)
    Unit cur, nxt; int ui = 0;
    if (!S.next(0, cur)) return;
    f32x4 acc[2][2][4][2];
#pragma unroll
    for (int a = 0; a < 2; ++a)
#pragma unroll
        for (int b = 0; b < 2; ++b)
#pragma unroll
            for (int m = 0; m < 4; ++m)
#pragma unroll
                for (int n = 0; n < 2; ++n) acc[a][b][m][n] = (f32x4){0.f, 0.f, 0.f, 0.f};
    bf16x8 At[4][2], B0[2][2], B1[2][2];
    unsigned vA0[2], vA1[2];
#pragma unroll
    for (int i = 0; i < 2; ++i) { vA0[i] = S.a_off(0, cur, 0, Rr[i], Cc[i]); vA1[i] = S.a_off(0, cur, 1, Rr[i], Cc[i]); }
    const char* Ab = (const char*)A;
    const char* cB = (const char*)Bt + (size_t)cur.bt * tstep;
    PG8_STAGE(PG8_SB(0, 0), cB, voffB); PG8_STAGE(PG8_SB(0, 1), cB + hstep, voffB); PG8_STAGE(PG8_SA(0, 0), Ab, vA0); PG8_STAGE(PG8_SA(0, 1), Ab, vA1);
    if (wr == 1) PG8_BAR;
    PG8_WAIT_V(2); PG8_BAR;
    PG8_STAGE(PG8_SB(1, 0), cB + kstep, voffB); PG8_STAGE(PG8_SA(1, 0), Ab + kstep, vA0); PG8_STAGE(PG8_SB(1, 1), cB + hstep + kstep, voffB);
    PG8_WAIT_V(6); PG8_BAR;
    for (;;) {
        const bool has_next = S.next(ui + 1, nxt);
        const char* nB = has_next ? (const char*)Bt + (size_t)nxt.bt * tstep : cB;
        for (int t = 0; t < nt; t += 2) {
            const bool last = (t == nt - 2);
            const char* a1 = Ab + (size_t)(t + 1) * kstep;
            const char* a2 = last ? Ab : Ab + (size_t)(t + 2) * kstep; const char* b2 = last ? nB : cB + (size_t)(t + 2) * kstep;
            const char* a3 = a2 + kstep; const char* b3 = b2 + kstep;
            unsigned v20[2], v21[2];
#pragma unroll
            for (int i = 0; i < 2; ++i) { v20[i] = vA0[i]; v21[i] = vA1[i]; }
            if (last && has_next) {
#pragma unroll
                for (int i = 0; i < 2; ++i) { v20[i] = S.a_off(ui + 1, nxt, 0, Rr[i], Cc[i]); v21[i] = S.a_off(ui + 1, nxt, 1, Rr[i], Cc[i]); } }
            PG8_LDB(B0, 0, 0); PG8_LDB(B1, 0, 1); PG8_SCHED; PG8_LDA(At, 0, 0); PG8_STAGE(PG8_SA(1, 1), a1, vA1);
            PG8_WAIT_V(8); PG8_WAIT_L(0); PG8_BAR; PG8_MMA(0, 0, At, B0); PG8_MMA(0, 1, At, B1); PG8_BAR; PG8_SCHED;
            PG8_LDA(At, 0, 1); PG8_STAGE(PG8_SB(0, 0), b2, voffB); PG8_STAGE(PG8_SB(0, 1), b2 + hstep, voffB); PG8_STAGE(PG8_SA(0, 0), a2, v20);
            PG8_WAIT_V(8); PG8_WAIT_L(0); PG8_BAR; PG8_MMA(1, 0, At, B0); PG8_MMA(1, 1, At, B1); PG8_BAR; PG8_SCHED;
            PG8_LDB(B0, 1, 0); PG8_LDB(B1, 1, 1); PG8_SCHED; PG8_LDA(At, 1, 0); PG8_STAGE(PG8_SA(0, 1), a2, v21);
            PG8_WAIT_V(8); PG8_WAIT_L(0); PG8_BAR; PG8_MMA(0, 0, At, B0); PG8_MMA(0, 1, At, B1); PG8_BAR; PG8_SCHED;
            PG8_LDA(At, 1, 1); PG8_STAGE(PG8_SB(1, 0), b3, voffB); PG8_STAGE(PG8_SB(1, 1), b3 + hstep, voffB); PG8_STAGE(PG8_SA(1, 0), a3, v20);
            PG8_WAIT_V(8); PG8_WAIT_L(0); PG8_BAR; PG8_MMA(1, 0, At, B0); PG8_MMA(1, 1, At, B1); PG8_BAR; PG8_SCHED;
        }
        if (wr == 0) PG8_BAR;
        E(acc, cur, wr, wc, fr, fq);
        if (!has_next) break;
#pragma unroll
        for (int a = 0; a < 2; ++a)
#pragma unroll
            for (int b = 0; b < 2; ++b)
#pragma unroll
                for (int m = 0; m < 4; ++m)
#pragma unroll
                    for (int n = 0; n < 2; ++n) acc[a][b][m][n] = (f32x4){0.f, 0.f, 0.f, 0.f};
        cur = nxt; cB = nB; ++ui;
#pragma unroll
        for (int i = 0; i < 2; ++i) { vA0[i] = S.a_off(ui, cur, 0, Rr[i], Cc[i]); vA1[i] = S.a_off(ui, cur, 1, Rr[i], Cc[i]); }
        if (wr == 1) PG8_BAR;
    }
    PG8_WAIT_V(0);
    PG8_BAR;
#undef PG8_SA
#undef PG8_SB
#undef PG8_STAGE
#undef PG8_LDA
#undef PG8_LDB
#undef PG8_MMA
#undef PG8_WAIT_V
#undef PG8_WAIT_L
#undef PG8_BAR
#undef PG8_SCHED
}

struct DenseOrder {
    int nM, nN, nwg, G, c, lda;
    __device__ void init(int M, int N, int G_, int c_, int lda_) { nM = M / BM; nN = N / BM; nwg = nM * nN; G = G_; c = c_; lda = lda_; }
    __device__ __forceinline__ bool next(int i, Unit& u) const {
        const long L = (long)i * G + c; if (L >= nwg) return false;
        int wgid = (int)L; { const int q = nwg / 8, r = nwg % 8, xcd = wgid % 8, off = wgid / 8; wgid = (xcd < r ? xcd * (q + 1) : r * (q + 1) + (xcd - r) * q) + off; }
        const int nig = 8 * nN, gid = wgid / nig, fm = gid * 8, gsz = (nM - fm) < 8 ? (nM - fm) : 8;
        u.pm = fm + ((wgid % nig) % gsz); u.pn = (wgid % nig) / gsz; u.bt = u.pn; u.e = 0; return true;
    }
    __device__ __forceinline__ unsigned a_off(int, const Unit& u, int h, int R, int C) const { return (unsigned)((u.pm * BM + h * HALF + R) * lda + C) * 2u; }
};
template <bool GATHER> struct MoeOrder {
    const LAS int* ts;
    const LAS int* tokL;
    int G, c, lda;
    __device__ __forceinline__ bool next(int i, Unit& u) const {
        const int L = i * G + c; const int ntile = __builtin_amdgcn_readfirstlane(ts[16]);
        if (L >= ntile * 4) return false;
        const int rt = L >> 2; int e = 0;
#pragma unroll
        for (int j = 1; j < 16; ++j) e += (rt >= ts[j]) ? 1 : 0;
        e = __builtin_amdgcn_readfirstlane(e);
        u.pm = rt; u.pn = L & 3; u.e = e; u.bt = e * 4 + (L & 3); return true;
    }
    __device__ __forceinline__ unsigned a_off(int ui, const Unit& u, int h, int R, int C) const {
        if (GATHER) { const int tok = tokL[ui * 256 + h * HALF + R]; return (unsigned)(tok * lda + C) * 2u; }
        return (unsigned)((u.pm * BM + h * HALF + R) * lda + C) * 2u;
    }
};

struct EpiPlain {
    bf16* O; int ldc; const float* bias; int scale_cols; float scale0;
    __device__ __forceinline__ void operator()(const f32x4 (&acc)[2][2][4][2], const Unit& u, int wr, int wc, int fr, int fq) const {
        const int row0 = u.pm * BM + wr * 64 + fr, col0 = u.pn * BM + wc * 32 + 8 * fq;
        const float sc = (u.pn * BM < scale_cols) ? scale0 : 1.f;
        f32x4 bv[2][2];
#pragma unroll
        for (int bj = 0; bj < 2; ++bj)
#pragma unroll
            for (int n = 0; n < 2; ++n) bv[bj][n] = bias ? *(const f32x4*)(bias + col0 + bj * HALF + 4 * n) : (f32x4){0.f, 0.f, 0.f, 0.f};
#pragma unroll
        for (int ai = 0; ai < 2; ++ai)
#pragma unroll
            for (int m = 0; m < 4; ++m) { bf16* rowp = O + (size_t)(row0 + ai * HALF + m * 16) * ldc + col0;
#pragma unroll
                for (int bj = 0; bj < 2; ++bj) { f32x4 v0 = (acc[ai][bj][m][0] + bv[bj][0]) * sc, v1 = (acc[ai][bj][m][1] + bv[bj][1]) * sc;
                    u32x4 w; w.x = cvt_pk_bf16(v0[0], v0[1]); w.y = cvt_pk_bf16(v0[2], v0[3]); w.z = cvt_pk_bf16(v1[0], v1[1]); w.w = cvt_pk_bf16(v1[2], v1[3]);
                    *(u32x4*)(rowp + bj * HALF) = w; } }
    }
};
struct EpiInProj {
    bf16* Z; bf16* XBC;
    __device__ __forceinline__ void operator()(const f32x4 (&acc)[2][2][4][2], const Unit& u, int wr, int wc, int fr, int fq) const {
        const int row0 = u.pm * BM + wr * 64 + fr; int colt = u.pn * BM; bf16* base; int ldc;
        if (colt < DI) { base = Z; ldc = DI; } else { base = XBC; ldc = CONVD; colt -= DI; }
        const int col0 = colt + wc * 32 + 8 * fq;
#pragma unroll
        for (int ai = 0; ai < 2; ++ai)
#pragma unroll
            for (int m = 0; m < 4; ++m) { bf16* rowp = base + (size_t)(row0 + ai * HALF + m * 16) * ldc + col0;
#pragma unroll
                for (int bj = 0; bj < 2; ++bj) { const f32x4 v0 = acc[ai][bj][m][0], v1 = acc[ai][bj][m][1];
                    u32x4 w; w.x = cvt_pk_bf16(v0[0], v0[1]); w.y = cvt_pk_bf16(v0[2], v0[3]); w.z = cvt_pk_bf16(v1[0], v1[1]); w.w = cvt_pk_bf16(v1[2], v1[3]);
                    *(u32x4*)(rowp + bj * HALF) = w; } }
    }
};
struct EpiGateUp {
    bf16* Hh;
    __device__ __forceinline__ void operator()(const f32x4 (&acc)[2][2][4][2], const Unit& u, int wr, int wc, int fr, int fq) const {
        const int row0 = u.pm * BM + wr * 64 + fr, col0 = (u.pn * BM + wc * 32 + 8 * fq) >> 1;
#pragma unroll
        for (int ai = 0; ai < 2; ++ai)
#pragma unroll
            for (int m = 0; m < 4; ++m) { bf16* rowp = Hh + (size_t)(row0 + ai * HALF + m * 16) * DFF + col0;
#pragma unroll
                for (int bj = 0; bj < 2; ++bj) { const f32x4 g = acc[ai][bj][m][0], up = acc[ai][bj][m][1];
                    u32x2 w; w.x = cvt_pk_bf16(silu_f(g[0]) * up[0], silu_f(g[1]) * up[1]); w.y = cvt_pk_bf16(silu_f(g[2]) * up[2], silu_f(g[3]) * up[3]);
                    *(u32x2*)(rowp + bj * (HALF / 2)) = w; } }
    }
};
}

#define XB_TMO      128
#define XB_XCNT(j)  (256  + 64 * (j))
#define XB_XSUB(j)  (1280 + 64 * (j))
#define XB_XGEN(j)  (2304 + 64 * (j))
#define XB_TOP      3328
#define XB_TOPGEN   3392
#define XCD_BAR_WORDS 3456
#define XB_SPIN_CAP (1u << 18)
__device__ __forceinline__ unsigned xb_ld(unsigned* p)              { return __hip_atomic_load(p, __ATOMIC_RELAXED, __HIP_MEMORY_SCOPE_AGENT); }
__device__ __forceinline__ unsigned xb_add(unsigned* p, unsigned v) { return __hip_atomic_fetch_add(p, v, __ATOMIC_RELAXED, __HIP_MEMORY_SCOPE_AGENT); }
__device__ __forceinline__ unsigned xb_xcc_id() { return (unsigned)__builtin_amdgcn_s_getreg((3 << 11) | 20) & 0xFu; }
#define XB_SPIN(cond, bar) do { unsigned _sp = 0; while (cond) { __builtin_amdgcn_s_sleep(1); \
    if ((++_sp & 255u) == 0u) { if (xb_ld(&(bar)[XB_TMO])) break; if (_sp > XB_SPIN_CAP) { atomicAdd(&(bar)[XB_TMO], 1u); break; } } } } while (0)
struct XcdBarrier { unsigned* bar; unsigned x; volatile LAS unsigned* st; };
__device__ __forceinline__ XcdBarrier xcd_barrier_post(unsigned* bar, volatile LAS unsigned* st) {
    XcdBarrier b; b.bar = bar; b.x = xb_xcc_id(); b.st = st;
    if (threadIdx.x == 0) (void)xb_add(&bar[XB_XCNT(b.x)], 1u);
    return b;
}
__device__ __forceinline__ void xcd_barrier_complete(unsigned* bar, unsigned x, unsigned& nloc, unsigned& nx) {
    const unsigned G = gridDim.x * gridDim.y * gridDim.z;
    unsigned sum, cnt, mine, sp = 0u;
    for (;;) {
        sum = 0u; cnt = 0u; mine = 0u;
#pragma unroll
        for (unsigned j = 0; j < 16; ++j) { const unsigned c = xb_ld(&bar[XB_XCNT(j)]); sum += c; cnt += (c > 0u) ? 1u : 0u; mine = (j == x) ? c : mine; }
        if (sum == G) break;
        __builtin_amdgcn_s_sleep(1);
        if ((++sp & 255u) == 0u) { if (xb_ld(&bar[XB_TMO])) break; if (sp > XB_SPIN_CAP) { atomicAdd(&bar[XB_TMO], 1u); break; } }
    }
    nloc = mine > 0u ? mine : 1u; nx = cnt > 0u ? cnt : 1u;
}
__device__ __forceinline__ void xcd_barrier(const XcdBarrier& b) {
    asm volatile("s_waitcnt vmcnt(0)" ::: "memory");
    __syncthreads();
    if (threadIdx.x == 0) {
        unsigned* bar = b.bar;
        __builtin_amdgcn_s_waitcnt(0);
        unsigned nloc = b.st[0], nx = b.st[1];
        if (nloc == 0u) { xcd_barrier_complete(bar, b.x, nloc, nx); b.st[0] = nloc; b.st[1] = nx; }
        const unsigned old = xb_add(&bar[XB_XSUB(b.x)], 1u);
        const unsigned gen = old / nloc;
        if (old + 1u == (gen + 1u) * nloc) {
            __builtin_amdgcn_fence(__ATOMIC_RELEASE, "agent");
            asm volatile("s_waitcnt vmcnt(0)" ::: "memory");
            const unsigned og = xb_add(&bar[XB_TOP], 1u);
            const unsigned tg = og / nx;
            if (og + 1u == (tg + 1u) * nx) xb_add(&bar[XB_TOPGEN], 1u);
            else XB_SPIN(xb_ld(&bar[XB_TOPGEN]) == tg, bar);
            __builtin_amdgcn_fence(__ATOMIC_ACQUIRE, "agent");
            xb_add(&bar[XB_XGEN(b.x)], 1u);
            asm volatile("s_waitcnt vmcnt(0)" ::: "memory");
        } else {
            XB_SPIN(xb_ld(&bar[XB_XGEN(b.x)]) == gen, bar);
            __builtin_amdgcn_fence(__ATOMIC_ACQUIRE, "agent");
            asm volatile("s_waitcnt vmcnt(0)" ::: "memory");
        }
    }
    __syncthreads();
}

struct Args { const float* in[23]; float* out; unsigned char* ws; int ph_lo, ph_hi; };

struct Frame {
    LAS unsigned char* lds;
    int tid, lane, wave, vcu, G;
};

__device__ __forceinline__ void transpose_item(const float* W, int K, int N, bf16* WT, int row_off, int mode, const float* kscale, LAS float* scr, int item, int lane) {
    const int nblk = N / 32, kb = item / nblk, nb = item % nblk, k0 = 64 * kb, n0 = 32 * nb;
#pragma unroll 8
    for (int i = 0; i < 32; ++i) { const int kk = 2 * i + (lane >> 5); scr[kk * 33 + (lane & 31)] = W[(size_t)(k0 + kk) * N + n0 + (lane & 31)]; }
    LDS_WAIT(); asm volatile("" ::: "memory");
    const int c = lane & 7;
    float ks[8];
#pragma unroll
    for (int q = 0; q < 8; ++q) ks[q] = kscale ? kscale[k0 + 8 * c + q] : 1.f;
#pragma unroll
    for (int j = 0; j < 4; ++j) { const int n = (lane >> 3) + 8 * j; const LAS float* s = scr + (8 * c) * 33 + n;
        u32x4 o; o.x = pk2(s[0 * 33] * ks[0], s[1 * 33] * ks[1]); o.y = pk2(s[2 * 33] * ks[2], s[3 * 33] * ks[3]); o.z = pk2(s[4 * 33] * ks[4], s[5 * 33] * ks[5]); o.w = pk2(s[6 * 33] * ks[6], s[7 * 33] * ks[7]);
        const int ng = n0 + n; const int dr = (mode == 0) ? ng : (8 * (ng >> 2) + (ng & 3) + (mode == 2 ? 4 : 0));
        *(GAS u32x4*)(WT + (size_t)(row_off + dr) * K + k0 + 8 * c) = o; }
    LDS_WAIT(); asm volatile("" ::: "memory");
}

__device__ __forceinline__ void ln_row(f32x4 (&v)[4], const float* g, const float* b, int lane) {
    float s = 0.f;
#pragma unroll
    for (int j = 0; j < 4; ++j) s += (v[j].x + v[j].y) + (v[j].z + v[j].w);
    const float mean = wave_sum(s) * (1.f / D); float s2 = 0.f;
#pragma unroll
    for (int j = 0; j < 4; ++j) { v[j] = v[j] - mean; s2 += (v[j].x * v[j].x + v[j].y * v[j].y) + (v[j].z * v[j].z + v[j].w * v[j].w); }
    const float rstd = 1.f / sqrtf(wave_sum(s2) * (1.f / D) + LN_EPS);
#pragma unroll
    for (int j = 0; j < 4; ++j) { const f32x4 gg = *(const f32x4*)(g + 4 * lane + 256 * j), bb = *(const f32x4*)(b + 4 * lane + 256 * j); v[j] = v[j] * rstd * gg + bb; }
}
__device__ __forceinline__ f32x4 ld_bf16x4(const bf16* p) { const u32x2 w = *(const u32x2*)p; return (f32x4){bflo(w.x), bfhi(w.x), bflo(w.y), bfhi(w.y)}; }
__device__ __forceinline__ void st_bf16x4(bf16* p, f32x4 v) { u32x2 w; w.x = pk2(v.x, v.y); w.y = pk2(v.z, v.w); *(u32x2*)p = w; }

#ifndef PH_MASK
#define PH_MASK 0x1ffff
#endif
#define IN(k) (((PH_MASK >> (k)) & 1) && lo <= (k) && (k) < hi)
#define SEAM(k) do { if (IN(k) && IN((k) + 1)) xcd_barrier(bar); } while (0)
#define PH_LOCALS \
    int tid = threadIdx.x; asm volatile("" : "+v"(tid)); const int lane = tid & 63, wave = __builtin_amdgcn_readfirstlane(tid >> 6); \
    size_t ws_z_ = 0; asm volatile("" : "+s"(ws_z_)); unsigned char* ws = args.ws + ws_z_;     \
    const int gw = F.vcu * 8 + wave, NGW = F.G * 8; (void)lane; (void)gw; (void)NGW; \
    const float* x_in = args.in[0]; (void)x_in; \
    bf16* Wt_in = (bf16*)(ws + WS_WIN); bf16* Wt_out = (bf16*)(ws + WS_WOUT); (void)Wt_in; (void)Wt_out; \
    bf16* XB = (bf16*)(ws + WS_XB); bf16* Zb = (bf16*)(ws + WS_Z); bf16* XBC = (bf16*)(ws + WS_XBC); (void)XB; (void)Zb; (void)XBC; \
    float* DTRAW = (float*)(ws + WS_DTRAW); float* SSQ = (float*)(ws + WS_SSQ); (void)DTRAW; (void)SSQ; \
    int* LIST = (int*)(ws + WS_LIST); unsigned* INFO = (unsigned*)(ws + WS_INFO); (void)LIST; (void)INFO;


template <int L>
__device__ __forceinline__ void layer_tail(const Args& args, const Frame& F, const XcdBarrier& bar, const int lo, const int hi) {
    const int pb = L ? 13 : 6;
#define LAYER_LOCALS \
    const bf16* MIX = (const bf16*)(ws + (L ? WS_MIX2 : WS_MIX1)); (void)MIX; \
    bf16* XN = (bf16*)(ws + (L ? WS_X3B : WS_X1B)); (void)XN;            \
    bf16* HB = (bf16*)(ws + (L ? WS_H1 : WS_H0)); (void)HB; \
    bf16* Y2 = (bf16*)(ws + (L ? WS_Y21 : WS_Y20)); (void)Y2; \
    gu32* gcnt = (gu32*)(ws + WS_CTL) + CW_CNT + 64 * L; (void)gcnt; \
    LAS int* tokL = (LAS int*)(F.lds + TOKL_OFF); (void)tokL; \
    LAS int* mo = (LAS int*)(F.lds + MOE_OFF); (void)mo;

    if (IN(pb)) { PH_LOCALS LAYER_LOCALS
        const float* lg = args.in[19] + L * D; const float* lb = args.in[20] + L * D;
        const float* rw = args.in[14]; const float* rbias = args.in[15];
        LAS float* rwl = (LAS float*)F.lds;
        LAS int* lcnt = (LAS int*)(F.lds + 65536);
        LAS int* rec = (LAS int*)(F.lds + 65536 + 256);
        for (int i = tid; i < D * NE; i += 512) rwl[(i & 15) * D + (i >> 4)] = rw[i];
        if (tid < 32) lcnt[tid] = 0;
        __syncthreads();
        int li = 0;
        f32x4 nx[4]; u32x2 nm[4];
#define RT_LOAD(mm) do { _Pragma("unroll") for (int j = 0; j < 4; ++j) { nm[j] = *(const u32x2*)(MIX + (size_t)(mm) * D + 4 * lane + 256 * j); \
            if (L == 0) nx[j] = *(const f32x4*)(x_in + (size_t)(mm) * D + 4 * lane + 256 * j); \
            else { const u32x2 t_ = *(const u32x2*)((const bf16*)(ws + WS_X2B) + (size_t)(mm) * D + 4 * lane + 256 * j); nx[j] = (f32x4){bflo(t_.x), bfhi(t_.x), bflo(t_.y), bfhi(t_.y)}; } } } while (0)
        if (gw < T) RT_LOAD(gw);
        for (int m = gw; m < T && li < 32; m += NGW, ++li) {
            f32x4 v[4];
#pragma unroll
            for (int j = 0; j < 4; ++j) v[j] = nx[j] * ALPHA + (f32x4){bflo(nm[j].x), bfhi(nm[j].x), bflo(nm[j].y), bfhi(nm[j].y)};
            if (m + NGW < T) RT_LOAD(m + NGW);
            ln_row(v, lg, lb, lane);
#pragma unroll
            for (int j = 0; j < 4; ++j) st_bf16x4(XN + (size_t)m * D + 4 * lane + 256 * j, v[j]);
            float lgt[NE];
#pragma unroll
            for (int e = 0; e < NE; ++e) { float a_ = 0.f;
#pragma unroll
                for (int j = 0; j < 4; ++j) { const f32x4 w = *(const LAS f32x4*)(rwl + e * D + 256 * j + 4 * lane); a_ += (v[j].x * w.x + v[j].y * w.y) + (v[j].z * w.z + v[j].w * w.w); }
                lgt[e] = a_; }
            { float t8[8], t4[4], t2[2], t1;
#pragma unroll
              for (int e = 0; e < 8; ++e) { const bool up = (lane & 32) != 0; const float snd = up ? lgt[e] : lgt[e + 8], kp = up ? lgt[e + 8] : lgt[e]; t8[e] = kp + __shfl_xor(snd, 32); }
#pragma unroll
              for (int e = 0; e < 4; ++e) { const bool up = (lane & 16) != 0; const float snd = up ? t8[e] : t8[e + 4], kp = up ? t8[e + 4] : t8[e]; t4[e] = kp + __shfl_xor(snd, 16); }
#pragma unroll
              for (int e = 0; e < 2; ++e) { const bool up = (lane & 8) != 0; const float snd = up ? t4[e] : t4[e + 2], kp = up ? t4[e + 2] : t4[e]; t2[e] = kp + __shfl_xor(snd, 8); }
              { const bool up = (lane & 4) != 0; const float snd = up ? t2[0] : t2[1], kp = up ? t2[1] : t2[0]; t1 = kp + __shfl_xor(snd, 4); }
              t1 += __shfl_xor(t1, 2); t1 += __shfl_xor(t1, 1);
#pragma unroll
              for (int e = 0; e < NE; ++e) lgt[e] = __builtin_bit_cast(float, __builtin_amdgcn_readlane(__builtin_bit_cast(int, t1), 4 * e)); }
            float mxl = lgt[0];
#pragma unroll
            for (int e = 1; e < NE; ++e) mxl = fmaxf(mxl, lgt[e]);
            float sc[NE], sel[NE], den = 0.f;
#pragma unroll
            for (int e = 0; e < NE; ++e) { sc[e] = __expf(lgt[e] - mxl); den += sc[e]; }
            const float iden = 1.f / den;
#pragma unroll
            for (int e = 0; e < NE; ++e) { sc[e] *= iden; sel[e] = sc[e] + rbias[e]; }
            int bg = 0; float bgs = -1e30f;
#pragma unroll
            for (int g = 0; g < 4; ++g) { const float a = sel[4 * g], b2 = sel[4 * g + 1], c2 = sel[4 * g + 2], d2 = sel[4 * g + 3];
                const float tot = a + b2 + c2 + d2, mn1 = fminf(fminf(a, b2), fminf(c2, d2));
                float hi1 = fmaxf(fmaxf(a, b2), fmaxf(c2, d2));
                const float m01 = fminf(a, b2), m23 = fminf(c2, d2), M01 = fmaxf(a, b2), M23 = fmaxf(c2, d2);
                const float second = fmaxf(fminf(M01, M23), fmaxf(m01, m23));
                (void)tot; (void)mn1;
                const float gs = hi1 + second;
                if (gs > bgs) { bgs = gs; bg = g; } }
            float s0 = 0.f, s1 = 0.f, s2 = 0.f, s3 = 0.f, p0 = 0.f, p1 = 0.f, p2 = 0.f, p3 = 0.f;
#pragma unroll
            for (int g = 0; g < 4; ++g) if (g == bg) { s0 = sel[4 * g]; s1 = sel[4 * g + 1]; s2 = sel[4 * g + 2]; s3 = sel[4 * g + 3]; p0 = sc[4 * g]; p1 = sc[4 * g + 1]; p2 = sc[4 * g + 2]; p3 = sc[4 * g + 3]; }
            int i1 = 0; float b1 = s0, q1 = p0;
            if (s1 > b1) { b1 = s1; i1 = 1; q1 = p1; } if (s2 > b1) { b1 = s2; i1 = 2; q1 = p2; } if (s3 > b1) { b1 = s3; i1 = 3; q1 = p3; }
            int i2 = -1; float b2v = -1e30f, q2 = 0.f;
            if (i1 != 0 && s0 > b2v) { b2v = s0; i2 = 0; q2 = p0; } if (i1 != 1 && s1 > b2v) { b2v = s1; i2 = 1; q2 = p1; }
            if (i1 != 2 && s2 > b2v) { b2v = s2; i2 = 2; q2 = p2; } if (i1 != 3 && s3 > b2v) { b2v = s3; i2 = 3; q2 = p3; }
            const int e1 = 4 * bg + i1, e2 = 4 * bg + i2; const float gsum = q1 + q2, g1 = q1 / gsum, g2 = q2 / gsum;
            if (lane == 0) {
                const int r1 = atomicAdd((int*)(lcnt + e1), 1), r2 = atomicAdd((int*)(lcnt + e2), 1);
                LAS int* rc = rec + (wave * 32 + li) * 8; rc[0] = e1; rc[1] = r1; rc[2] = e2; rc[3] = r2; rc[4] = __builtin_bit_cast(int, g1); rc[5] = __builtin_bit_cast(int, g2);
            }
        }
        __syncthreads();
        if (tid < NE) lcnt[16 + tid] = (int)__hip_atomic_fetch_add(gcnt + tid, (unsigned)lcnt[tid], RLX_AGENT);
        __syncthreads();
        li = 0;
        for (int m = gw; m < T; m += NGW, ++li) {
            if (lane == 0) {
                const LAS int* rc = rec + (wave * 32 + li) * 8;
                const int e1 = rc[0], e2 = rc[2], sl1 = lcnt[16 + e1] + rc[1], sl2 = lcnt[16 + e2] + rc[3];
                LIST[(size_t)e1 * T + sl1] = m; LIST[(size_t)e2 * T + sl2] = m;
                u32x4 w0; w0.x = (unsigned)e1; w0.y = (unsigned)sl1; w0.z = (unsigned)e2; w0.w = (unsigned)sl2;
                *(u32x4*)(INFO + (size_t)m * 8) = w0; INFO[(size_t)m * 8 + 4] = (unsigned)rc[4]; INFO[(size_t)m * 8 + 5] = (unsigned)rc[5];
            }
        }
    }
    SEAM(pb);

    if (IN(pb + 1) || IN(pb + 2) || IN(pb + 3)) { PH_LOCALS LAYER_LOCALS
        __syncthreads();
        if (tid == 0) { int acc_ = 0; for (int e = 0; e < NE; ++e) { const int c = (int)__hip_atomic_load(gcnt + e, RLX_AGENT); mo[e] = acc_; mo[32 + e] = c; acc_ += (c + 255) >> 8; } mo[16] = acc_; }
        __syncthreads();
    }
    if (IN(pb + 1)) { PH_LOCALS LAYER_LOCALS
        pg8::MoeOrder<true> S{mo, tokL, F.G, F.vcu, D};
        { pg8::Unit u; for (int ui = 0; ui < 6 && S.next(ui, u); ++ui) { if (tid < 256) { const int r = (u.pm - mo[u.e]) * 256 + tid, c = mo[32 + u.e]; tokL[ui * 256 + tid] = LIST[(size_t)u.e * T + (r < c ? r : c - 1)]; } } }
        __syncthreads();
        pg8::EpiGateUp E{HB};
        pg8::gemm_phase<pg8::EpiGateUp, pg8::MoeOrder<true>>(F.lds, XN, (const bf16*)(ws + (L ? WS_WGU1 : WS_WGU0)), D, S, E);
    }
    SEAM(pb + 1);
    if (IN(pb + 2)) { PH_LOCALS LAYER_LOCALS
        pg8::MoeOrder<false> S{mo, tokL, F.G, F.vcu, DFF};
        pg8::EpiPlain E{Y2, D, nullptr, 0, 1.f};
        pg8::gemm_phase<pg8::EpiPlain, pg8::MoeOrder<false>>(F.lds, HB, (const bf16*)(ws + (L ? WS_WD1 : WS_WD0)), DFF, S, E);
    }
    SEAM(pb + 2);
    if (IN(pb + 3)) { PH_LOCALS LAYER_LOCALS
        const float* lg = args.in[21] + L * D; const float* lb = args.in[22] + L * D;
        for (int m = gw; m < T; m += NGW) {
            const u32x4 w0 = *(const u32x4*)(INFO + (size_t)m * 8); const float g1 = __builtin_bit_cast(float, INFO[(size_t)m * 8 + 4]), g2 = __builtin_bit_cast(float, INFO[(size_t)m * 8 + 5]);
            const size_t r1 = (size_t)mo[w0.x] * 256 + w0.y, r2 = (size_t)mo[w0.z] * 256 + w0.w;
            f32x4 v[4];
#pragma unroll
            for (int j = 0; j < 4; ++j) { const int co = 4 * lane + 256 * j;
                v[j] = ld_bf16x4(XN + (size_t)m * D + co) * ALPHA + ld_bf16x4(Y2 + r1 * D + co) * g1 + ld_bf16x4(Y2 + r2 * D + co) * g2; }
            ln_row(v, lg, lb, lane);
            if (L == 0) {
#pragma unroll
                for (int j = 0; j < 4; ++j) st_bf16x4((bf16*)(ws + WS_X2B) + (size_t)m * D + 4 * lane + 256 * j, v[j]);
            } else {
#pragma unroll
                for (int j = 0; j < 4; ++j) *(f32x4*)(args.out + (size_t)m * D + 4 * lane + 256 * j) = v[j];
            }
        }
    }
}

__global__ void __launch_bounds__(512, 2) fwd_kernel(Args args) {
    extern __shared__ __attribute__((aligned(16))) unsigned char lds_raw[];
    Frame F;
    F.lds = (LAS unsigned char*)lds_raw;
    F.tid = threadIdx.x; F.lane = F.tid & 63; F.wave = __builtin_amdgcn_readfirstlane(F.tid >> 6);
    F.G = gridDim.x; { const int bx = blockIdx.x; F.vcu = (F.G % 8 == 0) ? (bx % 8) * (F.G / 8) + bx / 8 : bx; }
    unsigned char* ws = args.ws;
    gu32* ctl = (gu32*)(ws + WS_CTL);
    volatile LAS unsigned* MISC = (volatile LAS unsigned*)(F.lds + MISC_OFF);
    for (int u = F.tid; u < (LDS_BYTES - LDSCTL_OFF) / 4; u += 512) ((LAS unsigned*)(F.lds + LDSCTL_OFF))[u] = 0u;
    __syncthreads();
    XcdBarrier bar; bar.bar = (unsigned*)(ctl + CW_BAR); bar.x = 0; bar.st = nullptr;
    if (MK_N_LAUNCHES == 1) bar = xcd_barrier_post((unsigned*)(ctl + CW_BAR), MISC + 8);
    const int lo = args.ph_lo, hi = args.ph_hi;
    if (IN(0)) { PH_LOCALS
        LAS float* scr = (LAS float*)(F.lds + wave * 16384);
        constexpr int I_IN = (D / 64) * (INP / 32), I_OUT = (DI / 64) * (D / 32);
        for (int it = gw; it < I_IN + I_OUT; it += NGW) {
            if (it < I_IN) transpose_item(args.in[1], D, INP, Wt_in, 0, 0, nullptr, scr, it, lane);
            else transpose_item(args.in[8], DI, D, Wt_out, 0, 0, args.in[7], scr, it - I_IN, lane);
        }
        const size_t n8 = (size_t)T * D / 8, stride = (size_t)F.G * 512; size_t i = (size_t)blockIdx.x * 512 + tid;
        for (; i + 3 * stride < n8; i += 4 * stride) {
            f32x4 a[4], b[4];
#pragma unroll
            for (int u = 0; u < 4; ++u) { a[u] = *(const f32x4*)(x_in + (i + u * stride) * 8); b[u] = *(const f32x4*)(x_in + (i + u * stride) * 8 + 4); }
#pragma unroll
            for (int u = 0; u < 4; ++u) { u32x4 o; o.x = pk2(a[u].x, a[u].y); o.y = pk2(a[u].z, a[u].w); o.z = pk2(b[u].x, b[u].y); o.w = pk2(b[u].z, b[u].w); *(u32x4*)(XB + (i + u * stride) * 8) = o; }
        }
        for (; i < n8; i += stride) { const f32x4 a = *(const f32x4*)(x_in + i * 8), b = *(const f32x4*)(x_in + i * 8 + 4);
            u32x4 o; o.x = pk2(a.x, a.y); o.y = pk2(a.z, a.w); o.z = pk2(b.x, b.y); o.w = pk2(b.z, b.w); *(u32x4*)(XB + i * 8) = o; }
    }
    SEAM(0);

    if (IN(1)) { PH_LOCALS
        pg8::DenseOrder S; S.init(T, NZX, F.G, (int)blockIdx.x, D);
        pg8::EpiInProj E{Zb, XBC};
        pg8::gemm_phase<pg8::EpiInProj, pg8::DenseOrder>(F.lds, XB, Wt_in, D, S, E);
        for (int tile = gw; tile < T / 16; tile += NGW) {
            const int t0 = tile * 16, r = lane & 15, q = lane >> 4;
            const bf16* xp = XB + (size_t)(t0 + r) * D + 8 * q;
            const bf16* w0 = Wt_in + (size_t)(NZX + r) * D + 8 * q; const bf16* w1 = w0 + (size_t)16 * D;
            f32x4 a0 = {0.f, 0.f, 0.f, 0.f}, a1 = {0.f, 0.f, 0.f, 0.f};
#pragma unroll 4
            for (int k0 = 0; k0 < D; k0 += 32) {
                const bf16x8 xv = *(const bf16x8*)(xp + k0), wa = *(const bf16x8*)(w0 + k0), wb = *(const bf16x8*)(w1 + k0);
                a0 = __builtin_amdgcn_mfma_f32_16x16x32_bf16(wa, xv, a0, 0, 0, 0);
                a1 = __builtin_amdgcn_mfma_f32_16x16x32_bf16(wb, xv, a1, 0, 0, 0);
            }
            float* o = DTRAW + (size_t)(t0 + r) * NH + 4 * q;
            *(f32x4*)o = a0; *(f32x4*)(o + 16) = a1;
        }
    }
    SEAM(1);

    if (IN(2)) { PH_LOCALS
        const float* conv_w = args.in[2]; const float* conv_b = args.in[3];
        bf16* BCACT = (bf16*)(ws + WS_BCACT);
        for (int it = blockIdx.x * 512 + tid; it < (T / 8) * 128; it += F.G * 512) {
            const int ch = it & 127, seg = it >> 7, r0 = seg * 8, s0 = r0 & (SEQ - 1), col = DI + 8 * ch;
            u32x4 rw[11];
#pragma unroll
            for (int q = 0; q < 11; ++q) { const int sr = s0 - 3 + q; const int rc = sr < 0 ? 0 : sr; rw[q] = *(const u32x4*)(XBC + (size_t)(r0 - s0 + rc) * CONVD + col); }
#pragma unroll
            for (int q = 0; q < 3; ++q) if (s0 - 3 + q < 0) rw[q] = (u32x4){0u, 0u, 0u, 0u};
#pragma unroll
            for (int hf = 0; hf < 2; ++hf) {
                f32x4 wq[5];
#pragma unroll
                for (int k = 0; k < 4; ++k) wq[k] = *(const f32x4*)(conv_w + k * CONVD + col + 4 * hf);
                wq[4] = *(const f32x4*)(conv_b + col + 4 * hf);
#pragma unroll
                for (int jj = 0; jj < 8; ++jj) { f32x4 aq = wq[4];
#pragma unroll
                    for (int k = 0; k < 4; ++k) { const u32x4 rq = rw[jj + k]; const unsigned a0 = hf ? rq.z : rq.x, a1 = hf ? rq.w : rq.y; aq += wq[k] * (f32x4){bflo(a0), bfhi(a0), bflo(a1), bfhi(a1)}; }
#pragma unroll
                    for (int e = 0; e < 4; ++e) aq[e] = silu_f(aq[e]);
                    u32x2 o_; o_.x = pk2(aq[0], aq[1]); o_.y = pk2(aq[2], aq[3]);
                    *(u32x2*)(BCACT + (size_t)(r0 + jj) * 1024 + 8 * ch + 4 * hf) = o_; }
            }
        }
    }
    SEAM(2);

    if (IN(3)) { PH_LOCALS
#if NAIVE_SCAN
        const float* conv_w = args.in[2]; const float* conv_b = args.in[3]; const float* dt_bias = args.in[4]; const float* a_log = args.in[5]; const float* dsk = args.in[6];
        for (int item = blockIdx.x; item < NB * NH; item += F.G) {
            if (wave >= 2) continue;
            LAS float* sB = (LAS float*)(F.lds + wave * 8192); LAS float* sC = sB + 128; LAS float* cwl = sC + 128;
            const int b = item / NH, h = item % NH, g = h / 8, pp = 32 * wave + (lane & 31), nh = lane >> 5;
            int col[5]; col[0] = h * HP + pp; col[1] = DI + g * NS + lane; col[2] = col[1] + 64; col[3] = DI + NG * NS + g * NS + lane; col[4] = col[3] + 64;
            float hist[5][3];
#pragma unroll
            for (int c = 0; c < 5; ++c) { cwl[(c * 5 + 4) * 64 + lane] = conv_b[col[c]];
#pragma unroll
                for (int k = 0; k < 4; ++k) cwl[(c * 5 + k) * 64 + lane] = conv_w[k * CONVD + col[c]];
#pragma unroll
                for (int k = 0; k < 3; ++k) hist[c][k] = 0.f; }
            LDS_WAIT();
            const float dtb = dt_bias[h], av = -__expf(a_log[h]), dh = dsk[h];
            float hst[64];
#pragma unroll
            for (int n = 0; n < 64; ++n) hst[n] = 0.f;
            for (int t = 0; t < SEQ; ++t) {
                const size_t row = (size_t)b * SEQ + t;
                float v[5];
#pragma unroll
                for (int c = 0; c < 5; ++c) { const float cur = bf2f(XBC[row * CONVD + col[c]]);
                    float a = cwl[(c * 5 + 4) * 64 + lane] + cwl[(c * 5) * 64 + lane] * hist[c][0] + cwl[(c * 5 + 1) * 64 + lane] * hist[c][1] + cwl[(c * 5 + 2) * 64 + lane] * hist[c][2] + cwl[(c * 5 + 3) * 64 + lane] * cur;
                    hist[c][0] = hist[c][1]; hist[c][1] = hist[c][2]; hist[c][2] = cur; v[c] = silu_f(a); }
                const float raw = DTRAW[row * NH + h] + dtb;
                const float dtv = raw > 20.f ? raw : log1pf(__expf(raw));
                const float dA = __expf(dtv * av);
                sB[lane] = v[1]; sB[lane + 64] = v[2]; sC[lane] = v[3]; sC[lane + 64] = v[4];
                LDS_WAIT(); asm volatile("" ::: "memory");
                const float xd = dtv * v[0]; float y = 0.f;
#pragma unroll
                for (int n = 0; n < 64; n += 4) { const f32x4 bb = *(const LAS f32x4*)(sB + 64 * nh + n), cc = *(const LAS f32x4*)(sC + 64 * nh + n);
                    hst[n] = hst[n] * dA + xd * bb.x; y += cc.x * hst[n];
                    hst[n + 1] = hst[n + 1] * dA + xd * bb.y; y += cc.y * hst[n + 1];
                    hst[n + 2] = hst[n + 2] * dA + xd * bb.z; y += cc.z * hst[n + 2];
                    hst[n + 3] = hst[n + 3] * dA + xd * bb.w; y += cc.w * hst[n + 3]; }
                LDS_WAIT(); asm volatile("" ::: "memory");
                y += __shfl_xor(y, 32);
                y += dh * v[0];
                const float zv = bf2f(Zb[row * DI + h * HP + pp]);
                const float yg = y * silu_f(zv);
                float sq = (lane < 32) ? yg * yg : 0.f; sq = wave_sum(sq);
                if (lane < 32) Zb[row * DI + h * HP + pp] = (bf16)f2bf(yg);
                if (lane == 0) SSQ[row * 64 + h * 2 + wave] = sq;
            }
        }
#else
        const float* conv_w = args.in[2]; const float* conv_b = args.in[3]; const float* dt_bias = args.in[4]; const float* a_log = args.in[5]; const float* dsk = args.in[6];
        typedef short v4i16 __attribute__((ext_vector_type(4)));
        constexpr int SXB = 144, SBB = 272;
        constexpr int XS_OFF = 0, XW_OFF = 9216, BM_OFF = 18432, CM_OFF = 35840, WM_OFF = 53248, HB_OFF = 62464, VEC_OFF = 97280, CW_OFF = 98304;
        LAS unsigned char* Lb = F.lds;
        LAS float* cumL = (LAS float*)(Lb + VEC_OFF);
        LAS float* dtL = cumL + 128;
        LAS float* cwl = (LAS float*)(Lb + CW_OFF);
        const int r16 = lane & 15, q4 = lane >> 4;
#define TR8(dst, base_off, stride, k0, c0) do { const LAS unsigned char* _a = Lb + (base_off) + ((k0) + 8 * q4 + (r16 >> 2)) * (stride) + ((c0) + 4 * (lane & 3)) * 2; \
        const v4i16 _lo = __builtin_amdgcn_ds_read_tr16_b64_v4i16((LAS v4i16*)_a), _hi = __builtin_amdgcn_ds_read_tr16_b64_v4i16((LAS v4i16*)(_a + 4 * (stride))); \
        dst = (bf16x8){_lo[0], _lo[1], _lo[2], _lo[3], _hi[0], _hi[1], _hi[2], _hi[3]}; } while (0)
        if (blockIdx.x < NB * NH) {
            const int item = blockIdx.x; const int b = item / NH, h = item % NH, g = h >> 3;
            __syncthreads();
            for (int i = tid; i < 5 * 64; i += 512) { const int k = i >> 6, cl = i & 63; cwl[i] = k < 4 ? conv_w[k * CONVD + h * HP + cl] : conv_b[h * HP + cl]; }
            for (int i = tid; i < SBB * 64 / 4; i += 512) ((LAS unsigned*)(Lb + HB_OFF))[i] = 0u;
            const float dtb = dt_bias[h], av = -__expf(a_log[h]), dh = dsk[h];
            const int sj = tid >> 3, sxc = tid & 7;
            const bf16* BCACT = (const bf16*)(ws + WS_BCACT);
            const size_t row0 = (size_t)b * SEQ;
            f32x4 hacc[4];
#pragma unroll
            for (int i = 0; i < 4; ++i) hacc[i] = (f32x4){0.f, 0.f, 0.f, 0.f};
            u32x4 xrA[4], brA[2], crA[2], xrB[4], brB[2], crB[2]; u32x2 zr[2]; float dtr = 0.f;
            const int ti = wave & 3, wh = wave >> 2, irow = 16 * ti + r16;
#define SC_LOAD(c, S) do { _Pragma("unroll") for (int k = 0; k < 4; ++k) { const int rr = (c) * 64 + sj - 3 + k; const int rc = rr < 0 ? 0 : rr; \
                xr##S[k] = *(const u32x4*)(XBC + (row0 + rc) * CONVD + h * HP + 8 * sxc); } \
            _Pragma("unroll") for (int i = 0; i < 2; ++i) { const int idx = tid + 512 * i; const bf16* bp_ = BCACT + (row0 + (c) * 64 + (idx >> 4)) * 1024 + g * NS + 8 * (idx & 15); \
                br##S[i] = *(const u32x4*)bp_; cr##S[i] = *(const u32x4*)(bp_ + 512); } } while (0)
#define SC_LOADZ(c, S) do { _Pragma("unroll") for (int tt = 0; tt < 2; ++tt) zr[tt] = *(const u32x2*)(Zb + (row0 + (c) * 64 + irow) * DI + h * HP + 16 * (2 * wh + tt) + 4 * q4); } while (0)
#define SC_CUMDT(c) do { if (wave == 7) { const float rw_ = dtr + dtb; const float dtv = rw_ > 15.f ? rw_ : __logf(1.f + __expf(rw_)); float xx = dtv * av; \
                _Pragma("unroll") for (int o = 1; o < 64; o <<= 1) { const float vv = __shfl_up(xx, o); if (lane >= o) xx += vv; } \
                cumL[((c) & 1) * 64 + lane] = xx; dtL[((c) & 1) * 64 + lane] = dtv; } } while (0)
#define SC_STAGE(c, S) do { const int pr_ = ((c) & 1) * 64; const float wj = __expf(cumL[pr_ + 63] - cumL[pr_ + sj]) * dtL[pr_ + sj]; \
                _Pragma("unroll") for (int k = 0; k < 3; ++k) if ((c) * 64 + sj - 3 + k < 0) xr##S[k] = (u32x4){0u, 0u, 0u, 0u};     \
                _Pragma("unroll") for (int hf = 0; hf < 2; ++hf) { f32x4 aq = *(const LAS f32x4*)(cwl + 4 * 64 + 8 * sxc + 4 * hf); \
                    _Pragma("unroll") for (int k = 0; k < 4; ++k) { const f32x4 wq = *(const LAS f32x4*)(cwl + k * 64 + 8 * sxc + 4 * hf); const unsigned r0_ = hf ? xr##S[k].z : xr##S[k].x, r1_ = hf ? xr##S[k].w : xr##S[k].y; \
                        aq += wq * (f32x4){bflo(r0_), bfhi(r0_), bflo(r1_), bfhi(r1_)}; } \
                    _Pragma("unroll") for (int e = 0; e < 4; ++e) aq[e] = silu_f(aq[e]); \
                    u32x2 o_; o_.x = pk2(aq[0], aq[1]); o_.y = pk2(aq[2], aq[3]); \
                    *(LAS u32x2*)(Lb + XS_OFF + sj * SXB + 16 * sxc + 8 * hf) = o_; \
                    o_.x = pk2(aq[0] * wj, aq[1] * wj); o_.y = pk2(aq[2] * wj, aq[3] * wj); \
                    *(LAS u32x2*)(Lb + XW_OFF + sj * SXB + 16 * sxc + 8 * hf) = o_; } \
                _Pragma("unroll") for (int i = 0; i < 2; ++i) { const int idx = tid + 512 * i; \
                    *(LAS u32x4*)(Lb + BM_OFF + (idx >> 4) * SBB + 16 * (idx & 15)) = br##S[i]; *(LAS u32x4*)(Lb + CM_OFF + (idx >> 4) * SBB + 16 * (idx & 15)) = cr##S[i]; } } while (0)
            if (wave == 7) dtr = DTRAW[(row0 + lane) * NH + h];
            SC_LOAD(0, A); SC_LOADZ(0, A); SC_CUMDT(0);
            if (wave == 7) dtr = DTRAW[(row0 + 64 + lane) * NH + h];
            __syncthreads();
            SC_STAGE(0, A);
            SC_LOAD(1, B);
            __syncthreads();
            for (int c2 = 0; c2 < SEQ / 64; c2 += 2) {
                { const int c = c2;
                const int pr = (c & 1) * 64; const int hb_cur = HB_OFF + (c & 1) * (SBB * 64), hb_nxt = HB_OFF + ((c & 1) ^ 1) * (SBB * 64);
                if (c + 1 < SEQ / 64) { SC_CUMDT(c + 1); if (wave == 7 && c + 2 < SEQ / 64) dtr = DTRAW[(row0 + (c + 2) * 64 + lane) * NH + h]; }
                if (c + 2 < SEQ / 64) SC_LOAD(c + 2, A);
                bf16x8 cf[4];
#pragma unroll
                for (int ks = 0; ks < 4; ++ks) cf[ks] = *(const LAS bf16x8*)(Lb + CM_OFF + irow * SBB + (32 * ks + 8 * q4) * 2);
                const float ci = cumL[pr + irow];
#pragma unroll
                for (int tt = 0; tt < 2; ++tt) { const int tj = 2 * wh + tt; f32x4 ga = {0.f, 0.f, 0.f, 0.f};
#pragma unroll
                    for (int ks = 0; ks < 4; ++ks) { const bf16x8 bfr = *(const LAS bf16x8*)(Lb + BM_OFF + (16 * tj + r16) * SBB + (32 * ks + 8 * q4) * 2); ga = __builtin_amdgcn_mfma_f32_16x16x32_bf16(bfr, cf[ks], ga, 0, 0, 0); }
                    const int j0 = 16 * tj + 4 * q4; const f32x4 cj = *(const LAS f32x4*)(cumL + pr + j0), dj = *(const LAS f32x4*)(dtL + pr + j0);
                    float wv[4];
#pragma unroll
                    for (int r = 0; r < 4; ++r) { const int j = j0 + r; float v = ga[r] * __expf(ci - cj[r]) * dj[r]; v = (j <= irow) ? v : 0.f; if (j == irow) v += dh; wv[r] = v; }
                    u32x2 w_; w_.x = pk2(wv[0], wv[1]); w_.y = pk2(wv[2], wv[3]);
                    *(LAS u32x2*)(Lb + WM_OFF + irow * SXB + j0 * 2) = w_; }
                WG_BAR();
                { bf16x8 wf[2];
#pragma unroll
                  for (int ks = 0; ks < 2; ++ks) wf[ks] = *(const LAS bf16x8*)(Lb + WM_OFF + irow * SXB + (32 * ks + 8 * q4) * 2);
                  const float ec = __expf(ci); float ssq = 0.f;
#pragma unroll
                  for (int tt = 0; tt < 2; ++tt) { const int tp = 2 * wh + tt; f32x4 yd = {0.f, 0.f, 0.f, 0.f}, yo = {0.f, 0.f, 0.f, 0.f};
#pragma unroll
                      for (int ks = 0; ks < 2; ++ks) { bf16x8 xa; TR8(xa, XS_OFF, SXB, 32 * ks, 16 * tp); yd = __builtin_amdgcn_mfma_f32_16x16x32_bf16(xa, wf[ks], yd, 0, 0, 0); }
#pragma unroll
                      for (int ks = 0; ks < 4; ++ks) { const bf16x8 ha = *(const LAS bf16x8*)(Lb + hb_cur + (16 * tp + r16) * SBB + (32 * ks + 8 * q4) * 2); yo = __builtin_amdgcn_mfma_f32_16x16x32_bf16(ha, cf[ks], yo, 0, 0, 0); }
                      const float z0 = bflo(zr[tt].x), z1 = bfhi(zr[tt].x), z2 = bflo(zr[tt].y), z3 = bfhi(zr[tt].y);
                      const float y0 = (yd[0] + ec * yo[0]) * silu_f(z0), y1 = (yd[1] + ec * yo[1]) * silu_f(z1), y2 = (yd[2] + ec * yo[2]) * silu_f(z2), y3 = (yd[3] + ec * yo[3]) * silu_f(z3);
                      ssq += (y0 * y0 + y1 * y1) + (y2 * y2 + y3 * y3);
                      u32x2 o_; o_.x = pk2(y0, y1); o_.y = pk2(y2, y3);
                      *(u32x2*)(Zb + (row0 + c * 64 + irow) * DI + h * HP + 16 * tp + 4 * q4) = o_; }
                  ssq += __shfl_xor(ssq, 16); ssq += __shfl_xor(ssq, 32);
                  if (q4 == 0) SSQ[(row0 + c * 64 + irow) * 64 + h * 2 + wh] = ssq; }
                if (c + 1 < SEQ / 64) SC_LOADZ(c + 1, A);
                { const float eL = __expf(cumL[pr + 63]);
#pragma unroll
                  for (int tp = 0; tp < 4; ++tp) hacc[tp] = hacc[tp] * eL;
#pragma unroll
                  for (int ks = 0; ks < 2; ++ks) { bf16x8 ba; TR8(ba, BM_OFF, SBB, 32 * ks, 16 * wave);
#pragma unroll
                      for (int tp = 0; tp < 4; ++tp) { bf16x8 xb; TR8(xb, XW_OFF, SXB, 32 * ks, 16 * tp); hacc[tp] = __builtin_amdgcn_mfma_f32_16x16x32_bf16(ba, xb, hacc[tp], 0, 0, 0); } }
#pragma unroll
                  for (int tp = 0; tp < 4; ++tp) { u32x2 o_; o_.x = pk2(hacc[tp][0], hacc[tp][1]); o_.y = pk2(hacc[tp][2], hacc[tp][3]);
                      *(LAS u32x2*)(Lb + hb_nxt + (16 * tp + r16) * SBB + (16 * wave + 4 * q4) * 2) = o_; } }
                WG_BAR();
                if (c + 1 < SEQ / 64) SC_STAGE(c + 1, B);
                WG_BAR();
                }
                { const int c = c2 + 1;
                const int pr = (c & 1) * 64; const int hb_cur = HB_OFF + (c & 1) * (SBB * 64), hb_nxt = HB_OFF + ((c & 1) ^ 1) * (SBB * 64);
                if (c + 1 < SEQ / 64) { SC_CUMDT(c + 1); if (wave == 7 && c + 2 < SEQ / 64) dtr = DTRAW[(row0 + (c + 2) * 64 + lane) * NH + h]; }
                if (c + 2 < SEQ / 64) SC_LOAD(c + 2, B);
                bf16x8 cf[4];
#pragma unroll
                for (int ks = 0; ks < 4; ++ks) cf[ks] = *(const LAS bf16x8*)(Lb + CM_OFF + irow * SBB + (32 * ks + 8 * q4) * 2);
                const float ci = cumL[pr + irow];
#pragma unroll
                for (int tt = 0; tt < 2; ++tt) { const int tj = 2 * wh + tt; f32x4 ga = {0.f, 0.f, 0.f, 0.f};
#pragma unroll
                    for (int ks = 0; ks < 4; ++ks) { const bf16x8 bfr = *(const LAS bf16x8*)(Lb + BM_OFF + (16 * tj + r16) * SBB + (32 * ks + 8 * q4) * 2); ga = __builtin_amdgcn_mfma_f32_16x16x32_bf16(bfr, cf[ks], ga, 0, 0, 0); }
                    const int j0 = 16 * tj + 4 * q4; const f32x4 cj = *(const LAS f32x4*)(cumL + pr + j0), dj = *(const LAS f32x4*)(dtL + pr + j0);
                    float wv[4];
#pragma unroll
                    for (int r = 0; r < 4; ++r) { const int j = j0 + r; float v = ga[r] * __expf(ci - cj[r]) * dj[r]; v = (j <= irow) ? v : 0.f; if (j == irow) v += dh; wv[r] = v; }
                    u32x2 w_; w_.x = pk2(wv[0], wv[1]); w_.y = pk2(wv[2], wv[3]);
                    *(LAS u32x2*)(Lb + WM_OFF + irow * SXB + j0 * 2) = w_; }
                WG_BAR();
                { bf16x8 wf[2];
#pragma unroll
                  for (int ks = 0; ks < 2; ++ks) wf[ks] = *(const LAS bf16x8*)(Lb + WM_OFF + irow * SXB + (32 * ks + 8 * q4) * 2);
                  const float ec = __expf(ci); float ssq = 0.f;
#pragma unroll
                  for (int tt = 0; tt < 2; ++tt) { const int tp = 2 * wh + tt; f32x4 yd = {0.f, 0.f, 0.f, 0.f}, yo = {0.f, 0.f, 0.f, 0.f};
#pragma unroll
                      for (int ks = 0; ks < 2; ++ks) { bf16x8 xa; TR8(xa, XS_OFF, SXB, 32 * ks, 16 * tp); yd = __builtin_amdgcn_mfma_f32_16x16x32_bf16(xa, wf[ks], yd, 0, 0, 0); }
#pragma unroll
                      for (int ks = 0; ks < 4; ++ks) { const bf16x8 ha = *(const LAS bf16x8*)(Lb + hb_cur + (16 * tp + r16) * SBB + (32 * ks + 8 * q4) * 2); yo = __builtin_amdgcn_mfma_f32_16x16x32_bf16(ha, cf[ks], yo, 0, 0, 0); }
                      const float z0 = bflo(zr[tt].x), z1 = bfhi(zr[tt].x), z2 = bflo(zr[tt].y), z3 = bfhi(zr[tt].y);
                      const float y0 = (yd[0] + ec * yo[0]) * silu_f(z0), y1 = (yd[1] + ec * yo[1]) * silu_f(z1), y2 = (yd[2] + ec * yo[2]) * silu_f(z2), y3 = (yd[3] + ec * yo[3]) * silu_f(z3);
                      ssq += (y0 * y0 + y1 * y1) + (y2 * y2 + y3 * y3);
                      u32x2 o_; o_.x = pk2(y0, y1); o_.y = pk2(y2, y3);
                      *(u32x2*)(Zb + (row0 + c * 64 + irow) * DI + h * HP + 16 * tp + 4 * q4) = o_; }
                  ssq += __shfl_xor(ssq, 16); ssq += __shfl_xor(ssq, 32);
                  if (q4 == 0) SSQ[(row0 + c * 64 + irow) * 64 + h * 2 + wh] = ssq; }
                if (c + 1 < SEQ / 64) SC_LOADZ(c + 1, B);
                { const float eL = __expf(cumL[pr + 63]);
#pragma unroll
                  for (int tp = 0; tp < 4; ++tp) hacc[tp] = hacc[tp] * eL;
#pragma unroll
                  for (int ks = 0; ks < 2; ++ks) { bf16x8 ba; TR8(ba, BM_OFF, SBB, 32 * ks, 16 * wave);
#pragma unroll
                      for (int tp = 0; tp < 4; ++tp) { bf16x8 xb; TR8(xb, XW_OFF, SXB, 32 * ks, 16 * tp); hacc[tp] = __builtin_amdgcn_mfma_f32_16x16x32_bf16(ba, xb, hacc[tp], 0, 0, 0); } }
#pragma unroll
                  for (int tp = 0; tp < 4; ++tp) { u32x2 o_; o_.x = pk2(hacc[tp][0], hacc[tp][1]); o_.y = pk2(hacc[tp][2], hacc[tp][3]);
                      *(LAS u32x2*)(Lb + hb_nxt + (16 * tp + r16) * SBB + (16 * wave + 4 * q4) * 2) = o_; } }
                WG_BAR();
                if (c + 1 < SEQ / 64) SC_STAGE(c + 1, A);
                WG_BAR();
                }
            }
        }
#undef SC_LOADZ
#undef TR8
#undef SC_LOAD
#undef SC_CUMDT
#undef SC_STAGE
#endif
    }
    SEAM(3);

    if (IN(4)) { PH_LOCALS
        { float pn = 0.f; u32x4 yn[4];
#define NM_LOAD(mm) do { pn = SSQ[(size_t)(mm) * 64 + lane]; _Pragma("unroll") for (int j = 0; j < 4; ++j) yn[j] = *(const u32x4*)(Zb + (size_t)(mm) * DI + j * 512 + lane * 8); } while (0)
          if (gw < T) NM_LOAD(gw);
          for (int m = gw; m < T; m += NGW) {
            float p = pn; u32x4 yw[4];
#pragma unroll
            for (int j = 0; j < 4; ++j) yw[j] = yn[j];
            if (m + NGW < T) NM_LOAD(m + NGW);
            p += dpp_mov<0xB1>(p); p += dpp_mov<0x4E>(p); p += dpp_mov<0x141>(p); p += dpp_mov<0x140>(p);
            bf16* yr = Zb + (size_t)m * DI;
#pragma unroll
            for (int j = 0; j < 4; ++j) { const float ss = __builtin_bit_cast(float, __builtin_amdgcn_readlane(__builtin_bit_cast(int, p), 16 * j)); const float rs = 1.f / sqrtf(ss * (1.f / 512.f) + RMS_EPS);
                u32x4 w = yw[j];
                w.x = pk2(bflo(w.x) * rs, bfhi(w.x) * rs); w.y = pk2(bflo(w.y) * rs, bfhi(w.y) * rs); w.z = pk2(bflo(w.z) * rs, bfhi(w.z) * rs); w.w = pk2(bflo(w.w) * rs, bfhi(w.w) * rs);
                *(u32x4*)(yr + j * 512 + lane * 8) = w; }
          }
#undef NM_LOAD
        }
        LAS float* scr = (LAS float*)(F.lds + wave * 16384);
        constexpr int I_QKV = (D / 64) * (3 * D / 32), I_O = (D / 64) * (D / 32), I_G = (D / 64) * (DFF / 32), I_D = (DFF / 64) * (D / 32);
        constexpr int I_MOE = 2 * NE * (2 * I_G + I_D);
        for (int it = gw; it < I_QKV + I_O + I_MOE; it += NGW) {
            int r = it;
            if (r < I_QKV) { transpose_item(args.in[9], D, 3 * D, (bf16*)(ws + WS_WQKV), 0, 0, nullptr, scr, r, lane); continue; } r -= I_QKV;
            if (r < I_O) { transpose_item(args.in[12], D, D, (bf16*)(ws + WS_WO), 0, 0, nullptr, scr, r, lane); continue; } r -= I_O;
            const int le = r / (2 * I_G + I_D), L = le / NE, e = le % NE; r -= le * (2 * I_G + I_D);
            bf16* wgu = (bf16*)(ws + (L ? WS_WGU1 : WS_WGU0)) + (size_t)e * 1024 * D; bf16* wd = (bf16*)(ws + (L ? WS_WD1 : WS_WD0)) + (size_t)e * D * DFF;
            if (r < I_G) { transpose_item(args.in[16] + (size_t)le * D * DFF, D, DFF, wgu, 0, 1, nullptr, scr, r, lane); continue; } r -= I_G;
            if (r < I_G) { transpose_item(args.in[17] + (size_t)le * D * DFF, D, DFF, wgu, 0, 2, nullptr, scr, r, lane); continue; } r -= I_G;
            transpose_item(args.in[18] + (size_t)le * DFF * D, DFF, D, wd, 0, 0, nullptr, scr, r, lane);
        }
    }
    SEAM(4);

    if (IN(5)) { PH_LOCALS
        pg8::DenseOrder S; S.init(T, D, F.G, (int)blockIdx.x, DI);
        pg8::EpiPlain E{(bf16*)(ws + WS_MIX1), D, nullptr, 0, 1.f};
        pg8::gemm_phase<pg8::EpiPlain, pg8::DenseOrder>(F.lds, Zb, Wt_out, DI, S, E);
    }
    SEAM(5);

    layer_tail<0>(args, F, bar, lo, hi);
    SEAM(9);

    if (IN(10)) { PH_LOCALS
        pg8::DenseOrder S; S.init(T, 3 * D, F.G, (int)blockIdx.x, D);
        pg8::EpiPlain E{(bf16*)(ws + WS_QKV), 3 * D, args.in[10], D, 0.125f};
        pg8::gemm_phase<pg8::EpiPlain, pg8::DenseOrder>(F.lds, (const bf16*)(ws + WS_X2B), (const bf16*)(ws + WS_WQKV), D, S, E);
    }
    SEAM(10);
    if (IN(11)) { PH_LOCALS
#if NAIVE_ATTN
        const bf16* QKV = (const bf16*)(ws + WS_QKV); bf16* AO = (bf16*)(ws + WS_AO); const float* rel = args.in[11];
        for (int idx = blockIdx.x * 512 + tid; idx < NB * AH * SEQ; idx += F.G * 512) {
            const int s = idx % SEQ, bh = idx / SEQ, hh = bh % AH, b = bh / AH, c = s / 64;
            const bf16* qp = QKV + ((size_t)b * SEQ + s) * (3 * D) + hh * AD;
            float q[AD], o[AD];
#pragma unroll
            for (int d = 0; d < AD; ++d) { q[d] = bf2f(qp[d]); o[d] = 0.f; }
            float mx = -1e30f, l = 0.f;
            const int k0 = (c - LEFTC) * 64 < 0 ? 0 : (c - LEFTC) * 64, k1 = c * 64 + 64;
            for (int kp = k0; kp < k1; ++kp) {
                const bf16* kr = QKV + ((size_t)b * SEQ + kp) * (3 * D) + D + hh * AD; const bf16* vr = kr + D;
                float sc = 0.f;
#pragma unroll
                for (int d = 0; d < AD; d += 2) { const unsigned w = *(const unsigned*)(kr + d); sc += q[d] * bflo(w) + q[d + 1] * bfhi(w); }
                int dist = s - kp; dist = dist < -MAXREL ? -MAXREL : (dist > MAXREL ? MAXREL : dist);
                sc += rel[(dist + MAXREL) * AH + hh];
                const float mn = fmaxf(mx, sc), f = __expf(mx - mn), p = __expf(sc - mn);
                l = l * f + p; mx = mn;
#pragma unroll
                for (int d = 0; d < AD; d += 2) { const unsigned w = *(const unsigned*)(vr + d); o[d] = o[d] * f + p * bflo(w); o[d + 1] = o[d + 1] * f + p * bfhi(w); }
            }
            const float il = 1.f / l; bf16* op = AO + ((size_t)b * SEQ + s) * D + hh * AD;
#pragma unroll
            for (int d = 0; d < AD; d += 2) *(unsigned*)(op + d) = pk2(o[d] * il, o[d + 1] * il);
        }
#else
        const bf16* QKV = (const bf16*)(ws + WS_QKV); bf16* AO = (bf16*)(ws + WS_AO); const float* rel = args.in[11];
        typedef short v4i16 __attribute__((ext_vector_type(4)));
        constexpr int SKB = 144, KB_OFF = 0, VB_OFF = 18432, TB_OFF = 36864; constexpr float LOG2E = 1.4426950408889634f;
        LAS unsigned char* Lb = F.lds; LAS float* tb = (LAS float*)(Lb + TB_OFF);
        const int r16 = lane & 15, q4 = lane >> 4, wq = wave >> 2;
        const int NU = NB * AH * (SEQ / 128), per = (NU + F.G - 1) / F.G;
        int hprev = -1;
        for (int ui = 0; ui < per; ++ui) {
            const int u = F.vcu * per + ui; if (u >= NU) break;
            const int bh = u >> 5, cp = u & 31, b = bh >> 4, hh = bh & 15, c0 = 2 * cp;
            __syncthreads();
            if (hh != hprev) { for (int i = tid; i < 2 * MAXREL + 1; i += 512) tb[i] = rel[i * AH + hh] * LOG2E; hprev = hh; }
            const int cw = c0 + wq, qrow = 64 * cw + 16 * (wave & 3) + r16;
            const size_t tok0 = (size_t)b * SEQ;
            bf16x8 qf[2];
#pragma unroll
            for (int ds = 0; ds < 2; ++ds) qf[ds] = *(const bf16x8*)(QKV + (tok0 + qrow) * (3 * D) + hh * AD + 32 * ds + 8 * q4);
            f32x4 oacc[4];
#pragma unroll
            for (int i = 0; i < 4; ++i) oacc[i] = (f32x4){0.f, 0.f, 0.f, 0.f};
            float mrun = -1e30f, lrun = 0.f;
            const int kt_lo = c0 < 8 ? 8 - c0 : 0;
            const int kr = tid >> 3, pc = tid & 7;
            const bf16* kvp = QKV + (tok0 + kr) * (3 * D) + D + hh * AD + 8 * pc;
            u32x4 kreg, vreg;
            { const size_t co = (size_t)(c0 - 8 + kt_lo) * 64 * (3 * D); kreg = *(const u32x4*)(kvp + co); vreg = *(const u32x4*)(kvp + co + D); }
            *(LAS u32x4*)(Lb + KB_OFF + (kt_lo & 1) * 9216 + kr * SKB + pc * 16) = kreg; *(LAS u32x4*)(Lb + VB_OFF + (kt_lo & 1) * 9216 + kr * SKB + pc * 16) = vreg;
            __syncthreads();
            for (int kt = kt_lo; kt < 10; ++kt) {
                const int chunk = c0 - 8 + kt;
                if (kt + 1 < 10) { const size_t co = (size_t)(chunk + 1) * 64 * (3 * D); kreg = *(const u32x4*)(kvp + co); vreg = *(const u32x4*)(kvp + co + D); }
                if (kt >= wq && kt <= wq + 8) {
                    const LAS unsigned char* Kb = Lb + KB_OFF + (kt & 1) * 9216; const LAS unsigned char* Vb = Lb + VB_OFF + (kt & 1) * 9216;
                    f32x4 sc[4];
#pragma unroll
                    for (int t = 0; t < 4; ++t) { sc[t] = (f32x4){0.f, 0.f, 0.f, 0.f};
#pragma unroll
                        for (int ds = 0; ds < 2; ++ds) { const bf16x8 kf = *(const LAS bf16x8*)(Kb + (16 * t + r16) * SKB + (32 * ds + 8 * q4) * 2); sc[t] = __builtin_amdgcn_mfma_f32_16x16x32_bf16(kf, qf[ds], sc[t], 0, 0, 0); } }
                    if (cw - chunk >= 3) { const float bc = tb[2 * MAXREL];
#pragma unroll
                        for (int t = 0; t < 4; ++t) sc[t] = sc[t] * LOG2E + bc;
                    } else {
#pragma unroll
                        for (int t = 0; t < 4; ++t)
#pragma unroll
                            for (int r = 0; r < 4; ++r) { int dist = qrow - (64 * chunk + 16 * t + 4 * q4 + r); dist = dist < -MAXREL ? -MAXREL : (dist > MAXREL ? MAXREL : dist); sc[t][r] = sc[t][r] * LOG2E + tb[dist + MAXREL]; }
                    }
                    float mx = fmaxf(fmaxf(sc[0][0], sc[0][1]), fmaxf(sc[0][2], sc[0][3]));
#pragma unroll
                    for (int t = 1; t < 4; ++t) mx = fmaxf(mx, fmaxf(fmaxf(sc[t][0], sc[t][1]), fmaxf(sc[t][2], sc[t][3])));
                    mx = fmaxf(mx, __shfl_xor(mx, 16)); mx = fmaxf(mx, __shfl_xor(mx, 32));
                    const float mnew = fmaxf(mrun, mx), alpha = __builtin_amdgcn_exp2f(mrun - mnew); mrun = mnew;
                    float ls = 0.f;
#pragma unroll
                    for (int t = 0; t < 4; ++t)
#pragma unroll
                        for (int r = 0; r < 4; ++r) { sc[t][r] = __builtin_amdgcn_exp2f(sc[t][r] - mnew); ls += sc[t][r]; }
                    lrun = lrun * alpha + ls;
#pragma unroll
                    for (int i = 0; i < 4; ++i) oacc[i] = oacc[i] * alpha;
                    bf16x8 pb[2];
#pragma unroll
                    for (int kk = 0; kk < 2; ++kk) { u32x4 w_; w_.x = pk2(sc[2 * kk][0], sc[2 * kk][1]); w_.y = pk2(sc[2 * kk][2], sc[2 * kk][3]); w_.z = pk2(sc[2 * kk + 1][0], sc[2 * kk + 1][1]); w_.w = pk2(sc[2 * kk + 1][2], sc[2 * kk + 1][3]); pb[kk] = __builtin_bit_cast(bf16x8, w_); }
#pragma unroll
                    for (int dt = 0; dt < 4; ++dt)
#pragma unroll
                        for (int kk = 0; kk < 2; ++kk) { const LAS unsigned char* va_ = Vb + (32 * kk + 4 * q4 + (r16 >> 2)) * SKB + (16 * dt + 4 * (lane & 3)) * 2;
                            const v4i16 lo_ = __builtin_amdgcn_ds_read_tr16_b64_v4i16((LAS v4i16*)va_), hi_ = __builtin_amdgcn_ds_read_tr16_b64_v4i16((LAS v4i16*)(va_ + 16 * SKB));
                            const bf16x8 vf = (bf16x8){lo_[0], lo_[1], lo_[2], lo_[3], hi_[0], hi_[1], hi_[2], hi_[3]};
                            oacc[dt] = __builtin_amdgcn_mfma_f32_16x16x32_bf16(vf, pb[kk], oacc[dt], 0, 0, 0); }
                }
                if (kt + 1 < 10) { *(LAS u32x4*)(Lb + KB_OFF + ((kt + 1) & 1) * 9216 + kr * SKB + pc * 16) = kreg; *(LAS u32x4*)(Lb + VB_OFF + ((kt + 1) & 1) * 9216 + kr * SKB + pc * 16) = vreg; }
                WG_BAR();
            }
            lrun += __shfl_xor(lrun, 16); lrun += __shfl_xor(lrun, 32);
            const float il = 1.f / lrun; bf16* op = AO + (tok0 + qrow) * D + hh * AD + 4 * q4;
#pragma unroll
            for (int dt = 0; dt < 4; ++dt) { u32x2 o_; o_.x = pk2(oacc[dt][0] * il, oacc[dt][1] * il); o_.y = pk2(oacc[dt][2] * il, oacc[dt][3] * il); *(u32x2*)(op + 16 * dt) = o_; }
        }
#endif
    }
    SEAM(11);
    if (IN(12)) { PH_LOCALS
        pg8::DenseOrder S; S.init(T, D, F.G, (int)blockIdx.x, D);
        pg8::EpiPlain E{(bf16*)(ws + WS_MIX2), D, args.in[13], 0, 1.f};
        pg8::gemm_phase<pg8::EpiPlain, pg8::DenseOrder>(F.lds, (const bf16*)(ws + WS_AO), (const bf16*)(ws + WS_WO), D, S, E);
    }
    SEAM(12);
    layer_tail<1>(args, F, bar, lo, hi);
#undef IN
#undef SEAM
}

extern "C" void kernel_launch(void* const* d_in, const int* in_sizes, int n_in, void* d_out, int out_size, void* d_ws, size_t ws_size, hipStream_t stream) {
    static int grid = 0;
    if (grid == 0) {
        if (n_in != 23 || in_sizes[0] != T * D || out_size != T * D || ws_size < WS_END) { fprintf(stderr, "kernel_launch: unexpected shapes / workspace (n_in %d, ws %zu); nothing launched\n", n_in, ws_size); grid = -1; return; }
        int dev = 0, cus = 0, per_cu = 0;
        if (hipGetDevice(&dev) != hipSuccess || hipDeviceGetAttribute(&cus, hipDeviceAttributeMultiprocessorCount, dev) != hipSuccess) { grid = -1; return; }
        if (hipFuncSetAttribute((const void*)fwd_kernel, hipFuncAttributeMaxDynamicSharedMemorySize, LDS_BYTES) != hipSuccess) { fprintf(stderr, "kernel_launch: hipFuncSetAttribute failed\n"); grid = -1; return; }
        if (hipOccupancyMaxActiveBlocksPerMultiprocessor(&per_cu, (const void*)fwd_kernel, 512, LDS_BYTES) != hipSuccess || per_cu < 1) fprintf(stderr, "kernel_launch: occupancy query reports %d\n", per_cu);
        (void)hipGetLastError();
        grid = cus;
    }
    if (grid < 0) return;
    if (hipMemsetAsync((char*)d_ws + WS_CTL, 0, CTL_ZERO_BYTES, stream) != hipSuccess) return;
    Args a{};
    for (int i = 0; i < 23; ++i) a.in[i] = (const float*)d_in[i];
    a.out = (float*)d_out; a.ws = (unsigned char*)d_ws;
    if (MK_N_LAUNCHES == 1) { a.ph_lo = 0; a.ph_hi = NPHASE; hipLaunchKernelGGL(fwd_kernel, dim3(grid), dim3(512), LDS_BYTES, stream, a);
#ifdef PROBE_MASK
        for (int p = 0; p < NPHASE; ++p) if ((PROBE_MASK >> p) & 1) { a.ph_lo = p; a.ph_hi = p + 1; hipLaunchKernelGGL(fwd_kernel, dim3(grid), dim3(512), LDS_BYTES, stream, a); }
#endif
    }
    else for (int p = 0; p < NPHASE; ++p) { a.ph_lo = p; a.ph_hi = p + 1; hipLaunchKernelGGL(fwd_kernel, dim3(grid), dim3(512), LDS_BYTES, stream, a); }
}
```

```cpp
#include <hip/hip_runtime.h>
#include <cstdio>
#include <cstdint>

#ifndef MK_N_LAUNCHES
#define MK_N_LAUNCHES 1
#endif
#ifndef NAIVE_SCAN
#define NAIVE_SCAN 0
#endif
#ifndef NAIVE_ATTN
#define NAIVE_ATTN 0
#endif

#define LAS __attribute__((address_space(3)))
#define GAS __attribute__((address_space(1)))
typedef unsigned short bf16;
typedef short bf16x8 __attribute__((ext_vector_type(8)));
typedef float f32x4 __attribute__((ext_vector_type(4)));
typedef float f32x2 __attribute__((ext_vector_type(2)));
typedef unsigned u32x4 __attribute__((ext_vector_type(4)));
typedef unsigned u32x2 __attribute__((ext_vector_type(2)));
typedef GAS unsigned gu32;

constexpr int NB = 8, SEQ = 4096, D = 1024, T = NB * SEQ;
constexpr int DI = 2048, NH = 32, HP = 64, NG = 4, NS = 128, CONVD = 3072, INP = 5152, NZX = 5120;
constexpr int AH = 16, AD = 64, LEFTC = 8, MAXREL = 128;
constexpr int NE = 16, DFF = 512;
constexpr float ALPHA = 1.4142135623730951f;
constexpr float LN_EPS = 1e-5f, RMS_EPS = 1e-5f;
constexpr int NPHASE = 17;
constexpr int MAXTILES = 272;

constexpr size_t MiB = 1u << 20;
constexpr size_t WS_CTL = 0, CTL_ZERO_BYTES = 1 * MiB;
constexpr size_t WS_WIN = 1 * MiB;
constexpr size_t WS_WOUT = 12 * MiB;
constexpr size_t WS_XB = 16 * MiB;
constexpr size_t WS_BCACT = 16 * MiB;
constexpr size_t WS_WGU0 = 16 * MiB, WS_WD0 = 48 * MiB, WS_WQKV = 64 * MiB, WS_WO = 70 * MiB, WS_WGU1 = 72 * MiB, WS_WD1 = 104 * MiB;
constexpr size_t WS_Z = 120 * MiB;
constexpr size_t WS_XBC = 248 * MiB;
constexpr size_t WS_DTRAW = 440 * MiB;
constexpr size_t WS_SSQ = 444 * MiB;
constexpr size_t WS_MIX1 = 248 * MiB;
constexpr size_t WS_X1B = 324 * MiB;
constexpr size_t WS_H0 = 120 * MiB;
constexpr size_t WS_Y20 = 188 * MiB;
constexpr size_t WS_X2B = 120 * MiB;
constexpr size_t WS_QKV = 188 * MiB;
constexpr size_t WS_AO = 380 * MiB;
constexpr size_t WS_MIX2 = 188 * MiB;
constexpr size_t WS_X3B = 256 * MiB;
constexpr size_t WS_H1 = 320 * MiB;
constexpr size_t WS_Y21 = 120 * MiB;
constexpr size_t WS_LIST = 500 * MiB;
constexpr size_t WS_INFO = 504 * MiB;
constexpr size_t WS_END = 512 * MiB;
constexpr int CW_TMO = 0;
constexpr int CW_CNT = 1024;
constexpr int CW_BAR = 4096;

constexpr int RING_BYTES = 131072;
constexpr int LDSCTL_OFF = RING_BYTES, MISC_OFF = LDSCTL_OFF + 320;
constexpr int TOKL_OFF = LDSCTL_OFF + 1024;
constexpr int MOE_OFF = TOKL_OFF + 6 * 1024;
constexpr int LDS_BYTES = 147456;

#define RLX_AGENT __ATOMIC_RELAXED, __HIP_MEMORY_SCOPE_AGENT
#define LDS_WAIT() asm volatile("s_waitcnt lgkmcnt(0)" ::: "memory")
#define VM_WAIT() asm volatile("s_waitcnt vmcnt(0)" ::: "memory")
#define WG_BAR() do { asm volatile("s_waitcnt lgkmcnt(0)" ::: "memory"); __builtin_amdgcn_s_barrier(); asm volatile("" ::: "memory"); } while (0)

__device__ __forceinline__ unsigned f2bf(float f) { unsigned u = __builtin_bit_cast(unsigned, f); return (u + 0x7fffu + ((u >> 16) & 1u)) >> 16; }
__device__ __forceinline__ unsigned pk2(float lo, float hi) { return f2bf(lo) | (f2bf(hi) << 16); }
__device__ __forceinline__ float bf2f(unsigned short b) { return __builtin_bit_cast(float, ((unsigned)b) << 16); }
__device__ __forceinline__ float bflo(unsigned w) { return __builtin_bit_cast(float, w << 16); }
__device__ __forceinline__ float bfhi(unsigned w) { return __builtin_bit_cast(float, w & 0xffff0000u); }
__device__ __forceinline__ float silu_f(float v) { return v * __builtin_amdgcn_rcpf(1.f + __expf(-v)); }
template <int CTRL> __device__ __forceinline__ float dpp_mov(float v) { return __builtin_bit_cast(float, __builtin_amdgcn_update_dpp(0, __builtin_bit_cast(int, v), CTRL, 0xF, 0xF, true)); }
__device__ __forceinline__ float wave_sum(float v) {
    v += dpp_mov<0xB1>(v); v += dpp_mov<0x4E>(v); v += dpp_mov<0x141>(v); v += dpp_mov<0x140>(v);
    const int vi = __builtin_bit_cast(int, v);
    return (__builtin_bit_cast(float, __builtin_amdgcn_readlane(vi, 0)) + __builtin_bit_cast(float, __builtin_amdgcn_readlane(vi, 16))) + (__builtin_bit_cast(float, __builtin_amdgcn_readlane(vi, 32)) + __builtin_bit_cast(float, __builtin_amdgcn_readlane(vi, 48)));
}

namespace pg8 {
constexpr int BM = 256, BK = 64, HALF = 128, HTB = HALF * BK * 2, STAGE_BYTES = 8 * HTB;
__device__ __forceinline__ int lds_byte(int r, int c) { const int st = (r >> 4) * 2 + (c >> 5), rr = r & 15, cc = c & 31, ob = rr * 64 + cc * 2; return st * 1024 + (ob ^ (((ob >> 9) & 1) << 5)); }
__device__ __forceinline__ void stage_rc(int b, int& R, int& C) { const int st = b / 1024, sb = b % 1024, swz = sb ^ (((sb >> 9) & 1) << 5); R = (st >> 1) * 16 + swz / 64; C = (st & 1) * 32 + (swz % 64) / 2; }
__device__ __forceinline__ int perm32(int rho) { const int n = rho >> 4, i = rho & 15; return 8 * (i >> 2) + 4 * n + (i & 3); }
__device__ __forceinline__ unsigned cvt_pk_bf16(float lo, float hi) { unsigned r; asm volatile("v_cvt_pk_bf16_f32 %0, %1, %2" : "=v"(r) : "v"(lo), "v"(hi)); return r; }

struct Unit { int pm, pn, bt, e; };

template <class Epi, class Sched>
__device__ __forceinline__ void gemm_phase(LAS unsigned char* lds, const bf16* A, const bf16* Bt, int K, const Sched& S, const Epi& E) {
    int tid = threadIdx.x; asm volatile("" : "+v"(tid));
    const int wid = __builtin_amdgcn_readfirstlane(tid >> 6), lane = tid & 63, wr = wid >> 2, wc = wid & 3, fr = lane & 15, fq = lane >> 4;
    const int nt = K / BK;
    int Rr[2], Cc[2]; unsigned voffB[2];
#pragma unroll
    for (int i = 0; i < 2; ++i) { stage_rc(tid * 16 + i * 8192, Rr[i], Cc[i]); const int Rb = (Rr[i] & ~31) + perm32(Rr[i] & 31); voffB[i] = (unsigned)(Rb * K + Cc[i]) * 2u; }
    const size_t kstep = (size_t)(BK * 2);
    const size_t hstep = (size_t)HALF * K * 2;
    const size_t tstep = 2 * hstep;
    const unsigned ldsw = (unsigned)wid * 1024u;
    const int aoff = lds_byte(wr * 64 + fr, fq * 8), boff = lds_byte(wc * 32 + fr, fq * 8);
#define PG8_SA(b, h) (((b) * 2 + (h)) * HTB)
#define PG8_SB(b, h) ((4 + (b) * 2 + (h)) * HTB)
#define PG8_STAGE(bufoff, gbase, voff) do { _Pragma("unroll") for (int _i = 0; _i < 2; ++_i) \
        __builtin_amdgcn_global_load_lds((const unsigned*)((const char*)(gbase) + (voff)[_i]), (LAS unsigned*)(lds + (bufoff) + ldsw + _i * 8192), 16, 0, 0); } while (0)
#define PG8_LDA(dst, b, h) do { _Pragma("unroll") for (int m = 0; m < 4; ++m) _Pragma("unroll") for (int k = 0; k < 2; ++k) dst[m][k] = *(const LAS bf16x8*)(lds + PG8_SA(b, h) + aoff + m * 2048 + k * 1024); } while (0)
#define PG8_LDB(dst, b, h) do { _Pragma("unroll") for (int n = 0; n < 2; ++n) _Pragma("unroll") for (int k = 0; k < 2; ++k) dst[n][k] = *(const LAS bf16x8*)(lds + PG8_SB(b, h) + boff + n * 2048 + k * 1024); } while (0)
#define PG8_MMA(ai, bj, At, Bt_) do { __builtin_amdgcn_s_setprio(1); _Pragma("unroll") for (int m = 0; m < 4; ++m) _Pragma("unroll") for (int n = 0; n < 2; ++n) _Pragma("unroll") for (int k = 0; k < 2; ++k) \
        acc[ai][bj][m][n] = __builtin_amdgcn_mfma_f32_16x16x32_bf16(Bt_[n][k], At[m][k], acc[ai][bj][m][n], 0, 0, 0); __builtin_amdgcn_s_setprio(0); } while (0)
#define PG8_WAIT_V(n) asm volatile("s_waitcnt vmcnt(" #n ")" ::: "memory")
#define PG8_WAIT_L(n) asm volatile("s_waitcnt lgkmcnt(" #n ")" ::: "memory")
#define PG8_BAR __builtin_amdgcn_s_barrier()
#define PG8_SCHED __builtin_amdgcn_sched_barrier(0)
    Unit cur, nxt; int ui = 0;
    if (!S.next(0, cur)) return;
    f32x4 acc[2][2][4][2];
#pragma unroll
    for (int a = 0; a < 2; ++a)
#pragma unroll
        for (int b = 0; b < 2; ++b)
#pragma unroll
            for (int m = 0; m < 4; ++m)
#pragma unroll
                for (int n = 0; n < 2; ++n) acc[a][b][m][n] = (f32x4){0.f, 0.f, 0.f, 0.f};
    bf16x8 At[4][2], B0[2][2], B1[2][2];
    unsigned vA0[2], vA1[2];
#pragma unroll
    for (int i = 0; i < 2; ++i) { vA0[i] = S.a_off(0, cur, 0, Rr[i], Cc[i]); vA1[i] = S.a_off(0, cur, 1, Rr[i], Cc[i]); }
    const char* Ab = (const char*)A;
    const char* cB = (const char*)Bt + (size_t)cur.bt * tstep;
    PG8_STAGE(PG8_SB(0, 0), cB, voffB); PG8_STAGE(PG8_SB(0, 1), cB + hstep, voffB); PG8_STAGE(PG8_SA(0, 0), Ab, vA0); PG8_STAGE(PG8_SA(0, 1), Ab, vA1);
    if (wr == 1) PG8_BAR;
    PG8_WAIT_V(2); PG8_BAR;
    PG8_STAGE(PG8_SB(1, 0), cB + kstep, voffB); PG8_STAGE(PG8_SA(1, 0), Ab + kstep, vA0); PG8_STAGE(PG8_SB(1, 1), cB + hstep + kstep, voffB);
    PG8_WAIT_V(6); PG8_BAR;
    for (;;) {
        const bool has_next = S.next(ui + 1, nxt);
        const char* nB = has_next ? (const char*)Bt + (size_t)nxt.bt * tstep : cB;
        for (int t = 0; t < nt; t += 2) {
            const bool last = (t == nt - 2);
            const char* a1 = Ab + (size_t)(t + 1) * kstep;
            const char* a2 = last ? Ab : Ab + (size_t)(t + 2) * kstep; const char* b2 = last ? nB : cB + (size_t)(t + 2) * kstep;
            const char* a3 = a2 + kstep; const char* b3 = b2 + kstep;
            unsigned v20[2], v21[2];
#pragma unroll
            for (int i = 0; i < 2; ++i) { v20[i] = vA0[i]; v21[i] = vA1[i]; }
            if (last && has_next) {
#pragma unroll
                for (int i = 0; i < 2; ++i) { v20[i] = S.a_off(ui + 1, nxt, 0, Rr[i], Cc[i]); v21[i] = S.a_off(ui + 1, nxt, 1, Rr[i], Cc[i]); } }
            PG8_LDB(B0, 0, 0); PG8_LDB(B1, 0, 1); PG8_SCHED; PG8_LDA(At, 0, 0); PG8_STAGE(PG8_SA(1, 1), a1, vA1);
            PG8_WAIT_V(8); PG8_WAIT_L(0); PG8_BAR; PG8_MMA(0, 0, At, B0); PG8_MMA(0, 1, At, B1); PG8_BAR; PG8_SCHED;
            PG8_LDA(At, 0, 1); PG8_STAGE(PG8_SB(0, 0), b2, voffB); PG8_STAGE(PG8_SB(0, 1), b2 + hstep, voffB); PG8_STAGE(PG8_SA(0, 0), a2, v20);
            PG8_WAIT_V(8); PG8_WAIT_L(0); PG8_BAR; PG8_MMA(1, 0, At, B0); PG8_MMA(1, 1, At, B1); PG8_BAR; PG8_SCHED;
            PG8_LDB(B0, 1, 0); PG8_LDB(B1, 1, 1); PG8_SCHED; PG8_LDA(At, 1, 0); PG8_STAGE(PG8_SA(0, 1), a2, v21);
            PG8_WAIT_V(8); PG8_WAIT_L(0); PG8_BAR; PG8_MMA(0, 0, At, B0); PG8_MMA(0, 1, At, B1); PG8_BAR; PG8_SCHED;
            PG8_LDA(At, 1, 1); PG8_STAGE(PG8_SB(1, 0), b3, voffB); PG8_STAGE(PG8_SB(1, 1), b3 + hstep, voffB); PG8_STAGE(PG8_SA(1, 0), a3, v20);
            PG8_WAIT_V(8); PG8_WAIT_L(0); PG8_BAR; PG8_MMA(1, 0, At, B0); PG8_MMA(1, 1, At, B1); PG8_BAR; PG8_SCHED;
        }
        if (wr == 0) PG8_BAR;
        E(acc, cur, wr, wc, fr, fq);
        if (!has_next) break;
#pragma unroll
        for (int a = 0; a < 2; ++a)
#pragma unroll
            for (int b = 0; b < 2; ++b)
#pragma unroll
                for (int m = 0; m < 4; ++m)
#pragma unroll
                    for (int n = 0; n < 2; ++n) acc[a][b][m][n] = (f32x4){0.f, 0.f, 0.f, 0.f};
        cur = nxt; cB = nB; ++ui;
#pragma unroll
        for (int i = 0; i < 2; ++i) { vA0[i] = S.a_off(ui, cur, 0, Rr[i], Cc[i]); vA1[i] = S.a_off(ui, cur, 1, Rr[i], Cc[i]); }
        if (wr == 1) PG8_BAR;
    }
    PG8_WAIT_V(0);
    PG8_BAR;
#undef PG8_SA
#undef PG8_SB
#undef PG8_STAGE
#undef PG8_LDA
#undef PG8_LDB
#undef PG8_MMA
#undef PG8_WAIT_V
#undef PG8_WAIT_L
#undef PG8_BAR
#undef PG8_SCHED
}

struct DenseOrder {
    int nM, nN, nwg, G, c, lda;
    __device__ void init(int M, int N, int G_, int c_, int lda_) { nM = M / BM; nN = N / BM; nwg = nM * nN; G = G_; c = c_; lda = lda_; }
    __device__ __forceinline__ bool next(int i, Unit& u) const {
        const long L = (long)i * G + c; if (L >= nwg) return false;
        int wgid = (int)L; { const int q = nwg / 8, r = nwg % 8, xcd = wgid % 8, off = wgid / 8; wgid = (xcd < r ? xcd * (q + 1) : r * (q + 1) + (xcd - r) * q) + off; }
        const int nig = 8 * nN, gid = wgid / nig, fm = gid * 8, gsz = (nM - fm) < 8 ? (nM - fm) : 8;
        u.pm = fm + ((wgid % nig) % gsz); u.pn = (wgid % nig) / gsz; u.bt = u.pn; u.e = 0; return true;
    }
    __device__ __forceinline__ unsigned a_off(int, const Unit& u, int h, int R, int C) const { return (unsigned)((u.pm * BM + h * HALF + R) * lda + C) * 2u; }
};
template <bool GATHER> struct MoeOrder {
    const LAS int* ts;
    const LAS int* tokL;
    int G, c, lda;
    __device__ __forceinline__ bool next(int i, Unit& u) const {
        const int L = i * G + c; const int ntile = __builtin_amdgcn_readfirstlane(ts[16]);
        if (L >= ntile * 4) return false;
        const int rt = L >> 2; int e = 0;
#pragma unroll
        for (int j = 1; j < 16; ++j) e += (rt >= ts[j]) ? 1 : 0;
        e = __builtin_amdgcn_readfirstlane(e);
        u.pm = rt; u.pn = L & 3; u.e = e; u.bt = e * 4 + (L & 3); return true;
    }
    __device__ __forceinline__ unsigned a_off(int ui, const Unit& u, int h, int R, int C) const {
        if (GATHER) { const int tok = tokL[ui * 256 + h * HALF + R]; return (unsigned)(tok * lda + C) * 2u; }
        return (unsigned)((u.pm * BM + h * HALF + R) * lda + C) * 2u;
    }
};

struct EpiPlain {
    bf16* O; int ldc; const float* bias; int scale_cols; float scale0;
    __device__ __forceinline__ void operator()(const f32x4 (&acc)[2][2][4][2], const Unit& u, int wr, int wc, int fr, int fq) const {
        const int row0 = u.pm * BM + wr * 64 + fr, col0 = u.pn * BM + wc * 32 + 8 * fq;
        const float sc = (u.pn * BM < scale_cols) ? scale0 : 1.f;
        f32x4 bv[2][2];
#pragma unroll
        for (int bj = 0; bj < 2; ++bj)
#pragma unroll
            for (int n = 0; n < 2; ++n) bv[bj][n] = bias ? *(const f32x4*)(bias + col0 + bj * HALF + 4 * n) : (f32x4){0.f, 0.f, 0.f, 0.f};
#pragma unroll
        for (int ai = 0; ai < 2; ++ai)
#pragma unroll
            for (int m = 0; m < 4; ++m) { bf16* rowp = O + (size_t)(row0 + ai * HALF + m * 16) * ldc + col0;
#pragma unroll
                for (int bj = 0; bj < 2; ++bj) { f32x4 v0 = (acc[ai][bj][m][0] + bv[bj][0]) * sc, v1 = (acc[ai][bj][m][1] + bv[bj][1]) * sc;
                    u32x4 w; w.x = cvt_pk_bf16(v0[0], v0[1]); w.y = cvt_pk_bf16(v0[2], v0[3]); w.z = cvt_pk_bf16(v1[0], v1[1]); w.w = cvt_pk_bf16(v1[2], v1[3]);
                    *(u32x4*)(rowp + bj * HALF) = w; } }
    }
};
struct EpiInProj {
    bf16* Z; bf16* XBC;
    __device__ __forceinline__ void operator()(const f32x4 (&acc)[2][2][4][2], const Unit& u, int wr, int wc, int fr, int fq) const {
        const int row0 = u.pm * BM + wr * 64 + fr; int colt = u.pn * BM; bf16* base; int ldc;
        if (colt < DI) { base = Z; ldc = DI; } else { base = XBC; ldc = CONVD; colt -= DI; }
        const int col0 = colt + wc * 32 + 8 * fq;
#pragma unroll
        for (int ai = 0; ai < 2; ++ai)
#pragma unroll
            for (int m = 0; m < 4; ++m) { bf16* rowp = base + (size_t)(row0 + ai * HALF + m * 16) * ldc + col0;
#pragma unroll
                for (int bj = 0; bj < 2; ++bj) { const f32x4 v0 = acc[ai][bj][m][0], v1 = acc[ai][bj][m][1];
                    u32x4 w; w.x = cvt_pk_bf16(v0[0], v0[1]); w.y = cvt_pk_bf16(v0[2], v0[3]); w.z = cvt_pk_bf16(v1[0], v1[1]); w.w = cvt_pk_bf16(v1[2], v1[3]);
                    *(u32x4*)(rowp + bj * HALF) = w; } }
    }
};
struct EpiGateUp {
    bf16* Hh;
    __device__ __forceinline__ void operator()(const f32x4 (&acc)[2][2][4][2], const Unit& u, int wr, int wc, int fr, int fq) const {
        const int row0 = u.pm * BM + wr * 64 + fr, col0 = (u.pn * BM + wc * 32 + 8 * fq) >> 1;
#pragma unroll
        for (int ai = 0; ai < 2; ++ai)
#pragma unroll
            for (int m = 0; m < 4; ++m) { bf16* rowp = Hh + (size_t)(row0 + ai * HALF + m * 16) * DFF + col0;
#pragma unroll
                for (int bj = 0; bj < 2; ++bj) { const f32x4 g = acc[ai][bj][m][0], up = acc[ai][bj][m][1];
                    u32x2 w; w.x = cvt_pk_bf16(silu_f(g[0]) * up[0], silu_f(g[1]) * up[1]); w.y = cvt_pk_bf16(silu_f(g[2]) * up[2], silu_f(g[3]) * up[3]);
                    *(u32x2*)(rowp + bj * (HALF / 2)) = w; } }
    }
};
}

#define XB_TMO      128
#define XB_XCNT(j)  (256  + 64 * (j))
#define XB_XSUB(j)  (1280 + 64 * (j))
#define XB_XGEN(j)  (2304 + 64 * (j))
#define XB_TOP      3328
#define XB_TOPGEN   3392
#define XCD_BAR_WORDS 3456
#define XB_SPIN_CAP (1u << 18)
__device__ __forceinline__ unsigned xb_ld(unsigned* p)              { return __hip_atomic_load(p, __ATOMIC_RELAXED, __HIP_MEMORY_SCOPE_AGENT); }
__device__ __forceinline__ unsigned xb_add(unsigned* p, unsigned v) { return __hip_atomic_fetch_add(p, v, __ATOMIC_RELAXED, __HIP_MEMORY_SCOPE_AGENT); }
__device__ __forceinline__ unsigned xb_xcc_id() { return (unsigned)__builtin_amdgcn_s_getreg((3 << 11) | 20) & 0xFu; }
#define XB_SPIN(cond, bar) do { unsigned _sp = 0; while (cond) { __builtin_amdgcn_s_sleep(1); \
    if ((++_sp & 255u) == 0u) { if (xb_ld(&(bar)[XB_TMO])) break; if (_sp > XB_SPIN_CAP) { atomicAdd(&(bar)[XB_TMO], 1u); break; } } } } while (0)
struct XcdBarrier { unsigned* bar; unsigned x; volatile LAS unsigned* st; };
__device__ __forceinline__ XcdBarrier xcd_barrier_post(unsigned* bar, volatile LAS unsigned* st) {
    XcdBarrier b; b.bar = bar; b.x = xb_xcc_id(); b.st = st;
    if (threadIdx.x == 0) (void)xb_add(&bar[XB_XCNT(b.x)], 1u);
    return b;
}
__device__ __forceinline__ void xcd_barrier_complete(unsigned* bar, unsigned x, unsigned& nloc, unsigned& nx) {
    const unsigned G = gridDim.x * gridDim.y * gridDim.z;
    unsigned sum, cnt, mine, sp = 0u;
    for (;;) {
        sum = 0u; cnt = 0u; mine = 0u;
#pragma unroll
        for (unsigned j = 0; j < 16; ++j) { const unsigned c = xb_ld(&bar[XB_XCNT(j)]); sum += c; cnt += (c > 0u) ? 1u : 0u; mine = (j == x) ? c : mine; }
        if (sum == G) break;
        __builtin_amdgcn_s_sleep(1);
        if ((++sp & 255u) == 0u) { if (xb_ld(&bar[XB_TMO])) break; if (sp > XB_SPIN_CAP) { atomicAdd(&bar[XB_TMO], 1u); break; } }
    }
    nloc = mine > 0u ? mine : 1u; nx = cnt > 0u ? cnt : 1u;
}
__device__ __forceinline__ void xcd_barrier(const XcdBarrier& b) {
    asm volatile("s_waitcnt vmcnt(0)" ::: "memory");
    __syncthreads();
    if (threadIdx.x == 0) {
        unsigned* bar = b.bar;
        __builtin_amdgcn_s_waitcnt(0);
        unsigned nloc = b.st[0], nx = b.st[1];
        if (nloc == 0u) { xcd_barrier_complete(bar, b.x, nloc, nx); b.st[0] = nloc; b.st[1] = nx; }
        const unsigned old = xb_add(&bar[XB_XSUB(b.x)], 1u);
        const unsigned gen = old / nloc;
        if (old + 1u == (gen + 1u) * nloc) {
            __builtin_amdgcn_fence(__ATOMIC_RELEASE, "agent");
            asm volatile("s_waitcnt vmcnt(0)" ::: "memory");
            const unsigned og = xb_add(&bar[XB_TOP], 1u);
            const unsigned tg = og / nx;
            if (og + 1u == (tg + 1u) * nx) xb_add(&bar[XB_TOPGEN], 1u);
            else XB_SPIN(xb_ld(&bar[XB_TOPGEN]) == tg, bar);
            __builtin_amdgcn_fence(__ATOMIC_ACQUIRE, "agent");
            xb_add(&bar[XB_XGEN(b.x)], 1u);
            asm volatile("s_waitcnt vmcnt(0)" ::: "memory");
        } else {
            XB_SPIN(xb_ld(&bar[XB_XGEN(b.x)]) == gen, bar);
            __builtin_amdgcn_fence(__ATOMIC_ACQUIRE, "agent");
            asm volatile("s_waitcnt vmcnt(0)" ::: "memory");
        }
    }
    __syncthreads();
}

struct Args { const float* in[23]; float* out; unsigned char* ws; int ph_lo, ph_hi; };

struct Frame {
    LAS unsigned char* lds;
    int tid, lane, wave, vcu, G;
};

__device__ __forceinline__ void transpose_item(const float* W, int K, int N, bf16* WT, int row_off, int mode, const float* kscale, LAS float* scr, int item, int lane) {
    const int nblk = N / 32, kb = item / nblk, nb = item % nblk, k0 = 64 * kb, n0 = 32 * nb;
#pragma unroll 8
    for (int i = 0; i < 32; ++i) { const int kk = 2 * i + (lane >> 5); scr[kk * 33 + (lane & 31)] = W[(size_t)(k0 + kk) * N + n0 + (lane & 31)]; }
    LDS_WAIT(); asm volatile("" ::: "memory");
    const int c = lane & 7;
    float ks[8];
#pragma unroll
    for (int q = 0; q < 8; ++q) ks[q] = kscale ? kscale[k0 + 8 * c + q] : 1.f;
#pragma unroll
    for (int j = 0; j < 4; ++j) { const int n = (lane >> 3) + 8 * j; const LAS float* s = scr + (8 * c) * 33 + n;
        u32x4 o; o.x = pk2(s[0 * 33] * ks[0], s[1 * 33] * ks[1]); o.y = pk2(s[2 * 33] * ks[2], s[3 * 33] * ks[3]); o.z = pk2(s[4 * 33] * ks[4], s[5 * 33] * ks[5]); o.w = pk2(s[6 * 33] * ks[6], s[7 * 33] * ks[7]);
        const int ng = n0 + n; const int dr = (mode == 0) ? ng : (8 * (ng >> 2) + (ng & 3) + (mode == 2 ? 4 : 0));
        *(GAS u32x4*)(WT + (size_t)(row_off + dr) * K + k0 + 8 * c) = o; }
    LDS_WAIT(); asm volatile("" ::: "memory");
}

__device__ __forceinline__ void ln_row(f32x4 (&v)[4], const float* g, const float* b, int lane) {
    float s = 0.f;
#pragma unroll
    for (int j = 0; j < 4; ++j) s += (v[j].x + v[j].y) + (v[j].z + v[j].w);
    const float mean = wave_sum(s) * (1.f / D); float s2 = 0.f;
#pragma unroll
    for (int j = 0; j < 4; ++j) { v[j] = v[j] - mean; s2 += (v[j].x * v[j].x + v[j].y * v[j].y) + (v[j].z * v[j].z + v[j].w * v[j].w); }
    const float rstd = 1.f / sqrtf(wave_sum(s2) * (1.f / D) + LN_EPS);
#pragma unroll
    for (int j = 0; j < 4; ++j) { const f32x4 gg = *(const f32x4*)(g + 4 * lane + 256 * j), bb = *(const f32x4*)(b + 4 * lane + 256 * j); v[j] = v[j] * rstd * gg + bb; }
}
__device__ __forceinline__ f32x4 ld_bf16x4(const bf16* p) { const u32x2 w = *(const u32x2*)p; return (f32x4){bflo(w.x), bfhi(w.x), bflo(w.y), bfhi(w.y)}; }
__device__ __forceinline__ void st_bf16x4(bf16* p, f32x4 v) { u32x2 w; w.x = pk2(v.x, v.y); w.y = pk2(v.z, v.w); *(u32x2*)p = w; }

#ifndef PH_MASK
#define PH_MASK 0x1ffff
#endif
#define IN(k) (((PH_MASK >> (k)) & 1) && lo <= (k) && (k) < hi)
#define SEAM(k) do { if (IN(k) && IN((k) + 1)) xcd_barrier(bar); } while (0)
#define PH_LOCALS \
    int tid = threadIdx.x; asm volatile("" : "+v"(tid)); const int lane = tid & 63, wave = __builtin_amdgcn_readfirstlane(tid >> 6); \
    size_t ws_z_ = 0; asm volatile("" : "+s"(ws_z_)); unsigned char* ws = args.ws + ws_z_;     \
    const int gw = F.vcu * 8 + wave, NGW = F.G * 8; (void)lane; (void)gw; (void)NGW; \
    const float* x_in = args.in[0]; (void)x_in; \
    bf16* Wt_in = (bf16*)(ws + WS_WIN); bf16* Wt_out = (bf16*)(ws + WS_WOUT); (void)Wt_in; (void)Wt_out; \
    bf16* XB = (bf16*)(ws + WS_XB); bf16* Zb = (bf16*)(ws + WS_Z); bf16* XBC = (bf16*)(ws + WS_XBC); (void)XB; (void)Zb; (void)XBC; \
    float* DTRAW = (float*)(ws + WS_DTRAW); float* SSQ = (float*)(ws + WS_SSQ); (void)DTRAW; (void)SSQ; \
    int* LIST = (int*)(ws + WS_LIST); unsigned* INFO = (unsigned*)(ws + WS_INFO); (void)LIST; (void)INFO;


template <int L>
__device__ __forceinline__ void layer_tail(const Args& args, const Frame& F, const XcdBarrier& bar, const int lo, const int hi) {
    const int pb = L ? 13 : 6;
#define LAYER_LOCALS \
    const bf16* MIX = (const bf16*)(ws + (L ? WS_MIX2 : WS_MIX1)); (void)MIX; \
    bf16* XN = (bf16*)(ws + (L ? WS_X3B : WS_X1B)); (void)XN;            \
    bf16* HB = (bf16*)(ws + (L ? WS_H1 : WS_H0)); (void)HB; \
    bf16* Y2 = (bf16*)(ws + (L ? WS_Y21 : WS_Y20)); (void)Y2; \
    gu32* gcnt = (gu32*)(ws + WS_CTL) + CW_CNT + 64 * L; (void)gcnt; \
    LAS int* tokL = (LAS int*)(F.lds + TOKL_OFF); (void)tokL; \
    LAS int* mo = (LAS int*)(F.lds + MOE_OFF); (void)mo;

    if (IN(pb)) { PH_LOCALS LAYER_LOCALS
        const float* lg = args.in[19] + L * D; const float* lb = args.in[20] + L * D;
        const float* rw = args.in[14]; const float* rbias = args.in[15];
        constexpr int AST = 2064;
        LAS unsigned char* AH = F.lds; LAS unsigned char* AL = F.lds + 16 * AST;
        LAS float* PART = (LAS float*)(F.lds + 66048);
        LAS float* LG = (LAS float*)(F.lds + 74240);
        LAS int* lcnt = (LAS int*)(F.lds + 75264);
        LAS int* rec = (LAS int*)(F.lds + 75264 + 256);
        const int r16 = lane & 15, q4 = lane >> 4;
        bf16x8 wh[4], wl[4];
#pragma unroll
        for (int ks = 0; ks < 4; ++ks) { unsigned hh_[4], ll_[4];
#pragma unroll
            for (int jp = 0; jp < 4; ++jp) { const float w0 = rw[(128 * wave + 32 * ks + 8 * q4 + 2 * jp) * NE + r16], w1 = rw[(128 * wave + 32 * ks + 8 * q4 + 2 * jp + 1) * NE + r16];
                const unsigned h0 = f2bf(w0), h1 = f2bf(w1); hh_[jp] = h0 | (h1 << 16); ll_[jp] = pk2(w0 - bf2f((unsigned short)h0), w1 - bf2f((unsigned short)h1)); }
            wh[ks] = __builtin_bit_cast(bf16x8, (u32x4){hh_[0], hh_[1], hh_[2], hh_[3]}); wl[ks] = __builtin_bit_cast(bf16x8, (u32x4){ll_[0], ll_[1], ll_[2], ll_[3]}); }
        if (tid < 32) lcnt[tid] = 0;
        __syncthreads();
        f32x4 nx[2][4]; u32x2 nm[2][4];
#define RT_LOAD(tile_) do { _Pragma("unroll") for (int u = 0; u < 2; ++u) { const size_t mm = (size_t)(tile_) * 16 + 2 * wave + u; _Pragma("unroll") for (int j = 0; j < 4; ++j) { nm[u][j] = *(const u32x2*)(MIX + mm * D + 4 * lane + 256 * j); \
            if (L == 0) nx[u][j] = *(const f32x4*)(x_in + mm * D + 4 * lane + 256 * j); \
            else { const u32x2 t_ = *(const u32x2*)((const bf16*)(ws + WS_X2B) + mm * D + 4 * lane + 256 * j); nx[u][j] = (f32x4){bflo(t_.x), bfhi(t_.x), bflo(t_.y), bfhi(t_.y)}; } } } } while (0)
        if (F.vcu < T / 16) RT_LOAD(F.vcu);
        int ti_ = 0;
        for (int tile = F.vcu; tile < T / 16; tile += F.G, ++ti_) {
            f32x4 v[2][4];
#pragma unroll
            for (int u = 0; u < 2; ++u)
#pragma unroll
                for (int j = 0; j < 4; ++j) v[u][j] = nx[u][j] * ALPHA + (f32x4){bflo(nm[u][j].x), bfhi(nm[u][j].x), bflo(nm[u][j].y), bfhi(nm[u][j].y)};
            if (tile + F.G < T / 16) RT_LOAD(tile + F.G);
#pragma unroll
            for (int u = 0; u < 2; ++u) { const size_t m = (size_t)tile * 16 + 2 * wave + u;
                ln_row(v[u], lg, lb, lane);
#pragma unroll
                for (int j = 0; j < 4; ++j) { const f32x4 x = v[u][j]; const unsigned h0 = f2bf(x.x), h1 = f2bf(x.y), h2 = f2bf(x.z), h3 = f2bf(x.w);
                    u32x2 hw; hw.x = h0 | (h1 << 16); hw.y = h2 | (h3 << 16);
                    u32x2 lw; lw.x = pk2(x.x - bf2f((unsigned short)h0), x.y - bf2f((unsigned short)h1)); lw.y = pk2(x.z - bf2f((unsigned short)h2), x.w - bf2f((unsigned short)h3));
                    *(u32x2*)(XN + m * D + 4 * lane + 256 * j) = hw;
                    *(LAS u32x2*)(AH + (2 * wave + u) * AST + (256 * j + 4 * lane) * 2) = hw; *(LAS u32x2*)(AL + (2 * wave + u) * AST + (256 * j + 4 * lane) * 2) = lw; } }
            WG_BAR();
            { f32x4 acc = {0.f, 0.f, 0.f, 0.f};
#pragma unroll
              for (int ks = 0; ks < 4; ++ks) { const bf16x8 ah = *(const LAS bf16x8*)(AH + r16 * AST + (128 * wave + 32 * ks + 8 * q4) * 2), al = *(const LAS bf16x8*)(AL + r16 * AST + (128 * wave + 32 * ks + 8 * q4) * 2);
                  acc = __builtin_amdgcn_mfma_f32_16x16x32_bf16(ah, wh[ks], acc, 0, 0, 0); acc = __builtin_amdgcn_mfma_f32_16x16x32_bf16(ah, wl[ks], acc, 0, 0, 0); acc = __builtin_amdgcn_mfma_f32_16x16x32_bf16(al, wh[ks], acc, 0, 0, 0); }
#pragma unroll
              for (int r = 0; r < 4; ++r) PART[wave * 256 + (4 * q4 + r) * 16 + r16] = acc[r]; }
            WG_BAR();
            if (tid < 256) { float s_ = 0.f;
#pragma unroll
                for (int w = 0; w < 8; ++w) s_ += PART[w * 256 + tid];
                LG[tid] = s_; }
            WG_BAR();
            if (tid < 16) {
                float lgt[NE];
#pragma unroll
                for (int e4 = 0; e4 < 4; ++e4) { const f32x4 t_ = *(const LAS f32x4*)(LG + tid * 16 + 4 * e4); lgt[4 * e4] = t_.x; lgt[4 * e4 + 1] = t_.y; lgt[4 * e4 + 2] = t_.z; lgt[4 * e4 + 3] = t_.w; }
                float mxl = lgt[0];
#pragma unroll
                for (int e = 1; e < NE; ++e) mxl = fmaxf(mxl, lgt[e]);
                float sc[NE], sel[NE], den = 0.f;
#pragma unroll
                for (int e = 0; e < NE; ++e) { sc[e] = __expf(lgt[e] - mxl); den += sc[e]; }
                const float iden = 1.f / den;
#pragma unroll
                for (int e = 0; e < NE; ++e) { sc[e] *= iden; sel[e] = sc[e] + rbias[e]; }
                int bg = 0; float bgs = -1e30f;
#pragma unroll
                for (int g = 0; g < 4; ++g) { const float a = sel[4 * g], b2 = sel[4 * g + 1], c2 = sel[4 * g + 2], d2 = sel[4 * g + 3];
                    const float hi1 = fmaxf(fmaxf(a, b2), fmaxf(c2, d2));
                    const float m01 = fminf(a, b2), m23 = fminf(c2, d2), M01 = fmaxf(a, b2), M23 = fmaxf(c2, d2);
                    const float second = fmaxf(fminf(M01, M23), fmaxf(m01, m23));
                    const float gs = hi1 + second;
                    if (gs > bgs) { bgs = gs; bg = g; } }
                float s0 = 0.f, s1 = 0.f, s2 = 0.f, s3 = 0.f, p0 = 0.f, p1 = 0.f, p2 = 0.f, p3 = 0.f;
#pragma unroll
                for (int g = 0; g < 4; ++g) if (g == bg) { s0 = sel[4 * g]; s1 = sel[4 * g + 1]; s2 = sel[4 * g + 2]; s3 = sel[4 * g + 3]; p0 = sc[4 * g]; p1 = sc[4 * g + 1]; p2 = sc[4 * g + 2]; p3 = sc[4 * g + 3]; }
                int i1 = 0; float b1 = s0, q1 = p0;
                if (s1 > b1) { b1 = s1; i1 = 1; q1 = p1; } if (s2 > b1) { b1 = s2; i1 = 2; q1 = p2; } if (s3 > b1) { b1 = s3; i1 = 3; q1 = p3; }
                int i2 = -1; float b2v = -1e30f, q2 = 0.f;
                if (i1 != 0 && s0 > b2v) { b2v = s0; i2 = 0; q2 = p0; } if (i1 != 1 && s1 > b2v) { b2v = s1; i2 = 1; q2 = p1; }
                if (i1 != 2 && s2 > b2v) { b2v = s2; i2 = 2; q2 = p2; } if (i1 != 3 && s3 > b2v) { b2v = s3; i2 = 3; q2 = p3; }
                const int e1 = 4 * bg + i1, e2 = 4 * bg + i2; const float gsum = q1 + q2, g1 = q1 / gsum, g2 = q2 / gsum;
                const int r1 = atomicAdd((int*)(lcnt + e1), 1), r2 = atomicAdd((int*)(lcnt + e2), 1);
                LAS int* rc = rec + ((ti_ & 31) * 16 + tid) * 8; rc[0] = e1; rc[1] = r1; rc[2] = e2; rc[3] = r2; rc[4] = __builtin_bit_cast(int, g1); rc[5] = __builtin_bit_cast(int, g2);
            }
        }
#undef RT_LOAD
        __syncthreads();
        if (tid < NE) lcnt[16 + tid] = (int)__hip_atomic_fetch_add(gcnt + tid, (unsigned)lcnt[tid], RLX_AGENT);
        __syncthreads();
        for (int lt = tid; lt < ti_ * 16; lt += 512) {
            const int m = 16 * (F.vcu + (lt >> 4) * F.G) + (lt & 15);
            const LAS int* rc = rec + lt * 8;
            const int e1 = rc[0], e2 = rc[2], sl1 = lcnt[16 + e1] + rc[1], sl2 = lcnt[16 + e2] + rc[3];
            LIST[(size_t)e1 * T + sl1] = m; LIST[(size_t)e2 * T + sl2] = m;
            u32x4 w0; w0.x = (unsigned)e1; w0.y = (unsigned)sl1; w0.z = (unsigned)e2; w0.w = (unsigned)sl2;
            *(u32x4*)(INFO + (size_t)m * 8) = w0; INFO[(size_t)m * 8 + 4] = (unsigned)rc[4]; INFO[(size_t)m * 8 + 5] = (unsigned)rc[5];
        }
    }
    SEAM(pb);

    if (IN(pb + 1) || IN(pb + 2) || IN(pb + 3)) { PH_LOCALS LAYER_LOCALS
        __syncthreads();
        if (tid == 0) { int acc_ = 0; for (int e = 0; e < NE; ++e) { const int c = (int)__hip_atomic_load(gcnt + e, RLX_AGENT); mo[e] = acc_; mo[32 + e] = c; acc_ += (c + 255) >> 8; } mo[16] = acc_; }
        __syncthreads();
    }
    if (IN(pb + 1)) { PH_LOCALS LAYER_LOCALS
        pg8::MoeOrder<true> S{mo, tokL, F.G, F.vcu, D};
        { pg8::Unit u; for (int ui = 0; ui < 6 && S.next(ui, u); ++ui) { if (tid < 256) { const int r = (u.pm - mo[u.e]) * 256 + tid, c = mo[32 + u.e]; tokL[ui * 256 + tid] = LIST[(size_t)u.e * T + (r < c ? r : c - 1)]; } } }
        __syncthreads();
        pg8::EpiGateUp E{HB};
        pg8::gemm_phase<pg8::EpiGateUp, pg8::MoeOrder<true>>(F.lds, XN, (const bf16*)(ws + (L ? WS_WGU1 : WS_WGU0)), D, S, E);
    }
    SEAM(pb + 1);
    if (IN(pb + 2)) { PH_LOCALS LAYER_LOCALS
        pg8::MoeOrder<false> S{mo, tokL, F.G, F.vcu, DFF};
        pg8::EpiPlain E{Y2, D, nullptr, 0, 1.f};
        pg8::gemm_phase<pg8::EpiPlain, pg8::MoeOrder<false>>(F.lds, HB, (const bf16*)(ws + (L ? WS_WD1 : WS_WD0)), DFF, S, E);
    }
    SEAM(pb + 2);
    if (IN(pb + 3)) { PH_LOCALS LAYER_LOCALS
        const float* lg = args.in[21] + L * D; const float* lb = args.in[22] + L * D;
        for (int m = gw; m < T; m += NGW) {
            const u32x4 w0 = *(const u32x4*)(INFO + (size_t)m * 8); const float g1 = __builtin_bit_cast(float, INFO[(size_t)m * 8 + 4]), g2 = __builtin_bit_cast(float, INFO[(size_t)m * 8 + 5]);
            const size_t r1 = (size_t)mo[w0.x] * 256 + w0.y, r2 = (size_t)mo[w0.z] * 256 + w0.w;
            f32x4 v[4];
#pragma unroll
            for (int j = 0; j < 4; ++j) { const int co = 4 * lane + 256 * j;
                v[j] = ld_bf16x4(XN + (size_t)m * D + co) * ALPHA + ld_bf16x4(Y2 + r1 * D + co) * g1 + ld_bf16x4(Y2 + r2 * D + co) * g2; }
            ln_row(v, lg, lb, lane);
            if (L == 0) {
#pragma unroll
                for (int j = 0; j < 4; ++j) st_bf16x4((bf16*)(ws + WS_X2B) + (size_t)m * D + 4 * lane + 256 * j, v[j]);
            } else {
#pragma unroll
                for (int j = 0; j < 4; ++j) *(f32x4*)(args.out + (size_t)m * D + 4 * lane + 256 * j) = v[j];
            }
        }
    }
}

__global__ void __launch_bounds__(512, 2) fwd_kernel(Args args) {
    extern __shared__ __attribute__((aligned(16))) unsigned char lds_raw[];
    Frame F;
    F.lds = (LAS unsigned char*)lds_raw;
    F.tid = threadIdx.x; F.lane = F.tid & 63; F.wave = __builtin_amdgcn_readfirstlane(F.tid >> 6);
    F.G = gridDim.x; { const int bx = blockIdx.x; F.vcu = (F.G % 8 == 0) ? (bx % 8) * (F.G / 8) + bx / 8 : bx; }
    unsigned char* ws = args.ws;
    gu32* ctl = (gu32*)(ws + WS_CTL);
    volatile LAS unsigned* MISC = (volatile LAS unsigned*)(F.lds + MISC_OFF);
    for (int u = F.tid; u < (LDS_BYTES - LDSCTL_OFF) / 4; u += 512) ((LAS unsigned*)(F.lds + LDSCTL_OFF))[u] = 0u;
    __syncthreads();
    XcdBarrier bar; bar.bar = (unsigned*)(ctl + CW_BAR); bar.x = 0; bar.st = nullptr;
    if (MK_N_LAUNCHES == 1) bar = xcd_barrier_post((unsigned*)(ctl + CW_BAR), MISC + 8);
    const int lo = args.ph_lo, hi = args.ph_hi;
    if (IN(0)) { PH_LOCALS
        LAS float* scr = (LAS float*)(F.lds + wave * 16384);
        constexpr int I_IN = (D / 64) * (INP / 32), I_OUT = (DI / 64) * (D / 32);
        for (int it = gw; it < I_IN + I_OUT; it += NGW) {
            if (it < I_IN) transpose_item(args.in[1], D, INP, Wt_in, 0, 0, nullptr, scr, it, lane);
            else transpose_item(args.in[8], DI, D, Wt_out, 0, 0, args.in[7], scr, it - I_IN, lane);
        }
        const size_t n8 = (size_t)T * D / 8, stride = (size_t)F.G * 512; size_t i = (size_t)blockIdx.x * 512 + tid;
        for (; i + 3 * stride < n8; i += 4 * stride) {
            f32x4 a[4], b[4];
#pragma unroll
            for (int u = 0; u < 4; ++u) { a[u] = *(const f32x4*)(x_in + (i + u * stride) * 8); b[u] = *(const f32x4*)(x_in + (i + u * stride) * 8 + 4); }
#pragma unroll
            for (int u = 0; u < 4; ++u) { u32x4 o; o.x = pk2(a[u].x, a[u].y); o.y = pk2(a[u].z, a[u].w); o.z = pk2(b[u].x, b[u].y); o.w = pk2(b[u].z, b[u].w); *(u32x4*)(XB + (i + u * stride) * 8) = o; }
        }
        for (; i < n8; i += stride) { const f32x4 a = *(const f32x4*)(x_in + i * 8), b = *(const f32x4*)(x_in + i * 8 + 4);
            u32x4 o; o.x = pk2(a.x, a.y); o.y = pk2(a.z, a.w); o.z = pk2(b.x, b.y); o.w = pk2(b.z, b.w); *(u32x4*)(XB + i * 8) = o; }
    }
    SEAM(0);

    if (IN(1)) { PH_LOCALS
        pg8::DenseOrder S; S.init(T, NZX, F.G, (int)blockIdx.x, D);
        pg8::EpiInProj E{Zb, XBC};
        pg8::gemm_phase<pg8::EpiInProj, pg8::DenseOrder>(F.lds, XB, Wt_in, D, S, E);
        for (int tile = gw; tile < T / 16; tile += NGW) {
            const int t0 = tile * 16, r = lane & 15, q = lane >> 4;
            const bf16* xp = XB + (size_t)(t0 + r) * D + 8 * q;
            const bf16* w0 = Wt_in + (size_t)(NZX + r) * D + 8 * q; const bf16* w1 = w0 + (size_t)16 * D;
            f32x4 a0 = {0.f, 0.f, 0.f, 0.f}, a1 = {0.f, 0.f, 0.f, 0.f};
#pragma unroll 4
            for (int k0 = 0; k0 < D; k0 += 32) {
                const bf16x8 xv = *(const bf16x8*)(xp + k0), wa = *(const bf16x8*)(w0 + k0), wb = *(const bf16x8*)(w1 + k0);
                a0 = __builtin_amdgcn_mfma_f32_16x16x32_bf16(wa, xv, a0, 0, 0, 0);
                a1 = __builtin_amdgcn_mfma_f32_16x16x32_bf16(wb, xv, a1, 0, 0, 0);
            }
            float* o = DTRAW + (size_t)(t0 + r) * NH + 4 * q;
            *(f32x4*)o = a0; *(f32x4*)(o + 16) = a1;
        }
    }
    SEAM(1);

    if (IN(2)) { PH_LOCALS
        const float* conv_w = args.in[2]; const float* conv_b = args.in[3];
        bf16* BCACT = (bf16*)(ws + WS_BCACT);
        for (int it = blockIdx.x * 512 + tid; it < (T / 8) * 128; it += F.G * 512) {
            const int ch = it & 127, seg = it >> 7, r0 = seg * 8, s0 = r0 & (SEQ - 1), col = DI + 8 * ch;
            u32x4 rw[11];
#pragma unroll
            for (int q = 0; q < 11; ++q) { const int sr = s0 - 3 + q; const int rc = sr < 0 ? 0 : sr; rw[q] = *(const u32x4*)(XBC + (size_t)(r0 - s0 + rc) * CONVD + col); }
#pragma unroll
            for (int q = 0; q < 3; ++q) if (s0 - 3 + q < 0) rw[q] = (u32x4){0u, 0u, 0u, 0u};
#pragma unroll
            for (int hf = 0; hf < 2; ++hf) {
                f32x4 wq[5];
#pragma unroll
                for (int k = 0; k < 4; ++k) wq[k] = *(const f32x4*)(conv_w + k * CONVD + col + 4 * hf);
                wq[4] = *(const f32x4*)(conv_b + col + 4 * hf);
#pragma unroll
                for (int jj = 0; jj < 8; ++jj) { f32x4 aq = wq[4];
#pragma unroll
                    for (int k = 0; k < 4; ++k) { const u32x4 rq = rw[jj + k]; const unsigned a0 = hf ? rq.z : rq.x, a1 = hf ? rq.w : rq.y; aq += wq[k] * (f32x4){bflo(a0), bfhi(a0), bflo(a1), bfhi(a1)}; }
#pragma unroll
                    for (int e = 0; e < 4; ++e) aq[e] = silu_f(aq[e]);
                    u32x2 o_; o_.x = pk2(aq[0], aq[1]); o_.y = pk2(aq[2], aq[3]);
                    *(u32x2*)(BCACT + (size_t)(r0 + jj) * 1024 + 8 * ch + 4 * hf) = o_; }
            }
        }
    }
    SEAM(2);

    if (IN(3)) { PH_LOCALS
#if NAIVE_SCAN
        const float* conv_w = args.in[2]; const float* conv_b = args.in[3]; const float* dt_bias = args.in[4]; const float* a_log = args.in[5]; const float* dsk = args.in[6];
        for (int item = blockIdx.x; item < NB * NH; item += F.G) {
            if (wave >= 2) continue;
            LAS float* sB = (LAS float*)(F.lds + wave * 8192); LAS float* sC = sB + 128; LAS float* cwl = sC + 128;
            const int b = item / NH, h = item % NH, g = h / 8, pp = 32 * wave + (lane & 31), nh = lane >> 5;
            int col[5]; col[0] = h * HP + pp; col[1] = DI + g * NS + lane; col[2] = col[1] + 64; col[3] = DI + NG * NS + g * NS + lane; col[4] = col[3] + 64;
            float hist[5][3];
#pragma unroll
            for (int c = 0; c < 5; ++c) { cwl[(c * 5 + 4) * 64 + lane] = conv_b[col[c]];
#pragma unroll
                for (int k = 0; k < 4; ++k) cwl[(c * 5 + k) * 64 + lane] = conv_w[k * CONVD + col[c]];
#pragma unroll
                for (int k = 0; k < 3; ++k) hist[c][k] = 0.f; }
            LDS_WAIT();
            const float dtb = dt_bias[h], av = -__expf(a_log[h]), dh = dsk[h];
            float hst[64];
#pragma unroll
            for (int n = 0; n < 64; ++n) hst[n] = 0.f;
            for (int t = 0; t < SEQ; ++t) {
                const size_t row = (size_t)b * SEQ + t;
                float v[5];
#pragma unroll
                for (int c = 0; c < 5; ++c) { const float cur = bf2f(XBC[row * CONVD + col[c]]);
                    float a = cwl[(c * 5 + 4) * 64 + lane] + cwl[(c * 5) * 64 + lane] * hist[c][0] + cwl[(c * 5 + 1) * 64 + lane] * hist[c][1] + cwl[(c * 5 + 2) * 64 + lane] * hist[c][2] + cwl[(c * 5 + 3) * 64 + lane] * cur;
                    hist[c][0] = hist[c][1]; hist[c][1] = hist[c][2]; hist[c][2] = cur; v[c] = silu_f(a); }
                const float raw = DTRAW[row * NH + h] + dtb;
                const float dtv = raw > 20.f ? raw : log1pf(__expf(raw));
                const float dA = __expf(dtv * av);
                sB[lane] = v[1]; sB[lane + 64] = v[2]; sC[lane] = v[3]; sC[lane + 64] = v[4];
                LDS_WAIT(); asm volatile("" ::: "memory");
                const float xd = dtv * v[0]; float y = 0.f;
#pragma unroll
                for (int n = 0; n < 64; n += 4) { const f32x4 bb = *(const LAS f32x4*)(sB + 64 * nh + n), cc = *(const LAS f32x4*)(sC + 64 * nh + n);
                    hst[n] = hst[n] * dA + xd * bb.x; y += cc.x * hst[n];
                    hst[n + 1] = hst[n + 1] * dA + xd * bb.y; y += cc.y * hst[n + 1];
                    hst[n + 2] = hst[n + 2] * dA + xd * bb.z; y += cc.z * hst[n + 2];
                    hst[n + 3] = hst[n + 3] * dA + xd * bb.w; y += cc.w * hst[n + 3]; }
                LDS_WAIT(); asm volatile("" ::: "memory");
                y += __shfl_xor(y, 32);
                y += dh * v[0];
                const float zv = bf2f(Zb[row * DI + h * HP + pp]);
                const float yg = y * silu_f(zv);
                float sq = (lane < 32) ? yg * yg : 0.f; sq = wave_sum(sq);
                if (lane < 32) Zb[row * DI + h * HP + pp] = (bf16)f2bf(yg);
                if (lane == 0) SSQ[row * 64 + h * 2 + wave] = sq;
            }
        }
#else
        const float* conv_w = args.in[2]; const float* conv_b = args.in[3]; const float* dt_bias = args.in[4]; const float* a_log = args.in[5]; const float* dsk = args.in[6];
        typedef short v4i16 __attribute__((ext_vector_type(4)));
        constexpr int SXB = 144, SBB = 272;
        constexpr int XS_OFF = 0, XW_OFF = 9216, BM_OFF = 18432, CM_OFF = 35840, WM_OFF = 53248, HB_OFF = 62464, VEC_OFF = 97280, CW_OFF = 98304;
        LAS unsigned char* Lb = F.lds;
        LAS float* cumL = (LAS float*)(Lb + VEC_OFF);
        LAS float* dtL = cumL + 128;
        LAS float* cwl = (LAS float*)(Lb + CW_OFF);
        const int r16 = lane & 15, q4 = lane >> 4;
#define TR8(dst, base_off, stride, k0, c0) do { const LAS unsigned char* _a = Lb + (base_off) + ((k0) + 8 * q4 + (r16 >> 2)) * (stride) + ((c0) + 4 * (lane & 3)) * 2; \
        const v4i16 _lo = __builtin_amdgcn_ds_read_tr16_b64_v4i16((LAS v4i16*)_a), _hi = __builtin_amdgcn_ds_read_tr16_b64_v4i16((LAS v4i16*)(_a + 4 * (stride))); \
        dst = (bf16x8){_lo[0], _lo[1], _lo[2], _lo[3], _hi[0], _hi[1], _hi[2], _hi[3]}; } while (0)
        if (blockIdx.x < NB * NH) {
            const int item = blockIdx.x; const int b = item / NH, h = item % NH, g = h >> 3;
            __syncthreads();
            for (int i = tid; i < 5 * 64; i += 512) { const int k = i >> 6, cl = i & 63; cwl[i] = k < 4 ? conv_w[k * CONVD + h * HP + cl] : conv_b[h * HP + cl]; }
            for (int i = tid; i < SBB * 64 / 4; i += 512) ((LAS unsigned*)(Lb + HB_OFF))[i] = 0u;
            const float dtb = dt_bias[h], av = -__expf(a_log[h]), dh = dsk[h];
            const int sj = tid >> 3, sxc = tid & 7;
            const bf16* BCACT = (const bf16*)(ws + WS_BCACT);
            const size_t row0 = (size_t)b * SEQ;
            f32x4 hacc[4];
#pragma unroll
            for (int i = 0; i < 4; ++i) hacc[i] = (f32x4){0.f, 0.f, 0.f, 0.f};
            u32x4 xrA[4], brA[2], crA[2], xrB[4], brB[2], crB[2]; u32x2 zr[2]; float dtr = 0.f;
            const int ti = wave & 3, wh = wave >> 2, irow = 16 * ti + r16;
#define SC_LOAD(c, S) do { _Pragma("unroll") for (int k = 0; k < 4; ++k) { const int rr = (c) * 64 + sj - 3 + k; const int rc = rr < 0 ? 0 : rr; \
                xr##S[k] = *(const u32x4*)(XBC + (row0 + rc) * CONVD + h * HP + 8 * sxc); } \
            _Pragma("unroll") for (int i = 0; i < 2; ++i) { const int idx = tid + 512 * i; const bf16* bp_ = BCACT + (row0 + (c) * 64 + (idx >> 4)) * 1024 + g * NS + 8 * (idx & 15); \
                br##S[i] = *(const u32x4*)bp_; cr##S[i] = *(const u32x4*)(bp_ + 512); } } while (0)
#define SC_LOADZ(c, S) do { _Pragma("unroll") for (int tt = 0; tt < 2; ++tt) zr[tt] = *(const u32x2*)(Zb + (row0 + (c) * 64 + irow) * DI + h * HP + 16 * (2 * wh + tt) + 4 * q4); } while (0)
#define SC_CUMDT(c) do { if (wave == 7) { const float rw_ = dtr + dtb; const float dtv = rw_ > 15.f ? rw_ : __logf(1.f + __expf(rw_)); float xx = dtv * av; \
                _Pragma("unroll") for (int o = 1; o < 64; o <<= 1) { const float vv = __shfl_up(xx, o); if (lane >= o) xx += vv; } \
                cumL[((c) & 1) * 64 + lane] = xx; dtL[((c) & 1) * 64 + lane] = dtv; } } while (0)
#define SC_STAGE(c, S) do { const int pr_ = ((c) & 1) * 64; const float wj = __expf(cumL[pr_ + 63] - cumL[pr_ + sj]) * dtL[pr_ + sj]; \
                _Pragma("unroll") for (int k = 0; k < 3; ++k) if ((c) * 64 + sj - 3 + k < 0) xr##S[k] = (u32x4){0u, 0u, 0u, 0u};     \
                _Pragma("unroll") for (int hf = 0; hf < 2; ++hf) { f32x4 aq = *(const LAS f32x4*)(cwl + 4 * 64 + 8 * sxc + 4 * hf); \
                    _Pragma("unroll") for (int k = 0; k < 4; ++k) { const f32x4 wq = *(const LAS f32x4*)(cwl + k * 64 + 8 * sxc + 4 * hf); const unsigned r0_ = hf ? xr##S[k].z : xr##S[k].x, r1_ = hf ? xr##S[k].w : xr##S[k].y; \
                        aq += wq * (f32x4){bflo(r0_), bfhi(r0_), bflo(r1_), bfhi(r1_)}; } \
                    _Pragma("unroll") for (int e = 0; e < 4; ++e) aq[e] = silu_f(aq[e]); \
                    u32x2 o_; o_.x = pk2(aq[0], aq[1]); o_.y = pk2(aq[2], aq[3]); \
                    *(LAS u32x2*)(Lb + XS_OFF + sj * SXB + 16 * sxc + 8 * hf) = o_; \
                    o_.x = pk2(aq[0] * wj, aq[1] * wj); o_.y = pk2(aq[2] * wj, aq[3] * wj); \
                    *(LAS u32x2*)(Lb + XW_OFF + sj * SXB + 16 * sxc + 8 * hf) = o_; } \
                _Pragma("unroll") for (int i = 0; i < 2; ++i) { const int idx = tid + 512 * i; \
                    *(LAS u32x4*)(Lb + BM_OFF + (idx >> 4) * SBB + 16 * (idx & 15)) = br##S[i]; *(LAS u32x4*)(Lb + CM_OFF + (idx >> 4) * SBB + 16 * (idx & 15)) = cr##S[i]; } } while (0)
            if (wave == 7) dtr = DTRAW[(row0 + lane) * NH + h];
            SC_LOAD(0, A); SC_LOADZ(0, A); SC_CUMDT(0);
            if (wave == 7) dtr = DTRAW[(row0 + 64 + lane) * NH + h];
            __syncthreads();
            SC_STAGE(0, A);
            SC_LOAD(1, B);
            __syncthreads();
            for (int c2 = 0; c2 < SEQ / 64; c2 += 2) {
                { const int c = c2;
                const int pr = (c & 1) * 64; const int hb_cur = HB_OFF + (c & 1) * (SBB * 64), hb_nxt = HB_OFF + ((c & 1) ^ 1) * (SBB * 64);
                if (c + 1 < SEQ / 64) { SC_CUMDT(c + 1); if (wave == 7 && c + 2 < SEQ / 64) dtr = DTRAW[(row0 + (c + 2) * 64 + lane) * NH + h]; }
                if (c + 2 < SEQ / 64) SC_LOAD(c + 2, A);
                bf16x8 cf[4];
#pragma unroll
                for (int ks = 0; ks < 4; ++ks) cf[ks] = *(const LAS bf16x8*)(Lb + CM_OFF + irow * SBB + (32 * ks + 8 * q4) * 2);
                const float ci = cumL[pr + irow];
#pragma unroll
                for (int tt = 0; tt < 2; ++tt) { const int tj = 2 * wh + tt; f32x4 ga = {0.f, 0.f, 0.f, 0.f};
#pragma unroll
                    for (int ks = 0; ks < 4; ++ks) { const bf16x8 bfr = *(const LAS bf16x8*)(Lb + BM_OFF + (16 * tj + r16) * SBB + (32 * ks + 8 * q4) * 2); ga = __builtin_amdgcn_mfma_f32_16x16x32_bf16(bfr, cf[ks], ga, 0, 0, 0); }
                    const int j0 = 16 * tj + 4 * q4; const f32x4 cj = *(const LAS f32x4*)(cumL + pr + j0), dj = *(const LAS f32x4*)(dtL + pr + j0);
                    float wv[4];
#pragma unroll
                    for (int r = 0; r < 4; ++r) { const int j = j0 + r; float v = ga[r] * __expf(ci - cj[r]) * dj[r]; v = (j <= irow) ? v : 0.f; if (j == irow) v += dh; wv[r] = v; }
                    u32x2 w_; w_.x = pk2(wv[0], wv[1]); w_.y = pk2(wv[2], wv[3]);
                    *(LAS u32x2*)(Lb + WM_OFF + irow * SXB + j0 * 2) = w_; }
                WG_BAR();
                { bf16x8 wf[2];
#pragma unroll
                  for (int ks = 0; ks < 2; ++ks) wf[ks] = *(const LAS bf16x8*)(Lb + WM_OFF + irow * SXB + (32 * ks + 8 * q4) * 2);
                  const float ec = __expf(ci); float ssq = 0.f;
#pragma unroll
                  for (int tt = 0; tt < 2; ++tt) { const int tp = 2 * wh + tt; f32x4 yd = {0.f, 0.f, 0.f, 0.f}, yo = {0.f, 0.f, 0.f, 0.f};
#pragma unroll
                      for (int ks = 0; ks < 2; ++ks) { bf16x8 xa; TR8(xa, XS_OFF, SXB, 32 * ks, 16 * tp); yd = __builtin_amdgcn_mfma_f32_16x16x32_bf16(xa, wf[ks], yd, 0, 0, 0); }
#pragma unroll
                      for (int ks = 0; ks < 4; ++ks) { const bf16x8 ha = *(const LAS bf16x8*)(Lb + hb_cur + (16 * tp + r16) * SBB + (32 * ks + 8 * q4) * 2); yo = __builtin_amdgcn_mfma_f32_16x16x32_bf16(ha, cf[ks], yo, 0, 0, 0); }
                      const float z0 = bflo(zr[tt].x), z1 = bfhi(zr[tt].x), z2 = bflo(zr[tt].y), z3 = bfhi(zr[tt].y);
                      const float y0 = (yd[0] + ec * yo[0]) * silu_f(z0), y1 = (yd[1] + ec * yo[1]) * silu_f(z1), y2 = (yd[2] + ec * yo[2]) * silu_f(z2), y3 = (yd[3] + ec * yo[3]) * silu_f(z3);
                      ssq += (y0 * y0 + y1 * y1) + (y2 * y2 + y3 * y3);
                      u32x2 o_; o_.x = pk2(y0, y1); o_.y = pk2(y2, y3);
                      *(u32x2*)(Zb + (row0 + c * 64 + irow) * DI + h * HP + 16 * tp + 4 * q4) = o_; }
                  ssq += __shfl_xor(ssq, 16); ssq += __shfl_xor(ssq, 32);
                  if (q4 == 0) SSQ[(row0 + c * 64 + irow) * 64 + h * 2 + wh] = ssq; }
                if (c + 1 < SEQ / 64) SC_LOADZ(c + 1, A);
                { const float eL = __expf(cumL[pr + 63]);
#pragma unroll
                  for (int tp = 0; tp < 4; ++tp) hacc[tp] = hacc[tp] * eL;
#pragma unroll
                  for (int ks = 0; ks < 2; ++ks) { bf16x8 ba; TR8(ba, BM_OFF, SBB, 32 * ks, 16 * wave);
#pragma unroll
                      for (int tp = 0; tp < 4; ++tp) { bf16x8 xb; TR8(xb, XW_OFF, SXB, 32 * ks, 16 * tp); hacc[tp] = __builtin_amdgcn_mfma_f32_16x16x32_bf16(ba, xb, hacc[tp], 0, 0, 0); } }
#pragma unroll
                  for (int tp = 0; tp < 4; ++tp) { u32x2 o_; o_.x = pk2(hacc[tp][0], hacc[tp][1]); o_.y = pk2(hacc[tp][2], hacc[tp][3]);
                      *(LAS u32x2*)(Lb + hb_nxt + (16 * tp + r16) * SBB + (16 * wave + 4 * q4) * 2) = o_; } }
                WG_BAR();
                if (c + 1 < SEQ / 64) SC_STAGE(c + 1, B);
                WG_BAR();
                }
                { const int c = c2 + 1;
                const int pr = (c & 1) * 64; const int hb_cur = HB_OFF + (c & 1) * (SBB * 64), hb_nxt = HB_OFF + ((c & 1) ^ 1) * (SBB * 64);
                if (c + 1 < SEQ / 64) { SC_CUMDT(c + 1); if (wave == 7 && c + 2 < SEQ / 64) dtr = DTRAW[(row0 + (c + 2) * 64 + lane) * NH + h]; }
                if (c + 2 < SEQ / 64) SC_LOAD(c + 2, B);
                bf16x8 cf[4];
#pragma unroll
                for (int ks = 0; ks < 4; ++ks) cf[ks] = *(const LAS bf16x8*)(Lb + CM_OFF + irow * SBB + (32 * ks + 8 * q4) * 2);
                const float ci = cumL[pr + irow];
#pragma unroll
                for (int tt = 0; tt < 2; ++tt) { const int tj = 2 * wh + tt; f32x4 ga = {0.f, 0.f, 0.f, 0.f};
#pragma unroll
                    for (int ks = 0; ks < 4; ++ks) { const bf16x8 bfr = *(const LAS bf16x8*)(Lb + BM_OFF + (16 * tj + r16) * SBB + (32 * ks + 8 * q4) * 2); ga = __builtin_amdgcn_mfma_f32_16x16x32_bf16(bfr, cf[ks], ga, 0, 0, 0); }
                    const int j0 = 16 * tj + 4 * q4; const f32x4 cj = *(const LAS f32x4*)(cumL + pr + j0), dj = *(const LAS f32x4*)(dtL + pr + j0);
                    float wv[4];
#pragma unroll
                    for (int r = 0; r < 4; ++r) { const int j = j0 + r; float v = ga[r] * __expf(ci - cj[r]) * dj[r]; v = (j <= irow) ? v : 0.f; if (j == irow) v += dh; wv[r] = v; }
                    u32x2 w_; w_.x = pk2(wv[0], wv[1]); w_.y = pk2(wv[2], wv[3]);
                    *(LAS u32x2*)(Lb + WM_OFF + irow * SXB + j0 * 2) = w_; }
                WG_BAR();
                { bf16x8 wf[2];
#pragma unroll
                  for (int ks = 0; ks < 2; ++ks) wf[ks] = *(const LAS bf16x8*)(Lb + WM_OFF + irow * SXB + (32 * ks + 8 * q4) * 2);
                  const float ec = __expf(ci); float ssq = 0.f;
#pragma unroll
                  for (int tt = 0; tt < 2; ++tt) { const int tp = 2 * wh + tt; f32x4 yd = {0.f, 0.f, 0.f, 0.f}, yo = {0.f, 0.f, 0.f, 0.f};
#pragma unroll
                      for (int ks = 0; ks < 2; ++ks) { bf16x8 xa; TR8(xa, XS_OFF, SXB, 32 * ks, 16 * tp); yd = __builtin_amdgcn_mfma_f32_16x16x32_bf16(xa, wf[ks], yd, 0, 0, 0); }
#pragma unroll
                      for (int ks = 0; ks < 4; ++ks) { const bf16x8 ha = *(const LAS bf16x8*)(Lb + hb_cur + (16 * tp + r16) * SBB + (32 * ks + 8 * q4) * 2); yo = __builtin_amdgcn_mfma_f32_16x16x32_bf16(ha, cf[ks], yo, 0, 0, 0); }
                      const float z0 = bflo(zr[tt].x), z1 = bfhi(zr[tt].x), z2 = bflo(zr[tt].y), z3 = bfhi(zr[tt].y);
                      const float y0 = (yd[0] + ec * yo[0]) * silu_f(z0), y1 = (yd[1] + ec * yo[1]) * silu_f(z1), y2 = (yd[2] + ec * yo[2]) * silu_f(z2), y3 = (yd[3] + ec * yo[3]) * silu_f(z3);
                      ssq += (y0 * y0 + y1 * y1) + (y2 * y2 + y3 * y3);
                      u32x2 o_; o_.x = pk2(y0, y1); o_.y = pk2(y2, y3);
                      *(u32x2*)(Zb + (row0 + c * 64 + irow) * DI + h * HP + 16 * tp + 4 * q4) = o_; }
                  ssq += __shfl_xor(ssq, 16); ssq += __shfl_xor(ssq, 32);
                  if (q4 == 0) SSQ[(row0 + c * 64 + irow) * 64 + h * 2 + wh] = ssq; }
                if (c + 1 < SEQ / 64) SC_LOADZ(c + 1, B);
                { const float eL = __expf(cumL[pr + 63]);
#pragma unroll
                  for (int tp = 0; tp < 4; ++tp) hacc[tp] = hacc[tp] * eL;
#pragma unroll
                  for (int ks = 0; ks < 2; ++ks) { bf16x8 ba; TR8(ba, BM_OFF, SBB, 32 * ks, 16 * wave);
#pragma unroll
                      for (int tp = 0; tp < 4; ++tp) { bf16x8 xb; TR8(xb, XW_OFF, SXB, 32 * ks, 16 * tp); hacc[tp] = __builtin_amdgcn_mfma_f32_16x16x32_bf16(ba, xb, hacc[tp], 0, 0, 0); } }
#pragma unroll
                  for (int tp = 0; tp < 4; ++tp) { u32x2 o_; o_.x = pk2(hacc[tp][0], hacc[tp][1]); o_.y = pk2(hacc[tp][2], hacc[tp][3]);
                      *(LAS u32x2*)(Lb + hb_nxt + (16 * tp + r16) * SBB + (16 * wave + 4 * q4) * 2) = o_; } }
                WG_BAR();
                if (c + 1 < SEQ / 64) SC_STAGE(c + 1, A);
                WG_BAR();
                }
            }
        }
#undef SC_LOADZ
#undef TR8
#undef SC_LOAD
#undef SC_CUMDT
#undef SC_STAGE
#endif
    }
    SEAM(3);

    if (IN(4)) { PH_LOCALS
        { float pn = 0.f; u32x4 yn[4];
#define NM_LOAD(mm) do { pn = SSQ[(size_t)(mm) * 64 + lane]; _Pragma("unroll") for (int j = 0; j < 4; ++j) yn[j] = *(const u32x4*)(Zb + (size_t)(mm) * DI + j * 512 + lane * 8); } while (0)
          if (gw < T) NM_LOAD(gw);
          for (int m = gw; m < T; m += NGW) {
            float p = pn; u32x4 yw[4];
#pragma unroll
            for (int j = 0; j < 4; ++j) yw[j] = yn[j];
            if (m + NGW < T) NM_LOAD(m + NGW);
            p += dpp_mov<0xB1>(p); p += dpp_mov<0x4E>(p); p += dpp_mov<0x141>(p); p += dpp_mov<0x140>(p);
            bf16* yr = Zb + (size_t)m * DI;
#pragma unroll
            for (int j = 0; j < 4; ++j) { const float ss = __builtin_bit_cast(float, __builtin_amdgcn_readlane(__builtin_bit_cast(int, p), 16 * j)); const float rs = 1.f / sqrtf(ss * (1.f / 512.f) + RMS_EPS);
                u32x4 w = yw[j];
                w.x = pk2(bflo(w.x) * rs, bfhi(w.x) * rs); w.y = pk2(bflo(w.y) * rs, bfhi(w.y) * rs); w.z = pk2(bflo(w.z) * rs, bfhi(w.z) * rs); w.w = pk2(bflo(w.w) * rs, bfhi(w.w) * rs);
                *(u32x4*)(yr + j * 512 + lane * 8) = w; }
          }
#undef NM_LOAD
        }
        LAS float* scr = (LAS float*)(F.lds + wave * 16384);
        constexpr int I_QKV = (D / 64) * (3 * D / 32), I_O = (D / 64) * (D / 32), I_G = (D / 64) * (DFF / 32), I_D = (DFF / 64) * (D / 32);
        constexpr int I_MOE = 2 * NE * (2 * I_G + I_D);
        for (int it = gw; it < I_QKV + I_O + I_MOE; it += NGW) {
            int r = it;
            if (r < I_QKV) { transpose_item(args.in[9], D, 3 * D, (bf16*)(ws + WS_WQKV), 0, 0, nullptr, scr, r, lane); continue; } r -= I_QKV;
            if (r < I_O) { transpose_item(args.in[12], D, D, (bf16*)(ws + WS_WO), 0, 0, nullptr, scr, r, lane); continue; } r -= I_O;
            const int le = r / (2 * I_G + I_D), L = le / NE, e = le % NE; r -= le * (2 * I_G + I_D);
            bf16* wgu = (bf16*)(ws + (L ? WS_WGU1 : WS_WGU0)) + (size_t)e * 1024 * D; bf16* wd = (bf16*)(ws + (L ? WS_WD1 : WS_WD0)) + (size_t)e * D * DFF;
            if (r < I_G) { transpose_item(args.in[16] + (size_t)le * D * DFF, D, DFF, wgu, 0, 1, nullptr, scr, r, lane); continue; } r -= I_G;
            if (r < I_G) { transpose_item(args.in[17] + (size_t)le * D * DFF, D, DFF, wgu, 0, 2, nullptr, scr, r, lane); continue; } r -= I_G;
            transpose_item(args.in[18] + (size_t)le * DFF * D, DFF, D, wd, 0, 0, nullptr, scr, r, lane);
        }
    }
    SEAM(4);

    if (IN(5)) { PH_LOCALS
        pg8::DenseOrder S; S.init(T, D, F.G, (int)blockIdx.x, DI);
        pg8::EpiPlain E{(bf16*)(ws + WS_MIX1), D, nullptr, 0, 1.f};
        pg8::gemm_phase<pg8::EpiPlain, pg8::DenseOrder>(F.lds, Zb, Wt_out, DI, S, E);
    }
    SEAM(5);

    layer_tail<0>(args, F, bar, lo, hi);
    SEAM(9);

    if (IN(10)) { PH_LOCALS
        pg8::DenseOrder S; S.init(T, 3 * D, F.G, (int)blockIdx.x, D);
        pg8::EpiPlain E{(bf16*)(ws + WS_QKV), 3 * D, args.in[10], D, 0.125f};
        pg8::gemm_phase<pg8::EpiPlain, pg8::DenseOrder>(F.lds, (const bf16*)(ws + WS_X2B), (const bf16*)(ws + WS_WQKV), D, S, E);
    }
    SEAM(10);
    if (IN(11)) { PH_LOCALS
#if NAIVE_ATTN
        const bf16* QKV = (const bf16*)(ws + WS_QKV); bf16* AO = (bf16*)(ws + WS_AO); const float* rel = args.in[11];
        for (int idx = blockIdx.x * 512 + tid; idx < NB * AH * SEQ; idx += F.G * 512) {
            const int s = idx % SEQ, bh = idx / SEQ, hh = bh % AH, b = bh / AH, c = s / 64;
            const bf16* qp = QKV + ((size_t)b * SEQ + s) * (3 * D) + hh * AD;
            float q[AD], o[AD];
#pragma unroll
            for (int d = 0; d < AD; ++d) { q[d] = bf2f(qp[d]); o[d] = 0.f; }
            float mx = -1e30f, l = 0.f;
            const int k0 = (c - LEFTC) * 64 < 0 ? 0 : (c - LEFTC) * 64, k1 = c * 64 + 64;
            for (int kp = k0; kp < k1; ++kp) {
                const bf16* kr = QKV + ((size_t)b * SEQ + kp) * (3 * D) + D + hh * AD; const bf16* vr = kr + D;
                float sc = 0.f;
#pragma unroll
                for (int d = 0; d < AD; d += 2) { const unsigned w = *(const unsigned*)(kr + d); sc += q[d] * bflo(w) + q[d + 1] * bfhi(w); }
                int dist = s - kp; dist = dist < -MAXREL ? -MAXREL : (dist > MAXREL ? MAXREL : dist);
                sc += rel[(dist + MAXREL) * AH + hh];
                const float mn = fmaxf(mx, sc), f = __expf(mx - mn), p = __expf(sc - mn);
                l = l * f + p; mx = mn;
#pragma unroll
                for (int d = 0; d < AD; d += 2) { const unsigned w = *(const unsigned*)(vr + d); o[d] = o[d] * f + p * bflo(w); o[d + 1] = o[d + 1] * f + p * bfhi(w); }
            }
            const float il = 1.f / l; bf16* op = AO + ((size_t)b * SEQ + s) * D + hh * AD;
#pragma unroll
            for (int d = 0; d < AD; d += 2) *(unsigned*)(op + d) = pk2(o[d] * il, o[d + 1] * il);
        }
#else
        const bf16* QKV = (const bf16*)(ws + WS_QKV); bf16* AO = (bf16*)(ws + WS_AO); const float* rel = args.in[11];
        typedef short v4i16 __attribute__((ext_vector_type(4)));
        constexpr int SKB = 144, KB_OFF = 0, VB_OFF = 18432, TB_OFF = 36864; constexpr float LOG2E = 1.4426950408889634f;
        LAS unsigned char* Lb = F.lds; LAS float* tb = (LAS float*)(Lb + TB_OFF);
        const int r16 = lane & 15, q4 = lane >> 4, wq = wave >> 2;
        const int NU = NB * AH * (SEQ / 128), per = (NU + F.G - 1) / F.G;
        int hprev = -1;
        for (int ui = 0; ui < per; ++ui) {
            const int u = F.vcu * per + ui; if (u >= NU) break;
            const int bh = u >> 5, cp = u & 31, b = bh >> 4, hh = bh & 15, c0 = 2 * cp;
            __syncthreads();
            if (hh != hprev) { for (int i = tid; i < 2 * MAXREL + 1; i += 512) tb[i] = rel[i * AH + hh] * LOG2E; hprev = hh; }
            const int cw = c0 + wq, qrow = 64 * cw + 16 * (wave & 3) + r16;
            const size_t tok0 = (size_t)b * SEQ;
            bf16x8 qf[2];
#pragma unroll
            for (int ds = 0; ds < 2; ++ds) qf[ds] = *(const bf16x8*)(QKV + (tok0 + qrow) * (3 * D) + hh * AD + 32 * ds + 8 * q4);
            f32x4 oacc[4];
#pragma unroll
            for (int i = 0; i < 4; ++i) oacc[i] = (f32x4){0.f, 0.f, 0.f, 0.f};
            float mrun = -1e30f, lrun = 0.f;
            const int kt_lo = c0 < 8 ? 8 - c0 : 0;
            const int kr = tid >> 3, pc = tid & 7;
            const bf16* kvp = QKV + (tok0 + kr) * (3 * D) + D + hh * AD + 8 * pc;
            u32x4 kreg, vreg;
            { const size_t co = (size_t)(c0 - 8 + kt_lo) * 64 * (3 * D); kreg = *(const u32x4*)(kvp + co); vreg = *(const u32x4*)(kvp + co + D); }
            *(LAS u32x4*)(Lb + KB_OFF + (kt_lo & 1) * 9216 + kr * SKB + pc * 16) = kreg; *(LAS u32x4*)(Lb + VB_OFF + (kt_lo & 1) * 9216 + kr * SKB + pc * 16) = vreg;
            __syncthreads();
            for (int kt = kt_lo; kt < 10; ++kt) {
                const int chunk = c0 - 8 + kt;
                if (kt + 1 < 10) { const size_t co = (size_t)(chunk + 1) * 64 * (3 * D); kreg = *(const u32x4*)(kvp + co); vreg = *(const u32x4*)(kvp + co + D); }
                if (kt >= wq && kt <= wq + 8) {
                    const LAS unsigned char* Kb = Lb + KB_OFF + (kt & 1) * 9216; const LAS unsigned char* Vb = Lb + VB_OFF + (kt & 1) * 9216;
                    f32x4 sc[4];
#pragma unroll
                    for (int t = 0; t < 4; ++t) { sc[t] = (f32x4){0.f, 0.f, 0.f, 0.f};
#pragma unroll
                        for (int ds = 0; ds < 2; ++ds) { const bf16x8 kf = *(const LAS bf16x8*)(Kb + (16 * t + r16) * SKB + (32 * ds + 8 * q4) * 2); sc[t] = __builtin_amdgcn_mfma_f32_16x16x32_bf16(kf, qf[ds], sc[t], 0, 0, 0); } }
                    if (cw - chunk >= 3) { const float bc = tb[2 * MAXREL];
#pragma unroll
                        for (int t = 0; t < 4; ++t) sc[t] = sc[t] * LOG2E + bc;
                    } else {
#pragma unroll
                        for (int t = 0; t < 4; ++t)
#pragma unroll
                            for (int r = 0; r < 4; ++r) { int dist = qrow - (64 * chunk + 16 * t + 4 * q4 + r); dist = dist < -MAXREL ? -MAXREL : (dist > MAXREL ? MAXREL : dist); sc[t][r] = sc[t][r] * LOG2E + tb[dist + MAXREL]; }
                    }
                    float mx = fmaxf(fmaxf(sc[0][0], sc[0][1]), fmaxf(sc[0][2], sc[0][3]));
#pragma unroll
                    for (int t = 1; t < 4; ++t) mx = fmaxf(mx, fmaxf(fmaxf(sc[t][0], sc[t][1]), fmaxf(sc[t][2], sc[t][3])));
                    mx = fmaxf(mx, __shfl_xor(mx, 16)); mx = fmaxf(mx, __shfl_xor(mx, 32));
                    const float mnew = fmaxf(mrun, mx), alpha = __builtin_amdgcn_exp2f(mrun - mnew); mrun = mnew;
                    float ls = 0.f;
#pragma unroll
                    for (int t = 0; t < 4; ++t)
#pragma unroll
                        for (int r = 0; r < 4; ++r) { sc[t][r] = __builtin_amdgcn_exp2f(sc[t][r] - mnew); ls += sc[t][r]; }
                    lrun = lrun * alpha + ls;
#pragma unroll
                    for (int i = 0; i < 4; ++i) oacc[i] = oacc[i] * alpha;
                    bf16x8 pb[2];
#pragma unroll
                    for (int kk = 0; kk < 2; ++kk) { u32x4 w_; w_.x = pk2(sc[2 * kk][0], sc[2 * kk][1]); w_.y = pk2(sc[2 * kk][2], sc[2 * kk][3]); w_.z = pk2(sc[2 * kk + 1][0], sc[2 * kk + 1][1]); w_.w = pk2(sc[2 * kk + 1][2], sc[2 * kk + 1][3]); pb[kk] = __builtin_bit_cast(bf16x8, w_); }
#pragma unroll
                    for (int dt = 0; dt < 4; ++dt)
#pragma unroll
                        for (int kk = 0; kk < 2; ++kk) { const LAS unsigned char* va_ = Vb + (32 * kk + 4 * q4 + (r16 >> 2)) * SKB + (16 * dt + 4 * (lane & 3)) * 2;
                            const v4i16 lo_ = __builtin_amdgcn_ds_read_tr16_b64_v4i16((LAS v4i16*)va_), hi_ = __builtin_amdgcn_ds_read_tr16_b64_v4i16((LAS v4i16*)(va_ + 16 * SKB));
                            const bf16x8 vf = (bf16x8){lo_[0], lo_[1], lo_[2], lo_[3], hi_[0], hi_[1], hi_[2], hi_[3]};
                            oacc[dt] = __builtin_amdgcn_mfma_f32_16x16x32_bf16(vf, pb[kk], oacc[dt], 0, 0, 0); }
                }
                if (kt + 1 < 10) { *(LAS u32x4*)(Lb + KB_OFF + ((kt + 1) & 1) * 9216 + kr * SKB + pc * 16) = kreg; *(LAS u32x4*)(Lb + VB_OFF + ((kt + 1) & 1) * 9216 + kr * SKB + pc * 16) = vreg; }
                WG_BAR();
            }
            lrun += __shfl_xor(lrun, 16); lrun += __shfl_xor(lrun, 32);
            const float il = 1.f / lrun; bf16* op = AO + (tok0 + qrow) * D + hh * AD + 4 * q4;
#pragma unroll
            for (int dt = 0; dt < 4; ++dt) { u32x2 o_; o_.x = pk2(oacc[dt][0] * il, oacc[dt][1] * il); o_.y = pk2(oacc[dt][2] * il, oacc[dt][3] * il); *(u32x2*)(op + 16 * dt) = o_; }
        }
#endif
    }
    SEAM(11);
    if (IN(12)) { PH_LOCALS
        pg8::DenseOrder S; S.init(T, D, F.G, (int)blockIdx.x, D);
        pg8::EpiPlain E{(bf16*)(ws + WS_MIX2), D, args.in[13], 0, 1.f};
        pg8::gemm_phase<pg8::EpiPlain, pg8::DenseOrder>(F.lds, (const bf16*)(ws + WS_AO), (const bf16*)(ws + WS_WO), D, S, E);
    }
    SEAM(12);
    layer_tail<1>(args, F, bar, lo, hi);
#undef IN
#undef SEAM
}

extern "C" void kernel_launch(void* const* d_in, const int* in_sizes, int n_in, void* d_out, int out_size, void* d_ws, size_t ws_size, hipStream_t stream) {
    static int grid = 0;
    if (grid == 0) {
        if (n_in != 23 || in_sizes[0] != T * D || out_size != T * D || ws_size < WS_END) { fprintf(stderr, "kernel_launch: unexpected shapes / workspace (n_in %d, ws %zu); nothing launched\n", n_in, ws_size); grid = -1; return; }
        int dev = 0, cus = 0, per_cu = 0;
        if (hipGetDevice(&dev) != hipSuccess || hipDeviceGetAttribute(&cus, hipDeviceAttributeMultiprocessorCount, dev) != hipSuccess) { grid = -1; return; }
        if (hipFuncSetAttribute((const void*)fwd_kernel, hipFuncAttributeMaxDynamicSharedMemorySize, LDS_BYTES) != hipSuccess) { fprintf(stderr, "kernel_launch: hipFuncSetAttribute failed\n"); grid = -1; return; }
        if (hipOccupancyMaxActiveBlocksPerMultiprocessor(&per_cu, (const void*)fwd_kernel, 512, LDS_BYTES) != hipSuccess || per_cu < 1) fprintf(stderr, "kernel_launch: occupancy query reports %d\n", per_cu);
        (void)hipGetLastError();
        grid = cus;
    }
    if (grid < 0) return;
    if (hipMemsetAsync((char*)d_ws + WS_CTL, 0, CTL_ZERO_BYTES, stream) != hipSuccess) return;
    Args a{};
    for (int i = 0; i < 23; ++i) a.in[i] = (const float*)d_in[i];
    a.out = (float*)d_out; a.ws = (unsigned char*)d_ws;
    if (MK_N_LAUNCHES == 1) { a.ph_lo = 0; a.ph_hi = NPHASE; hipLaunchKernelGGL(fwd_kernel, dim3(grid), dim3(512), LDS_BYTES, stream, a);
#ifdef PROBE_MASK
        for (int p = 0; p < NPHASE; ++p) if ((PROBE_MASK >> p) & 1) { a.ph_lo = p; a.ph_hi = p + 1; hipLaunchKernelGGL(fwd_kernel, dim3(grid), dim3(512), LDS_BYTES, stream, a); }
#endif
    }
    else for (int p = 0; p < NPHASE; ++p) { a.ph_lo = p; a.ph_hi = p + 1; hipLaunchKernelGGL(fwd_kernel, dim3(grid), dim3(512), LDS_BYTES, stream, a); }
}
```

```cpp
#include <hip/hip_runtime.h>
#include <cstdio>
#include <cstdint>

#ifndef MK_N_LAUNCHES
#define MK_N_LAUNCHES 1
#endif
#ifndef NAIVE_SCAN
#define NAIVE_SCAN 0
#endif
#ifndef NAIVE_ATTN
#define NAIVE_ATTN 0
#endif

#define LAS __attribute__((address_space(3)))
#define GAS __attribute__((address_space(1)))
typedef unsigned short bf16;
typedef short bf16x8 __attribute__((ext_vector_type(8)));
typedef float f32x4 __attribute__((ext_vector_type(4)));
typedef float f32x2 __attribute__((ext_vector_type(2)));
typedef unsigned u32x4 __attribute__((ext_vector_type(4)));
typedef unsigned u32x2 __attribute__((ext_vector_type(2)));
typedef GAS unsigned gu32;

constexpr int NB = 8, SEQ = 4096, D = 1024, T = NB * SEQ;
constexpr int DI = 2048, NH = 32, HP = 64, NG = 4, NS = 128, CONVD = 3072, INP = 5152, NZX = 5120;
constexpr int AH = 16, AD = 64, LEFTC = 8, MAXREL = 128;
constexpr int NE = 16, DFF = 512;
constexpr float ALPHA = 1.4142135623730951f;
constexpr float LN_EPS = 1e-5f, RMS_EPS = 1e-5f;
constexpr int NPHASE = 17;
constexpr int MAXTILES = 272;

constexpr size_t MiB = 1u << 20;
constexpr size_t WS_CTL = 0, CTL_ZERO_BYTES = 1 * MiB;
constexpr size_t WS_WIN = 1 * MiB;
constexpr size_t WS_WOUT = 12 * MiB;
constexpr size_t WS_XB = 16 * MiB;
constexpr size_t WS_BCACT = 16 * MiB;
constexpr size_t WS_WGU0 = 16 * MiB, WS_WD0 = 48 * MiB, WS_WQKV = 64 * MiB, WS_WO = 70 * MiB, WS_WGU1 = 72 * MiB, WS_WD1 = 104 * MiB;
constexpr size_t WS_Z = 120 * MiB;
constexpr size_t WS_XBC = 248 * MiB;
constexpr size_t WS_DTRAW = 440 * MiB;
constexpr size_t WS_SSQ = 444 * MiB;
constexpr size_t WS_CUMV = 452 * MiB;
constexpr size_t WS_DTV = 456 * MiB;
constexpr size_t WS_MIX1 = 248 * MiB;
constexpr size_t WS_X1B = 324 * MiB;
constexpr size_t WS_H0 = 120 * MiB;
constexpr size_t WS_Y20 = 188 * MiB;
constexpr size_t WS_X2B = 120 * MiB;
constexpr size_t WS_QKV = 188 * MiB;
constexpr size_t WS_AO = 380 * MiB;
constexpr size_t WS_MIX2 = 188 * MiB;
constexpr size_t WS_X3B = 256 * MiB;
constexpr size_t WS_H1 = 320 * MiB;
constexpr size_t WS_Y21 = 120 * MiB;
constexpr size_t WS_LIST = 500 * MiB;
constexpr size_t WS_INFO = 504 * MiB;
constexpr size_t WS_END = 512 * MiB;
constexpr int CW_TMO = 0;
constexpr int CW_CNT = 1024;
constexpr int CW_BAR = 4096;

constexpr int RING_BYTES = 131072;
constexpr int LDSCTL_OFF = 139264, MISC_OFF = LDSCTL_OFF + 320;
constexpr int TOKL_OFF = LDSCTL_OFF + 1024;
constexpr int MOE_OFF = TOKL_OFF + 6 * 1024;
constexpr int LDS_BYTES = 147456;

#define RLX_AGENT __ATOMIC_RELAXED, __HIP_MEMORY_SCOPE_AGENT
#define LDS_WAIT() asm volatile("s_waitcnt lgkmcnt(0)" ::: "memory")
#define VM_WAIT() asm volatile("s_waitcnt vmcnt(0)" ::: "memory")
#define WG_BAR() do { asm volatile("s_waitcnt lgkmcnt(0)" ::: "memory"); __builtin_amdgcn_s_barrier(); asm volatile("" ::: "memory"); } while (0)

__device__ __forceinline__ unsigned f2bf(float f) { unsigned u = __builtin_bit_cast(unsigned, f); return (u + 0x7fffu + ((u >> 16) & 1u)) >> 16; }
__device__ __forceinline__ unsigned pk2(float lo, float hi) { return f2bf(lo) | (f2bf(hi) << 16); }
__device__ __forceinline__ float bf2f(unsigned short b) { return __builtin_bit_cast(float, ((unsigned)b) << 16); }
__device__ __forceinline__ float bflo(unsigned w) { return __builtin_bit_cast(float, w << 16); }
__device__ __forceinline__ float bfhi(unsigned w) { return __builtin_bit_cast(float, w & 0xffff0000u); }
__device__ __forceinline__ float silu_f(float v) { return v * __builtin_amdgcn_rcpf(1.f + __expf(-v)); }
template <int CTRL> __device__ __forceinline__ float dpp_mov(float v) { return __builtin_bit_cast(float, __builtin_amdgcn_update_dpp(0, __builtin_bit_cast(int, v), CTRL, 0xF, 0xF, true)); }
__device__ __forceinline__ float wave_sum(float v) {
    v += dpp_mov<0xB1>(v); v += dpp_mov<0x4E>(v); v += dpp_mov<0x141>(v); v += dpp_mov<0x140>(v);
    const int vi = __builtin_bit_cast(int, v);
    return (__builtin_bit_cast(float, __builtin_amdgcn_readlane(vi, 0)) + __builtin_bit_cast(float, __builtin_amdgcn_readlane(vi, 16))) + (__builtin_bit_cast(float, __builtin_amdgcn_readlane(vi, 32)) + __builtin_bit_cast(float, __builtin_amdgcn_readlane(vi, 48)));
}

namespace pg8 {
constexpr int BM = 256, BK = 64, HALF = 128, HTB = HALF * BK * 2, STAGE_BYTES = 8 * HTB;
__device__ __forceinline__ int lds_byte(int r, int c) { const int st = (r >> 4) * 2 + (c >> 5), rr = r & 15, cc = c & 31, ob = rr * 64 + cc * 2; return st * 1024 + (ob ^ (((ob >> 9) & 1) << 5)); }
__device__ __forceinline__ void stage_rc(int b, int& R, int& C) { const int st = b / 1024, sb = b % 1024, swz = sb ^ (((sb >> 9) & 1) << 5); R = (st >> 1) * 16 + swz / 64; C = (st & 1) * 32 + (swz % 64) / 2; }
__device__ __forceinline__ int perm32(int rho) { const int n = rho >> 4, i = rho & 15; return 8 * (i >> 2) + 4 * n + (i & 3); }
__device__ __forceinline__ unsigned cvt_pk_bf16(float lo, float hi) { unsigned r; asm volatile("v_cvt_pk_bf16_f32 %0, %1, %2" : "=v"(r) : "v"(lo), "v"(hi)); return r; }

struct Unit { int pm, pn, bt, e; };

template <class Epi, class Sched>
__device__ __forceinline__ void gemm_phase(LAS unsigned char* lds, const bf16* A, const bf16* Bt, int K, const Sched& S, const Epi& E) {
    int tid = threadIdx.x; asm volatile("" : "+v"(tid));
    const int wid = __builtin_amdgcn_readfirstlane(tid >> 6), lane = tid & 63, wr = wid >> 2, wc = wid & 3, fr = lane & 15, fq = lane >> 4;
    const int nt = K / BK;
    int Rr[2], Cc[2]; unsigned voffB[2];
#pragma unroll
    for (int i = 0; i < 2; ++i) { stage_rc(tid * 16 + i * 8192, Rr[i], Cc[i]); const int Rb = (Rr[i] & ~31) + perm32(Rr[i] & 31); voffB[i] = (unsigned)(Rb * K + Cc[i]) * 2u; }
    const size_t kstep = (size_t)(BK * 2);
    const size_t hstep = (size_t)HALF * K * 2;
    const size_t tstep = 2 * hstep;
    const unsigned ldsw = (unsigned)wid * 1024u;
    const int aoff = lds_byte(wr * 64 + fr, fq * 8), boff = lds_byte(wc * 32 + fr, fq * 8);
#define PG8_SA(b, h) (((b) * 2 + (h)) * HTB)
#define PG8_SB(b, h) ((4 + (b) * 2 + (h)) * HTB)
#define PG8_STAGE(bufoff, gbase, voff) do { _Pragma("unroll") for (int _i = 0; _i < 2; ++_i) \
        __builtin_amdgcn_global_load_lds((const unsigned*)((const char*)(gbase) + (voff)[_i]), (LAS unsigned*)(lds + (bufoff) + ldsw + _i * 8192), 16, 0, 0); } while (0)
#define PG8_LDA(dst, b, h) do { _Pragma("unroll") for (int m = 0; m < 4; ++m) _Pragma("unroll") for (int k = 0; k < 2; ++k) dst[m][k] = *(const LAS bf16x8*)(lds + PG8_SA(b, h) + aoff + m * 2048 + k * 1024); } while (0)
#define PG8_LDB(dst, b, h) do { _Pragma("unroll") for (int n = 0; n < 2; ++n) _Pragma("unroll") for (int k = 0; k < 2; ++k) dst[n][k] = *(const LAS bf16x8*)(lds + PG8_SB(b, h) + boff + n * 2048 + k * 1024); } while (0)
#define PG8_MMA(ai, bj, At, Bt_) do { __builtin_amdgcn_s_setprio(1); _Pragma("unroll") for (int m = 0; m < 4; ++m) _Pragma("unroll") for (int n = 0; n < 2; ++n) _Pragma("unroll") for (int k = 0; k < 2; ++k) \
        acc[ai][bj][m][n] = __builtin_amdgcn_mfma_f32_16x16x32_bf16(Bt_[n][k], At[m][k], acc[ai][bj][m][n], 0, 0, 0); __builtin_amdgcn_s_setprio(0); } while (0)
#define PG8_WAIT_V(n) asm volatile("s_waitcnt vmcnt(" #n ")" ::: "memory")
#define PG8_WAIT_L(n) asm volatile("s_waitcnt lgkmcnt(" #n ")" ::: "memory")
#define PG8_BAR __builtin_amdgcn_s_barrier()
#define PG8_SCHED __builtin_amdgcn_sched_barrier(0)
    Unit cur, nxt; int ui = 0;
    if (!S.next(0, cur)) return;
    f32x4 acc[2][2][4][2];
#pragma unroll
    for (int a = 0; a < 2; ++a)
#pragma unroll
        for (int b = 0; b < 2; ++b)
#pragma unroll
            for (int m = 0; m < 4; ++m)
#pragma unroll
                for (int n = 0; n < 2; ++n) acc[a][b][m][n] = (f32x4){0.f, 0.f, 0.f, 0.f};
    bf16x8 At[4][2], B0[2][2], B1[2][2];
    unsigned vA0[2], vA1[2];
#pragma unroll
    for (int i = 0; i < 2; ++i) { vA0[i] = S.a_off(0, cur, 0, Rr[i], Cc[i]); vA1[i] = S.a_off(0, cur, 1, Rr[i], Cc[i]); }
    const char* Ab = (const char*)A;
    const char* cB = (const char*)Bt + (size_t)cur.bt * tstep;
    PG8_STAGE(PG8_SB(0, 0), cB, voffB); PG8_STAGE(PG8_SB(0, 1), cB + hstep, voffB); PG8_STAGE(PG8_SA(0, 0), Ab, vA0); PG8_STAGE(PG8_SA(0, 1), Ab, vA1);
    if (wr == 1) PG8_BAR;
    PG8_WAIT_V(2); PG8_BAR;
    PG8_STAGE(PG8_SB(1, 0), cB + kstep, voffB); PG8_STAGE(PG8_SA(1, 0), Ab + kstep, vA0); PG8_STAGE(PG8_SB(1, 1), cB + hstep + kstep, voffB);
    PG8_WAIT_V(6); PG8_BAR;
    for (;;) {
        const bool has_next = S.next(ui + 1, nxt);
        const char* nB = has_next ? (const char*)Bt + (size_t)nxt.bt * tstep : cB;
        for (int t = 0; t < nt; t += 2) {
            const bool last = (t == nt - 2);
            const char* a1 = Ab + (size_t)(t + 1) * kstep;
            const char* a2 = last ? Ab : Ab + (size_t)(t + 2) * kstep; const char* b2 = last ? nB : cB + (size_t)(t + 2) * kstep;
            const char* a3 = a2 + kstep; const char* b3 = b2 + kstep;
            unsigned v20[2], v21[2];
#pragma unroll
            for (int i = 0; i < 2; ++i) { v20[i] = vA0[i]; v21[i] = vA1[i]; }
            if (last && has_next) {
#pragma unroll
                for (int i = 0; i < 2; ++i) { v20[i] = S.a_off(ui + 1, nxt, 0, Rr[i], Cc[i]); v21[i] = S.a_off(ui + 1, nxt, 1, Rr[i], Cc[i]); } }
            PG8_LDB(B0, 0, 0); PG8_LDB(B1, 0, 1); PG8_SCHED; PG8_LDA(At, 0, 0); PG8_STAGE(PG8_SA(1, 1), a1, vA1);
            PG8_WAIT_V(8); PG8_WAIT_L(0); PG8_BAR; PG8_MMA(0, 0, At, B0); PG8_MMA(0, 1, At, B1); PG8_BAR; PG8_SCHED;
            PG8_LDA(At, 0, 1); PG8_STAGE(PG8_SB(0, 0), b2, voffB); PG8_STAGE(PG8_SB(0, 1), b2 + hstep, voffB); PG8_STAGE(PG8_SA(0, 0), a2, v20);
            PG8_WAIT_V(8); PG8_WAIT_L(0); PG8_BAR; PG8_MMA(1, 0, At, B0); PG8_MMA(1, 1, At, B1); PG8_BAR; PG8_SCHED;
            PG8_LDB(B0, 1, 0); PG8_LDB(B1, 1, 1); PG8_SCHED; PG8_LDA(At, 1, 0); PG8_STAGE(PG8_SA(0, 1), a2, v21);
            PG8_WAIT_V(8); PG8_WAIT_L(0); PG8_BAR; PG8_MMA(0, 0, At, B0); PG8_MMA(0, 1, At, B1); PG8_BAR; PG8_SCHED;
            PG8_LDA(At, 1, 1); PG8_STAGE(PG8_SB(1, 0), b3, voffB); PG8_STAGE(PG8_SB(1, 1), b3 + hstep, voffB); PG8_STAGE(PG8_SA(1, 0), a3, v20);
            PG8_WAIT_V(8); PG8_WAIT_L(0); PG8_BAR; PG8_MMA(1, 0, At, B0); PG8_MMA(1, 1, At, B1); PG8_BAR; PG8_SCHED;
        }
        if (wr == 0) PG8_BAR;
        E(acc, cur, wr, wc, fr, fq);
        if (!has_next) break;
#pragma unroll
        for (int a = 0; a < 2; ++a)
#pragma unroll
            for (int b = 0; b < 2; ++b)
#pragma unroll
                for (int m = 0; m < 4; ++m)
#pragma unroll
                    for (int n = 0; n < 2; ++n) acc[a][b][m][n] = (f32x4){0.f, 0.f, 0.f, 0.f};
        cur = nxt; cB = nB; ++ui;
#pragma unroll
        for (int i = 0; i < 2; ++i) { vA0[i] = S.a_off(ui, cur, 0, Rr[i], Cc[i]); vA1[i] = S.a_off(ui, cur, 1, Rr[i], Cc[i]); }
        if (wr == 1) PG8_BAR;
    }
    PG8_WAIT_V(0);
    PG8_BAR;
#undef PG8_SA
#undef PG8_SB
#undef PG8_STAGE
#undef PG8_LDA
#undef PG8_LDB
#undef PG8_MMA
#undef PG8_WAIT_V
#undef PG8_WAIT_L
#undef PG8_BAR
#undef PG8_SCHED
}

struct DenseOrder {
    int nM, nN, nwg, G, c, lda;
    __device__ void init(int M, int N, int G_, int c_, int lda_) { nM = M / BM; nN = N / BM; nwg = nM * nN; G = G_; c = c_; lda = lda_; }
    __device__ __forceinline__ bool next(int i, Unit& u) const {
        const long L = (long)i * G + c; if (L >= nwg) return false;
        int wgid = (int)L; { const int q = nwg / 8, r = nwg % 8, xcd = wgid % 8, off = wgid / 8; wgid = (xcd < r ? xcd * (q + 1) : r * (q + 1) + (xcd - r) * q) + off; }
        const int nig = 8 * nN, gid = wgid / nig, fm = gid * 8, gsz = (nM - fm) < 8 ? (nM - fm) : 8;
        u.pm = fm + ((wgid % nig) % gsz); u.pn = (wgid % nig) / gsz; u.bt = u.pn; u.e = 0; return true;
    }
    __device__ __forceinline__ unsigned a_off(int, const Unit& u, int h, int R, int C) const { return (unsigned)((u.pm * BM + h * HALF + R) * lda + C) * 2u; }
};
template <bool GATHER> struct MoeOrder {
    const LAS int* ts;
    const LAS int* tokL;
    int G, c, lda;
    __device__ __forceinline__ bool next(int i, Unit& u) const {
        const int L = i * G + c; const int ntile = __builtin_amdgcn_readfirstlane(ts[16]);
        if (L >= ntile * 4) return false;
        const int rt = L >> 2; int e = 0;
#pragma unroll
        for (int j = 1; j < 16; ++j) e += (rt >= ts[j]) ? 1 : 0;
        e = __builtin_amdgcn_readfirstlane(e);
        u.pm = rt; u.pn = L & 3; u.e = e; u.bt = e * 4 + (L & 3); return true;
    }
    __device__ __forceinline__ unsigned a_off(int ui, const Unit& u, int h, int R, int C) const {
        if (GATHER) { const int tok = tokL[ui * 256 + h * HALF + R]; return (unsigned)(tok * lda + C) * 2u; }
        return (unsigned)((u.pm * BM + h * HALF + R) * lda + C) * 2u;
    }
};

struct EpiPlain {
    bf16* O; int ldc; const float* bias; int scale_cols; float scale0;
    __device__ __forceinline__ void operator()(const f32x4 (&acc)[2][2][4][2], const Unit& u, int wr, int wc, int fr, int fq) const {
        const int row0 = u.pm * BM + wr * 64 + fr, col0 = u.pn * BM + wc * 32 + 8 * fq;
        const float sc = (u.pn * BM < scale_cols) ? scale0 : 1.f;
        f32x4 bv[2][2];
#pragma unroll
        for (int bj = 0; bj < 2; ++bj)
#pragma unroll
            for (int n = 0; n < 2; ++n) bv[bj][n] = bias ? *(const f32x4*)(bias + col0 + bj * HALF + 4 * n) : (f32x4){0.f, 0.f, 0.f, 0.f};
#pragma unroll
        for (int ai = 0; ai < 2; ++ai)
#pragma unroll
            for (int m = 0; m < 4; ++m) { bf16* rowp = O + (size_t)(row0 + ai * HALF + m * 16) * ldc + col0;
#pragma unroll
                for (int bj = 0; bj < 2; ++bj) { f32x4 v0 = (acc[ai][bj][m][0] + bv[bj][0]) * sc, v1 = (acc[ai][bj][m][1] + bv[bj][1]) * sc;
                    u32x4 w; w.x = cvt_pk_bf16(v0[0], v0[1]); w.y = cvt_pk_bf16(v0[2], v0[3]); w.z = cvt_pk_bf16(v1[0], v1[1]); w.w = cvt_pk_bf16(v1[2], v1[3]);
                    *(u32x4*)(rowp + bj * HALF) = w; } }
    }
};
struct EpiInProj {
    bf16* Z; bf16* XBC;
    __device__ __forceinline__ void operator()(const f32x4 (&acc)[2][2][4][2], const Unit& u, int wr, int wc, int fr, int fq) const {
        const int row0 = u.pm * BM + wr * 64 + fr; int colt = u.pn * BM; bf16* base; int ldc;
        if (colt < DI) { base = Z; ldc = DI; } else { base = XBC; ldc = CONVD; colt -= DI; }
        const int col0 = colt + wc * 32 + 8 * fq;
#pragma unroll
        for (int ai = 0; ai < 2; ++ai)
#pragma unroll
            for (int m = 0; m < 4; ++m) { bf16* rowp = base + (size_t)(row0 + ai * HALF + m * 16) * ldc + col0;
#pragma unroll
                for (int bj = 0; bj < 2; ++bj) { const f32x4 v0 = acc[ai][bj][m][0], v1 = acc[ai][bj][m][1];
                    u32x4 w; w.x = cvt_pk_bf16(v0[0], v0[1]); w.y = cvt_pk_bf16(v0[2], v0[3]); w.z = cvt_pk_bf16(v1[0], v1[1]); w.w = cvt_pk_bf16(v1[2], v1[3]);
                    *(u32x4*)(rowp + bj * HALF) = w; } }
    }
};
struct EpiGateUp {
    bf16* Hh;
    __device__ __forceinline__ void operator()(const f32x4 (&acc)[2][2][4][2], const Unit& u, int wr, int wc, int fr, int fq) const {
        const int row0 = u.pm * BM + wr * 64 + fr, col0 = (u.pn * BM + wc * 32 + 8 * fq) >> 1;
#pragma unroll
        for (int ai = 0; ai < 2; ++ai)
#pragma unroll
            for (int m = 0; m < 4; ++m) { bf16* rowp = Hh + (size_t)(row0 + ai * HALF + m * 16) * DFF + col0;
#pragma unroll
                for (int bj = 0; bj < 2; ++bj) { const f32x4 g = acc[ai][bj][m][0], up = acc[ai][bj][m][1];
                    u32x2 w; w.x = cvt_pk_bf16(silu_f(g[0]) * up[0], silu_f(g[1]) * up[1]); w.y = cvt_pk_bf16(silu_f(g[2]) * up[2], silu_f(g[3]) * up[3]);
                    *(u32x2*)(rowp + bj * (HALF / 2)) = w; } }
    }
};
}

#define XB_TMO      128
#define XB_XCNT(j)  (256  + 64 * (j))
#define XB_XSUB(j)  (1280 + 64 * (j))
#define XB_XGEN(j)  (2304 + 64 * (j))
#define XB_TOP      3328
#define XB_TOPGEN   3392
#define XCD_BAR_WORDS 3456
#define XB_SPIN_CAP (1u << 18)
__device__ __forceinline__ unsigned xb_ld(unsigned* p)              { return __hip_atomic_load(p, __ATOMIC_RELAXED, __HIP_MEMORY_SCOPE_AGENT); }
__device__ __forceinline__ unsigned xb_add(unsigned* p, unsigned v) { return __hip_atomic_fetch_add(p, v, __ATOMIC_RELAXED, __HIP_MEMORY_SCOPE_AGENT); }
__device__ __forceinline__ unsigned xb_xcc_id() { return (unsigned)__builtin_amdgcn_s_getreg((3 << 11) | 20) & 0xFu; }
#define XB_SPIN(cond, bar) do { unsigned _sp = 0; while (cond) { __builtin_amdgcn_s_sleep(1); \
    if ((++_sp & 255u) == 0u) { if (xb_ld(&(bar)[XB_TMO])) break; if (_sp > XB_SPIN_CAP) { atomicAdd(&(bar)[XB_TMO], 1u); break; } } } } while (0)
struct XcdBarrier { unsigned* bar; unsigned x; volatile LAS unsigned* st; };
__device__ __forceinline__ XcdBarrier xcd_barrier_post(unsigned* bar, volatile LAS unsigned* st) {
    XcdBarrier b; b.bar = bar; b.x = xb_xcc_id(); b.st = st;
    if (threadIdx.x == 0) (void)xb_add(&bar[XB_XCNT(b.x)], 1u);
    return b;
}
__device__ __forceinline__ void xcd_barrier_complete(unsigned* bar, unsigned x, unsigned& nloc, unsigned& nx) {
    const unsigned G = gridDim.x * gridDim.y * gridDim.z;
    unsigned sum, cnt, mine, sp = 0u;
    for (;;) {
        sum = 0u; cnt = 0u; mine = 0u;
#pragma unroll
        for (unsigned j = 0; j < 16; ++j) { const unsigned c = xb_ld(&bar[XB_XCNT(j)]); sum += c; cnt += (c > 0u) ? 1u : 0u; mine = (j == x) ? c : mine; }
        if (sum == G) break;
        __builtin_amdgcn_s_sleep(1);
        if ((++sp & 255u) == 0u) { if (xb_ld(&bar[XB_TMO])) break; if (sp > XB_SPIN_CAP) { atomicAdd(&bar[XB_TMO], 1u); break; } }
    }
    nloc = mine > 0u ? mine : 1u; nx = cnt > 0u ? cnt : 1u;
}
__device__ __forceinline__ void xcd_barrier(const XcdBarrier& b) {
    asm volatile("s_waitcnt vmcnt(0)" ::: "memory");
    __syncthreads();
    if (threadIdx.x == 0) {
        unsigned* bar = b.bar;
        __builtin_amdgcn_s_waitcnt(0);
        unsigned nloc = b.st[0], nx = b.st[1];
        if (nloc == 0u) { xcd_barrier_complete(bar, b.x, nloc, nx); b.st[0] = nloc; b.st[1] = nx; }
        const unsigned old = xb_add(&bar[XB_XSUB(b.x)], 1u);
        const unsigned gen = old / nloc;
        if (old + 1u == (gen + 1u) * nloc) {
            __builtin_amdgcn_fence(__ATOMIC_RELEASE, "agent");
            asm volatile("s_waitcnt vmcnt(0)" ::: "memory");
            const unsigned og = xb_add(&bar[XB_TOP], 1u);
            const unsigned tg = og / nx;
            if (og + 1u == (tg + 1u) * nx) xb_add(&bar[XB_TOPGEN], 1u);
            else XB_SPIN(xb_ld(&bar[XB_TOPGEN]) == tg, bar);
            __builtin_amdgcn_fence(__ATOMIC_ACQUIRE, "agent");
            xb_add(&bar[XB_XGEN(b.x)], 1u);
            asm volatile("s_waitcnt vmcnt(0)" ::: "memory");
        } else {
            XB_SPIN(xb_ld(&bar[XB_XGEN(b.x)]) == gen, bar);
            __builtin_amdgcn_fence(__ATOMIC_ACQUIRE, "agent");
            asm volatile("s_waitcnt vmcnt(0)" ::: "memory");
        }
    }
    __syncthreads();
}

struct Args { const float* in[23]; float* out; unsigned char* ws; int ph_lo, ph_hi; };

struct Frame {
    LAS unsigned char* lds;
    int tid, lane, wave, vcu, G;
};

__device__ __forceinline__ void transpose_item(const float* W, int K, int N, bf16* WT, int row_off, int mode, const float* kscale, LAS float* scr, int item, int lane) {
    const int nblk = N / 32, kb = item / nblk, nb = item % nblk, k0 = 64 * kb, n0 = 32 * nb;
#pragma unroll 8
    for (int i = 0; i < 32; ++i) { const int kk = 2 * i + (lane >> 5); scr[kk * 33 + (lane & 31)] = W[(size_t)(k0 + kk) * N + n0 + (lane & 31)]; }
    LDS_WAIT(); asm volatile("" ::: "memory");
    const int c = lane & 7;
    float ks[8];
#pragma unroll
    for (int q = 0; q < 8; ++q) ks[q] = kscale ? kscale[k0 + 8 * c + q] : 1.f;
#pragma unroll
    for (int j = 0; j < 4; ++j) { const int n = (lane >> 3) + 8 * j; const LAS float* s = scr + (8 * c) * 33 + n;
        u32x4 o; o.x = pk2(s[0 * 33] * ks[0], s[1 * 33] * ks[1]); o.y = pk2(s[2 * 33] * ks[2], s[3 * 33] * ks[3]); o.z = pk2(s[4 * 33] * ks[4], s[5 * 33] * ks[5]); o.w = pk2(s[6 * 33] * ks[6], s[7 * 33] * ks[7]);
        const int ng = n0 + n; const int dr = (mode == 0) ? ng : (8 * (ng >> 2) + (ng & 3) + (mode == 2 ? 4 : 0));
        *(GAS u32x4*)(WT + (size_t)(row_off + dr) * K + k0 + 8 * c) = o; }
    LDS_WAIT(); asm volatile("" ::: "memory");
}

__device__ __forceinline__ void ln_row(f32x4 (&v)[4], const float* g, const float* b, int lane) {
    float s = 0.f;
#pragma unroll
    for (int j = 0; j < 4; ++j) s += (v[j].x + v[j].y) + (v[j].z + v[j].w);
    const float mean = wave_sum(s) * (1.f / D); float s2 = 0.f;
#pragma unroll
    for (int j = 0; j < 4; ++j) { v[j] = v[j] - mean; s2 += (v[j].x * v[j].x + v[j].y * v[j].y) + (v[j].z * v[j].z + v[j].w * v[j].w); }
    const float rstd = 1.f / sqrtf(wave_sum(s2) * (1.f / D) + LN_EPS);
#pragma unroll
    for (int j = 0; j < 4; ++j) { const f32x4 gg = *(const f32x4*)(g + 4 * lane + 256 * j), bb = *(const f32x4*)(b + 4 * lane + 256 * j); v[j] = v[j] * rstd * gg + bb; }
}
__device__ __forceinline__ f32x4 ld_bf16x4(const bf16* p) { const u32x2 w = *(const u32x2*)p; return (f32x4){bflo(w.x), bfhi(w.x), bflo(w.y), bfhi(w.y)}; }
__device__ __forceinline__ void st_bf16x4(bf16* p, f32x4 v) { u32x2 w; w.x = pk2(v.x, v.y); w.y = pk2(v.z, v.w); *(u32x2*)p = w; }

#ifndef PH_MASK
#define PH_MASK 0x1ffff
#endif
#define IN(k) (((PH_MASK >> (k)) & 1) && lo <= (k) && (k) < hi)
#define SEAM(k) do { if (IN(k) && IN((k) + 1)) xcd_barrier(bar); } while (0)
#define PH_LOCALS \
    int tid = threadIdx.x; asm volatile("" : "+v"(tid)); const int lane = tid & 63, wave = __builtin_amdgcn_readfirstlane(tid >> 6); \
    size_t ws_z_ = 0; asm volatile("" : "+s"(ws_z_)); unsigned char* ws = args.ws + ws_z_;     \
    const int gw = F.vcu * 8 + wave, NGW = F.G * 8; (void)lane; (void)gw; (void)NGW; \
    const float* x_in = args.in[0]; (void)x_in; \
    bf16* Wt_in = (bf16*)(ws + WS_WIN); bf16* Wt_out = (bf16*)(ws + WS_WOUT); (void)Wt_in; (void)Wt_out; \
    bf16* XB = (bf16*)(ws + WS_XB); bf16* Zb = (bf16*)(ws + WS_Z); bf16* XBC = (bf16*)(ws + WS_XBC); (void)XB; (void)Zb; (void)XBC; \
    float* DTRAW = (float*)(ws + WS_DTRAW); float* SSQ = (float*)(ws + WS_SSQ); (void)DTRAW; (void)SSQ; \
    int* LIST = (int*)(ws + WS_LIST); unsigned* INFO = (unsigned*)(ws + WS_INFO); (void)LIST; (void)INFO;


template <int L>
__device__ __forceinline__ void layer_tail(const Args& args, const Frame& F, const XcdBarrier& bar, const int lo, const int hi) {
    const int pb = L ? 13 : 6;
#define LAYER_LOCALS \
    const bf16* MIX = (const bf16*)(ws + (L ? WS_MIX2 : WS_MIX1)); (void)MIX; \
    bf16* XN = (bf16*)(ws + (L ? WS_X3B : WS_X1B)); (void)XN;            \
    bf16* HB = (bf16*)(ws + (L ? WS_H1 : WS_H0)); (void)HB; \
    bf16* Y2 = (bf16*)(ws + (L ? WS_Y21 : WS_Y20)); (void)Y2; \
    gu32* gcnt = (gu32*)(ws + WS_CTL) + CW_CNT + 64 * L; (void)gcnt; \
    LAS int* tokL = (LAS int*)(F.lds + TOKL_OFF); (void)tokL; \
    LAS int* mo = (LAS int*)(F.lds + MOE_OFF); (void)mo;

    if (IN(pb)) { PH_LOCALS LAYER_LOCALS
        const float* lg = args.in[19] + L * D; const float* lb = args.in[20] + L * D;
        const float* rw = args.in[14]; const float* rbias = args.in[15];
        constexpr int AST = 2064;
        LAS unsigned char* AH = F.lds; LAS unsigned char* AL = F.lds + 16 * AST;
        LAS float* PART = (LAS float*)(F.lds + 66048);
        LAS float* LG = (LAS float*)(F.lds + 74240);
        LAS int* lcnt = (LAS int*)(F.lds + 75264);
        LAS int* rec = (LAS int*)(F.lds + 75264 + 256);
        const int r16 = lane & 15, q4 = lane >> 4;
        bf16x8 wh[4], wl[4];
#pragma unroll
        for (int ks = 0; ks < 4; ++ks) { unsigned hh_[4], ll_[4];
#pragma unroll
            for (int jp = 0; jp < 4; ++jp) { const float w0 = rw[(128 * wave + 32 * ks + 8 * q4 + 2 * jp) * NE + r16], w1 = rw[(128 * wave + 32 * ks + 8 * q4 + 2 * jp + 1) * NE + r16];
                const unsigned h0 = f2bf(w0), h1 = f2bf(w1); hh_[jp] = h0 | (h1 << 16); ll_[jp] = pk2(w0 - bf2f((unsigned short)h0), w1 - bf2f((unsigned short)h1)); }
            wh[ks] = __builtin_bit_cast(bf16x8, (u32x4){hh_[0], hh_[1], hh_[2], hh_[3]}); wl[ks] = __builtin_bit_cast(bf16x8, (u32x4){ll_[0], ll_[1], ll_[2], ll_[3]}); }
        if (tid < 32) lcnt[tid] = 0;
        __syncthreads();
        f32x4 nx[2][4]; u32x2 nm[2][4];
#define RT_LOAD(tile_) do { _Pragma("unroll") for (int u = 0; u < 2; ++u) { const size_t mm = (size_t)(tile_) * 16 + 2 * wave + u; _Pragma("unroll") for (int j = 0; j < 4; ++j) { nm[u][j] = *(const u32x2*)(MIX + mm * D + 4 * lane + 256 * j); \
            if (L == 0) nx[u][j] = *(const f32x4*)(x_in + mm * D + 4 * lane + 256 * j); \
            else { const u32x2 t_ = *(const u32x2*)((const bf16*)(ws + WS_X2B) + mm * D + 4 * lane + 256 * j); nx[u][j] = (f32x4){bflo(t_.x), bfhi(t_.x), bflo(t_.y), bfhi(t_.y)}; } } } } while (0)
        if (F.vcu < T / 16) RT_LOAD(F.vcu);
        int ti_ = 0;
        for (int tile = F.vcu; tile < T / 16; tile += F.G, ++ti_) {
            f32x4 v[2][4];
#pragma unroll
            for (int u = 0; u < 2; ++u)
#pragma unroll
                for (int j = 0; j < 4; ++j) v[u][j] = nx[u][j] * ALPHA + (f32x4){bflo(nm[u][j].x), bfhi(nm[u][j].x), bflo(nm[u][j].y), bfhi(nm[u][j].y)};
            if (tile + F.G < T / 16) RT_LOAD(tile + F.G);
#pragma unroll
            for (int u = 0; u < 2; ++u) { const size_t m = (size_t)tile * 16 + 2 * wave + u;
                ln_row(v[u], lg, lb, lane);
#pragma unroll
                for (int j = 0; j < 4; ++j) { const f32x4 x = v[u][j]; const unsigned h0 = f2bf(x.x), h1 = f2bf(x.y), h2 = f2bf(x.z), h3 = f2bf(x.w);
                    u32x2 hw; hw.x = h0 | (h1 << 16); hw.y = h2 | (h3 << 16);
                    u32x2 lw; lw.x = pk2(x.x - bf2f((unsigned short)h0), x.y - bf2f((unsigned short)h1)); lw.y = pk2(x.z - bf2f((unsigned short)h2), x.w - bf2f((unsigned short)h3));
                    *(u32x2*)(XN + m * D + 4 * lane + 256 * j) = hw;
                    *(LAS u32x2*)(AH + (2 * wave + u) * AST + (256 * j + 4 * lane) * 2) = hw; *(LAS u32x2*)(AL + (2 * wave + u) * AST + (256 * j + 4 * lane) * 2) = lw; } }
            WG_BAR();
            { f32x4 acc = {0.f, 0.f, 0.f, 0.f};
#pragma unroll
              for (int ks = 0; ks < 4; ++ks) { const bf16x8 ah = *(const LAS bf16x8*)(AH + r16 * AST + (128 * wave + 32 * ks + 8 * q4) * 2), al = *(const LAS bf16x8*)(AL + r16 * AST + (128 * wave + 32 * ks + 8 * q4) * 2);
                  acc = __builtin_amdgcn_mfma_f32_16x16x32_bf16(ah, wh[ks], acc, 0, 0, 0); acc = __builtin_amdgcn_mfma_f32_16x16x32_bf16(ah, wl[ks], acc, 0, 0, 0); acc = __builtin_amdgcn_mfma_f32_16x16x32_bf16(al, wh[ks], acc, 0, 0, 0); }
#pragma unroll
              for (int r = 0; r < 4; ++r) PART[wave * 256 + (4 * q4 + r) * 16 + r16] = acc[r]; }
            WG_BAR();
            if (tid < 256) { float s_ = 0.f;
#pragma unroll
                for (int w = 0; w < 8; ++w) s_ += PART[w * 256 + tid];
                LG[tid] = s_; }
            WG_BAR();
            if (tid < 16) {
                float lgt[NE];
#pragma unroll
                for (int e4 = 0; e4 < 4; ++e4) { const f32x4 t_ = *(const LAS f32x4*)(LG + tid * 16 + 4 * e4); lgt[4 * e4] = t_.x; lgt[4 * e4 + 1] = t_.y; lgt[4 * e4 + 2] = t_.z; lgt[4 * e4 + 3] = t_.w; }
                float mxl = lgt[0];
#pragma unroll
                for (int e = 1; e < NE; ++e) mxl = fmaxf(mxl, lgt[e]);
                float sc[NE], sel[NE], den = 0.f;
#pragma unroll
                for (int e = 0; e < NE; ++e) { sc[e] = __expf(lgt[e] - mxl); den += sc[e]; }
                const float iden = 1.f / den;
#pragma unroll
                for (int e = 0; e < NE; ++e) { sc[e] *= iden; sel[e] = sc[e] + rbias[e]; }
                int bg = 0; float bgs = -1e30f;
#pragma unroll
                for (int g = 0; g < 4; ++g) { const float a = sel[4 * g], b2 = sel[4 * g + 1], c2 = sel[4 * g + 2], d2 = sel[4 * g + 3];
                    const float hi1 = fmaxf(fmaxf(a, b2), fmaxf(c2, d2));
                    const float m01 = fminf(a, b2), m23 = fminf(c2, d2), M01 = fmaxf(a, b2), M23 = fmaxf(c2, d2);
                    const float second = fmaxf(fminf(M01, M23), fmaxf(m01, m23));
                    const float gs = hi1 + second;
                    if (gs > bgs) { bgs = gs; bg = g; } }
                float s0 = 0.f, s1 = 0.f, s2 = 0.f, s3 = 0.f, p0 = 0.f, p1 = 0.f, p2 = 0.f, p3 = 0.f;
#pragma unroll
                for (int g = 0; g < 4; ++g) if (g == bg) { s0 = sel[4 * g]; s1 = sel[4 * g + 1]; s2 = sel[4 * g + 2]; s3 = sel[4 * g + 3]; p0 = sc[4 * g]; p1 = sc[4 * g + 1]; p2 = sc[4 * g + 2]; p3 = sc[4 * g + 3]; }
                int i1 = 0; float b1 = s0, q1 = p0;
                if (s1 > b1) { b1 = s1; i1 = 1; q1 = p1; } if (s2 > b1) { b1 = s2; i1 = 2; q1 = p2; } if (s3 > b1) { b1 = s3; i1 = 3; q1 = p3; }
                int i2 = -1; float b2v = -1e30f, q2 = 0.f;
                if (i1 != 0 && s0 > b2v) { b2v = s0; i2 = 0; q2 = p0; } if (i1 != 1 && s1 > b2v) { b2v = s1; i2 = 1; q2 = p1; }
                if (i1 != 2 && s2 > b2v) { b2v = s2; i2 = 2; q2 = p2; } if (i1 != 3 && s3 > b2v) { b2v = s3; i2 = 3; q2 = p3; }
                const int e1 = 4 * bg + i1, e2 = 4 * bg + i2; const float gsum = q1 + q2, g1 = q1 / gsum, g2 = q2 / gsum;
                const int r1 = atomicAdd((int*)(lcnt + e1), 1), r2 = atomicAdd((int*)(lcnt + e2), 1);
                LAS int* rc = rec + ((ti_ & 31) * 16 + tid) * 8; rc[0] = e1; rc[1] = r1; rc[2] = e2; rc[3] = r2; rc[4] = __builtin_bit_cast(int, g1); rc[5] = __builtin_bit_cast(int, g2);
            }
        }
#undef RT_LOAD
        __syncthreads();
        if (tid < NE) lcnt[16 + tid] = (int)__hip_atomic_fetch_add(gcnt + tid, (unsigned)lcnt[tid], RLX_AGENT);
        __syncthreads();
        for (int lt = tid; lt < ti_ * 16; lt += 512) {
            const int m = 16 * (F.vcu + (lt >> 4) * F.G) + (lt & 15);
            const LAS int* rc = rec + lt * 8;
            const int e1 = rc[0], e2 = rc[2], sl1 = lcnt[16 + e1] + rc[1], sl2 = lcnt[16 + e2] + rc[3];
            LIST[(size_t)e1 * T + sl1] = m; LIST[(size_t)e2 * T + sl2] = m;
            u32x4 w0; w0.x = (unsigned)e1; w0.y = (unsigned)sl1; w0.z = (unsigned)e2; w0.w = (unsigned)sl2;
            *(u32x4*)(INFO + (size_t)m * 8) = w0; INFO[(size_t)m * 8 + 4] = (unsigned)rc[4]; INFO[(size_t)m * 8 + 5] = (unsigned)rc[5];
        }
    }
    SEAM(pb);

    if (IN(pb + 1) || IN(pb + 2) || IN(pb + 3)) { PH_LOCALS LAYER_LOCALS
        __syncthreads();
        if (tid == 0) { int acc_ = 0; for (int e = 0; e < NE; ++e) { const int c = (int)__hip_atomic_load(gcnt + e, RLX_AGENT); mo[e] = acc_; mo[32 + e] = c; acc_ += (c + 255) >> 8; } mo[16] = acc_; }
        __syncthreads();
    }
    if (IN(pb + 1)) { PH_LOCALS LAYER_LOCALS
        pg8::MoeOrder<true> S{mo, tokL, F.G, F.vcu, D};
        { pg8::Unit u; for (int ui = 0; ui < 6 && S.next(ui, u); ++ui) { if (tid < 256) { const int r = (u.pm - mo[u.e]) * 256 + tid, c = mo[32 + u.e]; tokL[ui * 256 + tid] = LIST[(size_t)u.e * T + (r < c ? r : c - 1)]; } } }
        __syncthreads();
        pg8::EpiGateUp E{HB};
        pg8::gemm_phase<pg8::EpiGateUp, pg8::MoeOrder<true>>(F.lds, XN, (const bf16*)(ws + (L ? WS_WGU1 : WS_WGU0)), D, S, E);
    }
    SEAM(pb + 1);
    if (IN(pb + 2)) { PH_LOCALS LAYER_LOCALS
        pg8::MoeOrder<false> S{mo, tokL, F.G, F.vcu, DFF};
        pg8::EpiPlain E{Y2, D, nullptr, 0, 1.f};
        pg8::gemm_phase<pg8::EpiPlain, pg8::MoeOrder<false>>(F.lds, HB, (const bf16*)(ws + (L ? WS_WD1 : WS_WD0)), DFF, S, E);
    }
    SEAM(pb + 2);
    if (IN(pb + 3)) { PH_LOCALS LAYER_LOCALS
        const float* lg = args.in[21] + L * D; const float* lb = args.in[22] + L * D;
        for (int m = gw; m < T; m += NGW) {
            const u32x4 w0 = *(const u32x4*)(INFO + (size_t)m * 8); const float g1 = __builtin_bit_cast(float, INFO[(size_t)m * 8 + 4]), g2 = __builtin_bit_cast(float, INFO[(size_t)m * 8 + 5]);
            const size_t r1 = (size_t)mo[w0.x] * 256 + w0.y, r2 = (size_t)mo[w0.z] * 256 + w0.w;
            f32x4 v[4];
#pragma unroll
            for (int j = 0; j < 4; ++j) { const int co = 4 * lane + 256 * j;
                v[j] = ld_bf16x4(XN + (size_t)m * D + co) * ALPHA + ld_bf16x4(Y2 + r1 * D + co) * g1 + ld_bf16x4(Y2 + r2 * D + co) * g2; }
            ln_row(v, lg, lb, lane);
            if (L == 0) {
#pragma unroll
                for (int j = 0; j < 4; ++j) st_bf16x4((bf16*)(ws + WS_X2B) + (size_t)m * D + 4 * lane + 256 * j, v[j]);
            } else {
#pragma unroll
                for (int j = 0; j < 4; ++j) *(f32x4*)(args.out + (size_t)m * D + 4 * lane + 256 * j) = v[j];
            }
        }
    }
}

__global__ void __launch_bounds__(512, 2) fwd_kernel(Args args) {
    extern __shared__ __attribute__((aligned(16))) unsigned char lds_raw[];
    Frame F;
    F.lds = (LAS unsigned char*)lds_raw;
    F.tid = threadIdx.x; F.lane = F.tid & 63; F.wave = __builtin_amdgcn_readfirstlane(F.tid >> 6);
    F.G = gridDim.x; { const int bx = blockIdx.x; F.vcu = (F.G % 8 == 0) ? (bx % 8) * (F.G / 8) + bx / 8 : bx; }
    unsigned char* ws = args.ws;
    gu32* ctl = (gu32*)(ws + WS_CTL);
    volatile LAS unsigned* MISC = (volatile LAS unsigned*)(F.lds + MISC_OFF);
    for (int u = F.tid; u < (LDS_BYTES - LDSCTL_OFF) / 4; u += 512) ((LAS unsigned*)(F.lds + LDSCTL_OFF))[u] = 0u;
    __syncthreads();
    XcdBarrier bar; bar.bar = (unsigned*)(ctl + CW_BAR); bar.x = 0; bar.st = nullptr;
    if (MK_N_LAUNCHES == 1) bar = xcd_barrier_post((unsigned*)(ctl + CW_BAR), MISC + 8);
    const int lo = args.ph_lo, hi = args.ph_hi;
    if (IN(0)) { PH_LOCALS
        LAS float* scr = (LAS float*)(F.lds + wave * 16384);
        constexpr int I_IN = (D / 64) * (INP / 32), I_OUT = (DI / 64) * (D / 32);
        for (int it = gw; it < I_IN + I_OUT; it += NGW) {
            if (it < I_IN) transpose_item(args.in[1], D, INP, Wt_in, 0, 0, nullptr, scr, it, lane);
            else transpose_item(args.in[8], DI, D, Wt_out, 0, 0, args.in[7], scr, it - I_IN, lane);
        }
        const size_t n8 = (size_t)T * D / 8, stride = (size_t)F.G * 512; size_t i = (size_t)blockIdx.x * 512 + tid;
        for (; i + 3 * stride < n8; i += 4 * stride) {
            f32x4 a[4], b[4];
#pragma unroll
            for (int u = 0; u < 4; ++u) { a[u] = *(const f32x4*)(x_in + (i + u * stride) * 8); b[u] = *(const f32x4*)(x_in + (i + u * stride) * 8 + 4); }
#pragma unroll
            for (int u = 0; u < 4; ++u) { u32x4 o; o.x = pk2(a[u].x, a[u].y); o.y = pk2(a[u].z, a[u].w); o.z = pk2(b[u].x, b[u].y); o.w = pk2(b[u].z, b[u].w); *(u32x4*)(XB + (i + u * stride) * 8) = o; }
        }
        for (; i < n8; i += stride) { const f32x4 a = *(const f32x4*)(x_in + i * 8), b = *(const f32x4*)(x_in + i * 8 + 4);
            u32x4 o; o.x = pk2(a.x, a.y); o.y = pk2(a.z, a.w); o.z = pk2(b.x, b.y); o.w = pk2(b.z, b.w); *(u32x4*)(XB + i * 8) = o; }
    }
    SEAM(0);

    if (IN(1)) { PH_LOCALS
        pg8::DenseOrder S; S.init(T, NZX, F.G, (int)blockIdx.x, D);
        pg8::EpiInProj E{Zb, XBC};
        pg8::gemm_phase<pg8::EpiInProj, pg8::DenseOrder>(F.lds, XB, Wt_in, D, S, E);
        for (int tile = gw; tile < T / 16; tile += NGW) {
            const int t0 = tile * 16, r = lane & 15, q = lane >> 4;
            const bf16* xp = XB + (size_t)(t0 + r) * D + 8 * q;
            const bf16* w0 = Wt_in + (size_t)(NZX + r) * D + 8 * q; const bf16* w1 = w0 + (size_t)16 * D;
            f32x4 a0 = {0.f, 0.f, 0.f, 0.f}, a1 = {0.f, 0.f, 0.f, 0.f};
#pragma unroll 4
            for (int k0 = 0; k0 < D; k0 += 32) {
                const bf16x8 xv = *(const bf16x8*)(xp + k0), wa = *(const bf16x8*)(w0 + k0), wb = *(const bf16x8*)(w1 + k0);
                a0 = __builtin_amdgcn_mfma_f32_16x16x32_bf16(wa, xv, a0, 0, 0, 0);
                a1 = __builtin_amdgcn_mfma_f32_16x16x32_bf16(wb, xv, a1, 0, 0, 0);
            }
            float* o = DTRAW + (size_t)(t0 + r) * NH + 4 * q;
            *(f32x4*)o = a0; *(f32x4*)(o + 16) = a1;
        }
    }
    SEAM(1);

    if (IN(2)) { PH_LOCALS
        const float* conv_w = args.in[2]; const float* conv_b = args.in[3];
        bf16* BCACT = (bf16*)(ws + WS_BCACT);
        { const float* dt_bias = args.in[4]; const float* a_log = args.in[5]; float* CUMV = (float*)(ws + WS_CUMV); float* DTV = (float*)(ws + WS_DTV);
          for (int it = gw; it < NB * NH * (SEQ / 64); it += NGW) { const int c = it & 63, h = (it >> 6) & 31, b = it >> 11;
              const float rw_ = DTRAW[((size_t)b * SEQ + c * 64 + lane) * NH + h] + dt_bias[h]; const float dtv = rw_ > 15.f ? rw_ : __logf(1.f + __expf(rw_)); float xx = dtv * (-__expf(a_log[h]));
#pragma unroll
              for (int o_ = 1; o_ < 64; o_ <<= 1) { const float vv = __shfl_up(xx, o_); if (lane >= o_) xx += vv; }
              const size_t oi = ((size_t)b * NH + h) * SEQ + c * 64 + lane; CUMV[oi] = xx; DTV[oi] = dtv; } }
        for (int it = blockIdx.x * 512 + tid; it < (T / 8) * 128; it += F.G * 512) {
            const int ch = it & 127, seg = it >> 7, r0 = seg * 8, s0 = r0 & (SEQ - 1), col = DI + 8 * ch;
            u32x4 rw[11];
#pragma unroll
            for (int q = 0; q < 11; ++q) { const int sr = s0 - 3 + q; const int rc = sr < 0 ? 0 : sr; rw[q] = *(const u32x4*)(XBC + (size_t)(r0 - s0 + rc) * CONVD + col); }
#pragma unroll
            for (int q = 0; q < 3; ++q) if (s0 - 3 + q < 0) rw[q] = (u32x4){0u, 0u, 0u, 0u};
#pragma unroll
            for (int hf = 0; hf < 2; ++hf) {
                f32x4 wq[5];
#pragma unroll
                for (int k = 0; k < 4; ++k) wq[k] = *(const f32x4*)(conv_w + k * CONVD + col + 4 * hf);
                wq[4] = *(const f32x4*)(conv_b + col + 4 * hf);
#pragma unroll
                for (int jj = 0; jj < 8; ++jj) { f32x4 aq = wq[4];
#pragma unroll
                    for (int k = 0; k < 4; ++k) { const u32x4 rq = rw[jj + k]; const unsigned a0 = hf ? rq.z : rq.x, a1 = hf ? rq.w : rq.y; aq += wq[k] * (f32x4){bflo(a0), bfhi(a0), bflo(a1), bfhi(a1)}; }
#pragma unroll
                    for (int e = 0; e < 4; ++e) aq[e] = silu_f(aq[e]);
                    u32x2 o_; o_.x = pk2(aq[0], aq[1]); o_.y = pk2(aq[2], aq[3]);
                    *(u32x2*)(BCACT + (size_t)(r0 + jj) * 1024 + 8 * ch + 4 * hf) = o_; }
            }
        }
    }
    SEAM(2);

    if (IN(3)) { PH_LOCALS
#if NAIVE_SCAN
        const float* conv_w = args.in[2]; const float* conv_b = args.in[3]; const float* dt_bias = args.in[4]; const float* a_log = args.in[5]; const float* dsk = args.in[6];
        for (int item = blockIdx.x; item < NB * NH; item += F.G) {
            if (wave >= 2) continue;
            LAS float* sB = (LAS float*)(F.lds + wave * 8192); LAS float* sC = sB + 128; LAS float* cwl = sC + 128;
            const int b = item / NH, h = item % NH, g = h / 8, pp = 32 * wave + (lane & 31), nh = lane >> 5;
            int col[5]; col[0] = h * HP + pp; col[1] = DI + g * NS + lane; col[2] = col[1] + 64; col[3] = DI + NG * NS + g * NS + lane; col[4] = col[3] + 64;
            float hist[5][3];
#pragma unroll
            for (int c = 0; c < 5; ++c) { cwl[(c * 5 + 4) * 64 + lane] = conv_b[col[c]];
#pragma unroll
                for (int k = 0; k < 4; ++k) cwl[(c * 5 + k) * 64 + lane] = conv_w[k * CONVD + col[c]];
#pragma unroll
                for (int k = 0; k < 3; ++k) hist[c][k] = 0.f; }
            LDS_WAIT();
            const float dtb = dt_bias[h], av = -__expf(a_log[h]), dh = dsk[h];
            float hst[64];
#pragma unroll
            for (int n = 0; n < 64; ++n) hst[n] = 0.f;
            for (int t = 0; t < SEQ; ++t) {
                const size_t row = (size_t)b * SEQ + t;
                float v[5];
#pragma unroll
                for (int c = 0; c < 5; ++c) { const float cur = bf2f(XBC[row * CONVD + col[c]]);
                    float a = cwl[(c * 5 + 4) * 64 + lane] + cwl[(c * 5) * 64 + lane] * hist[c][0] + cwl[(c * 5 + 1) * 64 + lane] * hist[c][1] + cwl[(c * 5 + 2) * 64 + lane] * hist[c][2] + cwl[(c * 5 + 3) * 64 + lane] * cur;
                    hist[c][0] = hist[c][1]; hist[c][1] = hist[c][2]; hist[c][2] = cur; v[c] = silu_f(a); }
                const float raw = DTRAW[row * NH + h] + dtb;
                const float dtv = raw > 20.f ? raw : log1pf(__expf(raw));
                const float dA = __expf(dtv * av);
                sB[lane] = v[1]; sB[lane + 64] = v[2]; sC[lane] = v[3]; sC[lane + 64] = v[4];
                LDS_WAIT(); asm volatile("" ::: "memory");
                const float xd = dtv * v[0]; float y = 0.f;
#pragma unroll
                for (int n = 0; n < 64; n += 4) { const f32x4 bb = *(const LAS f32x4*)(sB + 64 * nh + n), cc = *(const LAS f32x4*)(sC + 64 * nh + n);
                    hst[n] = hst[n] * dA + xd * bb.x; y += cc.x * hst[n];
                    hst[n + 1] = hst[n + 1] * dA + xd * bb.y; y += cc.y * hst[n + 1];
                    hst[n + 2] = hst[n + 2] * dA + xd * bb.z; y += cc.z * hst[n + 2];
                    hst[n + 3] = hst[n + 3] * dA + xd * bb.w; y += cc.w * hst[n + 3]; }
                LDS_WAIT(); asm volatile("" ::: "memory");
                y += __shfl_xor(y, 32);
                y += dh * v[0];
                const float zv = bf2f(Zb[row * DI + h * HP + pp]);
                const float yg = y * silu_f(zv);
                float sq = (lane < 32) ? yg * yg : 0.f; sq = wave_sum(sq);
                if (lane < 32) Zb[row * DI + h * HP + pp] = (bf16)f2bf(yg);
                if (lane == 0) SSQ[row * 64 + h * 2 + wave] = sq;
            }
        }
#else
        const float* conv_w = args.in[2]; const float* conv_b = args.in[3]; const float* dt_bias = args.in[4]; const float* a_log = args.in[5]; const float* dsk = args.in[6];
        typedef short v4i16 __attribute__((ext_vector_type(4)));
        constexpr int SXB = 144, SBB = 272;
        constexpr int XS_OFF = 0, XW_OFF = 18432, BM_OFF = 36864, CM_OFF = 71680, WM_OFF = 89088, HB_OFF = 98304, VEC_OFF = 133120, CW_OFF = 134144;
        static_assert(CW_OFF + 5 * 64 * 4 <= LDSCTL_OFF, "scan LDS map");
        LAS unsigned char* Lb = F.lds;
        LAS float* cumL = (LAS float*)(Lb + VEC_OFF);
        LAS float* dtL = cumL + 128;
        LAS float* cwl = (LAS float*)(Lb + CW_OFF);
        const int r16 = lane & 15, q4 = lane >> 4;
#define TR8(dst, base_off, stride, k0, c0) do { const LAS unsigned char* _a = Lb + (base_off) + ((k0) + 8 * q4 + (r16 >> 2)) * (stride) + ((c0) + 4 * (lane & 3)) * 2; \
        const v4i16 _lo = __builtin_amdgcn_ds_read_tr16_b64_v4i16((LAS v4i16*)_a), _hi = __builtin_amdgcn_ds_read_tr16_b64_v4i16((LAS v4i16*)(_a + 4 * (stride))); \
        dst = (bf16x8){_lo[0], _lo[1], _lo[2], _lo[3], _hi[0], _hi[1], _hi[2], _hi[3]}; } while (0)
        if (blockIdx.x < NB * NH) {
            const int item = blockIdx.x; const int b = item / NH, h = item % NH, g = h >> 3;
            __syncthreads();
            for (int i = tid; i < 5 * 64; i += 512) { const int k = i >> 6, cl = i & 63; cwl[i] = k < 4 ? conv_w[k * CONVD + h * HP + cl] : conv_b[h * HP + cl]; }
            for (int i = tid; i < SBB * 64 / 4; i += 512) ((LAS unsigned*)(Lb + HB_OFF))[i] = 0u;
            const float dh = dsk[h];
            const int sj = tid >> 3, sxc = tid & 7;
            const bf16* BCACT = (const bf16*)(ws + WS_BCACT);
            const float* cvp = (const float*)(ws + (tid < 64 ? WS_CUMV : WS_DTV)) + ((size_t)b * NH + h) * SEQ + (tid & 63);
            const size_t row0 = (size_t)b * SEQ;
            f32x4 hacc[4];
#pragma unroll
            for (int i = 0; i < 4; ++i) hacc[i] = (f32x4){0.f, 0.f, 0.f, 0.f};
            u32x4 xrA[4], brA[2], crA[2], xrB[4], brB[2], crB[2]; u32x2 zr[2]; float cv = 0.f;
            const int ti = wave & 3, wh = wave >> 2, irow = 16 * ti + r16;
#define SC_LOAD(c, S) do { _Pragma("unroll") for (int k = 0; k < 4; ++k) { const int rr = (c) * 64 + sj - 3 + k; const int rc = rr < 0 ? 0 : rr; \
                xr##S[k] = *(const u32x4*)(XBC + (row0 + rc) * CONVD + h * HP + 8 * sxc); } \
            _Pragma("unroll") for (int i = 0; i < 2; ++i) { const int idx = tid + 512 * i; const bf16* bp_ = BCACT + (row0 + (c) * 64 + (idx >> 4)) * 1024 + g * NS + 8 * (idx & 15); \
                br##S[i] = *(const u32x4*)bp_; cr##S[i] = *(const u32x4*)(bp_ + 512); } } while (0)
#define SC_LOADZ(c) do { _Pragma("unroll") for (int tt = 0; tt < 2; ++tt) zr[tt] = *(const u32x2*)(Zb + (row0 + (c) * 64 + irow) * DI + h * HP + 16 * (2 * wh + tt) + 4 * q4); } while (0)
#define SC_STAGE(c, S) do { const int pr_ = ((c) & 1) * 64, tb_ = (c) & 1; const float wj = __expf(cumL[pr_ + 63] - cumL[pr_ + sj]) * dtL[pr_ + sj]; \
                _Pragma("unroll") for (int k = 0; k < 3; ++k) if ((c) * 64 + sj - 3 + k < 0) xr##S[k] = (u32x4){0u, 0u, 0u, 0u};     \
                _Pragma("unroll") for (int hf = 0; hf < 2; ++hf) { f32x4 aq = *(const LAS f32x4*)(cwl + 4 * 64 + 8 * sxc + 4 * hf); \
                    _Pragma("unroll") for (int k = 0; k < 4; ++k) { const f32x4 wq = *(const LAS f32x4*)(cwl + k * 64 + 8 * sxc + 4 * hf); const unsigned r0_ = hf ? xr##S[k].z : xr##S[k].x, r1_ = hf ? xr##S[k].w : xr##S[k].y; \
                        aq += wq * (f32x4){bflo(r0_), bfhi(r0_), bflo(r1_), bfhi(r1_)}; } \
                    _Pragma("unroll") for (int e = 0; e < 4; ++e) aq[e] = silu_f(aq[e]); \
                    u32x2 o_; o_.x = pk2(aq[0], aq[1]); o_.y = pk2(aq[2], aq[3]); \
                    *(LAS u32x2*)(Lb + XS_OFF + tb_ * 9216 + sj * SXB + 16 * sxc + 8 * hf) = o_; \
                    o_.x = pk2(aq[0] * wj, aq[1] * wj); o_.y = pk2(aq[2] * wj, aq[3] * wj); \
                    *(LAS u32x2*)(Lb + XW_OFF + tb_ * 9216 + sj * SXB + 16 * sxc + 8 * hf) = o_; } \
                _Pragma("unroll") for (int i = 0; i < 2; ++i) { const int idx = tid + 512 * i; \
                    *(LAS u32x4*)(Lb + BM_OFF + tb_ * 17408 + (idx >> 4) * SBB + 16 * (idx & 15)) = br##S[i]; *(LAS u32x4*)(Lb + CM_OFF + (idx >> 4) * SBB + 16 * (idx & 15)) = cr##S[i]; } } while (0)
            if (tid < 128) { cumL[(tid >> 6) * 128 + (tid & 63)] = cvp[0]; cv = cvp[64]; }
            SC_LOAD(0, A); SC_LOADZ(0);
            __syncthreads();
            SC_STAGE(0, A);
            SC_LOAD(1, B);
            __syncthreads();
            for (int c2 = 0; c2 < SEQ / 64; c2 += 2) {
                { const int c = c2; const int pr = (c & 1) * 64, tb = c & 1; const int hb_cur = HB_OFF + (c & 1) * (SBB * 64), hb_nxt = HB_OFF + ((c & 1) ^ 1) * (SBB * 64);
                  if (tid < 128) { if (c + 1 < SEQ / 64) cumL[(tid >> 6) * 128 + (pr ^ 64) + (tid & 63)] = cv; if (c + 2 < SEQ / 64) cv = cvp[(c + 2) * 64]; }
                  if (c + 2 < SEQ / 64) SC_LOAD(c + 2, A);
                  bf16x8 cf[4], bfr[2][4];
#pragma unroll
                  for (int ks = 0; ks < 4; ++ks) cf[ks] = *(const LAS bf16x8*)(Lb + CM_OFF + irow * SBB + (32 * ks + 8 * q4) * 2);
#pragma unroll
                  for (int tt = 0; tt < 2; ++tt)
#pragma unroll
                      for (int ks = 0; ks < 4; ++ks) bfr[tt][ks] = *(const LAS bf16x8*)(Lb + BM_OFF + tb * 17408 + (16 * (2 * wh + tt) + r16) * SBB + (32 * ks + 8 * q4) * 2);
                  const float ci = cumL[pr + irow];
                  f32x4 cjv[2], djv[2];
#pragma unroll
                  for (int tt = 0; tt < 2; ++tt) { cjv[tt] = *(const LAS f32x4*)(cumL + pr + 16 * (2 * wh + tt) + 4 * q4); djv[tt] = *(const LAS f32x4*)(dtL + pr + 16 * (2 * wh + tt) + 4 * q4); }
                  f32x4 ga[2] = {{0.f, 0.f, 0.f, 0.f}, {0.f, 0.f, 0.f, 0.f}};
#pragma unroll
                  for (int ks = 0; ks < 4; ++ks)
#pragma unroll
                      for (int tt = 0; tt < 2; ++tt) ga[tt] = __builtin_amdgcn_mfma_f32_16x16x32_bf16(bfr[tt][ks], cf[ks], ga[tt], 0, 0, 0);
#pragma unroll
                  for (int tt = 0; tt < 2; ++tt) { const int j0 = 16 * (2 * wh + tt) + 4 * q4; float wv[4];
#pragma unroll
                      for (int r = 0; r < 4; ++r) { const int j = j0 + r; float v = ga[tt][r] * __expf(ci - cjv[tt][r]) * djv[tt][r]; v = (j <= irow) ? v : 0.f; if (j == irow) v += dh; wv[r] = v; }
                      u32x2 w_; w_.x = pk2(wv[0], wv[1]); w_.y = pk2(wv[2], wv[3]);
                      *(LAS u32x2*)(Lb + WM_OFF + irow * SXB + j0 * 2) = w_; }
                  WG_BAR();
                  if (c + 1 < SEQ / 64) SC_STAGE(c + 1, B);
                  { bf16x8 wf[2], xa[2][2], ha[2][4];
#pragma unroll
                    for (int ks = 0; ks < 2; ++ks) wf[ks] = *(const LAS bf16x8*)(Lb + WM_OFF + irow * SXB + (32 * ks + 8 * q4) * 2);
#pragma unroll
                    for (int tt = 0; tt < 2; ++tt) {
#pragma unroll
                        for (int ks = 0; ks < 2; ++ks) TR8(xa[tt][ks], XS_OFF + tb * 9216, SXB, 32 * ks, 16 * (2 * wh + tt));
#pragma unroll
                        for (int ks = 0; ks < 4; ++ks) ha[tt][ks] = *(const LAS bf16x8*)(Lb + hb_cur + (16 * (2 * wh + tt) + r16) * SBB + (32 * ks + 8 * q4) * 2); }
                    f32x4 yd[2] = {{0.f, 0.f, 0.f, 0.f}, {0.f, 0.f, 0.f, 0.f}}, yo[2] = {{0.f, 0.f, 0.f, 0.f}, {0.f, 0.f, 0.f, 0.f}};
#pragma unroll
                    for (int ks = 0; ks < 4; ++ks)
#pragma unroll
                        for (int tt = 0; tt < 2; ++tt) { yo[tt] = __builtin_amdgcn_mfma_f32_16x16x32_bf16(ha[tt][ks], cf[ks], yo[tt], 0, 0, 0); if (ks < 2) yd[tt] = __builtin_amdgcn_mfma_f32_16x16x32_bf16(xa[tt][ks], wf[ks], yd[tt], 0, 0, 0); }
                    const float ec = __expf(ci); float ssq = 0.f;
#pragma unroll
                    for (int tt = 0; tt < 2; ++tt) { const int tp = 2 * wh + tt;
                        const float z0 = bflo(zr[tt].x), z1 = bfhi(zr[tt].x), z2 = bflo(zr[tt].y), z3 = bfhi(zr[tt].y);
                        const float y0 = (yd[tt][0] + ec * yo[tt][0]) * silu_f(z0), y1 = (yd[tt][1] + ec * yo[tt][1]) * silu_f(z1), y2 = (yd[tt][2] + ec * yo[tt][2]) * silu_f(z2), y3 = (yd[tt][3] + ec * yo[tt][3]) * silu_f(z3);
                        ssq += (y0 * y0 + y1 * y1) + (y2 * y2 + y3 * y3);
                        u32x2 o_; o_.x = pk2(y0, y1); o_.y = pk2(y2, y3);
                        *(u32x2*)(Zb + (row0 + c * 64 + irow) * DI + h * HP + 16 * tp + 4 * q4) = o_; }
                    ssq += __shfl_xor(ssq, 16); ssq += __shfl_xor(ssq, 32);
                    if (q4 == 0) SSQ[(row0 + c * 64 + irow) * 64 + h * 2 + wh] = ssq; }
                  if (c + 1 < SEQ / 64) SC_LOADZ(c + 1);
                  { const float eL = __expf(cumL[pr + 63]);
                    bf16x8 ba[2], xb[2][4];
#pragma unroll
                    for (int ks = 0; ks < 2; ++ks) { TR8(ba[ks], BM_OFF + tb * 17408, SBB, 32 * ks, 16 * wave);
#pragma unroll
                        for (int tp = 0; tp < 4; ++tp) TR8(xb[ks][tp], XW_OFF + tb * 9216, SXB, 32 * ks, 16 * tp); }
#pragma unroll
                    for (int tp = 0; tp < 4; ++tp) hacc[tp] = hacc[tp] * eL;
#pragma unroll
                    for (int ks = 0; ks < 2; ++ks)
#pragma unroll
                        for (int tp = 0; tp < 4; ++tp) hacc[tp] = __builtin_amdgcn_mfma_f32_16x16x32_bf16(ba[ks], xb[ks][tp], hacc[tp], 0, 0, 0);
#pragma unroll
                    for (int tp = 0; tp < 4; ++tp) { u32x2 o_; o_.x = pk2(hacc[tp][0], hacc[tp][1]); o_.y = pk2(hacc[tp][2], hacc[tp][3]);
                        *(LAS u32x2*)(Lb + hb_nxt + (16 * tp + r16) * SBB + (16 * wave + 4 * q4) * 2) = o_; } }
                  WG_BAR();
                }
                { const int c = c2 + 1; const int pr = (c & 1) * 64, tb = c & 1; const int hb_cur = HB_OFF + (c & 1) * (SBB * 64), hb_nxt = HB_OFF + ((c & 1) ^ 1) * (SBB * 64);
                  if (tid < 128) { if (c + 1 < SEQ / 64) cumL[(tid >> 6) * 128 + (pr ^ 64) + (tid & 63)] = cv; if (c + 2 < SEQ / 64) cv = cvp[(c + 2) * 64]; }
                  if (c + 2 < SEQ / 64) SC_LOAD(c + 2, B);
                  bf16x8 cf[4], bfr[2][4];
#pragma unroll
                  for (int ks = 0; ks < 4; ++ks) cf[ks] = *(const LAS bf16x8*)(Lb + CM_OFF + irow * SBB + (32 * ks + 8 * q4) * 2);
#pragma unroll
                  for (int tt = 0; tt < 2; ++tt)
#pragma unroll
                      for (int ks = 0; ks < 4; ++ks) bfr[tt][ks] = *(const LAS bf16x8*)(Lb + BM_OFF + tb * 17408 + (16 * (2 * wh + tt) + r16) * SBB + (32 * ks + 8 * q4) * 2);
                  const float ci = cumL[pr + irow];
                  f32x4 cjv[2], djv[2];
#pragma unroll
                  for (int tt = 0; tt < 2; ++tt) { cjv[tt] = *(const LAS f32x4*)(cumL + pr + 16 * (2 * wh + tt) + 4 * q4); djv[tt] = *(const LAS f32x4*)(dtL + pr + 16 * (2 * wh + tt) + 4 * q4); }
                  f32x4 ga[2] = {{0.f, 0.f, 0.f, 0.f}, {0.f, 0.f, 0.f, 0.f}};
#pragma unroll
                  for (int ks = 0; ks < 4; ++ks)
#pragma unroll
                      for (int tt = 0; tt < 2; ++tt) ga[tt] = __builtin_amdgcn_mfma_f32_16x16x32_bf16(bfr[tt][ks], cf[ks], ga[tt], 0, 0, 0);
#pragma unroll
                  for (int tt = 0; tt < 2; ++tt) { const int j0 = 16 * (2 * wh + tt) + 4 * q4; float wv[4];
#pragma unroll
                      for (int r = 0; r < 4; ++r) { const int j = j0 + r; float v = ga[tt][r] * __expf(ci - cjv[tt][r]) * djv[tt][r]; v = (j <= irow) ? v : 0.f; if (j == irow) v += dh; wv[r] = v; }
                      u32x2 w_; w_.x = pk2(wv[0], wv[1]); w_.y = pk2(wv[2], wv[3]);
                      *(LAS u32x2*)(Lb + WM_OFF + irow * SXB + j0 * 2) = w_; }
                  WG_BAR();
                  if (c + 1 < SEQ / 64) SC_STAGE(c + 1, A);
                  { bf16x8 wf[2], xa[2][2], ha[2][4];
#pragma unroll
                    for (int ks = 0; ks < 2; ++ks) wf[ks] = *(const LAS bf16x8*)(Lb + WM_OFF + irow * SXB + (32 * ks + 8 * q4) * 2);
#pragma unroll
                    for (int tt = 0; tt < 2; ++tt) {
#pragma unroll
                        for (int ks = 0; ks < 2; ++ks) TR8(xa[tt][ks], XS_OFF + tb * 9216, SXB, 32 * ks, 16 * (2 * wh + tt));
#pragma unroll
                        for (int ks = 0; ks < 4; ++ks) ha[tt][ks] = *(const LAS bf16x8*)(Lb + hb_cur + (16 * (2 * wh + tt) + r16) * SBB + (32 * ks + 8 * q4) * 2); }
                    f32x4 yd[2] = {{0.f, 0.f, 0.f, 0.f}, {0.f, 0.f, 0.f, 0.f}}, yo[2] = {{0.f, 0.f, 0.f, 0.f}, {0.f, 0.f, 0.f, 0.f}};
#pragma unroll
                    for (int ks = 0; ks < 4; ++ks)
#pragma unroll
                        for (int tt = 0; tt < 2; ++tt) { yo[tt] = __builtin_amdgcn_mfma_f32_16x16x32_bf16(ha[tt][ks], cf[ks], yo[tt], 0, 0, 0); if (ks < 2) yd[tt] = __builtin_amdgcn_mfma_f32_16x16x32_bf16(xa[tt][ks], wf[ks], yd[tt], 0, 0, 0); }
                    const float ec = __expf(ci); float ssq = 0.f;
#pragma unroll
                    for (int tt = 0; tt < 2; ++tt) { const int tp = 2 * wh + tt;
                        const float z0 = bflo(zr[tt].x), z1 = bfhi(zr[tt].x), z2 = bflo(zr[tt].y), z3 = bfhi(zr[tt].y);
                        const float y0 = (yd[tt][0] + ec * yo[tt][0]) * silu_f(z0), y1 = (yd[tt][1] + ec * yo[tt][1]) * silu_f(z1), y2 = (yd[tt][2] + ec * yo[tt][2]) * silu_f(z2), y3 = (yd[tt][3] + ec * yo[tt][3]) * silu_f(z3);
                        ssq += (y0 * y0 + y1 * y1) + (y2 * y2 + y3 * y3);
                        u32x2 o_; o_.x = pk2(y0, y1); o_.y = pk2(y2, y3);
                        *(u32x2*)(Zb + (row0 + c * 64 + irow) * DI + h * HP + 16 * tp + 4 * q4) = o_; }
                    ssq += __shfl_xor(ssq, 16); ssq += __shfl_xor(ssq, 32);
                    if (q4 == 0) SSQ[(row0 + c * 64 + irow) * 64 + h * 2 + wh] = ssq; }
                  if (c + 1 < SEQ / 64) SC_LOADZ(c + 1);
                  { const float eL = __expf(cumL[pr + 63]);
                    bf16x8 ba[2], xb[2][4];
#pragma unroll
                    for (int ks = 0; ks < 2; ++ks) { TR8(ba[ks], BM_OFF + tb * 17408, SBB, 32 * ks, 16 * wave);
#pragma unroll
                        for (int tp = 0; tp < 4; ++tp) TR8(xb[ks][tp], XW_OFF + tb * 9216, SXB, 32 * ks, 16 * tp); }
#pragma unroll
                    for (int tp = 0; tp < 4; ++tp) hacc[tp] = hacc[tp] * eL;
#pragma unroll
                    for (int ks = 0; ks < 2; ++ks)
#pragma unroll
                        for (int tp = 0; tp < 4; ++tp) hacc[tp] = __builtin_amdgcn_mfma_f32_16x16x32_bf16(ba[ks], xb[ks][tp], hacc[tp], 0, 0, 0);
#pragma unroll
                    for (int tp = 0; tp < 4; ++tp) { u32x2 o_; o_.x = pk2(hacc[tp][0], hacc[tp][1]); o_.y = pk2(hacc[tp][2], hacc[tp][3]);
                        *(LAS u32x2*)(Lb + hb_nxt + (16 * tp + r16) * SBB + (16 * wave + 4 * q4) * 2) = o_; } }
                  WG_BAR();
                }
            }
        }
#undef SC_LOADZ
#undef TR8
#undef SC_LOAD
#undef SC_STAGE
#endif
    }
    SEAM(3);

    if (IN(4)) { PH_LOCALS
        { float pn = 0.f; u32x4 yn[4];
#define NM_LOAD(mm) do { pn = SSQ[(size_t)(mm) * 64 + lane]; _Pragma("unroll") for (int j = 0; j < 4; ++j) yn[j] = *(const u32x4*)(Zb + (size_t)(mm) * DI + j * 512 + lane * 8); } while (0)
          if (gw < T) NM_LOAD(gw);
          for (int m = gw; m < T; m += NGW) {
            float p = pn; u32x4 yw[4];
#pragma unroll
            for (int j = 0; j < 4; ++j) yw[j] = yn[j];
            if (m + NGW < T) NM_LOAD(m + NGW);
            p += dpp_mov<0xB1>(p); p += dpp_mov<0x4E>(p); p += dpp_mov<0x141>(p); p += dpp_mov<0x140>(p);
            bf16* yr = Zb + (size_t)m * DI;
#pragma unroll
            for (int j = 0; j < 4; ++j) { const float ss = __builtin_bit_cast(float, __builtin_amdgcn_readlane(__builtin_bit_cast(int, p), 16 * j)); const float rs = 1.f / sqrtf(ss * (1.f / 512.f) + RMS_EPS);
                u32x4 w = yw[j];
                w.x = pk2(bflo(w.x) * rs, bfhi(w.x) * rs); w.y = pk2(bflo(w.y) * rs, bfhi(w.y) * rs); w.z = pk2(bflo(w.z) * rs, bfhi(w.z) * rs); w.w = pk2(bflo(w.w) * rs, bfhi(w.w) * rs);
                *(u32x4*)(yr + j * 512 + lane * 8) = w; }
          }
#undef NM_LOAD
        }
        LAS float* scr = (LAS float*)(F.lds + wave * 16384);
        constexpr int I_QKV = (D / 64) * (3 * D / 32), I_O = (D / 64) * (D / 32), I_G = (D / 64) * (DFF / 32), I_D = (DFF / 64) * (D / 32);
        constexpr int I_MOE = 2 * NE * (2 * I_G + I_D);
        for (int it = gw; it < I_QKV + I_O + I_MOE; it += NGW) {
            int r = it;
            if (r < I_QKV) { transpose_item(args.in[9], D, 3 * D, (bf16*)(ws + WS_WQKV), 0, 0, nullptr, scr, r, lane); continue; } r -= I_QKV;
            if (r < I_O) { transpose_item(args.in[12], D, D, (bf16*)(ws + WS_WO), 0, 0, nullptr, scr, r, lane); continue; } r -= I_O;
            const int le = r / (2 * I_G + I_D), L = le / NE, e = le % NE; r -= le * (2 * I_G + I_D);
            bf16* wgu = (bf16*)(ws + (L ? WS_WGU1 : WS_WGU0)) + (size_t)e * 1024 * D; bf16* wd = (bf16*)(ws + (L ? WS_WD1 : WS_WD0)) + (size_t)e * D * DFF;
            if (r < I_G) { transpose_item(args.in[16] + (size_t)le * D * DFF, D, DFF, wgu, 0, 1, nullptr, scr, r, lane); continue; } r -= I_G;
            if (r < I_G) { transpose_item(args.in[17] + (size_t)le * D * DFF, D, DFF, wgu, 0, 2, nullptr, scr, r, lane); continue; } r -= I_G;
            transpose_item(args.in[18] + (size_t)le * DFF * D, DFF, D, wd, 0, 0, nullptr, scr, r, lane);
        }
    }
    SEAM(4);

    if (IN(5)) { PH_LOCALS
        pg8::DenseOrder S; S.init(T, D, F.G, (int)blockIdx.x, DI);
        pg8::EpiPlain E{(bf16*)(ws + WS_MIX1), D, nullptr, 0, 1.f};
        pg8::gemm_phase<pg8::EpiPlain, pg8::DenseOrder>(F.lds, Zb, Wt_out, DI, S, E);
    }
    SEAM(5);

    layer_tail<0>(args, F, bar, lo, hi);
    SEAM(9);

    if (IN(10)) { PH_LOCALS
        pg8::DenseOrder S; S.init(T, 3 * D, F.G, (int)blockIdx.x, D);
        pg8::EpiPlain E{(bf16*)(ws + WS_QKV), 3 * D, args.in[10], D, 0.125f};
        pg8::gemm_phase<pg8::EpiPlain, pg8::DenseOrder>(F.lds, (const bf16*)(ws + WS_X2B), (const bf16*)(ws + WS_WQKV), D, S, E);
    }
    SEAM(10);
    if (IN(11)) { PH_LOCALS
#if NAIVE_ATTN
        const bf16* QKV = (const bf16*)(ws + WS_QKV); bf16* AO = (bf16*)(ws + WS_AO); const float* rel = args.in[11];
        for (int idx = blockIdx.x * 512 + tid; idx < NB * AH * SEQ; idx += F.G * 512) {
            const int s = idx % SEQ, bh = idx / SEQ, hh = bh % AH, b = bh / AH, c = s / 64;
            const bf16* qp = QKV + ((size_t)b * SEQ + s) * (3 * D) + hh * AD;
            float q[AD], o[AD];
#pragma unroll
            for (int d = 0; d < AD; ++d) { q[d] = bf2f(qp[d]); o[d] = 0.f; }
            float mx = -1e30f, l = 0.f;
            const int k0 = (c - LEFTC) * 64 < 0 ? 0 : (c - LEFTC) * 64, k1 = c * 64 + 64;
            for (int kp = k0; kp < k1; ++kp) {
                const bf16* kr = QKV + ((size_t)b * SEQ + kp) * (3 * D) + D + hh * AD; const bf16* vr = kr + D;
                float sc = 0.f;
#pragma unroll
                for (int d = 0; d < AD; d += 2) { const unsigned w = *(const unsigned*)(kr + d); sc += q[d] * bflo(w) + q[d + 1] * bfhi(w); }
                int dist = s - kp; dist = dist < -MAXREL ? -MAXREL : (dist > MAXREL ? MAXREL : dist);
                sc += rel[(dist + MAXREL) * AH + hh];
                const float mn = fmaxf(mx, sc), f = __expf(mx - mn), p = __expf(sc - mn);
                l = l * f + p; mx = mn;
#pragma unroll
                for (int d = 0; d < AD; d += 2) { const unsigned w = *(const unsigned*)(vr + d); o[d] = o[d] * f + p * bflo(w); o[d + 1] = o[d + 1] * f + p * bfhi(w); }
            }
            const float il = 1.f / l; bf16* op = AO + ((size_t)b * SEQ + s) * D + hh * AD;
#pragma unroll
            for (int d = 0; d < AD; d += 2) *(unsigned*)(op + d) = pk2(o[d] * il, o[d + 1] * il);
        }
#else
        const bf16* QKV = (const bf16*)(ws + WS_QKV); bf16* AO = (bf16*)(ws + WS_AO); const float* rel = args.in[11];
        typedef short v4i16 __attribute__((ext_vector_type(4)));
        constexpr int SKB = 144, KB_OFF = 0, VB_OFF = 18432, TB_OFF = 36864; constexpr float LOG2E = 1.4426950408889634f;
        LAS unsigned char* Lb = F.lds; LAS float* tb = (LAS float*)(Lb + TB_OFF);
        const int r16 = lane & 15, q4 = lane >> 4, wq = wave >> 2;
        const int NU = NB * AH * (SEQ / 128), per = (NU + F.G - 1) / F.G;
        int hprev = -1;
        for (int ui = 0; ui < per; ++ui) {
            const int u = F.vcu * per + ui; if (u >= NU) break;
            const int bh = u >> 5, cp = u & 31, b = bh >> 4, hh = bh & 15, c0 = 2 * cp;
            __syncthreads();
            if (hh != hprev) { for (int i = tid; i < 2 * MAXREL + 1; i += 512) tb[i] = rel[i * AH + hh] * LOG2E; hprev = hh; }
            const int cw = c0 + wq, qrow = 64 * cw + 16 * (wave & 3) + r16;
            const size_t tok0 = (size_t)b * SEQ;
            bf16x8 qf[2];
#pragma unroll
            for (int ds = 0; ds < 2; ++ds) qf[ds] = *(const bf16x8*)(QKV + (tok0 + qrow) * (3 * D) + hh * AD + 32 * ds + 8 * q4);
            f32x4 oacc[4];
#pragma unroll
            for (int i = 0; i < 4; ++i) oacc[i] = (f32x4){0.f, 0.f, 0.f, 0.f};
            float mrun = -1e30f, lrun = 0.f;
            const int kt_lo = c0 < 8 ? 8 - c0 : 0;
            const int kr = tid >> 3, pc = tid & 7;
            const bf16* kvp = QKV + (tok0 + kr) * (3 * D) + D + hh * AD + 8 * pc;
            u32x4 kreg, vreg;
            { const size_t co = (size_t)(c0 - 8 + kt_lo) * 64 * (3 * D); kreg = *(const u32x4*)(kvp + co); vreg = *(const u32x4*)(kvp + co + D); }
            *(LAS u32x4*)(Lb + KB_OFF + (kt_lo & 1) * 9216 + kr * SKB + pc * 16) = kreg; *(LAS u32x4*)(Lb + VB_OFF + (kt_lo & 1) * 9216 + kr * SKB + pc * 16) = vreg;
            __syncthreads();
            for (int kt = kt_lo; kt < 10; ++kt) {
                const int chunk = c0 - 8 + kt;
                if (kt + 1 < 10) { const size_t co = (size_t)(chunk + 1) * 64 * (3 * D); kreg = *(const u32x4*)(kvp + co); vreg = *(const u32x4*)(kvp + co + D); }
                if (kt >= wq && kt <= wq + 8) {
                    const LAS unsigned char* Kb = Lb + KB_OFF + (kt & 1) * 9216; const LAS unsigned char* Vb = Lb + VB_OFF + (kt & 1) * 9216;
                    f32x4 sc[4];
#pragma unroll
                    for (int t = 0; t < 4; ++t) { sc[t] = (f32x4){0.f, 0.f, 0.f, 0.f};
#pragma unroll
                        for (int ds = 0; ds < 2; ++ds) { const bf16x8 kf = *(const LAS bf16x8*)(Kb + (16 * t + r16) * SKB + (32 * ds + 8 * q4) * 2); sc[t] = __builtin_amdgcn_mfma_f32_16x16x32_bf16(kf, qf[ds], sc[t], 0, 0, 0); } }
                    if (cw - chunk >= 3) { const float bc = tb[2 * MAXREL];
#pragma unroll
                        for (int t = 0; t < 4; ++t) sc[t] = sc[t] * LOG2E + bc;
                    } else {
#pragma unroll
                        for (int t = 0; t < 4; ++t)
#pragma unroll
                            for (int r = 0; r < 4; ++r) { int dist = qrow - (64 * chunk + 16 * t + 4 * q4 + r); dist = dist < -MAXREL ? -MAXREL : (dist > MAXREL ? MAXREL : dist); sc[t][r] = sc[t][r] * LOG2E + tb[dist + MAXREL]; }
                    }
                    float mx = fmaxf(fmaxf(sc[0][0], sc[0][1]), fmaxf(sc[0][2], sc[0][3]));
#pragma unroll
                    for (int t = 1; t < 4; ++t) mx = fmaxf(mx, fmaxf(fmaxf(sc[t][0], sc[t][1]), fmaxf(sc[t][2], sc[t][3])));
                    mx = fmaxf(mx, __shfl_xor(mx, 16)); mx = fmaxf(mx, __shfl_xor(mx, 32));
                    const float mnew = fmaxf(mrun, mx), alpha = __builtin_amdgcn_exp2f(mrun - mnew); mrun = mnew;
                    float ls = 0.f;
#pragma unroll
                    for (int t = 0; t < 4; ++t)
#pragma unroll
                        for (int r = 0; r < 4; ++r) { sc[t][r] = __builtin_amdgcn_exp2f(sc[t][r] - mnew); ls += sc[t][r]; }
                    lrun = lrun * alpha + ls;
#pragma unroll
                    for (int i = 0; i < 4; ++i) oacc[i] = oacc[i] * alpha;
                    bf16x8 pb[2];
#pragma unroll
                    for (int kk = 0; kk < 2; ++kk) { u32x4 w_; w_.x = pk2(sc[2 * kk][0], sc[2 * kk][1]); w_.y = pk2(sc[2 * kk][2], sc[2 * kk][3]); w_.z = pk2(sc[2 * kk + 1][0], sc[2 * kk + 1][1]); w_.w = pk2(sc[2 * kk + 1][2], sc[2 * kk + 1][3]); pb[kk] = __builtin_bit_cast(bf16x8, w_); }
#pragma unroll
                    for (int dt = 0; dt < 4; ++dt)
#pragma unroll
                        for (int kk = 0; kk < 2; ++kk) { const LAS unsigned char* va_ = Vb + (32 * kk + 4 * q4 + (r16 >> 2)) * SKB + (16 * dt + 4 * (lane & 3)) * 2;
                            const v4i16 lo_ = __builtin_amdgcn_ds_read_tr16_b64_v4i16((LAS v4i16*)va_), hi_ = __builtin_amdgcn_ds_read_tr16_b64_v4i16((LAS v4i16*)(va_ + 16 * SKB));
                            const bf16x8 vf = (bf16x8){lo_[0], lo_[1], lo_[2], lo_[3], hi_[0], hi_[1], hi_[2], hi_[3]};
                            oacc[dt] = __builtin_amdgcn_mfma_f32_16x16x32_bf16(vf, pb[kk], oacc[dt], 0, 0, 0); }
                }
                if (kt + 1 < 10) { *(LAS u32x4*)(Lb + KB_OFF + ((kt + 1) & 1) * 9216 + kr * SKB + pc * 16) = kreg; *(LAS u32x4*)(Lb + VB_OFF + ((kt + 1) & 1) * 9216 + kr * SKB + pc * 16) = vreg; }
                WG_BAR();
            }
            lrun += __shfl_xor(lrun, 16); lrun += __shfl_xor(lrun, 32);
            const float il = 1.f / lrun; bf16* op = AO + (tok0 + qrow) * D + hh * AD + 4 * q4;
#pragma unroll
            for (int dt = 0; dt < 4; ++dt) { u32x2 o_; o_.x = pk2(oacc[dt][0] * il, oacc[dt][1] * il); o_.y = pk2(oacc[dt][2] * il, oacc[dt][3] * il); *(u32x2*)(op + 16 * dt) = o_; }
        }
#endif
    }
    SEAM(11);
    if (IN(12)) { PH_LOCALS
        pg8::DenseOrder S; S.init(T, D, F.G, (int)blockIdx.x, D);
        pg8::EpiPlain E{(bf16*)(ws + WS_MIX2), D, args.in[13], 0, 1.f};
        pg8::gemm_phase<pg8::EpiPlain, pg8::DenseOrder>(F.lds, (const bf16*)(ws + WS_AO), (const bf16*)(ws + WS_WO), D, S, E);
    }
    SEAM(12);
    layer_tail<1>(args, F, bar, lo, hi);
#undef IN
#undef SEAM
}

extern "C" void kernel_launch(void* const* d_in, const int* in_sizes, int n_in, void* d_out, int out_size, void* d_ws, size_t ws_size, hipStream_t stream) {
    static int grid = 0;
    if (grid == 0) {
        if (n_in != 23 || in_sizes[0] != T * D || out_size != T * D || ws_size < WS_END) { fprintf(stderr, "kernel_launch: unexpected shapes / workspace (n_in %d, ws %zu); nothing launched\n", n_in, ws_size); grid = -1; return; }
        int dev = 0, cus = 0, per_cu = 0;
        if (hipGetDevice(&dev) != hipSuccess || hipDeviceGetAttribute(&cus, hipDeviceAttributeMultiprocessorCount, dev) != hipSuccess) { grid = -1; return; }
        if (hipFuncSetAttribute((const void*)fwd_kernel, hipFuncAttributeMaxDynamicSharedMemorySize, LDS_BYTES) != hipSuccess) { fprintf(stderr, "kernel_launch: hipFuncSetAttribute failed\n"); grid = -1; return; }
        if (hipOccupancyMaxActiveBlocksPerMultiprocessor(&per_cu, (const void*)fwd_kernel, 512, LDS_BYTES) != hipSuccess || per_cu < 1) fprintf(stderr, "kernel_launch: occupancy query reports %d\n", per_cu);
        (void)hipGetLastError();
        grid = cus;
    }
    if (grid < 0) return;
    if (hipMemsetAsync((char*)d_ws + WS_CTL, 0, CTL_ZERO_BYTES, stream) != hipSuccess) return;
    Args a{};
    for (int i = 0; i < 23; ++i) a.in[i] = (const float*)d_in[i];
    a.out = (float*)d_out; a.ws = (unsigned char*)d_ws;
    if (MK_N_LAUNCHES == 1) { a.ph_lo = 0; a.ph_hi = NPHASE; hipLaunchKernelGGL(fwd_kernel, dim3(grid), dim3(512), LDS_BYTES, stream, a);
#ifdef PROBE_MASK
        for (int p = 0; p < NPHASE; ++p) if ((PROBE_MASK >> p) & 1) { a.ph_lo = p; a.ph_hi = p + 1; hipLaunchKernelGGL(fwd_kernel, dim3(grid), dim3(512), LDS_BYTES, stream, a); }
#endif
    }
    else for (int p = 0; p < NPHASE; ++p) { a.ph_lo = p; a.ph_hi = p + 1; hipLaunchKernelGGL(fwd_kernel, dim3(grid), dim3(512), LDS_BYTES, stream, a); }
}
```

```cpp
#include <hip/hip_runtime.h>
#include <cstdio>
#include <cstdint>

#ifndef MK_N_LAUNCHES
#define MK_N_LAUNCHES 1
#endif
#ifndef NAIVE_SCAN
#define NAIVE_SCAN 0
#endif
#ifndef NAIVE_ATTN
#define NAIVE_ATTN 0
#endif

#define LAS __attribute__((address_space(3)))
#define GAS __attribute__((address_space(1)))
typedef unsigned short bf16;
typedef short bf16x8 __attribute__((ext_vector_type(8)));
typedef float f32x4 __attribute__((ext_vector_type(4)));
typedef float f32x2 __attribute__((ext_vector_type(2)));
typedef unsigned u32x4 __attribute__((ext_vector_type(4)));
typedef unsigned u32x2 __attribute__((ext_vector_type(2)));
typedef GAS unsigned gu32;

constexpr int NB = 8, SEQ = 4096, D = 1024, T = NB * SEQ;
constexpr int DI = 2048, NH = 32, HP = 64, NG = 4, NS = 128, CONVD = 3072, INP = 5152, NZX = 5120;
constexpr int AH = 16, AD = 64, LEFTC = 8, MAXREL = 128;
constexpr int NE = 16, DFF = 512;
constexpr float ALPHA = 1.4142135623730951f;
constexpr float LN_EPS = 1e-5f, RMS_EPS = 1e-5f;
constexpr int NPHASE = 17;
constexpr int MAXTILES = 272;

constexpr size_t MiB = 1u << 20;
constexpr size_t WS_CTL = 0, CTL_ZERO_BYTES = 1 * MiB;
constexpr size_t WS_WIN = 1 * MiB;
constexpr size_t WS_WOUT = 12 * MiB;
constexpr size_t WS_XB = 16 * MiB;
constexpr size_t WS_BCACT = 16 * MiB;
constexpr size_t WS_WGU0 = 16 * MiB, WS_WD0 = 48 * MiB, WS_WQKV = 64 * MiB, WS_WO = 70 * MiB, WS_WGU1 = 72 * MiB, WS_WD1 = 104 * MiB;
constexpr size_t WS_Z = 120 * MiB;
constexpr size_t WS_XBC = 248 * MiB;
constexpr size_t WS_DTRAW = 440 * MiB;
constexpr size_t WS_SSQ = 444 * MiB;
constexpr size_t WS_CUMV = 452 * MiB;
constexpr size_t WS_DTV = 456 * MiB;
constexpr size_t WS_MIX1 = 248 * MiB;
constexpr size_t WS_X1B = 324 * MiB;
constexpr size_t WS_H0 = 120 * MiB;
constexpr size_t WS_Y20 = 188 * MiB;
constexpr size_t WS_X2B = 120 * MiB;
constexpr size_t WS_QKV = 188 * MiB;
constexpr size_t WS_AO = 380 * MiB;
constexpr size_t WS_MIX2 = 188 * MiB;
constexpr size_t WS_X3B = 256 * MiB;
constexpr size_t WS_H1 = 320 * MiB;
constexpr size_t WS_Y21 = 120 * MiB;
constexpr size_t WS_LIST = 500 * MiB;
constexpr size_t WS_INFO = 504 * MiB;
constexpr size_t WS_END = 512 * MiB;
constexpr int CW_TMO = 0;
constexpr int CW_CNT = 1024;
constexpr int CW_BAR = 4096;

constexpr int RING_BYTES = 131072;
constexpr int LDSCTL_OFF = 139264, MISC_OFF = LDSCTL_OFF + 320;
constexpr int TOKL_OFF = LDSCTL_OFF + 1024;
constexpr int MOE_OFF = TOKL_OFF + 6 * 1024;
constexpr int LDS_BYTES = 147456;

#define RLX_AGENT __ATOMIC_RELAXED, __HIP_MEMORY_SCOPE_AGENT
#define LDS_WAIT() asm volatile("s_waitcnt lgkmcnt(0)" ::: "memory")
#define VM_WAIT() asm volatile("s_waitcnt vmcnt(0)" ::: "memory")
#define WG_BAR() do { asm volatile("s_waitcnt lgkmcnt(0)" ::: "memory"); __builtin_amdgcn_s_barrier(); asm volatile("" ::: "memory"); } while (0)

__device__ __forceinline__ unsigned f2bf(float f) { unsigned u = __builtin_bit_cast(unsigned, f); return (u + 0x7fffu + ((u >> 16) & 1u)) >> 16; }
__device__ __forceinline__ unsigned pk2(float lo, float hi) { return f2bf(lo) | (f2bf(hi) << 16); }
__device__ __forceinline__ float bf2f(unsigned short b) { return __builtin_bit_cast(float, ((unsigned)b) << 16); }
__device__ __forceinline__ float bflo(unsigned w) { return __builtin_bit_cast(float, w << 16); }
__device__ __forceinline__ float bfhi(unsigned w) { return __builtin_bit_cast(float, w & 0xffff0000u); }
__device__ __forceinline__ float silu_f(float v) { return v * __builtin_amdgcn_rcpf(1.f + __expf(-v)); }
template <int CTRL> __device__ __forceinline__ float dpp_mov(float v) { return __builtin_bit_cast(float, __builtin_amdgcn_update_dpp(0, __builtin_bit_cast(int, v), CTRL, 0xF, 0xF, true)); }
__device__ __forceinline__ float wave_sum(float v) {
    v += dpp_mov<0xB1>(v); v += dpp_mov<0x4E>(v); v += dpp_mov<0x141>(v); v += dpp_mov<0x140>(v);
    const int vi = __builtin_bit_cast(int, v);
    return (__builtin_bit_cast(float, __builtin_amdgcn_readlane(vi, 0)) + __builtin_bit_cast(float, __builtin_amdgcn_readlane(vi, 16))) + (__builtin_bit_cast(float, __builtin_amdgcn_readlane(vi, 32)) + __builtin_bit_cast(float, __builtin_amdgcn_readlane(vi, 48)));
}

namespace pg8 {
constexpr int BM = 256, BK = 64, HALF = 128, HTB = HALF * BK * 2, STAGE_BYTES = 8 * HTB;
__device__ __forceinline__ int lds_byte(int r, int c) { const int st = (r >> 4) * 2 + (c >> 5), rr = r & 15, cc = c & 31, ob = rr * 64 + cc * 2; return st * 1024 + (ob ^ (((ob >> 9) & 1) << 5)); }
__device__ __forceinline__ void stage_rc(int b, int& R, int& C) { const int st = b / 1024, sb = b % 1024, swz = sb ^ (((sb >> 9) & 1) << 5); R = (st >> 1) * 16 + swz / 64; C = (st & 1) * 32 + (swz % 64) / 2; }
__device__ __forceinline__ int perm32(int rho) { const int n = rho >> 4, i = rho & 15; return 8 * (i >> 2) + 4 * n + (i & 3); }
__device__ __forceinline__ unsigned cvt_pk_bf16(float lo, float hi) { unsigned r; asm volatile("v_cvt_pk_bf16_f32 %0, %1, %2" : "=v"(r) : "v"(lo), "v"(hi)); return r; }

struct Unit { int pm, pn, bt, e; };

template <class Epi, class Sched>
__device__ __forceinline__ void gemm_phase(LAS unsigned char* lds, const bf16* A, const bf16* Bt, int K, const Sched& S, const Epi& E) {
    int tid = threadIdx.x; asm volatile("" : "+v"(tid));
    const int wid = __builtin_amdgcn_readfirstlane(tid >> 6), lane = tid & 63, wr = wid >> 2, wc = wid & 3, fr = lane & 15, fq = lane >> 4;
    const int nt = K / BK;
    int Rr[2], Cc[2]; unsigned voffB[2];
#pragma unroll
    for (int i = 0; i < 2; ++i) { stage_rc(tid * 16 + i * 8192, Rr[i], Cc[i]); const int Rb = (Rr[i] & ~31) + perm32(Rr[i] & 31); voffB[i] = (unsigned)(Rb * K + Cc[i]) * 2u; }
    const size_t kstep = (size_t)(BK * 2);
    const size_t hstep = (size_t)HALF * K * 2;
    const size_t tstep = 2 * hstep;
    const unsigned ldsw = (unsigned)wid * 1024u;
    const int aoff = lds_byte(wr * 64 + fr, fq * 8), boff = lds_byte(wc * 32 + fr, fq * 8);
#define PG8_SA(b, h) (((b) * 2 + (h)) * HTB)
#define PG8_SB(b, h) ((4 + (b) * 2 + (h)) * HTB)
#define PG8_STAGE(bufoff, gbase, voff) do { _Pragma("unroll") for (int _i = 0; _i < 2; ++_i) \
        __builtin_amdgcn_global_load_lds((const unsigned*)((const char*)(gbase) + (voff)[_i]), (LAS unsigned*)(lds + (bufoff) + ldsw + _i * 8192), 16, 0, 0); } while (0)
#define PG8_LDA(dst, b, h) do { _Pragma("unroll") for (int m = 0; m < 4; ++m) _Pragma("unroll") for (int k = 0; k < 2; ++k) dst[m][k] = *(const LAS bf16x8*)(lds + PG8_SA(b, h) + aoff + m * 2048 + k * 1024); } while (0)
#define PG8_LDB(dst, b, h) do { _Pragma("unroll") for (int n = 0; n < 2; ++n) _Pragma("unroll") for (int k = 0; k < 2; ++k) dst[n][k] = *(const LAS bf16x8*)(lds + PG8_SB(b, h) + boff + n * 2048 + k * 1024); } while (0)
#define PG8_MMA(ai, bj, At, Bt_) do { __builtin_amdgcn_s_setprio(1); _Pragma("unroll") for (int m = 0; m < 4; ++m) _Pragma("unroll") for (int n = 0; n < 2; ++n) _Pragma("unroll") for (int k = 0; k < 2; ++k) \
        acc[ai][bj][m][n] = __builtin_amdgcn_mfma_f32_16x16x32_bf16(Bt_[n][k], At[m][k], acc[ai][bj][m][n], 0, 0, 0); __builtin_amdgcn_s_setprio(0); } while (0)
#define PG8_WAIT_V(n) asm volatile("s_waitcnt vmcnt(" #n ")" ::: "memory")
#define PG8_WAIT_L(n) asm volatile("s_waitcnt lgkmcnt(" #n ")" ::: "memory")
#define PG8_BAR __builtin_amdgcn_s_barrier()
#define PG8_SCHED __builtin_amdgcn_sched_barrier(0)
    Unit cur, nxt; int ui = 0;
    if (!S.next(0, cur)) return;
    f32x4 acc[2][2][4][2];
#pragma unroll
    for (int a = 0; a < 2; ++a)
#pragma unroll
        for (int b = 0; b < 2; ++b)
#pragma unroll
            for (int m = 0; m < 4; ++m)
#pragma unroll
                for (int n = 0; n < 2; ++n) acc[a][b][m][n] = (f32x4){0.f, 0.f, 0.f, 0.f};
    bf16x8 At[4][2], B0[2][2], B1[2][2];
    unsigned vA0[2], vA1[2];
#pragma unroll
    for (int i = 0; i < 2; ++i) { vA0[i] = S.a_off(0, cur, 0, Rr[i], Cc[i]); vA1[i] = S.a_off(0, cur, 1, Rr[i], Cc[i]); }
    const char* Ab = (const char*)A;
    const char* cB = (const char*)Bt + (size_t)cur.bt * tstep;
    PG8_STAGE(PG8_SB(0, 0), cB, voffB); PG8_STAGE(PG8_SB(0, 1), cB + hstep, voffB); PG8_STAGE(PG8_SA(0, 0), Ab, vA0); PG8_STAGE(PG8_SA(0, 1), Ab, vA1);
    if (wr == 1) PG8_BAR;
    PG8_WAIT_V(2); PG8_BAR;
    PG8_STAGE(PG8_SB(1, 0), cB + kstep, voffB); PG8_STAGE(PG8_SA(1, 0), Ab + kstep, vA0); PG8_STAGE(PG8_SB(1, 1), cB + hstep + kstep, voffB);
    PG8_WAIT_V(6); PG8_BAR;
    for (;;) {
        const bool has_next = S.next(ui + 1, nxt);
        const char* nB = has_next ? (const char*)Bt + (size_t)nxt.bt * tstep : cB;
        for (int t = 0; t < nt; t += 2) {
            const bool last = (t == nt - 2);
            const char* a1 = Ab + (size_t)(t + 1) * kstep;
            const char* a2 = last ? Ab : Ab + (size_t)(t + 2) * kstep; const char* b2 = last ? nB : cB + (size_t)(t + 2) * kstep;
            const char* a3 = a2 + kstep; const char* b3 = b2 + kstep;
            unsigned v20[2], v21[2];
#pragma unroll
            for (int i = 0; i < 2; ++i) { v20[i] = vA0[i]; v21[i] = vA1[i]; }
            if (last && has_next) {
#pragma unroll
                for (int i = 0; i < 2; ++i) { v20[i] = S.a_off(ui + 1, nxt, 0, Rr[i], Cc[i]); v21[i] = S.a_off(ui + 1, nxt, 1, Rr[i], Cc[i]); } }
            PG8_LDB(B0, 0, 0); PG8_LDB(B1, 0, 1); PG8_SCHED; PG8_LDA(At, 0, 0); PG8_STAGE(PG8_SA(1, 1), a1, vA1);
            PG8_WAIT_V(8); PG8_WAIT_L(0); PG8_BAR; PG8_MMA(0, 0, At, B0); PG8_MMA(0, 1, At, B1); PG8_BAR; PG8_SCHED;
            PG8_LDA(At, 0, 1); PG8_STAGE(PG8_SB(0, 0), b2, voffB); PG8_STAGE(PG8_SB(0, 1), b2 + hstep, voffB); PG8_STAGE(PG8_SA(0, 0), a2, v20);
            PG8_WAIT_V(8); PG8_WAIT_L(0); PG8_BAR; PG8_MMA(1, 0, At, B0); PG8_MMA(1, 1, At, B1); PG8_BAR; PG8_SCHED;
            PG8_LDB(B0, 1, 0); PG8_LDB(B1, 1, 1); PG8_SCHED; PG8_LDA(At, 1, 0); PG8_STAGE(PG8_SA(0, 1), a2, v21);
            PG8_WAIT_V(8); PG8_WAIT_L(0); PG8_BAR; PG8_MMA(0, 0, At, B0); PG8_MMA(0, 1, At, B1); PG8_BAR; PG8_SCHED;
            PG8_LDA(At, 1, 1); PG8_STAGE(PG8_SB(1, 0), b3, voffB); PG8_STAGE(PG8_SB(1, 1), b3 + hstep, voffB); PG8_STAGE(PG8_SA(1, 0), a3, v20);
            PG8_WAIT_V(8); PG8_WAIT_L(0); PG8_BAR; PG8_MMA(1, 0, At, B0); PG8_MMA(1, 1, At, B1); PG8_BAR; PG8_SCHED;
        }
        if (wr == 0) PG8_BAR;
        E(acc, cur, wr, wc, fr, fq);
        if (!has_next) break;
#pragma unroll
        for (int a = 0; a < 2; ++a)
#pragma unroll
            for (int b = 0; b < 2; ++b)
#pragma unroll
                for (int m = 0; m < 4; ++m)
#pragma unroll
                    for (int n = 0; n < 2; ++n) acc[a][b][m][n] = (f32x4){0.f, 0.f, 0.f, 0.f};
        cur = nxt; cB = nB; ++ui;
#pragma unroll
        for (int i = 0; i < 2; ++i) { vA0[i] = S.a_off(ui, cur, 0, Rr[i], Cc[i]); vA1[i] = S.a_off(ui, cur, 1, Rr[i], Cc[i]); }
        if (wr == 1) PG8_BAR;
    }
    PG8_WAIT_V(0);
    PG8_BAR;
#undef PG8_SA
#undef PG8_SB
#undef PG8_STAGE
#undef PG8_LDA
#undef PG8_LDB
#undef PG8_MMA
#undef PG8_WAIT_V
#undef PG8_WAIT_L
#undef PG8_BAR
#undef PG8_SCHED
}

struct DenseOrder {
    int nM, nN, nwg, G, c, lda;
    __device__ void init(int M, int N, int G_, int c_, int lda_) { nM = M / BM; nN = N / BM; nwg = nM * nN; G = G_; c = c_; lda = lda_; }
    __device__ __forceinline__ bool next(int i, Unit& u) const {
        const long L = (long)i * G + c; if (L >= nwg) return false;
        int wgid = (int)L; { const int q = nwg / 8, r = nwg % 8, xcd = wgid % 8, off = wgid / 8; wgid = (xcd < r ? xcd * (q + 1) : r * (q + 1) + (xcd - r) * q) + off; }
        const int nig = 8 * nN, gid = wgid / nig, fm = gid * 8, gsz = (nM - fm) < 8 ? (nM - fm) : 8;
        u.pm = fm + ((wgid % nig) % gsz); u.pn = (wgid % nig) / gsz; u.bt = u.pn; u.e = 0; return true;
    }
    __device__ __forceinline__ unsigned a_off(int, const Unit& u, int h, int R, int C) const { return (unsigned)((u.pm * BM + h * HALF + R) * lda + C) * 2u; }
};
template <bool GATHER> struct MoeOrder {
    const LAS int* ts;
    const LAS int* tokL;
    int G, c, lda;
    __device__ __forceinline__ bool next(int i, Unit& u) const {
        const int L = i * G + c; const int ntile = __builtin_amdgcn_readfirstlane(ts[16]);
        if (L >= ntile * 4) return false;
        const int rt = L >> 2; int e = 0;
#pragma unroll
        for (int j = 1; j < 16; ++j) e += (rt >= ts[j]) ? 1 : 0;
        e = __builtin_amdgcn_readfirstlane(e);
        u.pm = rt; u.pn = L & 3; u.e = e; u.bt = e * 4 + (L & 3); return true;
    }
    __device__ __forceinline__ unsigned a_off(int ui, const Unit& u, int h, int R, int C) const {
        if (GATHER) { const int tok = tokL[ui * 256 + h * HALF + R]; return (unsigned)(tok * lda + C) * 2u; }
        return (unsigned)((u.pm * BM + h * HALF + R) * lda + C) * 2u;
    }
};

struct EpiPlain {
    bf16* O; int ldc; const float* bias; int scale_cols; float scale0;
    __device__ __forceinline__ void operator()(const f32x4 (&acc)[2][2][4][2], const Unit& u, int wr, int wc, int fr, int fq) const {
        const int row0 = u.pm * BM + wr * 64 + fr, col0 = u.pn * BM + wc * 32 + 8 * fq;
        const float sc = (u.pn * BM < scale_cols) ? scale0 : 1.f;
        f32x4 bv[2][2];
#pragma unroll
        for (int bj = 0; bj < 2; ++bj)
#pragma unroll
            for (int n = 0; n < 2; ++n) bv[bj][n] = bias ? *(const f32x4*)(bias + col0 + bj * HALF + 4 * n) : (f32x4){0.f, 0.f, 0.f, 0.f};
#pragma unroll
        for (int ai = 0; ai < 2; ++ai)
#pragma unroll
            for (int m = 0; m < 4; ++m) { bf16* rowp = O + (size_t)(row0 + ai * HALF + m * 16) * ldc + col0;
#pragma unroll
                for (int bj = 0; bj < 2; ++bj) { f32x4 v0 = (acc[ai][bj][m][0] + bv[bj][0]) * sc, v1 = (acc[ai][bj][m][1] + bv[bj][1]) * sc;
                    u32x4 w; w.x = cvt_pk_bf16(v0[0], v0[1]); w.y = cvt_pk_bf16(v0[2], v0[3]); w.z = cvt_pk_bf16(v1[0], v1[1]); w.w = cvt_pk_bf16(v1[2], v1[3]);
                    *(u32x4*)(rowp + bj * HALF) = w; } }
    }
};
struct EpiInProj {
    bf16* Z; bf16* XBC;
    __device__ __forceinline__ void operator()(const f32x4 (&acc)[2][2][4][2], const Unit& u, int wr, int wc, int fr, int fq) const {
        const int row0 = u.pm * BM + wr * 64 + fr; int colt = u.pn * BM; bf16* base; int ldc;
        if (colt < DI) { base = Z; ldc = DI; } else { base = XBC; ldc = CONVD; colt -= DI; }
        const int col0 = colt + wc * 32 + 8 * fq;
#pragma unroll
        for (int ai = 0; ai < 2; ++ai)
#pragma unroll
            for (int m = 0; m < 4; ++m) { bf16* rowp = base + (size_t)(row0 + ai * HALF + m * 16) * ldc + col0;
#pragma unroll
                for (int bj = 0; bj < 2; ++bj) { const f32x4 v0 = acc[ai][bj][m][0], v1 = acc[ai][bj][m][1];
                    u32x4 w; w.x = cvt_pk_bf16(v0[0], v0[1]); w.y = cvt_pk_bf16(v0[2], v0[3]); w.z = cvt_pk_bf16(v1[0], v1[1]); w.w = cvt_pk_bf16(v1[2], v1[3]);
                    *(u32x4*)(rowp + bj * HALF) = w; } }
    }
};
struct EpiGateUp {
    bf16* Hh;
    __device__ __forceinline__ void operator()(const f32x4 (&acc)[2][2][4][2], const Unit& u, int wr, int wc, int fr, int fq) const {
        const int row0 = u.pm * BM + wr * 64 + fr, col0 = (u.pn * BM + wc * 32 + 8 * fq) >> 1;
#pragma unroll
        for (int ai = 0; ai < 2; ++ai)
#pragma unroll
            for (int m = 0; m < 4; ++m) { bf16* rowp = Hh + (size_t)(row0 + ai * HALF + m * 16) * DFF + col0;
#pragma unroll
                for (int bj = 0; bj < 2; ++bj) { const f32x4 g = acc[ai][bj][m][0], up = acc[ai][bj][m][1];
                    u32x2 w; w.x = cvt_pk_bf16(silu_f(g[0]) * up[0], silu_f(g[1]) * up[1]); w.y = cvt_pk_bf16(silu_f(g[2]) * up[2], silu_f(g[3]) * up[3]);
                    *(u32x2*)(rowp + bj * (HALF / 2)) = w; } }
    }
};
}

#define XB_TMO      128
#define XB_XCNT(j)  (256  + 64 * (j))
#define XB_XSUB(j)  (1280 + 64 * (j))
#define XB_XGEN(j)  (2304 + 64 * (j))
#define XB_TOP      3328
#define XB_TOPGEN   3392
#define XCD_BAR_WORDS 3456
#define XB_SPIN_CAP (1u << 18)
__device__ __forceinline__ unsigned xb_ld(unsigned* p)              { return __hip_atomic_load(p, __ATOMIC_RELAXED, __HIP_MEMORY_SCOPE_AGENT); }
__device__ __forceinline__ unsigned xb_add(unsigned* p, unsigned v) { return __hip_atomic_fetch_add(p, v, __ATOMIC_RELAXED, __HIP_MEMORY_SCOPE_AGENT); }
__device__ __forceinline__ unsigned xb_xcc_id() { return (unsigned)__builtin_amdgcn_s_getreg((3 << 11) | 20) & 0xFu; }
#define XB_SPIN(cond, bar) do { unsigned _sp = 0; while (cond) { __builtin_amdgcn_s_sleep(1); \
    if ((++_sp & 255u) == 0u) { if (xb_ld(&(bar)[XB_TMO])) break; if (_sp > XB_SPIN_CAP) { atomicAdd(&(bar)[XB_TMO], 1u); break; } } } } while (0)
struct XcdBarrier { unsigned* bar; unsigned x; volatile LAS unsigned* st; };
__device__ __forceinline__ XcdBarrier xcd_barrier_post(unsigned* bar, volatile LAS unsigned* st) {
    XcdBarrier b; b.bar = bar; b.x = xb_xcc_id(); b.st = st;
    if (threadIdx.x == 0) (void)xb_add(&bar[XB_XCNT(b.x)], 1u);
    return b;
}
__device__ __forceinline__ void xcd_barrier_complete(unsigned* bar, unsigned x, unsigned& nloc, unsigned& nx) {
    const unsigned G = gridDim.x * gridDim.y * gridDim.z;
    unsigned sum, cnt, mine, sp = 0u;
    for (;;) {
        sum = 0u; cnt = 0u; mine = 0u;
#pragma unroll
        for (unsigned j = 0; j < 16; ++j) { const unsigned c = xb_ld(&bar[XB_XCNT(j)]); sum += c; cnt += (c > 0u) ? 1u : 0u; mine = (j == x) ? c : mine; }
        if (sum == G) break;
        __builtin_amdgcn_s_sleep(1);
        if ((++sp & 255u) == 0u) { if (xb_ld(&bar[XB_TMO])) break; if (sp > XB_SPIN_CAP) { atomicAdd(&bar[XB_TMO], 1u); break; } }
    }
    nloc = mine > 0u ? mine : 1u; nx = cnt > 0u ? cnt : 1u;
}
__device__ __forceinline__ void xcd_barrier(const XcdBarrier& b) {
    asm volatile("s_waitcnt vmcnt(0)" ::: "memory");
    __syncthreads();
    if (threadIdx.x == 0) {
        unsigned* bar = b.bar;
        __builtin_amdgcn_s_waitcnt(0);
        unsigned nloc = b.st[0], nx = b.st[1];
        if (nloc == 0u) { xcd_barrier_complete(bar, b.x, nloc, nx); b.st[0] = nloc; b.st[1] = nx; }
        const unsigned old = xb_add(&bar[XB_XSUB(b.x)], 1u);
        const unsigned gen = old / nloc;
        if (old + 1u == (gen + 1u) * nloc) {
            __builtin_amdgcn_fence(__ATOMIC_RELEASE, "agent");
            asm volatile("s_waitcnt vmcnt(0)" ::: "memory");
            const unsigned og = xb_add(&bar[XB_TOP], 1u);
            const unsigned tg = og / nx;
            if (og + 1u == (tg + 1u) * nx) xb_add(&bar[XB_TOPGEN], 1u);
            else XB_SPIN(xb_ld(&bar[XB_TOPGEN]) == tg, bar);
            __builtin_amdgcn_fence(__ATOMIC_ACQUIRE, "agent");
            xb_add(&bar[XB_XGEN(b.x)], 1u);
            asm volatile("s_waitcnt vmcnt(0)" ::: "memory");
        } else {
            XB_SPIN(xb_ld(&bar[XB_XGEN(b.x)]) == gen, bar);
            __builtin_amdgcn_fence(__ATOMIC_ACQUIRE, "agent");
            asm volatile("s_waitcnt vmcnt(0)" ::: "memory");
        }
    }
    __syncthreads();
}

struct Args { const float* in[23]; float* out; unsigned char* ws; int ph_lo, ph_hi; };

struct Frame {
    LAS unsigned char* lds;
    int tid, lane, wave, vcu, G;
};

__device__ __forceinline__ void transpose_item(const float* W, int K, int N, bf16* WT, int row_off, int mode, const float* kscale, LAS float* scr, int item, int lane) {
    const int nblk = N / 32, kb = item / nblk, nb = item % nblk, k0 = 64 * kb, n0 = 32 * nb;
#pragma unroll 8
    for (int i = 0; i < 32; ++i) { const int kk = 2 * i + (lane >> 5); scr[kk * 33 + (lane & 31)] = W[(size_t)(k0 + kk) * N + n0 + (lane & 31)]; }
    LDS_WAIT(); asm volatile("" ::: "memory");
    const int c = lane & 7;
    float ks[8];
#pragma unroll
    for (int q = 0; q < 8; ++q) ks[q] = kscale ? kscale[k0 + 8 * c + q] : 1.f;
#pragma unroll
    for (int j = 0; j < 4; ++j) { const int n = (lane >> 3) + 8 * j; const LAS float* s = scr + (8 * c) * 33 + n;
        u32x4 o; o.x = pk2(s[0 * 33] * ks[0], s[1 * 33] * ks[1]); o.y = pk2(s[2 * 33] * ks[2], s[3 * 33] * ks[3]); o.z = pk2(s[4 * 33] * ks[4], s[5 * 33] * ks[5]); o.w = pk2(s[6 * 33] * ks[6], s[7 * 33] * ks[7]);
        const int ng = n0 + n; const int dr = (mode == 0) ? ng : (8 * (ng >> 2) + (ng & 3) + (mode == 2 ? 4 : 0));
        *(GAS u32x4*)(WT + (size_t)(row_off + dr) * K + k0 + 8 * c) = o; }
    LDS_WAIT(); asm volatile("" ::: "memory");
}

__device__ __forceinline__ void ln_row(f32x4 (&v)[4], const float* g, const float* b, int lane) {
    float s = 0.f;
#pragma unroll
    for (int j = 0; j < 4; ++j) s += (v[j].x + v[j].y) + (v[j].z + v[j].w);
    const float mean = wave_sum(s) * (1.f / D); float s2 = 0.f;
#pragma unroll
    for (int j = 0; j < 4; ++j) { v[j] = v[j] - mean; s2 += (v[j].x * v[j].x + v[j].y * v[j].y) + (v[j].z * v[j].z + v[j].w * v[j].w); }
    const float rstd = 1.f / sqrtf(wave_sum(s2) * (1.f / D) + LN_EPS);
#pragma unroll
    for (int j = 0; j < 4; ++j) { const f32x4 gg = *(const f32x4*)(g + 4 * lane + 256 * j), bb = *(const f32x4*)(b + 4 * lane + 256 * j); v[j] = v[j] * rstd * gg + bb; }
}
__device__ __forceinline__ f32x4 ld_bf16x4(const bf16* p) { const u32x2 w = *(const u32x2*)p; return (f32x4){bflo(w.x), bfhi(w.x), bflo(w.y), bfhi(w.y)}; }
__device__ __forceinline__ void st_bf16x4(bf16* p, f32x4 v) { u32x2 w; w.x = pk2(v.x, v.y); w.y = pk2(v.z, v.w); *(u32x2*)p = w; }

#ifndef PH_MASK
#define PH_MASK 0x1ffff
#endif
#define IN(k) (((PH_MASK >> (k)) & 1) && lo <= (k) && (k) < hi)
#define SEAM(k) do { if (IN(k) && IN((k) + 1)) xcd_barrier(bar); } while (0)
#define PH_LOCALS \
    int tid = threadIdx.x; asm volatile("" : "+v"(tid)); const int lane = tid & 63, wave = __builtin_amdgcn_readfirstlane(tid >> 6); \
    size_t ws_z_ = 0; asm volatile("" : "+s"(ws_z_)); unsigned char* ws = args.ws + ws_z_;     \
    const int gw = F.vcu * 8 + wave, NGW = F.G * 8; (void)lane; (void)gw; (void)NGW; \
    const float* x_in = args.in[0]; (void)x_in; \
    bf16* Wt_in = (bf16*)(ws + WS_WIN); bf16* Wt_out = (bf16*)(ws + WS_WOUT); (void)Wt_in; (void)Wt_out; \
    bf16* XB = (bf16*)(ws + WS_XB); bf16* Zb = (bf16*)(ws + WS_Z); bf16* XBC = (bf16*)(ws + WS_XBC); (void)XB; (void)Zb; (void)XBC; \
    float* DTRAW = (float*)(ws + WS_DTRAW); float* SSQ = (float*)(ws + WS_SSQ); (void)DTRAW; (void)SSQ; \
    int* LIST = (int*)(ws + WS_LIST); unsigned* INFO = (unsigned*)(ws + WS_INFO); (void)LIST; (void)INFO;


template <int L>
__device__ __forceinline__ void layer_tail(const Args& args, const Frame& F, const XcdBarrier& bar, const int lo, const int hi) {
    const int pb = L ? 13 : 6;
#define LAYER_LOCALS \
    const bf16* MIX = (const bf16*)(ws + (L ? WS_MIX2 : WS_MIX1)); (void)MIX; \
    bf16* XN = (bf16*)(ws + (L ? WS_X3B : WS_X1B)); (void)XN;            \
    bf16* HB = (bf16*)(ws + (L ? WS_H1 : WS_H0)); (void)HB; \
    bf16* Y2 = (bf16*)(ws + (L ? WS_Y21 : WS_Y20)); (void)Y2; \
    gu32* gcnt = (gu32*)(ws + WS_CTL) + CW_CNT + 64 * L; (void)gcnt; \
    LAS int* tokL = (LAS int*)(F.lds + TOKL_OFF); (void)tokL; \
    LAS int* mo = (LAS int*)(F.lds + MOE_OFF); (void)mo;

    if (IN(pb)) { PH_LOCALS LAYER_LOCALS
        const float* lg = args.in[19] + L * D; const float* lb = args.in[20] + L * D;
        const float* rw = args.in[14]; const float* rbias = args.in[15];
        constexpr int AST = 2064;
        LAS unsigned char* AH = F.lds; LAS unsigned char* AL = F.lds + 16 * AST;
        LAS float* PART = (LAS float*)(F.lds + 66048);
        LAS float* LG = (LAS float*)(F.lds + 74240);
        LAS int* lcnt = (LAS int*)(F.lds + 75264);
        LAS int* rec = (LAS int*)(F.lds + 75264 + 256);
        const int r16 = lane & 15, q4 = lane >> 4;
        bf16x8 wh[4], wl[4];
#pragma unroll
        for (int ks = 0; ks < 4; ++ks) { unsigned hh_[4], ll_[4];
#pragma unroll
            for (int jp = 0; jp < 4; ++jp) { const float w0 = rw[(128 * wave + 32 * ks + 8 * q4 + 2 * jp) * NE + r16], w1 = rw[(128 * wave + 32 * ks + 8 * q4 + 2 * jp + 1) * NE + r16];
                const unsigned h0 = f2bf(w0), h1 = f2bf(w1); hh_[jp] = h0 | (h1 << 16); ll_[jp] = pk2(w0 - bf2f((unsigned short)h0), w1 - bf2f((unsigned short)h1)); }
            wh[ks] = __builtin_bit_cast(bf16x8, (u32x4){hh_[0], hh_[1], hh_[2], hh_[3]}); wl[ks] = __builtin_bit_cast(bf16x8, (u32x4){ll_[0], ll_[1], ll_[2], ll_[3]}); }
        if (tid < 32) lcnt[tid] = 0;
        __syncthreads();
        f32x4 nx[2][4]; u32x2 nm[2][4];
#define RT_LOAD(tile_) do { _Pragma("unroll") for (int u = 0; u < 2; ++u) { const size_t mm = (size_t)(tile_) * 16 + 2 * wave + u; _Pragma("unroll") for (int j = 0; j < 4; ++j) { nm[u][j] = *(const u32x2*)(MIX + mm * D + 4 * lane + 256 * j); \
            if (L == 0) nx[u][j] = *(const f32x4*)(x_in + mm * D + 4 * lane + 256 * j); \
            else { const u32x2 t_ = *(const u32x2*)((const bf16*)(ws + WS_X2B) + mm * D + 4 * lane + 256 * j); nx[u][j] = (f32x4){bflo(t_.x), bfhi(t_.x), bflo(t_.y), bfhi(t_.y)}; } } } } while (0)
        if (F.vcu < T / 16) RT_LOAD(F.vcu);
        int ti_ = 0;
        for (int tile = F.vcu; tile < T / 16; tile += F.G, ++ti_) {
            f32x4 v[2][4];
#pragma unroll
            for (int u = 0; u < 2; ++u)
#pragma unroll
                for (int j = 0; j < 4; ++j) v[u][j] = nx[u][j] * ALPHA + (f32x4){bflo(nm[u][j].x), bfhi(nm[u][j].x), bflo(nm[u][j].y), bfhi(nm[u][j].y)};
            RT_LOAD((tile + F.G < T / 16 ? tile + F.G : tile));
#pragma unroll
            for (int u = 0; u < 2; ++u) { const size_t m = (size_t)tile * 16 + 2 * wave + u;
                ln_row(v[u], lg, lb, lane);
#pragma unroll
                for (int j = 0; j < 4; ++j) { const f32x4 x = v[u][j]; const unsigned h0 = f2bf(x.x), h1 = f2bf(x.y), h2 = f2bf(x.z), h3 = f2bf(x.w);
                    u32x2 hw; hw.x = h0 | (h1 << 16); hw.y = h2 | (h3 << 16);
                    u32x2 lw; lw.x = pk2(x.x - bf2f((unsigned short)h0), x.y - bf2f((unsigned short)h1)); lw.y = pk2(x.z - bf2f((unsigned short)h2), x.w - bf2f((unsigned short)h3));
                    *(u32x2*)(XN + m * D + 4 * lane + 256 * j) = hw;
                    *(LAS u32x2*)(AH + (2 * wave + u) * AST + (256 * j + 4 * lane) * 2) = hw; *(LAS u32x2*)(AL + (2 * wave + u) * AST + (256 * j + 4 * lane) * 2) = lw; } }
            WG_BAR();
            { f32x4 acc = {0.f, 0.f, 0.f, 0.f};
#pragma unroll
              for (int ks = 0; ks < 4; ++ks) { const bf16x8 ah = *(const LAS bf16x8*)(AH + r16 * AST + (128 * wave + 32 * ks + 8 * q4) * 2), al = *(const LAS bf16x8*)(AL + r16 * AST + (128 * wave + 32 * ks + 8 * q4) * 2);
                  acc = __builtin_amdgcn_mfma_f32_16x16x32_bf16(ah, wh[ks], acc, 0, 0, 0); acc = __builtin_amdgcn_mfma_f32_16x16x32_bf16(ah, wl[ks], acc, 0, 0, 0); acc = __builtin_amdgcn_mfma_f32_16x16x32_bf16(al, wh[ks], acc, 0, 0, 0); }
#pragma unroll
              for (int r = 0; r < 4; ++r) PART[wave * 256 + (4 * q4 + r) * 16 + r16] = acc[r]; }
            WG_BAR();
            if (tid < 256) { float s_ = 0.f;
#pragma unroll
                for (int w = 0; w < 8; ++w) s_ += PART[w * 256 + tid];
                LG[tid] = s_; }
            WG_BAR();
            if (tid < 16) {
                float lgt[NE];
#pragma unroll
                for (int e4 = 0; e4 < 4; ++e4) { const f32x4 t_ = *(const LAS f32x4*)(LG + tid * 16 + 4 * e4); lgt[4 * e4] = t_.x; lgt[4 * e4 + 1] = t_.y; lgt[4 * e4 + 2] = t_.z; lgt[4 * e4 + 3] = t_.w; }
                float mxl = lgt[0];
#pragma unroll
                for (int e = 1; e < NE; ++e) mxl = fmaxf(mxl, lgt[e]);
                float sc[NE], sel[NE], den = 0.f;
#pragma unroll
                for (int e = 0; e < NE; ++e) { sc[e] = __expf(lgt[e] - mxl); den += sc[e]; }
                const float iden = 1.f / den;
#pragma unroll
                for (int e = 0; e < NE; ++e) { sc[e] *= iden; sel[e] = sc[e] + rbias[e]; }
                int bg = 0; float bgs = -1e30f;
#pragma unroll
                for (int g = 0; g < 4; ++g) { const float a = sel[4 * g], b2 = sel[4 * g + 1], c2 = sel[4 * g + 2], d2 = sel[4 * g + 3];
                    const float hi1 = fmaxf(fmaxf(a, b2), fmaxf(c2, d2));
                    const float m01 = fminf(a, b2), m23 = fminf(c2, d2), M01 = fmaxf(a, b2), M23 = fmaxf(c2, d2);
                    const float second = fmaxf(fminf(M01, M23), fmaxf(m01, m23));
                    const float gs = hi1 + second;
                    if (gs > bgs) { bgs = gs; bg = g; } }
                float s0 = 0.f, s1 = 0.f, s2 = 0.f, s3 = 0.f, p0 = 0.f, p1 = 0.f, p2 = 0.f, p3 = 0.f;
#pragma unroll
                for (int g = 0; g < 4; ++g) if (g == bg) { s0 = sel[4 * g]; s1 = sel[4 * g + 1]; s2 = sel[4 * g + 2]; s3 = sel[4 * g + 3]; p0 = sc[4 * g]; p1 = sc[4 * g + 1]; p2 = sc[4 * g + 2]; p3 = sc[4 * g + 3]; }
                int i1 = 0; float b1 = s0, q1 = p0;
                if (s1 > b1) { b1 = s1; i1 = 1; q1 = p1; } if (s2 > b1) { b1 = s2; i1 = 2; q1 = p2; } if (s3 > b1) { b1 = s3; i1 = 3; q1 = p3; }
                int i2 = -1; float b2v = -1e30f, q2 = 0.f;
                if (i1 != 0 && s0 > b2v) { b2v = s0; i2 = 0; q2 = p0; } if (i1 != 1 && s1 > b2v) { b2v = s1; i2 = 1; q2 = p1; }
                if (i1 != 2 && s2 > b2v) { b2v = s2; i2 = 2; q2 = p2; } if (i1 != 3 && s3 > b2v) { b2v = s3; i2 = 3; q2 = p3; }
                const int e1 = 4 * bg + i1, e2 = 4 * bg + i2; const float gsum = q1 + q2, g1 = q1 / gsum, g2 = q2 / gsum;
                const int r1 = atomicAdd((int*)(lcnt + e1), 1), r2 = atomicAdd((int*)(lcnt + e2), 1);
                LAS int* rc = rec + ((ti_ & 31) * 16 + tid) * 8; rc[0] = e1; rc[1] = r1; rc[2] = e2; rc[3] = r2; rc[4] = __builtin_bit_cast(int, g1); rc[5] = __builtin_bit_cast(int, g2);
            }
        }
#undef RT_LOAD
        __syncthreads();
        if (tid < NE) lcnt[16 + tid] = (int)__hip_atomic_fetch_add(gcnt + tid, (unsigned)lcnt[tid], RLX_AGENT);
        __syncthreads();
        for (int lt = tid; lt < ti_ * 16; lt += 512) {
            const int m = 16 * (F.vcu + (lt >> 4) * F.G) + (lt & 15);
            const LAS int* rc = rec + lt * 8;
            const int e1 = rc[0], e2 = rc[2], sl1 = lcnt[16 + e1] + rc[1], sl2 = lcnt[16 + e2] + rc[3];
            LIST[(size_t)e1 * T + sl1] = m; LIST[(size_t)e2 * T + sl2] = m;
            u32x4 w0; w0.x = (unsigned)e1; w0.y = (unsigned)sl1; w0.z = (unsigned)e2; w0.w = (unsigned)sl2;
            *(u32x4*)(INFO + (size_t)m * 8) = w0; INFO[(size_t)m * 8 + 4] = (unsigned)rc[4]; INFO[(size_t)m * 8 + 5] = (unsigned)rc[5];
        }
    }
    SEAM(pb);

    if (IN(pb + 1) || IN(pb + 2) || IN(pb + 3)) { PH_LOCALS LAYER_LOCALS
        __syncthreads();
        if (tid == 0) { int acc_ = 0; for (int e = 0; e < NE; ++e) { const int c = (int)__hip_atomic_load(gcnt + e, RLX_AGENT); mo[e] = acc_; mo[32 + e] = c; acc_ += (c + 255) >> 8; } mo[16] = acc_; }
        __syncthreads();
    }
    if (IN(pb + 1)) { PH_LOCALS LAYER_LOCALS
        pg8::MoeOrder<true> S{mo, tokL, F.G, F.vcu, D};
        { pg8::Unit u; for (int ui = 0; ui < 6 && S.next(ui, u); ++ui) { if (tid < 256) { const int r = (u.pm - mo[u.e]) * 256 + tid, c = mo[32 + u.e]; tokL[ui * 256 + tid] = LIST[(size_t)u.e * T + (r < c ? r : c - 1)]; } } }
        __syncthreads();
        pg8::EpiGateUp E{HB};
        pg8::gemm_phase<pg8::EpiGateUp, pg8::MoeOrder<true>>(F.lds, XN, (const bf16*)(ws + (L ? WS_WGU1 : WS_WGU0)), D, S, E);
    }
    SEAM(pb + 1);
    if (IN(pb + 2)) { PH_LOCALS LAYER_LOCALS
        pg8::MoeOrder<false> S{mo, tokL, F.G, F.vcu, DFF};
        pg8::EpiPlain E{Y2, D, nullptr, 0, 1.f};
        pg8::gemm_phase<pg8::EpiPlain, pg8::MoeOrder<false>>(F.lds, HB, (const bf16*)(ws + (L ? WS_WD1 : WS_WD0)), DFF, S, E);
    }
    SEAM(pb + 2);
    if (IN(pb + 3)) { PH_LOCALS LAYER_LOCALS
        const float* lg = args.in[21] + L * D; const float* lb = args.in[22] + L * D;
        for (int m = gw; m < T; m += NGW) {
            const u32x4 w0 = *(const u32x4*)(INFO + (size_t)m * 8); const float g1 = __builtin_bit_cast(float, INFO[(size_t)m * 8 + 4]), g2 = __builtin_bit_cast(float, INFO[(size_t)m * 8 + 5]);
            const size_t r1 = (size_t)mo[w0.x] * 256 + w0.y, r2 = (size_t)mo[w0.z] * 256 + w0.w;
            f32x4 v[4];
#pragma unroll
            for (int j = 0; j < 4; ++j) { const int co = 4 * lane + 256 * j;
                v[j] = ld_bf16x4(XN + (size_t)m * D + co) * ALPHA + ld_bf16x4(Y2 + r1 * D + co) * g1 + ld_bf16x4(Y2 + r2 * D + co) * g2; }
            ln_row(v, lg, lb, lane);
            if (L == 0) {
#pragma unroll
                for (int j = 0; j < 4; ++j) st_bf16x4((bf16*)(ws + WS_X2B) + (size_t)m * D + 4 * lane + 256 * j, v[j]);
            } else {
#pragma unroll
                for (int j = 0; j < 4; ++j) *(f32x4*)(args.out + (size_t)m * D + 4 * lane + 256 * j) = v[j];
            }
        }
    }
}

__global__ void __launch_bounds__(512, 2) fwd_kernel(Args args) {
    extern __shared__ __attribute__((aligned(16))) unsigned char lds_raw[];
    Frame F;
    F.lds = (LAS unsigned char*)lds_raw;
    F.tid = threadIdx.x; F.lane = F.tid & 63; F.wave = __builtin_amdgcn_readfirstlane(F.tid >> 6);
    F.G = gridDim.x; { const int bx = blockIdx.x; F.vcu = (F.G % 8 == 0) ? (bx % 8) * (F.G / 8) + bx / 8 : bx; }
    unsigned char* ws = args.ws;
    gu32* ctl = (gu32*)(ws + WS_CTL);
    volatile LAS unsigned* MISC = (volatile LAS unsigned*)(F.lds + MISC_OFF);
    for (int u = F.tid; u < (LDS_BYTES - LDSCTL_OFF) / 4; u += 512) ((LAS unsigned*)(F.lds + LDSCTL_OFF))[u] = 0u;
    __syncthreads();
    XcdBarrier bar; bar.bar = (unsigned*)(ctl + CW_BAR); bar.x = 0; bar.st = nullptr;
    if (MK_N_LAUNCHES == 1) bar = xcd_barrier_post((unsigned*)(ctl + CW_BAR), MISC + 8);
    const int lo = args.ph_lo, hi = args.ph_hi;
    if (IN(0)) { PH_LOCALS
        LAS float* scr = (LAS float*)(F.lds + wave * 16384);
        constexpr int I_IN = (D / 64) * (INP / 32), I_OUT = (DI / 64) * (D / 32);
        for (int it = gw; it < I_IN + I_OUT; it += NGW) {
            if (it < I_IN) transpose_item(args.in[1], D, INP, Wt_in, 0, 0, nullptr, scr, it, lane);
            else transpose_item(args.in[8], DI, D, Wt_out, 0, 0, args.in[7], scr, it - I_IN, lane);
        }
        const size_t n8 = (size_t)T * D / 8, stride = (size_t)F.G * 512; size_t i = (size_t)blockIdx.x * 512 + tid;
        for (; i + 3 * stride < n8; i += 4 * stride) {
            f32x4 a[4], b[4];
#pragma unroll
            for (int u = 0; u < 4; ++u) { a[u] = *(const f32x4*)(x_in + (i + u * stride) * 8); b[u] = *(const f32x4*)(x_in + (i + u * stride) * 8 + 4); }
#pragma unroll
            for (int u = 0; u < 4; ++u) { u32x4 o; o.x = pk2(a[u].x, a[u].y); o.y = pk2(a[u].z, a[u].w); o.z = pk2(b[u].x, b[u].y); o.w = pk2(b[u].z, b[u].w); *(u32x4*)(XB + (i + u * stride) * 8) = o; }
        }
        for (; i < n8; i += stride) { const f32x4 a = *(const f32x4*)(x_in + i * 8), b = *(const f32x4*)(x_in + i * 8 + 4);
            u32x4 o; o.x = pk2(a.x, a.y); o.y = pk2(a.z, a.w); o.z = pk2(b.x, b.y); o.w = pk2(b.z, b.w); *(u32x4*)(XB + i * 8) = o; }
    }
    SEAM(0);

    if (IN(1)) { PH_LOCALS
        pg8::DenseOrder S; S.init(T, NZX, F.G, (int)blockIdx.x, D);
        pg8::EpiInProj E{Zb, XBC};
        pg8::gemm_phase<pg8::EpiInProj, pg8::DenseOrder>(F.lds, XB, Wt_in, D, S, E);
        for (int tile = gw; tile < T / 16; tile += NGW) {
            const int t0 = tile * 16, r = lane & 15, q = lane >> 4;
            const bf16* xp = XB + (size_t)(t0 + r) * D + 8 * q;
            const bf16* w0 = Wt_in + (size_t)(NZX + r) * D + 8 * q; const bf16* w1 = w0 + (size_t)16 * D;
            f32x4 a0 = {0.f, 0.f, 0.f, 0.f}, a1 = {0.f, 0.f, 0.f, 0.f};
#pragma unroll 4
            for (int k0 = 0; k0 < D; k0 += 32) {
                const bf16x8 xv = *(const bf16x8*)(xp + k0), wa = *(const bf16x8*)(w0 + k0), wb = *(const bf16x8*)(w1 + k0);
                a0 = __builtin_amdgcn_mfma_f32_16x16x32_bf16(wa, xv, a0, 0, 0, 0);
                a1 = __builtin_amdgcn_mfma_f32_16x16x32_bf16(wb, xv, a1, 0, 0, 0);
            }
            float* o = DTRAW + (size_t)(t0 + r) * NH + 4 * q;
            *(f32x4*)o = a0; *(f32x4*)(o + 16) = a1;
        }
    }
    SEAM(1);

    if (IN(2)) { PH_LOCALS
        const float* conv_w = args.in[2]; const float* conv_b = args.in[3];
        bf16* BCACT = (bf16*)(ws + WS_BCACT);
        { const float* dt_bias = args.in[4]; const float* a_log = args.in[5]; float* CUMV = (float*)(ws + WS_CUMV); float* DTV = (float*)(ws + WS_DTV);
          for (int it = gw; it < NB * NH * (SEQ / 64); it += NGW) { const int c = it & 63, h = (it >> 6) & 31, b = it >> 11;
              const float rw_ = DTRAW[((size_t)b * SEQ + c * 64 + lane) * NH + h] + dt_bias[h]; const float dtv = rw_ > 15.f ? rw_ : __logf(1.f + __expf(rw_)); float xx = dtv * (-__expf(a_log[h]));
#pragma unroll
              for (int o_ = 1; o_ < 64; o_ <<= 1) { const float vv = __shfl_up(xx, o_); if (lane >= o_) xx += vv; }
              const size_t oi = ((size_t)b * NH + h) * SEQ + c * 64 + lane; CUMV[oi] = xx; DTV[oi] = dtv; } }
        for (int it = blockIdx.x * 512 + tid; it < (T / 8) * 128; it += F.G * 512) {
            const int ch = it & 127, seg = it >> 7, r0 = seg * 8, s0 = r0 & (SEQ - 1), col = DI + 8 * ch;
            u32x4 rw[11];
#pragma unroll
            for (int q = 0; q < 11; ++q) { const int sr = s0 - 3 + q; const int rc = sr < 0 ? 0 : sr; rw[q] = *(const u32x4*)(XBC + (size_t)(r0 - s0 + rc) * CONVD + col); }
#pragma unroll
            for (int q = 0; q < 3; ++q) if (s0 - 3 + q < 0) rw[q] = (u32x4){0u, 0u, 0u, 0u};
#pragma unroll
            for (int hf = 0; hf < 2; ++hf) {
                f32x4 wq[5];
#pragma unroll
                for (int k = 0; k < 4; ++k) wq[k] = *(const f32x4*)(conv_w + k * CONVD + col + 4 * hf);
                wq[4] = *(const f32x4*)(conv_b + col + 4 * hf);
#pragma unroll
                for (int jj = 0; jj < 8; ++jj) { f32x4 aq = wq[4];
#pragma unroll
                    for (int k = 0; k < 4; ++k) { const u32x4 rq = rw[jj + k]; const unsigned a0 = hf ? rq.z : rq.x, a1 = hf ? rq.w : rq.y; aq += wq[k] * (f32x4){bflo(a0), bfhi(a0), bflo(a1), bfhi(a1)}; }
#pragma unroll
                    for (int e = 0; e < 4; ++e) aq[e] = silu_f(aq[e]);
                    u32x2 o_; o_.x = pk2(aq[0], aq[1]); o_.y = pk2(aq[2], aq[3]);
                    *(u32x2*)(BCACT + (size_t)(r0 + jj) * 1024 + 8 * ch + 4 * hf) = o_; }
            }
        }
    }
    SEAM(2);

    if (IN(3)) { PH_LOCALS
#if NAIVE_SCAN
        const float* conv_w = args.in[2]; const float* conv_b = args.in[3]; const float* dt_bias = args.in[4]; const float* a_log = args.in[5]; const float* dsk = args.in[6];
        for (int item = blockIdx.x; item < NB * NH; item += F.G) {
            if (wave >= 2) continue;
            LAS float* sB = (LAS float*)(F.lds + wave * 8192); LAS float* sC = sB + 128; LAS float* cwl = sC + 128;
            const int b = item / NH, h = item % NH, g = h / 8, pp = 32 * wave + (lane & 31), nh = lane >> 5;
            int col[5]; col[0] = h * HP + pp; col[1] = DI + g * NS + lane; col[2] = col[1] + 64; col[3] = DI + NG * NS + g * NS + lane; col[4] = col[3] + 64;
            float hist[5][3];
#pragma unroll
            for (int c = 0; c < 5; ++c) { cwl[(c * 5 + 4) * 64 + lane] = conv_b[col[c]];
#pragma unroll
                for (int k = 0; k < 4; ++k) cwl[(c * 5 + k) * 64 + lane] = conv_w[k * CONVD + col[c]];
#pragma unroll
                for (int k = 0; k < 3; ++k) hist[c][k] = 0.f; }
            LDS_WAIT();
            const float dtb = dt_bias[h], av = -__expf(a_log[h]), dh = dsk[h];
            float hst[64];
#pragma unroll
            for (int n = 0; n < 64; ++n) hst[n] = 0.f;
            for (int t = 0; t < SEQ; ++t) {
                const size_t row = (size_t)b * SEQ + t;
                float v[5];
#pragma unroll
                for (int c = 0; c < 5; ++c) { const float cur = bf2f(XBC[row * CONVD + col[c]]);
                    float a = cwl[(c * 5 + 4) * 64 + lane] + cwl[(c * 5) * 64 + lane] * hist[c][0] + cwl[(c * 5 + 1) * 64 + lane] * hist[c][1] + cwl[(c * 5 + 2) * 64 + lane] * hist[c][2] + cwl[(c * 5 + 3) * 64 + lane] * cur;
                    hist[c][0] = hist[c][1]; hist[c][1] = hist[c][2]; hist[c][2] = cur; v[c] = silu_f(a); }
                const float raw = DTRAW[row * NH + h] + dtb;
                const float dtv = raw > 20.f ? raw : log1pf(__expf(raw));
                const float dA = __expf(dtv * av);
                sB[lane] = v[1]; sB[lane + 64] = v[2]; sC[lane] = v[3]; sC[lane + 64] = v[4];
                LDS_WAIT(); asm volatile("" ::: "memory");
                const float xd = dtv * v[0]; float y = 0.f;
#pragma unroll
                for (int n = 0; n < 64; n += 4) { const f32x4 bb = *(const LAS f32x4*)(sB + 64 * nh + n), cc = *(const LAS f32x4*)(sC + 64 * nh + n);
                    hst[n] = hst[n] * dA + xd * bb.x; y += cc.x * hst[n];
                    hst[n + 1] = hst[n + 1] * dA + xd * bb.y; y += cc.y * hst[n + 1];
                    hst[n + 2] = hst[n + 2] * dA + xd * bb.z; y += cc.z * hst[n + 2];
                    hst[n + 3] = hst[n + 3] * dA + xd * bb.w; y += cc.w * hst[n + 3]; }
                LDS_WAIT(); asm volatile("" ::: "memory");
                y += __shfl_xor(y, 32);
                y += dh * v[0];
                const float zv = bf2f(Zb[row * DI + h * HP + pp]);
                const float yg = y * silu_f(zv);
                float sq = (lane < 32) ? yg * yg : 0.f; sq = wave_sum(sq);
                if (lane < 32) Zb[row * DI + h * HP + pp] = (bf16)f2bf(yg);
                if (lane == 0) SSQ[row * 64 + h * 2 + wave] = sq;
            }
        }
#else
        const float* conv_w = args.in[2]; const float* conv_b = args.in[3]; const float* dt_bias = args.in[4]; const float* a_log = args.in[5]; const float* dsk = args.in[6];
        typedef short v4i16 __attribute__((ext_vector_type(4)));
        constexpr int SXB = 144, SBB = 272;
        constexpr int XS_OFF = 0, XW_OFF = 18432, BM_OFF = 36864, CM_OFF = 71680, WM_OFF = 89088, HB_OFF = 98304, VEC_OFF = 133120, CW_OFF = 134144;
        static_assert(CW_OFF + 5 * 64 * 4 <= LDSCTL_OFF, "scan LDS map");
        LAS unsigned char* Lb = F.lds;
        LAS float* cumL = (LAS float*)(Lb + VEC_OFF);
        LAS float* dtL = cumL + 128;
        LAS float* cwl = (LAS float*)(Lb + CW_OFF);
        const int r16 = lane & 15, q4 = lane >> 4;
#define TR8(dst, base_off, stride, k0, c0) do { const LAS unsigned char* _a = Lb + (base_off) + ((k0) + 8 * q4 + (r16 >> 2)) * (stride) + ((c0) + 4 * (lane & 3)) * 2; \
        const v4i16 _lo = __builtin_amdgcn_ds_read_tr16_b64_v4i16((LAS v4i16*)_a), _hi = __builtin_amdgcn_ds_read_tr16_b64_v4i16((LAS v4i16*)(_a + 4 * (stride))); \
        dst = (bf16x8){_lo[0], _lo[1], _lo[2], _lo[3], _hi[0], _hi[1], _hi[2], _hi[3]}; } while (0)
        if (blockIdx.x < NB * NH) {
            const int item = blockIdx.x; const int b = item / NH, h = item % NH, g = h >> 3;
            __syncthreads();
            for (int i = tid; i < 5 * 64; i += 512) { const int k = i >> 6, cl = i & 63; cwl[i] = k < 4 ? conv_w[k * CONVD + h * HP + cl] : conv_b[h * HP + cl]; }
            for (int i = tid; i < SBB * 64 / 4; i += 512) ((LAS unsigned*)(Lb + HB_OFF))[i] = 0u;
            const float dh = dsk[h];
            const int sj = tid >> 3, sxc = tid & 7;
            const bf16* BCACT = (const bf16*)(ws + WS_BCACT);
            const float* cvp = (const float*)(ws + (tid < 64 ? WS_CUMV : WS_DTV)) + ((size_t)b * NH + h) * SEQ + (tid & 63);
            const size_t row0 = (size_t)b * SEQ;
            f32x4 hacc[4];
#pragma unroll
            for (int i = 0; i < 4; ++i) hacc[i] = (f32x4){0.f, 0.f, 0.f, 0.f};
            u32x4 xrA[4], brA[2], crA[2], xrB[4], brB[2], crB[2]; u32x2 zr[2]; float cv = 0.f;
            const int ti = wave & 3, wh = wave >> 2, irow = 16 * ti + r16;
#define SC_LOAD(c, S) do { _Pragma("unroll") for (int k = 0; k < 4; ++k) { const int rr = (c) * 64 + sj - 3 + k; const int rc = rr < 0 ? 0 : rr; \
                xr##S[k] = *(const u32x4*)(XBC + (row0 + rc) * CONVD + h * HP + 8 * sxc); } \
            _Pragma("unroll") for (int i = 0; i < 2; ++i) { const int idx = tid + 512 * i; const bf16* bp_ = BCACT + (row0 + (c) * 64 + (idx >> 4)) * 1024 + g * NS + 8 * (idx & 15); \
                br##S[i] = *(const u32x4*)bp_; cr##S[i] = *(const u32x4*)(bp_ + 512); } } while (0)
#define SC_LOADZ(c) do { _Pragma("unroll") for (int tt = 0; tt < 2; ++tt) zr[tt] = *(const u32x2*)(Zb + (row0 + (c) * 64 + irow) * DI + h * HP + 16 * (2 * wh + tt) + 4 * q4); } while (0)
#define SC_STAGE(c, S) do { const int pr_ = ((c) & 1) * 64, tb_ = (c) & 1; const float wj = __expf(cumL[pr_ + 63] - cumL[pr_ + sj]) * dtL[pr_ + sj]; \
                _Pragma("unroll") for (int k = 0; k < 3; ++k) if ((c) * 64 + sj - 3 + k < 0) xr##S[k] = (u32x4){0u, 0u, 0u, 0u};     \
                _Pragma("unroll") for (int hf = 0; hf < 2; ++hf) { f32x4 aq = *(const LAS f32x4*)(cwl + 4 * 64 + 8 * sxc + 4 * hf); \
                    _Pragma("unroll") for (int k = 0; k < 4; ++k) { const f32x4 wq = *(const LAS f32x4*)(cwl + k * 64 + 8 * sxc + 4 * hf); const unsigned r0_ = hf ? xr##S[k].z : xr##S[k].x, r1_ = hf ? xr##S[k].w : xr##S[k].y; \
                        aq += wq * (f32x4){bflo(r0_), bfhi(r0_), bflo(r1_), bfhi(r1_)}; } \
                    _Pragma("unroll") for (int e = 0; e < 4; ++e) aq[e] = silu_f(aq[e]); \
                    u32x2 o_; o_.x = pk2(aq[0], aq[1]); o_.y = pk2(aq[2], aq[3]); \
                    *(LAS u32x2*)(Lb + XS_OFF + tb_ * 9216 + sj * SXB + 16 * sxc + 8 * hf) = o_; \
                    o_.x = pk2(aq[0] * wj, aq[1] * wj); o_.y = pk2(aq[2] * wj, aq[3] * wj); \
                    *(LAS u32x2*)(Lb + XW_OFF + tb_ * 9216 + sj * SXB + 16 * sxc + 8 * hf) = o_; } \
                _Pragma("unroll") for (int i = 0; i < 2; ++i) { const int idx = tid + 512 * i; \
                    *(LAS u32x4*)(Lb + BM_OFF + tb_ * 17408 + (idx >> 4) * SBB + 16 * (idx & 15)) = br##S[i]; *(LAS u32x4*)(Lb + CM_OFF + (idx >> 4) * SBB + 16 * (idx & 15)) = cr##S[i]; } } while (0)
            if (tid < 128) { cumL[(tid >> 6) * 128 + (tid & 63)] = cvp[0]; cv = cvp[64]; }
            SC_LOAD(0, A); SC_LOADZ(0);
            __syncthreads();
            SC_STAGE(0, A);
            SC_LOAD(1, B);
            __syncthreads();
            for (int c2 = 0; c2 < SEQ / 64; c2 += 2) {
                { const int c = c2; const int pr = (c & 1) * 64, tb = c & 1; const int hb_cur = HB_OFF + (c & 1) * (SBB * 64), hb_nxt = HB_OFF + ((c & 1) ^ 1) * (SBB * 64);
                  if (tid < 128) { if (c + 1 < SEQ / 64) cumL[(tid >> 6) * 128 + (pr ^ 64) + (tid & 63)] = cv; if (c + 2 < SEQ / 64) cv = cvp[(c + 2) * 64]; }
                  SC_LOAD((c + 2 < SEQ / 64 ? c + 2 : SEQ / 64 - 1), A);
                  bf16x8 cf[4], bfr[2][4];
#pragma unroll
                  for (int ks = 0; ks < 4; ++ks) cf[ks] = *(const LAS bf16x8*)(Lb + CM_OFF + irow * SBB + (32 * ks + 8 * q4) * 2);
#pragma unroll
                  for (int tt = 0; tt < 2; ++tt)
#pragma unroll
                      for (int ks = 0; ks < 4; ++ks) bfr[tt][ks] = *(const LAS bf16x8*)(Lb + BM_OFF + tb * 17408 + (16 * (2 * wh + tt) + r16) * SBB + (32 * ks + 8 * q4) * 2);
                  const float ci = cumL[pr + irow];
                  f32x4 cjv[2], djv[2];
#pragma unroll
                  for (int tt = 0; tt < 2; ++tt) { cjv[tt] = *(const LAS f32x4*)(cumL + pr + 16 * (2 * wh + tt) + 4 * q4); djv[tt] = *(const LAS f32x4*)(dtL + pr + 16 * (2 * wh + tt) + 4 * q4); }
                  f32x4 ga[2] = {{0.f, 0.f, 0.f, 0.f}, {0.f, 0.f, 0.f, 0.f}};
#pragma unroll
                  for (int ks = 0; ks < 4; ++ks)
#pragma unroll
                      for (int tt = 0; tt < 2; ++tt) ga[tt] = __builtin_amdgcn_mfma_f32_16x16x32_bf16(bfr[tt][ks], cf[ks], ga[tt], 0, 0, 0);
#pragma unroll
                  for (int tt = 0; tt < 2; ++tt) { const int j0 = 16 * (2 * wh + tt) + 4 * q4; float wv[4];
#pragma unroll
                      for (int r = 0; r < 4; ++r) { const int j = j0 + r; float v = ga[tt][r] * __expf(ci - cjv[tt][r]) * djv[tt][r]; v = (j <= irow) ? v : 0.f; if (j == irow) v += dh; wv[r] = v; }
                      u32x2 w_; w_.x = pk2(wv[0], wv[1]); w_.y = pk2(wv[2], wv[3]);
                      *(LAS u32x2*)(Lb + WM_OFF + irow * SXB + j0 * 2) = w_; }
                  WG_BAR();
                  if (c + 1 < SEQ / 64) SC_STAGE(c + 1, B);
                  { bf16x8 wf[2], xa[2][2], ha[2][4];
#pragma unroll
                    for (int ks = 0; ks < 2; ++ks) wf[ks] = *(const LAS bf16x8*)(Lb + WM_OFF + irow * SXB + (32 * ks + 8 * q4) * 2);
#pragma unroll
                    for (int tt = 0; tt < 2; ++tt) {
#pragma unroll
                        for (int ks = 0; ks < 2; ++ks) TR8(xa[tt][ks], XS_OFF + tb * 9216, SXB, 32 * ks, 16 * (2 * wh + tt));
#pragma unroll
                        for (int ks = 0; ks < 4; ++ks) ha[tt][ks] = *(const LAS bf16x8*)(Lb + hb_cur + (16 * (2 * wh + tt) + r16) * SBB + (32 * ks + 8 * q4) * 2); }
                    f32x4 yd[2] = {{0.f, 0.f, 0.f, 0.f}, {0.f, 0.f, 0.f, 0.f}}, yo[2] = {{0.f, 0.f, 0.f, 0.f}, {0.f, 0.f, 0.f, 0.f}};
#pragma unroll
                    for (int ks = 0; ks < 4; ++ks)
#pragma unroll
                        for (int tt = 0; tt < 2; ++tt) { yo[tt] = __builtin_amdgcn_mfma_f32_16x16x32_bf16(ha[tt][ks], cf[ks], yo[tt], 0, 0, 0); if (ks < 2) yd[tt] = __builtin_amdgcn_mfma_f32_16x16x32_bf16(xa[tt][ks], wf[ks], yd[tt], 0, 0, 0); }
                    const float ec = __expf(ci); float ssq = 0.f;
#pragma unroll
                    for (int tt = 0; tt < 2; ++tt) { const int tp = 2 * wh + tt;
                        const float z0 = bflo(zr[tt].x), z1 = bfhi(zr[tt].x), z2 = bflo(zr[tt].y), z3 = bfhi(zr[tt].y);
                        const float y0 = (yd[tt][0] + ec * yo[tt][0]) * silu_f(z0), y1 = (yd[tt][1] + ec * yo[tt][1]) * silu_f(z1), y2 = (yd[tt][2] + ec * yo[tt][2]) * silu_f(z2), y3 = (yd[tt][3] + ec * yo[tt][3]) * silu_f(z3);
                        ssq += (y0 * y0 + y1 * y1) + (y2 * y2 + y3 * y3);
                        u32x2 o_; o_.x = pk2(y0, y1); o_.y = pk2(y2, y3);
                        *(u32x2*)(Zb + (row0 + c * 64 + irow) * DI + h * HP + 16 * tp + 4 * q4) = o_; }
                    ssq += __shfl_xor(ssq, 16); ssq += __shfl_xor(ssq, 32);
                    if (q4 == 0) SSQ[(row0 + c * 64 + irow) * 64 + h * 2 + wh] = ssq; }
                  SC_LOADZ((c + 1 < SEQ / 64 ? c + 1 : c));
                  { const float eL = __expf(cumL[pr + 63]);
                    bf16x8 ba[2], xb[2][4];
#pragma unroll
                    for (int ks = 0; ks < 2; ++ks) { TR8(ba[ks], BM_OFF + tb * 17408, SBB, 32 * ks, 16 * wave);
#pragma unroll
                        for (int tp = 0; tp < 4; ++tp) TR8(xb[ks][tp], XW_OFF + tb * 9216, SXB, 32 * ks, 16 * tp); }
#pragma unroll
                    for (int tp = 0; tp < 4; ++tp) hacc[tp] = hacc[tp] * eL;
#pragma unroll
                    for (int ks = 0; ks < 2; ++ks)
#pragma unroll
                        for (int tp = 0; tp < 4; ++tp) hacc[tp] = __builtin_amdgcn_mfma_f32_16x16x32_bf16(ba[ks], xb[ks][tp], hacc[tp], 0, 0, 0);
#pragma unroll
                    for (int tp = 0; tp < 4; ++tp) { u32x2 o_; o_.x = pk2(hacc[tp][0], hacc[tp][1]); o_.y = pk2(hacc[tp][2], hacc[tp][3]);
                        *(LAS u32x2*)(Lb + hb_nxt + (16 * tp + r16) * SBB + (16 * wave + 4 * q4) * 2) = o_; } }
                  WG_BAR();
                }
                { const int c = c2 + 1; const int pr = (c & 1) * 64, tb = c & 1; const int hb_cur = HB_OFF + (c & 1) * (SBB * 64), hb_nxt = HB_OFF + ((c & 1) ^ 1) * (SBB * 64);
                  if (tid < 128) { if (c + 1 < SEQ / 64) cumL[(tid >> 6) * 128 + (pr ^ 64) + (tid & 63)] = cv; if (c + 2 < SEQ / 64) cv = cvp[(c + 2) * 64]; }
                  SC_LOAD((c + 2 < SEQ / 64 ? c + 2 : SEQ / 64 - 1), B);
                  bf16x8 cf[4], bfr[2][4];
#pragma unroll
                  for (int ks = 0; ks < 4; ++ks) cf[ks] = *(const LAS bf16x8*)(Lb + CM_OFF + irow * SBB + (32 * ks + 8 * q4) * 2);
#pragma unroll
                  for (int tt = 0; tt < 2; ++tt)
#pragma unroll
                      for (int ks = 0; ks < 4; ++ks) bfr[tt][ks] = *(const LAS bf16x8*)(Lb + BM_OFF + tb * 17408 + (16 * (2 * wh + tt) + r16) * SBB + (32 * ks + 8 * q4) * 2);
                  const float ci = cumL[pr + irow];
                  f32x4 cjv[2], djv[2];
#pragma unroll
                  for (int tt = 0; tt < 2; ++tt) { cjv[tt] = *(const LAS f32x4*)(cumL + pr + 16 * (2 * wh + tt) + 4 * q4); djv[tt] = *(const LAS f32x4*)(dtL + pr + 16 * (2 * wh + tt) + 4 * q4); }
                  f32x4 ga[2] = {{0.f, 0.f, 0.f, 0.f}, {0.f, 0.f, 0.f, 0.f}};
#pragma unroll
                  for (int ks = 0; ks < 4; ++ks)
#pragma unroll
                      for (int tt = 0; tt < 2; ++tt) ga[tt] = __builtin_amdgcn_mfma_f32_16x16x32_bf16(bfr[tt][ks], cf[ks], ga[tt], 0, 0, 0);
#pragma unroll
                  for (int tt = 0; tt < 2; ++tt) { const int j0 = 16 * (2 * wh + tt) + 4 * q4; float wv[4];
#pragma unroll
                      for (int r = 0; r < 4; ++r) { const int j = j0 + r; float v = ga[tt][r] * __expf(ci - cjv[tt][r]) * djv[tt][r]; v = (j <= irow) ? v : 0.f; if (j == irow) v += dh; wv[r] = v; }
                      u32x2 w_; w_.x = pk2(wv[0], wv[1]); w_.y = pk2(wv[2], wv[3]);
                      *(LAS u32x2*)(Lb + WM_OFF + irow * SXB + j0 * 2) = w_; }
                  WG_BAR();
                  if (c + 1 < SEQ / 64) SC_STAGE(c + 1, A);
                  { bf16x8 wf[2], xa[2][2], ha[2][4];
#pragma unroll
                    for (int ks = 0; ks < 2; ++ks) wf[ks] = *(const LAS bf16x8*)(Lb + WM_OFF + irow * SXB + (32 * ks + 8 * q4) * 2);
#pragma unroll
                    for (int tt = 0; tt < 2; ++tt) {
#pragma unroll
                        for (int ks = 0; ks < 2; ++ks) TR8(xa[tt][ks], XS_OFF + tb * 9216, SXB, 32 * ks, 16 * (2 * wh + tt));
#pragma unroll
                        for (int ks = 0; ks < 4; ++ks) ha[tt][ks] = *(const LAS bf16x8*)(Lb + hb_cur + (16 * (2 * wh + tt) + r16) * SBB + (32 * ks + 8 * q4) * 2); }
                    f32x4 yd[2] = {{0.f, 0.f, 0.f, 0.f}, {0.f, 0.f, 0.f, 0.f}}, yo[2] = {{0.f, 0.f, 0.f, 0.f}, {0.f, 0.f, 0.f, 0.f}};
#pragma unroll
                    for (int ks = 0; ks < 4; ++ks)
#pragma unroll
                        for (int tt = 0; tt < 2; ++tt) { yo[tt] = __builtin_amdgcn_mfma_f32_16x16x32_bf16(ha[tt][ks], cf[ks], yo[tt], 0, 0, 0); if (ks < 2) yd[tt] = __builtin_amdgcn_mfma_f32_16x16x32_bf16(xa[tt][ks], wf[ks], yd[tt], 0, 0, 0); }
                    const float ec = __expf(ci); float ssq = 0.f;
#pragma unroll
                    for (int tt = 0; tt < 2; ++tt) { const int tp = 2 * wh + tt;
                        const float z0 = bflo(zr[tt].x), z1 = bfhi(zr[tt].x), z2 = bflo(zr[tt].y), z3 = bfhi(zr[tt].y);
                        const float y0 = (yd[tt][0] + ec * yo[tt][0]) * silu_f(z0), y1 = (yd[tt][1] + ec * yo[tt][1]) * silu_f(z1), y2 = (yd[tt][2] + ec * yo[tt][2]) * silu_f(z2), y3 = (yd[tt][3] + ec * yo[tt][3]) * silu_f(z3);
                        ssq += (y0 * y0 + y1 * y1) + (y2 * y2 + y3 * y3);
                        u32x2 o_; o_.x = pk2(y0, y1); o_.y = pk2(y2, y3);
                        *(u32x2*)(Zb + (row0 + c * 64 + irow) * DI + h * HP + 16 * tp + 4 * q4) = o_; }
                    ssq += __shfl_xor(ssq, 16); ssq += __shfl_xor(ssq, 32);
                    if (q4 == 0) SSQ[(row0 + c * 64 + irow) * 64 + h * 2 + wh] = ssq; }
                  SC_LOADZ((c + 1 < SEQ / 64 ? c + 1 : c));
                  { const float eL = __expf(cumL[pr + 63]);
                    bf16x8 ba[2], xb[2][4];
#pragma unroll
                    for (int ks = 0; ks < 2; ++ks) { TR8(ba[ks], BM_OFF + tb * 17408, SBB, 32 * ks, 16 * wave);
#pragma unroll
                        for (int tp = 0; tp < 4; ++tp) TR8(xb[ks][tp], XW_OFF + tb * 9216, SXB, 32 * ks, 16 * tp); }
#pragma unroll
                    for (int tp = 0; tp < 4; ++tp) hacc[tp] = hacc[tp] * eL;
#pragma unroll
                    for (int ks = 0; ks < 2; ++ks)
#pragma unroll
                        for (int tp = 0; tp < 4; ++tp) hacc[tp] = __builtin_amdgcn_mfma_f32_16x16x32_bf16(ba[ks], xb[ks][tp], hacc[tp], 0, 0, 0);
#pragma unroll
                    for (int tp = 0; tp < 4; ++tp) { u32x2 o_; o_.x = pk2(hacc[tp][0], hacc[tp][1]); o_.y = pk2(hacc[tp][2], hacc[tp][3]);
                        *(LAS u32x2*)(Lb + hb_nxt + (16 * tp + r16) * SBB + (16 * wave + 4 * q4) * 2) = o_; } }
                  WG_BAR();
                }
            }
        }
#undef SC_LOADZ
#undef TR8
#undef SC_LOAD
#undef SC_STAGE
#endif
    }
    SEAM(3);

    if (IN(4)) { PH_LOCALS
        { float pn = 0.f; u32x4 yn[4];
#define NM_LOAD(mm) do { pn = SSQ[(size_t)(mm) * 64 + lane]; _Pragma("unroll") for (int j = 0; j < 4; ++j) yn[j] = *(const u32x4*)(Zb + (size_t)(mm) * DI + j * 512 + lane * 8); } while (0)
          if (gw < T) NM_LOAD(gw);
          for (int m = gw; m < T; m += NGW) {
            float p = pn; u32x4 yw[4];
#pragma unroll
            for (int j = 0; j < 4; ++j) yw[j] = yn[j];
            NM_LOAD((m + NGW < T ? m + NGW : m));
            p += dpp_mov<0xB1>(p); p += dpp_mov<0x4E>(p); p += dpp_mov<0x141>(p); p += dpp_mov<0x140>(p);
            bf16* yr = Zb + (size_t)m * DI;
#pragma unroll
            for (int j = 0; j < 4; ++j) { const float ss = __builtin_bit_cast(float, __builtin_amdgcn_readlane(__builtin_bit_cast(int, p), 16 * j)); const float rs = 1.f / sqrtf(ss * (1.f / 512.f) + RMS_EPS);
                u32x4 w = yw[j];
                w.x = pk2(bflo(w.x) * rs, bfhi(w.x) * rs); w.y = pk2(bflo(w.y) * rs, bfhi(w.y) * rs); w.z = pk2(bflo(w.z) * rs, bfhi(w.z) * rs); w.w = pk2(bflo(w.w) * rs, bfhi(w.w) * rs);
                *(u32x4*)(yr + j * 512 + lane * 8) = w; }
          }
#undef NM_LOAD
        }
        LAS float* scr = (LAS float*)(F.lds + wave * 16384);
        constexpr int I_QKV = (D / 64) * (3 * D / 32), I_O = (D / 64) * (D / 32), I_G = (D / 64) * (DFF / 32), I_D = (DFF / 64) * (D / 32);
        constexpr int I_MOE = 2 * NE * (2 * I_G + I_D);
        for (int it = gw; it < I_QKV + I_O + I_MOE; it += NGW) {
            int r = it;
            if (r < I_QKV) { transpose_item(args.in[9], D, 3 * D, (bf16*)(ws + WS_WQKV), 0, 0, nullptr, scr, r, lane); continue; } r -= I_QKV;
            if (r < I_O) { transpose_item(args.in[12], D, D, (bf16*)(ws + WS_WO), 0, 0, nullptr, scr, r, lane); continue; } r -= I_O;
            const int le = r / (2 * I_G + I_D), L = le / NE, e = le % NE; r -= le * (2 * I_G + I_D);
            bf16* wgu = (bf16*)(ws + (L ? WS_WGU1 : WS_WGU0)) + (size_t)e * 1024 * D; bf16* wd = (bf16*)(ws + (L ? WS_WD1 : WS_WD0)) + (size_t)e * D * DFF;
            if (r < I_G) { transpose_item(args.in[16] + (size_t)le * D * DFF, D, DFF, wgu, 0, 1, nullptr, scr, r, lane); continue; } r -= I_G;
            if (r < I_G) { transpose_item(args.in[17] + (size_t)le * D * DFF, D, DFF, wgu, 0, 2, nullptr, scr, r, lane); continue; } r -= I_G;
            transpose_item(args.in[18] + (size_t)le * DFF * D, DFF, D, wd, 0, 0, nullptr, scr, r, lane);
        }
    }
    SEAM(4);

    if (IN(5)) { PH_LOCALS
        pg8::DenseOrder S; S.init(T, D, F.G, (int)blockIdx.x, DI);
        pg8::EpiPlain E{(bf16*)(ws + WS_MIX1), D, nullptr, 0, 1.f};
        pg8::gemm_phase<pg8::EpiPlain, pg8::DenseOrder>(F.lds, Zb, Wt_out, DI, S, E);
    }
    SEAM(5);

    layer_tail<0>(args, F, bar, lo, hi);
    SEAM(9);

    if (IN(10)) { PH_LOCALS
        pg8::DenseOrder S; S.init(T, 3 * D, F.G, (int)blockIdx.x, D);
        pg8::EpiPlain E{(bf16*)(ws + WS_QKV), 3 * D, args.in[10], D, 0.125f};
        pg8::gemm_phase<pg8::EpiPlain, pg8::DenseOrder>(F.lds, (const bf16*)(ws + WS_X2B), (const bf16*)(ws + WS_WQKV), D, S, E);
    }
    SEAM(10);
    if (IN(11)) { PH_LOCALS
#if NAIVE_ATTN
        const bf16* QKV = (const bf16*)(ws + WS_QKV); bf16* AO = (bf16*)(ws + WS_AO); const float* rel = args.in[11];
        for (int idx = blockIdx.x * 512 + tid; idx < NB * AH * SEQ; idx += F.G * 512) {
            const int s = idx % SEQ, bh = idx / SEQ, hh = bh % AH, b = bh / AH, c = s / 64;
            const bf16* qp = QKV + ((size_t)b * SEQ + s) * (3 * D) + hh * AD;
            float q[AD], o[AD];
#pragma unroll
            for (int d = 0; d < AD; ++d) { q[d] = bf2f(qp[d]); o[d] = 0.f; }
            float mx = -1e30f, l = 0.f;
            const int k0 = (c - LEFTC) * 64 < 0 ? 0 : (c - LEFTC) * 64, k1 = c * 64 + 64;
            for (int kp = k0; kp < k1; ++kp) {
                const bf16* kr = QKV + ((size_t)b * SEQ + kp) * (3 * D) + D + hh * AD; const bf16* vr = kr + D;
                float sc = 0.f;
#pragma unroll
                for (int d = 0; d < AD; d += 2) { const unsigned w = *(const unsigned*)(kr + d); sc += q[d] * bflo(w) + q[d + 1] * bfhi(w); }
                int dist = s - kp; dist = dist < -MAXREL ? -MAXREL : (dist > MAXREL ? MAXREL : dist);
                sc += rel[(dist + MAXREL) * AH + hh];
                const float mn = fmaxf(mx, sc), f = __expf(mx - mn), p = __expf(sc - mn);
                l = l * f + p; mx = mn;
#pragma unroll
                for (int d = 0; d < AD; d += 2) { const unsigned w = *(const unsigned*)(vr + d); o[d] = o[d] * f + p * bflo(w); o[d + 1] = o[d + 1] * f + p * bfhi(w); }
            }
            const float il = 1.f / l; bf16* op = AO + ((size_t)b * SEQ + s) * D + hh * AD;
#pragma unroll
            for (int d = 0; d < AD; d += 2) *(unsigned*)(op + d) = pk2(o[d] * il, o[d + 1] * il);
        }
#else
        const bf16* QKV = (const bf16*)(ws + WS_QKV); bf16* AO = (bf16*)(ws + WS_AO); const float* rel = args.in[11];
        typedef short v4i16 __attribute__((ext_vector_type(4)));
        constexpr int SKB = 144, KB_OFF = 0, VB_OFF = 18432, TB_OFF = 36864; constexpr float LOG2E = 1.4426950408889634f;
        LAS unsigned char* Lb = F.lds; LAS float* tb = (LAS float*)(Lb + TB_OFF);
        const int r16 = lane & 15, q4 = lane >> 4, wq = wave >> 2;
        const int NU = NB * AH * (SEQ / 128), per = (NU + F.G - 1) / F.G;
        const int u_begin = F.vcu * per, u_end = (u_begin + per < NU) ? u_begin + per : NU;
        const int kr = tid >> 3, pc = tid & 7;
        if (u_begin < u_end) {
            u32x4 kq[3], vq[3];
#define AT_KTLO(u_) ((2 * ((u_) & 31)) < 8 ? 8 - 2 * ((u_) & 31) : 0)
#define AT_ISSUE(slot) do { { const int lu_ = lu < u_end ? lu : u_end - 1, lk_ = lu < u_end ? lkt : 9;        \
                const int b_ = lu_ >> 9, hh_ = (lu_ >> 5) & 15, c0_ = 2 * (lu_ & 31); \
                const bf16* p_ = QKV + ((size_t)b_ * SEQ + (size_t)(c0_ - 8 + lk_) * 64 + kr) * (3 * D) + D + hh_ * AD + 8 * pc; kq[slot] = *(const u32x4*)p_; vq[slot] = *(const u32x4*)(p_ + D); } \
            ++lkt; if (lkt == 10) { ++lu; lkt = AT_KTLO(lu); } } while (0)
#define AT_QLOAD(dst, u_) do { const int b_ = (u_) >> 9, hh_ = ((u_) >> 5) & 15, c0_ = 2 * ((u_) & 31); const int qr_ = 64 * (c0_ + wq) + 16 * (wave & 3) + r16; \
            _Pragma("unroll") for (int ds = 0; ds < 2; ++ds) dst[ds] = *(const bf16x8*)(QKV + ((size_t)b_ * SEQ + qr_) * (3 * D) + hh_ * AD + 32 * ds + 8 * q4); } while (0)
            int lu = u_begin, lkt = AT_KTLO(u_begin);
            int cu = u_begin, ckt = AT_KTLO(u_begin), step = 0;
            int hcur = (cu >> 5) & 15;
            __syncthreads();
            for (int i = tid; i < 384; i += 512) tb[i] = rel[(i < 2 * MAXREL ? i : 2 * MAXREL) * AH + hcur] * LOG2E;
            AT_ISSUE(0); AT_ISSUE(1); AT_ISSUE(2);
            bf16x8 qf[2], qn[2];
            AT_QLOAD(qf, cu);
            qn[0] = qf[0]; qn[1] = qf[1];
            AT_QLOAD(qn, (cu + 1 < u_end ? cu + 1 : cu));
            *(LAS u32x4*)(Lb + KB_OFF + kr * SKB + pc * 16) = kq[0]; *(LAS u32x4*)(Lb + VB_OFF + kr * SKB + pc * 16) = vq[0];
            f32x4 oacc[4];
#pragma unroll
            for (int i = 0; i < 4; ++i) oacc[i] = (f32x4){0.f, 0.f, 0.f, 0.f};
            float mrun = -1e30f, lrun = 0.f;
            WG_BAR();
#define AT_STEP(J) do { \
            AT_ISSUE(J);                                                                          \
            { const int b = cu >> 9, hh = (cu >> 5) & 15, c0 = 2 * (cu & 31); const int cw = c0 + wq, qrow = 64 * cw + 16 * (wave & 3) + r16, chunk = c0 - 8 + ckt, par = step & 1; \
              if (ckt >= wq && ckt <= wq + 8) { \
                const LAS unsigned char* Kb = Lb + KB_OFF + par * 9216; const LAS unsigned char* Vb = Lb + VB_OFF + par * 9216; \
                bf16x8 kf[4][2]; \
                _Pragma("unroll") for (int t = 0; t < 4; ++t) _Pragma("unroll") for (int ds = 0; ds < 2; ++ds) kf[t][ds] = *(const LAS bf16x8*)(Kb + (16 * t + r16) * SKB + (32 * ds + 8 * q4) * 2); \
                f32x4 sc[4]; \
                _Pragma("unroll") for (int t = 0; t < 4; ++t) sc[t] = (f32x4){0.f, 0.f, 0.f, 0.f}; \
                _Pragma("unroll") for (int ds = 0; ds < 2; ++ds) _Pragma("unroll") for (int t = 0; t < 4; ++t) sc[t] = __builtin_amdgcn_mfma_f32_16x16x32_bf16(kf[t][ds], qf[ds], sc[t], 0, 0, 0); \
                bf16x8 vf[4][2]; \
                _Pragma("unroll") for (int dt = 0; dt < 4; ++dt) _Pragma("unroll") for (int kk = 0; kk < 2; ++kk) { const LAS unsigned char* va_ = Vb + (32 * kk + 4 * q4 + (r16 >> 2)) * SKB + (16 * dt + 4 * (lane & 3)) * 2; \
                    const v4i16 lo_ = __builtin_amdgcn_ds_read_tr16_b64_v4i16((LAS v4i16*)va_), hi_ = __builtin_amdgcn_ds_read_tr16_b64_v4i16((LAS v4i16*)(va_ + 16 * SKB)); \
                    vf[dt][kk] = (bf16x8){lo_[0], lo_[1], lo_[2], lo_[3], hi_[0], hi_[1], hi_[2], hi_[3]}; } \
                if (cw - chunk >= 3) { const float bc = tb[2 * MAXREL]; \
                    _Pragma("unroll") for (int t = 0; t < 4; ++t) sc[t] = sc[t] * LOG2E + bc; \
                } else { \
                    const LAS float* tbp = tb + (qrow - 64 * chunk - 4 * q4 + MAXREL);            \
                    _Pragma("unroll") for (int t = 0; t < 4; ++t) _Pragma("unroll") for (int r = 0; r < 4; ++r) sc[t][r] = sc[t][r] * LOG2E + tbp[-(16 * t + r)]; \
                } \
                float mx = fmaxf(fmaxf(sc[0][0], sc[0][1]), fmaxf(sc[0][2], sc[0][3])); \
                _Pragma("unroll") for (int t = 1; t < 4; ++t) mx = fmaxf(mx, fmaxf(fmaxf(sc[t][0], sc[t][1]), fmaxf(sc[t][2], sc[t][3]))); \
                if (__any(mx > mrun + 8.f)) {                                                       \
                    mx = fmaxf(mx, __shfl_xor(mx, 16)); mx = fmaxf(mx, __shfl_xor(mx, 32)); \
                    const float mnew = fmaxf(mrun, mx), alpha = __builtin_amdgcn_exp2f(mrun - mnew); mrun = mnew; lrun *= alpha; \
                    _Pragma("unroll") for (int i = 0; i < 4; ++i) oacc[i] = oacc[i] * alpha; } \
                float ls = 0.f; \
                _Pragma("unroll") for (int t = 0; t < 4; ++t) _Pragma("unroll") for (int r = 0; r < 4; ++r) { sc[t][r] = __builtin_amdgcn_exp2f(sc[t][r] - mrun); ls += sc[t][r]; } \
                lrun += ls; \
                bf16x8 pb[2]; \
                _Pragma("unroll") for (int kk = 0; kk < 2; ++kk) { u32x4 w_; w_.x = pk2(sc[2 * kk][0], sc[2 * kk][1]); w_.y = pk2(sc[2 * kk][2], sc[2 * kk][3]); w_.z = pk2(sc[2 * kk + 1][0], sc[2 * kk + 1][1]); w_.w = pk2(sc[2 * kk + 1][2], sc[2 * kk + 1][3]); pb[kk] = __builtin_bit_cast(bf16x8, w_); } \
                _Pragma("unroll") for (int kk = 0; kk < 2; ++kk) _Pragma("unroll") for (int dt = 0; dt < 4; ++dt) oacc[dt] = __builtin_amdgcn_mfma_f32_16x16x32_bf16(vf[dt][kk], pb[kk], oacc[dt], 0, 0, 0); \
              } \
              if (ckt == 9) {                                                                     \
                lrun += __shfl_xor(lrun, 16); lrun += __shfl_xor(lrun, 32); \
                const float il = 1.f / lrun; bf16* op = AO + ((size_t)b * SEQ + qrow) * D + hh * AD + 4 * q4; \
                _Pragma("unroll") for (int dt = 0; dt < 4; ++dt) { u32x2 o_; o_.x = pk2(oacc[dt][0] * il, oacc[dt][1] * il); o_.y = pk2(oacc[dt][2] * il, oacc[dt][3] * il); *(u32x2*)(op + 16 * dt) = o_; oacc[dt] = (f32x4){0.f, 0.f, 0.f, 0.f}; } \
                mrun = -1e30f; lrun = 0.f; ++cu; ckt = AT_KTLO(cu); qf[0] = qn[0]; qf[1] = qn[1]; \
                AT_QLOAD(qn, (cu + 1 < u_end ? cu + 1 : u_end - 1)); \
                if (cu < u_end && ((cu >> 5) & 15) != hcur) { hcur = (cu >> 5) & 15; WG_BAR(); for (int i = tid; i < 384; i += 512) tb[i] = rel[(i < 2 * MAXREL ? i : 2 * MAXREL) * AH + hcur] * LOG2E; } \
              } else ++ckt; \
              *(LAS u32x4*)(Lb + KB_OFF + (par ^ 1) * 9216 + kr * SKB + pc * 16) = kq[((J) + 1) % 3]; *(LAS u32x4*)(Lb + VB_OFF + (par ^ 1) * 9216 + kr * SKB + pc * 16) = vq[((J) + 1) % 3]; \
              WG_BAR(); ++step; } } while (0)
            while (cu < u_end) { AT_STEP(0); if (cu >= u_end) break; AT_STEP(1); if (cu >= u_end) break; AT_STEP(2); }
#undef AT_STEP
#undef AT_QLOAD
#undef AT_ISSUE
#undef AT_KTLO
        }
#endif
    }
    SEAM(11);
    if (IN(12)) { PH_LOCALS
        pg8::DenseOrder S; S.init(T, D, F.G, (int)blockIdx.x, D);
        pg8::EpiPlain E{(bf16*)(ws + WS_MIX2), D, args.in[13], 0, 1.f};
        pg8::gemm_phase<pg8::EpiPlain, pg8::DenseOrder>(F.lds, (const bf16*)(ws + WS_AO), (const bf16*)(ws + WS_WO), D, S, E);
    }
    SEAM(12);
    layer_tail<1>(args, F, bar, lo, hi);
#undef IN
#undef SEAM
}

extern "C" void kernel_launch(void* const* d_in, const int* in_sizes, int n_in, void* d_out, int out_size, void* d_ws, size_t ws_size, hipStream_t stream) {
    static int grid = 0;
    if (grid == 0) {
        if (n_in != 23 || in_sizes[0] != T * D || out_size != T * D || ws_size < WS_END) { fprintf(stderr, "kernel_launch: unexpected shapes / workspace (n_in %d, ws %zu); nothing launched\n", n_in, ws_size); grid = -1; return; }
        int dev = 0, cus = 0, per_cu = 0;
        if (hipGetDevice(&dev) != hipSuccess || hipDeviceGetAttribute(&cus, hipDeviceAttributeMultiprocessorCount, dev) != hipSuccess) { grid = -1; return; }
        if (hipFuncSetAttribute((const void*)fwd_kernel, hipFuncAttributeMaxDynamicSharedMemorySize, LDS_BYTES) != hipSuccess) { fprintf(stderr, "kernel_launch: hipFuncSetAttribute failed\n"); grid = -1; return; }
        if (hipOccupancyMaxActiveBlocksPerMultiprocessor(&per_cu, (const void*)fwd_kernel, 512, LDS_BYTES) != hipSuccess || per_cu < 1) fprintf(stderr, "kernel_launch: occupancy query reports %d\n", per_cu);
        (void)hipGetLastError();
        grid = cus;
    }
    if (grid < 0) return;
    if (hipMemsetAsync((char*)d_ws + WS_CTL, 0, CTL_ZERO_BYTES, stream) != hipSuccess) return;
    Args a{};
    for (int i = 0; i < 23; ++i) a.in[i] = (const float*)d_in[i];
    a.out = (float*)d_out; a.ws = (unsigned char*)d_ws;
    if (MK_N_LAUNCHES == 1) { a.ph_lo = 0; a.ph_hi = NPHASE; hipLaunchKernelGGL(fwd_kernel, dim3(grid), dim3(512), LDS_BYTES, stream, a);
#ifdef PROBE_MASK
        for (int p = 0; p < NPHASE; ++p) if ((PROBE_MASK >> p) & 1) { a.ph_lo = p; a.ph_hi = p + 1; hipLaunchKernelGGL(fwd_kernel, dim3(grid), dim3(512), LDS_BYTES, stream, a); }
#endif
    }
    else for (int p = 0; p < NPHASE; ++p) { a.ph_lo = p; a.ph_hi = p + 1; hipLaunchKernelGGL(fwd_kernel, dim3(grid), dim3(512), LDS_BYTES, stream, a); }
}
```

```cpp
#include <hip/hip_runtime.h>
#include <cstdio>
#include <cstdint>

#ifndef MK_N_LAUNCHES
#define MK_N_LAUNCHES 1
#endif
#ifndef NAIVE_SCAN
#define NAIVE_SCAN 0
#endif
#ifndef NAIVE_ATTN
#define NAIVE_ATTN 0
#endif

#define LAS __attribute__((address_space(3)))
#define GAS __attribute__((address_space(1)))
typedef unsigned short bf16;
typedef short bf16x8 __attribute__((ext_vector_type(8)));
typedef float f32x4 __attribute__((ext_vector_type(4)));
typedef float f32x2 __attribute__((ext_vector_type(2)));
typedef unsigned u32x4 __attribute__((ext_vector_type(4)));
typedef unsigned u32x2 __attribute__((ext_vector_type(2)));
typedef GAS unsigned gu32;

constexpr int NB = 8, SEQ = 4096, D = 1024, T = NB * SEQ;
constexpr int DI = 2048, NH = 32, HP = 64, NG = 4, NS = 128, CONVD = 3072, INP = 5152, NZX = 5120;
constexpr int AH = 16, AD = 64, LEFTC = 8, MAXREL = 128;
constexpr int NE = 16, DFF = 512;
constexpr float ALPHA = 1.4142135623730951f;
constexpr float LN_EPS = 1e-5f, RMS_EPS = 1e-5f;
constexpr int NPHASE = 17;
constexpr int MAXTILES = 272;

constexpr size_t MiB = 1u << 20;
constexpr size_t WS_CTL = 0, CTL_ZERO_BYTES = 1 * MiB;
constexpr size_t WS_WIN = 1 * MiB;
constexpr size_t WS_WOUT = 12 * MiB;
constexpr size_t WS_XB = 16 * MiB;
constexpr size_t WS_BCACT = 16 * MiB;
constexpr size_t WS_WGU0 = 16 * MiB, WS_WD0 = 48 * MiB, WS_WQKV = 64 * MiB, WS_WO = 70 * MiB, WS_WGU1 = 72 * MiB, WS_WD1 = 104 * MiB;
constexpr size_t WS_Z = 120 * MiB;
constexpr size_t WS_XBC = 248 * MiB;
constexpr size_t WS_DTRAW = 440 * MiB;
constexpr size_t WS_SSQ = 444 * MiB;
constexpr size_t WS_CUMV = 452 * MiB;
constexpr size_t WS_DTV = 456 * MiB;
constexpr size_t WS_MIX1 = 248 * MiB;
constexpr size_t WS_X1B = 324 * MiB;
constexpr size_t WS_H0 = 120 * MiB;
constexpr size_t WS_Y20 = 188 * MiB;
constexpr size_t WS_X2B = 120 * MiB;
constexpr size_t WS_QKV = 188 * MiB;
constexpr size_t WS_AO = 380 * MiB;
constexpr size_t WS_MIX2 = 188 * MiB;
constexpr size_t WS_X3B = 256 * MiB;
constexpr size_t WS_H1 = 320 * MiB;
constexpr size_t WS_Y21 = 120 * MiB;
constexpr size_t WS_LIST = 500 * MiB;
constexpr size_t WS_INFO = 504 * MiB;
constexpr size_t WS_END = 512 * MiB;
constexpr int CW_TMO = 0;
constexpr int CW_CNT = 1024;
constexpr int CW_BAR = 4096;

constexpr int RING_BYTES = 131072;
constexpr int LDSCTL_OFF = 139264, MISC_OFF = LDSCTL_OFF + 320;
constexpr int TOKL_OFF = LDSCTL_OFF + 1024;
constexpr int MOE_OFF = TOKL_OFF + 6 * 1024;
constexpr int LDS_BYTES = 147456;

#define RLX_AGENT __ATOMIC_RELAXED, __HIP_MEMORY_SCOPE_AGENT
#define LDS_WAIT() asm volatile("s_waitcnt lgkmcnt(0)" ::: "memory")
#define VM_WAIT() asm volatile("s_waitcnt vmcnt(0)" ::: "memory")
#define WG_BAR() do { asm volatile("s_waitcnt lgkmcnt(0)" ::: "memory"); __builtin_amdgcn_s_barrier(); asm volatile("" ::: "memory"); } while (0)

__device__ __forceinline__ unsigned f2bf(float f) { unsigned u = __builtin_bit_cast(unsigned, f); return (u + 0x7fffu + ((u >> 16) & 1u)) >> 16; }
__device__ __forceinline__ unsigned pk2(float lo, float hi) { return f2bf(lo) | (f2bf(hi) << 16); }
__device__ __forceinline__ float bf2f(unsigned short b) { return __builtin_bit_cast(float, ((unsigned)b) << 16); }
__device__ __forceinline__ float bflo(unsigned w) { return __builtin_bit_cast(float, w << 16); }
__device__ __forceinline__ float bfhi(unsigned w) { return __builtin_bit_cast(float, w & 0xffff0000u); }
__device__ __forceinline__ float silu_f(float v) { return v * __builtin_amdgcn_rcpf(1.f + __expf(-v)); }
template <int CTRL> __device__ __forceinline__ float dpp_mov(float v) { return __builtin_bit_cast(float, __builtin_amdgcn_update_dpp(0, __builtin_bit_cast(int, v), CTRL, 0xF, 0xF, true)); }
__device__ __forceinline__ float wave_sum(float v) {
    v += dpp_mov<0xB1>(v); v += dpp_mov<0x4E>(v); v += dpp_mov<0x141>(v); v += dpp_mov<0x140>(v);
    const int vi = __builtin_bit_cast(int, v);
    return (__builtin_bit_cast(float, __builtin_amdgcn_readlane(vi, 0)) + __builtin_bit_cast(float, __builtin_amdgcn_readlane(vi, 16))) + (__builtin_bit_cast(float, __builtin_amdgcn_readlane(vi, 32)) + __builtin_bit_cast(float, __builtin_amdgcn_readlane(vi, 48)));
}

namespace pg8 {
constexpr int BM = 256, BK = 64, HALF = 128, HTB = HALF * BK * 2, STAGE_BYTES = 8 * HTB;
__device__ __forceinline__ int lds_byte(int r, int c) { const int st = (r >> 4) * 2 + (c >> 5), rr = r & 15, cc = c & 31, ob = rr * 64 + cc * 2; return st * 1024 + (ob ^ (((ob >> 9) & 1) << 5)); }
__device__ __forceinline__ void stage_rc(int b, int& R, int& C) { const int st = b / 1024, sb = b % 1024, swz = sb ^ (((sb >> 9) & 1) << 5); R = (st >> 1) * 16 + swz / 64; C = (st & 1) * 32 + (swz % 64) / 2; }
__device__ __forceinline__ int perm32(int rho) { const int n = rho >> 4, i = rho & 15; return 8 * (i >> 2) + 4 * n + (i & 3); }
__device__ __forceinline__ unsigned cvt_pk_bf16(float lo, float hi) { unsigned r; asm volatile("v_cvt_pk_bf16_f32 %0, %1, %2" : "=v"(r) : "v"(lo), "v"(hi)); return r; }

struct Unit { int pm, pn, bt, e; };

template <class Epi, class Sched>
__device__ __forceinline__ void gemm_phase(LAS unsigned char* lds, const bf16* A, const bf16* Bt, int K, const Sched& S, const Epi& E) {
    int tid = threadIdx.x; asm volatile("" : "+v"(tid));
    const int wid = __builtin_amdgcn_readfirstlane(tid >> 6), lane = tid & 63, wr = wid >> 2, wc = wid & 3, fr = lane & 15, fq = lane >> 4;
    const int nt = K / BK;
    int Rr[2], Cc[2]; unsigned voffB[2];
#pragma unroll
    for (int i = 0; i < 2; ++i) { stage_rc(tid * 16 + i * 8192, Rr[i], Cc[i]); const int Rb = (Rr[i] & ~31) + perm32(Rr[i] & 31); voffB[i] = (unsigned)(Rb * K + Cc[i]) * 2u; }
    const size_t kstep = (size_t)(BK * 2);
    const size_t hstep = (size_t)HALF * K * 2;
    const size_t tstep = 2 * hstep;
    const unsigned ldsw = (unsigned)wid * 1024u;
    const int aoff = lds_byte(wr * 64 + fr, fq * 8), boff = lds_byte(wc * 32 + fr, fq * 8);
#define PG8_SA(b, h) (((b) * 2 + (h)) * HTB)
#define PG8_SB(b, h) ((4 + (b) * 2 + (h)) * HTB)
#define PG8_STAGE(bufoff, gbase, voff) do { _Pragma("unroll") for (int _i = 0; _i < 2; ++_i) \
        __builtin_amdgcn_global_load_lds((const unsigned*)((const char*)(gbase) + (voff)[_i]), (LAS unsigned*)(lds + (bufoff) + ldsw + _i * 8192), 16, 0, 0); } while (0)
#define PG8_LDA(dst, b, h) do { _Pragma("unroll") for (int m = 0; m < 4; ++m) _Pragma("unroll") for (int k = 0; k < 2; ++k) dst[m][k] = *(const LAS bf16x8*)(lds + PG8_SA(b, h) + aoff + m * 2048 + k * 1024); } while (0)
#define PG8_LDB(dst, b, h) do { _Pragma("unroll") for (int n = 0; n < 2; ++n) _Pragma("unroll") for (int k = 0; k < 2; ++k) dst[n][k] = *(const LAS bf16x8*)(lds + PG8_SB(b, h) + boff + n * 2048 + k * 1024); } while (0)
#define PG8_MMA(ai, bj, At, Bt_) do { __builtin_amdgcn_s_setprio(1); _Pragma("unroll") for (int m = 0; m < 4; ++m) _Pragma("unroll") for (int n = 0; n < 2; ++n) _Pragma("unroll") for (int k = 0; k < 2; ++k) \
        acc[ai][bj][m][n] = __builtin_amdgcn_mfma_f32_16x16x32_bf16(Bt_[n][k], At[m][k], acc[ai][bj][m][n], 0, 0, 0); __builtin_amdgcn_s_setprio(0); } while (0)
#define PG8_WAIT_V(n) asm volatile("s_waitcnt vmcnt(" #n ")" ::: "memory")
#define PG8_WAIT_L(n) asm volatile("s_waitcnt lgkmcnt(" #n ")" ::: "memory")
#define PG8_BAR __builtin_amdgcn_s_barrier()
#define PG8_SCHED __builtin_amdgcn_sched_barrier(0)
    Unit cur, nxt; int ui = 0;
    if (!S.next(0, cur)) return;
    f32x4 acc[2][2][4][2];
#pragma unroll
    for (int a = 0; a < 2; ++a)
#pragma unroll
        for (int b = 0; b < 2; ++b)
#pragma unroll
            for (int m = 0; m < 4; ++m)
#pragma unroll
                for (int n = 0; n < 2; ++n) acc[a][b][m][n] = (f32x4){0.f, 0.f, 0.f, 0.f};
    bf16x8 At[4][2], B0[2][2], B1[2][2];
    unsigned vA0[2], vA1[2];
#pragma unroll
    for (int i = 0; i < 2; ++i) { vA0[i] = S.a_off(0, cur, 0, Rr[i], Cc[i]); vA1[i] = S.a_off(0, cur, 1, Rr[i], Cc[i]); }
    const char* Ab = (const char*)A;
    const char* cB = (const char*)Bt + (size_t)cur.bt * tstep;
    PG8_STAGE(PG8_SB(0, 0), cB, voffB); PG8_STAGE(PG8_SB(0, 1), cB + hstep, voffB); PG8_STAGE(PG8_SA(0, 0), Ab, vA0); PG8_STAGE(PG8_SA(0, 1), Ab, vA1);
    if (wr == 1) PG8_BAR;
    PG8_WAIT_V(2); PG8_BAR;
    PG8_STAGE(PG8_SB(1, 0), cB + kstep, voffB); PG8_STAGE(PG8_SA(1, 0), Ab + kstep, vA0); PG8_STAGE(PG8_SB(1, 1), cB + hstep + kstep, voffB);
    PG8_WAIT_V(6); PG8_BAR;
    for (;;) {
        const bool has_next = S.next(ui + 1, nxt);
        const char* nB = has_next ? (const char*)Bt + (size_t)nxt.bt * tstep : cB;
        for (int t = 0; t < nt; t += 2) {
            const bool last = (t == nt - 2);
            const char* a1 = Ab + (size_t)(t + 1) * kstep;
            const char* a2 = last ? Ab : Ab + (size_t)(t + 2) * kstep; const char* b2 = last ? nB : cB + (size_t)(t + 2) * kstep;
            const char* a3 = a2 + kstep; const char* b3 = b2 + kstep;
            unsigned v20[2], v21[2];
#pragma unroll
            for (int i = 0; i < 2; ++i) { v20[i] = vA0[i]; v21[i] = vA1[i]; }
            if (last && has_next) {
#pragma unroll
                for (int i = 0; i < 2; ++i) { v20[i] = S.a_off(ui + 1, nxt, 0, Rr[i], Cc[i]); v21[i] = S.a_off(ui + 1, nxt, 1, Rr[i], Cc[i]); } }
            PG8_LDB(B0, 0, 0); PG8_LDB(B1, 0, 1); PG8_SCHED; PG8_LDA(At, 0, 0); PG8_STAGE(PG8_SA(1, 1), a1, vA1);
            PG8_WAIT_V(8); PG8_WAIT_L(0); PG8_BAR; PG8_MMA(0, 0, At, B0); PG8_MMA(0, 1, At, B1); PG8_BAR; PG8_SCHED;
            PG8_LDA(At, 0, 1); PG8_STAGE(PG8_SB(0, 0), b2, voffB); PG8_STAGE(PG8_SB(0, 1), b2 + hstep, voffB); PG8_STAGE(PG8_SA(0, 0), a2, v20);
            PG8_WAIT_V(8); PG8_WAIT_L(0); PG8_BAR; PG8_MMA(1, 0, At, B0); PG8_MMA(1, 1, At, B1); PG8_BAR; PG8_SCHED;
            PG8_LDB(B0, 1, 0); PG8_LDB(B1, 1, 1); PG8_SCHED; PG8_LDA(At, 1, 0); PG8_STAGE(PG8_SA(0, 1), a2, v21);
            PG8_WAIT_V(8); PG8_WAIT_L(0); PG8_BAR; PG8_MMA(0, 0, At, B0); PG8_MMA(0, 1, At, B1); PG8_BAR; PG8_SCHED;
            PG8_LDA(At, 1, 1); PG8_STAGE(PG8_SB(1, 0), b3, voffB); PG8_STAGE(PG8_SB(1, 1), b3 + hstep, voffB); PG8_STAGE(PG8_SA(1, 0), a3, v20);
            PG8_WAIT_V(8); PG8_WAIT_L(0); PG8_BAR; PG8_MMA(1, 0, At, B0); PG8_MMA(1, 1, At, B1); PG8_BAR; PG8_SCHED;
        }
        if (wr == 0) PG8_BAR;
        E(acc, cur, wr, wc, fr, fq);
        if (!has_next) break;
#pragma unroll
        for (int a = 0; a < 2; ++a)
#pragma unroll
            for (int b = 0; b < 2; ++b)
#pragma unroll
                for (int m = 0; m < 4; ++m)
#pragma unroll
                    for (int n = 0; n < 2; ++n) acc[a][b][m][n] = (f32x4){0.f, 0.f, 0.f, 0.f};
        cur = nxt; cB = nB; ++ui;
#pragma unroll
        for (int i = 0; i < 2; ++i) { vA0[i] = S.a_off(ui, cur, 0, Rr[i], Cc[i]); vA1[i] = S.a_off(ui, cur, 1, Rr[i], Cc[i]); }
        if (wr == 1) PG8_BAR;
    }
    PG8_WAIT_V(0);
    PG8_BAR;
#undef PG8_SA
#undef PG8_SB
#undef PG8_STAGE
#undef PG8_LDA
#undef PG8_LDB
#undef PG8_MMA
#undef PG8_WAIT_V
#undef PG8_WAIT_L
#undef PG8_BAR
#undef PG8_SCHED
}

struct DenseOrder {
    int nM, nN, nwg, G, c, lda;
    __device__ void init(int M, int N, int G_, int c_, int lda_) { nM = M / BM; nN = N / BM; nwg = nM * nN; G = G_; c = c_; lda = lda_; }
    __device__ __forceinline__ bool next(int i, Unit& u) const {
        const long L = (long)i * G + c; if (L >= nwg) return false;
        int wgid = (int)L; { const int q = nwg / 8, r = nwg % 8, xcd = wgid % 8, off = wgid / 8; wgid = (xcd < r ? xcd * (q + 1) : r * (q + 1) + (xcd - r) * q) + off; }
        const int nig = 8 * nN, gid = wgid / nig, fm = gid * 8, gsz = (nM - fm) < 8 ? (nM - fm) : 8;
        u.pm = fm + ((wgid % nig) % gsz); u.pn = (wgid % nig) / gsz; u.bt = u.pn; u.e = 0; return true;
    }
    __device__ __forceinline__ unsigned a_off(int, const Unit& u, int h, int R, int C) const { return (unsigned)((u.pm * BM + h * HALF + R) * lda + C) * 2u; }
};
template <bool GATHER> struct MoeOrder {
    const LAS int* ts;
    const LAS int* tokL;
    int G, c, lda;
    __device__ __forceinline__ bool next(int i, Unit& u) const {
        const int L = i * G + c; const int ntile = __builtin_amdgcn_readfirstlane(ts[16]);
        if (L >= ntile * 4) return false;
        const int rt = L >> 2; int e = 0;
#pragma unroll
        for (int j = 1; j < 16; ++j) e += (rt >= ts[j]) ? 1 : 0;
        e = __builtin_amdgcn_readfirstlane(e);
        u.pm = rt; u.pn = L & 3; u.e = e; u.bt = e * 4 + (L & 3); return true;
    }
    __device__ __forceinline__ unsigned a_off(int ui, const Unit& u, int h, int R, int C) const {
        if (GATHER) { const int tok = tokL[ui * 256 + h * HALF + R]; return (unsigned)(tok * lda + C) * 2u; }
        return (unsigned)((u.pm * BM + h * HALF + R) * lda + C) * 2u;
    }
};

struct EpiPlain {
    bf16* O; int ldc; const float* bias; int scale_cols; float scale0;
    __device__ __forceinline__ void operator()(const f32x4 (&acc)[2][2][4][2], const Unit& u, int wr, int wc, int fr, int fq) const {
        const int row0 = u.pm * BM + wr * 64 + fr, col0 = u.pn * BM + wc * 32 + 8 * fq;
        const float sc = (u.pn * BM < scale_cols) ? scale0 : 1.f;
        f32x4 bv[2][2];
#pragma unroll
        for (int bj = 0; bj < 2; ++bj)
#pragma unroll
            for (int n = 0; n < 2; ++n) bv[bj][n] = bias ? *(const f32x4*)(bias + col0 + bj * HALF + 4 * n) : (f32x4){0.f, 0.f, 0.f, 0.f};
#pragma unroll
        for (int ai = 0; ai < 2; ++ai)
#pragma unroll
            for (int m = 0; m < 4; ++m) { bf16* rowp = O + (size_t)(row0 + ai * HALF + m * 16) * ldc + col0;
#pragma unroll
                for (int bj = 0; bj < 2; ++bj) { f32x4 v0 = (acc[ai][bj][m][0] + bv[bj][0]) * sc, v1 = (acc[ai][bj][m][1] + bv[bj][1]) * sc;
                    u32x4 w; w.x = cvt_pk_bf16(v0[0], v0[1]); w.y = cvt_pk_bf16(v0[2], v0[3]); w.z = cvt_pk_bf16(v1[0], v1[1]); w.w = cvt_pk_bf16(v1[2], v1[3]);
                    *(u32x4*)(rowp + bj * HALF) = w; } }
    }
};
struct EpiInProj {
    bf16* Z; bf16* XBC;
    __device__ __forceinline__ void operator()(const f32x4 (&acc)[2][2][4][2], const Unit& u, int wr, int wc, int fr, int fq) const {
        const int row0 = u.pm * BM + wr * 64 + fr; int colt = u.pn * BM; bf16* base; int ldc;
        if (colt < DI) { base = Z; ldc = DI; } else { base = XBC; ldc = CONVD; colt -= DI; }
        const int col0 = colt + wc * 32 + 8 * fq;
#pragma unroll
        for (int ai = 0; ai < 2; ++ai)
#pragma unroll
            for (int m = 0; m < 4; ++m) { bf16* rowp = base + (size_t)(row0 + ai * HALF + m * 16) * ldc + col0;
#pragma unroll
                for (int bj = 0; bj < 2; ++bj) { const f32x4 v0 = acc[ai][bj][m][0], v1 = acc[ai][bj][m][1];
                    u32x4 w; w.x = cvt_pk_bf16(v0[0], v0[1]); w.y = cvt_pk_bf16(v0[2], v0[3]); w.z = cvt_pk_bf16(v1[0], v1[1]); w.w = cvt_pk_bf16(v1[2], v1[3]);
                    *(u32x4*)(rowp + bj * HALF) = w; } }
    }
};
struct EpiGateUp {
    bf16* Hh;
    __device__ __forceinline__ void operator()(const f32x4 (&acc)[2][2][4][2], const Unit& u, int wr, int wc, int fr, int fq) const {
        const int row0 = u.pm * BM + wr * 64 + fr, col0 = (u.pn * BM + wc * 32 + 8 * fq) >> 1;
#pragma unroll
        for (int ai = 0; ai < 2; ++ai)
#pragma unroll
            for (int m = 0; m < 4; ++m) { bf16* rowp = Hh + (size_t)(row0 + ai * HALF + m * 16) * DFF + col0;
#pragma unroll
                for (int bj = 0; bj < 2; ++bj) { const f32x4 g = acc[ai][bj][m][0], up = acc[ai][bj][m][1];
                    u32x2 w; w.x = cvt_pk_bf16(silu_f(g[0]) * up[0], silu_f(g[1]) * up[1]); w.y = cvt_pk_bf16(silu_f(g[2]) * up[2], silu_f(g[3]) * up[3]);
                    *(u32x2*)(rowp + bj * (HALF / 2)) = w; } }
    }
};
}

#define XB_TMO      128
#define XB_XCNT(j)  (256  + 64 * (j))
#define XB_XSUB(j)  (1280 + 64 * (j))
#define XB_XGEN(j)  (2304 + 64 * (j))
#define XB_TOP      3328
#define XB_TOPGEN   3392
#define XCD_BAR_WORDS 3456
#define XB_SPIN_CAP (1u << 18)
__device__ __forceinline__ unsigned xb_ld(unsigned* p)              { return __hip_atomic_load(p, __ATOMIC_RELAXED, __HIP_MEMORY_SCOPE_AGENT); }
__device__ __forceinline__ unsigned xb_add(unsigned* p, unsigned v) { return __hip_atomic_fetch_add(p, v, __ATOMIC_RELAXED, __HIP_MEMORY_SCOPE_AGENT); }
__device__ __forceinline__ unsigned xb_xcc_id() { return (unsigned)__builtin_amdgcn_s_getreg((3 << 11) | 20) & 0xFu; }
#define XB_SPIN(cond, bar) do { unsigned _sp = 0; while (cond) { __builtin_amdgcn_s_sleep(1); \
    if ((++_sp & 255u) == 0u) { if (xb_ld(&(bar)[XB_TMO])) break; if (_sp > XB_SPIN_CAP) { atomicAdd(&(bar)[XB_TMO], 1u); break; } } } } while (0)
struct XcdBarrier { unsigned* bar; unsigned x; volatile LAS unsigned* st; };
__device__ __forceinline__ XcdBarrier xcd_barrier_post(unsigned* bar, volatile LAS unsigned* st) {
    XcdBarrier b; b.bar = bar; b.x = xb_xcc_id(); b.st = st;
    if (threadIdx.x == 0) (void)xb_add(&bar[XB_XCNT(b.x)], 1u);
    return b;
}
__device__ __forceinline__ void xcd_barrier_complete(unsigned* bar, unsigned x, unsigned& nloc, unsigned& nx) {
    const unsigned G = gridDim.x * gridDim.y * gridDim.z;
    unsigned sum, cnt, mine, sp = 0u;
    for (;;) {
        sum = 0u; cnt = 0u; mine = 0u;
#pragma unroll
        for (unsigned j = 0; j < 16; ++j) { const unsigned c = xb_ld(&bar[XB_XCNT(j)]); sum += c; cnt += (c > 0u) ? 1u : 0u; mine = (j == x) ? c : mine; }
        if (sum == G) break;
        __builtin_amdgcn_s_sleep(1);
        if ((++sp & 255u) == 0u) { if (xb_ld(&bar[XB_TMO])) break; if (sp > XB_SPIN_CAP) { atomicAdd(&bar[XB_TMO], 1u); break; } }
    }
    nloc = mine > 0u ? mine : 1u; nx = cnt > 0u ? cnt : 1u;
}
__device__ __forceinline__ void xcd_barrier(const XcdBarrier& b) {
    asm volatile("s_waitcnt vmcnt(0)" ::: "memory");
    __syncthreads();
    if (threadIdx.x == 0) {
        unsigned* bar = b.bar;
        __builtin_amdgcn_s_waitcnt(0);
        unsigned nloc = b.st[0], nx = b.st[1];
        if (nloc == 0u) { xcd_barrier_complete(bar, b.x, nloc, nx); b.st[0] = nloc; b.st[1] = nx; }
        const unsigned old = xb_add(&bar[XB_XSUB(b.x)], 1u);
        const unsigned gen = old / nloc;
        if (old + 1u == (gen + 1u) * nloc) {
            __builtin_amdgcn_fence(__ATOMIC_RELEASE, "agent");
            asm volatile("s_waitcnt vmcnt(0)" ::: "memory");
            const unsigned og = xb_add(&bar[XB_TOP], 1u);
            const unsigned tg = og / nx;
            if (og + 1u == (tg + 1u) * nx) xb_add(&bar[XB_TOPGEN], 1u);
            else XB_SPIN(xb_ld(&bar[XB_TOPGEN]) == tg, bar);
            __builtin_amdgcn_fence(__ATOMIC_ACQUIRE, "agent");
            xb_add(&bar[XB_XGEN(b.x)], 1u);
            asm volatile("s_waitcnt vmcnt(0)" ::: "memory");
        } else {
            XB_SPIN(xb_ld(&bar[XB_XGEN(b.x)]) == gen, bar);
            __builtin_amdgcn_fence(__ATOMIC_ACQUIRE, "agent");
            asm volatile("s_waitcnt vmcnt(0)" ::: "memory");
        }
    }
    __syncthreads();
}

struct Args { const float* in[23]; float* out; unsigned char* ws; int ph_lo, ph_hi; };

struct Frame {
    LAS unsigned char* lds;
    int tid, lane, wave, vcu, G;
};

__device__ __forceinline__ void transpose_item(const float* W, int K, int N, bf16* WT, int row_off, int mode, const float* kscale, LAS float* scr, int item, int lane) {
    const int nblk = N / 32, kb = item / nblk, nb = item % nblk, k0 = 64 * kb, n0 = 32 * nb;
#pragma unroll 8
    for (int i = 0; i < 32; ++i) { const int kk = 2 * i + (lane >> 5); scr[kk * 33 + (lane & 31)] = W[(size_t)(k0 + kk) * N + n0 + (lane & 31)]; }
    LDS_WAIT(); asm volatile("" ::: "memory");
    const int c = lane & 7;
    float ks[8];
#pragma unroll
    for (int q = 0; q < 8; ++q) ks[q] = kscale ? kscale[k0 + 8 * c + q] : 1.f;
#pragma unroll
    for (int j = 0; j < 4; ++j) { const int n = (lane >> 3) + 8 * j; const LAS float* s = scr + (8 * c) * 33 + n;
        u32x4 o; o.x = pk2(s[0 * 33] * ks[0], s[1 * 33] * ks[1]); o.y = pk2(s[2 * 33] * ks[2], s[3 * 33] * ks[3]); o.z = pk2(s[4 * 33] * ks[4], s[5 * 33] * ks[5]); o.w = pk2(s[6 * 33] * ks[6], s[7 * 33] * ks[7]);
        const int ng = n0 + n; const int dr = (mode == 0) ? ng : (8 * (ng >> 2) + (ng & 3) + (mode == 2 ? 4 : 0));
        *(GAS u32x4*)(WT + (size_t)(row_off + dr) * K + k0 + 8 * c) = o; }
    LDS_WAIT(); asm volatile("" ::: "memory");
}

__device__ __forceinline__ void ln_row(f32x4 (&v)[4], const float* g, const float* b, int lane) {
    float s = 0.f;
#pragma unroll
    for (int j = 0; j < 4; ++j) s += (v[j].x + v[j].y) + (v[j].z + v[j].w);
    const float mean = wave_sum(s) * (1.f / D); float s2 = 0.f;
#pragma unroll
    for (int j = 0; j < 4; ++j) { v[j] = v[j] - mean; s2 += (v[j].x * v[j].x + v[j].y * v[j].y) + (v[j].z * v[j].z + v[j].w * v[j].w); }
    const float rstd = 1.f / sqrtf(wave_sum(s2) * (1.f / D) + LN_EPS);
#pragma unroll
    for (int j = 0; j < 4; ++j) { const f32x4 gg = *(const f32x4*)(g + 4 * lane + 256 * j), bb = *(const f32x4*)(b + 4 * lane + 256 * j); v[j] = v[j] * rstd * gg + bb; }
}
__device__ __forceinline__ f32x4 ld_bf16x4(const bf16* p) { const u32x2 w = *(const u32x2*)p; return (f32x4){bflo(w.x), bfhi(w.x), bflo(w.y), bfhi(w.y)}; }
__device__ __forceinline__ void st_bf16x4(bf16* p, f32x4 v) { u32x2 w; w.x = pk2(v.x, v.y); w.y = pk2(v.z, v.w); *(u32x2*)p = w; }

#ifndef PH_MASK
#define PH_MASK 0x1ffff
#endif
#define IN(k) (((PH_MASK >> (k)) & 1) && lo <= (k) && (k) < hi)
#define SEAM(k) do { if (IN(k) && IN((k) + 1)) xcd_barrier(bar); } while (0)
#define PH_LOCALS \
    int tid = threadIdx.x; asm volatile("" : "+v"(tid)); const int lane = tid & 63, wave = __builtin_amdgcn_readfirstlane(tid >> 6); \
    size_t ws_z_ = 0; asm volatile("" : "+s"(ws_z_)); unsigned char* ws = args.ws + ws_z_;     \
    const int gw = F.vcu * 8 + wave, NGW = F.G * 8; (void)lane; (void)gw; (void)NGW; \
    const float* x_in = args.in[0]; (void)x_in; \
    bf16* Wt_in = (bf16*)(ws + WS_WIN); bf16* Wt_out = (bf16*)(ws + WS_WOUT); (void)Wt_in; (void)Wt_out; \
    bf16* XB = (bf16*)(ws + WS_XB); bf16* Zb = (bf16*)(ws + WS_Z); bf16* XBC = (bf16*)(ws + WS_XBC); (void)XB; (void)Zb; (void)XBC; \
    float* DTRAW = (float*)(ws + WS_DTRAW); float* SSQ = (float*)(ws + WS_SSQ); (void)DTRAW; (void)SSQ; \
    int* LIST = (int*)(ws + WS_LIST); unsigned* INFO = (unsigned*)(ws + WS_INFO); (void)LIST; (void)INFO;


template <int L>
__device__ __forceinline__ void layer_tail(const Args& args, const Frame& F, const XcdBarrier& bar, const int lo, const int hi) {
    const int pb = L ? 13 : 6;
#define LAYER_LOCALS \
    const bf16* MIX = (const bf16*)(ws + (L ? WS_MIX2 : WS_MIX1)); (void)MIX; \
    bf16* XN = (bf16*)(ws + (L ? WS_X3B : WS_X1B)); (void)XN;            \
    bf16* HB = (bf16*)(ws + (L ? WS_H1 : WS_H0)); (void)HB; \
    bf16* Y2 = (bf16*)(ws + (L ? WS_Y21 : WS_Y20)); (void)Y2; \
    gu32* gcnt = (gu32*)(ws + WS_CTL) + CW_CNT + 64 * L; (void)gcnt; \
    LAS int* tokL = (LAS int*)(F.lds + TOKL_OFF); (void)tokL; \
    LAS int* mo = (LAS int*)(F.lds + MOE_OFF); (void)mo;

    if (IN(pb)) { PH_LOCALS LAYER_LOCALS
        const float* lg = args.in[19] + L * D; const float* lb = args.in[20] + L * D;
        const float* rw = args.in[14]; const float* rbias = args.in[15];
        constexpr int AST = 2064;
        LAS unsigned char* AH = F.lds; LAS unsigned char* AL = F.lds + 16 * AST;
        LAS float* PART = (LAS float*)(F.lds + 66048);
        LAS float* LG = (LAS float*)(F.lds + 74240);
        LAS int* lcnt = (LAS int*)(F.lds + 75264);
        LAS int* rec = (LAS int*)(F.lds + 75264 + 256);
        const int r16 = lane & 15, q4 = lane >> 4;
        bf16x8 wh[4], wl[4];
#pragma unroll
        for (int ks = 0; ks < 4; ++ks) { unsigned hh_[4], ll_[4];
#pragma unroll
            for (int jp = 0; jp < 4; ++jp) { const float w0 = rw[(128 * wave + 32 * ks + 8 * q4 + 2 * jp) * NE + r16], w1 = rw[(128 * wave + 32 * ks + 8 * q4 + 2 * jp + 1) * NE + r16];
                const unsigned h0 = f2bf(w0), h1 = f2bf(w1); hh_[jp] = h0 | (h1 << 16); ll_[jp] = pk2(w0 - bf2f((unsigned short)h0), w1 - bf2f((unsigned short)h1)); }
            wh[ks] = __builtin_bit_cast(bf16x8, (u32x4){hh_[0], hh_[1], hh_[2], hh_[3]}); wl[ks] = __builtin_bit_cast(bf16x8, (u32x4){ll_[0], ll_[1], ll_[2], ll_[3]}); }
        if (tid < 32) lcnt[tid] = 0;
        __syncthreads();
        f32x4 nx[2][4]; u32x2 nm[2][4];
#define RT_LOAD(tile_) do { _Pragma("unroll") for (int u = 0; u < 2; ++u) { const size_t mm = (size_t)(tile_) * 16 + 2 * wave + u; _Pragma("unroll") for (int j = 0; j < 4; ++j) { nm[u][j] = *(const u32x2*)(MIX + mm * D + 4 * lane + 256 * j); \
            if (L == 0) nx[u][j] = *(const f32x4*)(x_in + mm * D + 4 * lane + 256 * j); \
            else { const u32x2 t_ = *(const u32x2*)((const bf16*)(ws + WS_X2B) + mm * D + 4 * lane + 256 * j); nx[u][j] = (f32x4){bflo(t_.x), bfhi(t_.x), bflo(t_.y), bfhi(t_.y)}; } } } } while (0)
        if (F.vcu < T / 16) RT_LOAD(F.vcu);
        int ti_ = 0;
        for (int tile = F.vcu; tile < T / 16; tile += F.G, ++ti_) {
            f32x4 v[2][4];
#pragma unroll
            for (int u = 0; u < 2; ++u)
#pragma unroll
                for (int j = 0; j < 4; ++j) v[u][j] = nx[u][j] * ALPHA + (f32x4){bflo(nm[u][j].x), bfhi(nm[u][j].x), bflo(nm[u][j].y), bfhi(nm[u][j].y)};
            RT_LOAD((tile + F.G < T / 16 ? tile + F.G : tile));
#pragma unroll
            for (int u = 0; u < 2; ++u) { const size_t m = (size_t)tile * 16 + 2 * wave + u;
                ln_row(v[u], lg, lb, lane);
#pragma unroll
                for (int j = 0; j < 4; ++j) { const f32x4 x = v[u][j]; const unsigned h0 = f2bf(x.x), h1 = f2bf(x.y), h2 = f2bf(x.z), h3 = f2bf(x.w);
                    u32x2 hw; hw.x = h0 | (h1 << 16); hw.y = h2 | (h3 << 16);
                    u32x2 lw; lw.x = pk2(x.x - bf2f((unsigned short)h0), x.y - bf2f((unsigned short)h1)); lw.y = pk2(x.z - bf2f((unsigned short)h2), x.w - bf2f((unsigned short)h3));
                    *(u32x2*)(XN + m * D + 4 * lane + 256 * j) = hw;
                    *(LAS u32x2*)(AH + (2 * wave + u) * AST + (256 * j + 4 * lane) * 2) = hw; *(LAS u32x2*)(AL + (2 * wave + u) * AST + (256 * j + 4 * lane) * 2) = lw; } }
            WG_BAR();
            { f32x4 acc = {0.f, 0.f, 0.f, 0.f};
#pragma unroll
              for (int ks = 0; ks < 4; ++ks) { const bf16x8 ah = *(const LAS bf16x8*)(AH + r16 * AST + (128 * wave + 32 * ks + 8 * q4) * 2), al = *(const LAS bf16x8*)(AL + r16 * AST + (128 * wave + 32 * ks + 8 * q4) * 2);
                  acc = __builtin_amdgcn_mfma_f32_16x16x32_bf16(ah, wh[ks], acc, 0, 0, 0); acc = __builtin_amdgcn_mfma_f32_16x16x32_bf16(ah, wl[ks], acc, 0, 0, 0); acc = __builtin_amdgcn_mfma_f32_16x16x32_bf16(al, wh[ks], acc, 0, 0, 0); }
#pragma unroll
              for (int r = 0; r < 4; ++r) PART[wave * 256 + (4 * q4 + r) * 16 + r16] = acc[r]; }
            WG_BAR();
            if (tid < 256) { float s_ = 0.f;
#pragma unroll
                for (int w = 0; w < 8; ++w) s_ += PART[w * 256 + tid];
                LG[tid] = s_; }
            WG_BAR();
            if (tid < 16) {
                float lgt[NE];
#pragma unroll
                for (int e4 = 0; e4 < 4; ++e4) { const f32x4 t_ = *(const LAS f32x4*)(LG + tid * 16 + 4 * e4); lgt[4 * e4] = t_.x; lgt[4 * e4 + 1] = t_.y; lgt[4 * e4 + 2] = t_.z; lgt[4 * e4 + 3] = t_.w; }
                float mxl = lgt[0];
#pragma unroll
                for (int e = 1; e < NE; ++e) mxl = fmaxf(mxl, lgt[e]);
                float sc[NE], sel[NE], den = 0.f;
#pragma unroll
                for (int e = 0; e < NE; ++e) { sc[e] = __expf(lgt[e] - mxl); den += sc[e]; }
                const float iden = 1.f / den;
#pragma unroll
                for (int e = 0; e < NE; ++e) { sc[e] *= iden; sel[e] = sc[e] + rbias[e]; }
                int bg = 0; float bgs = -1e30f;
#pragma unroll
                for (int g = 0; g < 4; ++g) { const float a = sel[4 * g], b2 = sel[4 * g + 1], c2 = sel[4 * g + 2], d2 = sel[4 * g + 3];
                    const float hi1 = fmaxf(fmaxf(a, b2), fmaxf(c2, d2));
                    const float m01 = fminf(a, b2), m23 = fminf(c2, d2), M01 = fmaxf(a, b2), M23 = fmaxf(c2, d2);
                    const float second = fmaxf(fminf(M01, M23), fmaxf(m01, m23));
                    const float gs = hi1 + second;
                    if (gs > bgs) { bgs = gs; bg = g; } }
                float s0 = 0.f, s1 = 0.f, s2 = 0.f, s3 = 0.f, p0 = 0.f, p1 = 0.f, p2 = 0.f, p3 = 0.f;
#pragma unroll
                for (int g = 0; g < 4; ++g) if (g == bg) { s0 = sel[4 * g]; s1 = sel[4 * g + 1]; s2 = sel[4 * g + 2]; s3 = sel[4 * g + 3]; p0 = sc[4 * g]; p1 = sc[4 * g + 1]; p2 = sc[4 * g + 2]; p3 = sc[4 * g + 3]; }
                int i1 = 0; float b1 = s0, q1 = p0;
                if (s1 > b1) { b1 = s1; i1 = 1; q1 = p1; } if (s2 > b1) { b1 = s2; i1 = 2; q1 = p2; } if (s3 > b1) { b1 = s3; i1 = 3; q1 = p3; }
                int i2 = -1; float b2v = -1e30f, q2 = 0.f;
                if (i1 != 0 && s0 > b2v) { b2v = s0; i2 = 0; q2 = p0; } if (i1 != 1 && s1 > b2v) { b2v = s1; i2 = 1; q2 = p1; }
                if (i1 != 2 && s2 > b2v) { b2v = s2; i2 = 2; q2 = p2; } if (i1 != 3 && s3 > b2v) { b2v = s3; i2 = 3; q2 = p3; }
                const int e1 = 4 * bg + i1, e2 = 4 * bg + i2; const float gsum = q1 + q2, g1 = q1 / gsum, g2 = q2 / gsum;
                const int r1 = atomicAdd((int*)(lcnt + e1), 1), r2 = atomicAdd((int*)(lcnt + e2), 1);
                LAS int* rc = rec + ((ti_ & 31) * 16 + tid) * 8; rc[0] = e1; rc[1] = r1; rc[2] = e2; rc[3] = r2; rc[4] = __builtin_bit_cast(int, g1); rc[5] = __builtin_bit_cast(int, g2);
            }
        }
#undef RT_LOAD
        __syncthreads();
        if (tid < NE) lcnt[16 + tid] = (int)__hip_atomic_fetch_add(gcnt + tid, (unsigned)lcnt[tid], RLX_AGENT);
        __syncthreads();
        for (int lt = tid; lt < ti_ * 16; lt += 512) {
            const int m = 16 * (F.vcu + (lt >> 4) * F.G) + (lt & 15);
            const LAS int* rc = rec + lt * 8;
            const int e1 = rc[0], e2 = rc[2], sl1 = lcnt[16 + e1] + rc[1], sl2 = lcnt[16 + e2] + rc[3];
            LIST[(size_t)e1 * T + sl1] = m; LIST[(size_t)e2 * T + sl2] = m;
            u32x4 w0; w0.x = (unsigned)e1; w0.y = (unsigned)sl1; w0.z = (unsigned)e2; w0.w = (unsigned)sl2;
            *(u32x4*)(INFO + (size_t)m * 8) = w0; INFO[(size_t)m * 8 + 4] = (unsigned)rc[4]; INFO[(size_t)m * 8 + 5] = (unsigned)rc[5];
        }
    }
    SEAM(pb);

    if (IN(pb + 1) || IN(pb + 2) || IN(pb + 3)) { PH_LOCALS LAYER_LOCALS
        __syncthreads();
        if (tid == 0) { int acc_ = 0; for (int e = 0; e < NE; ++e) { const int c = (int)__hip_atomic_load(gcnt + e, RLX_AGENT); mo[e] = acc_; mo[32 + e] = c; acc_ += (c + 255) >> 8; } mo[16] = acc_; }
        __syncthreads();
    }
    if (IN(pb + 1)) { PH_LOCALS LAYER_LOCALS
        pg8::MoeOrder<true> S{mo, tokL, F.G, F.vcu, D};
        { pg8::Unit u; for (int ui = 0; ui < 6 && S.next(ui, u); ++ui) { if (tid < 256) { const int r = (u.pm - mo[u.e]) * 256 + tid, c = mo[32 + u.e]; tokL[ui * 256 + tid] = LIST[(size_t)u.e * T + (r < c ? r : c - 1)]; } } }
        __syncthreads();
        pg8::EpiGateUp E{HB};
        pg8::gemm_phase<pg8::EpiGateUp, pg8::MoeOrder<true>>(F.lds, XN, (const bf16*)(ws + (L ? WS_WGU1 : WS_WGU0)), D, S, E);
    }
    SEAM(pb + 1);
    if (IN(pb + 2)) { PH_LOCALS LAYER_LOCALS
        pg8::MoeOrder<false> S{mo, tokL, F.G, F.vcu, DFF};
        pg8::EpiPlain E{Y2, D, nullptr, 0, 1.f};
        pg8::gemm_phase<pg8::EpiPlain, pg8::MoeOrder<false>>(F.lds, HB, (const bf16*)(ws + (L ? WS_WD1 : WS_WD0)), DFF, S, E);
    }
    SEAM(pb + 2);
    if (IN(pb + 3)) { PH_LOCALS LAYER_LOCALS
        const float* lg = args.in[21] + L * D; const float* lb = args.in[22] + L * D;
        for (int m = gw; m < T; m += NGW) {
            const u32x4 w0 = *(const u32x4*)(INFO + (size_t)m * 8); const float g1 = __builtin_bit_cast(float, INFO[(size_t)m * 8 + 4]), g2 = __builtin_bit_cast(float, INFO[(size_t)m * 8 + 5]);
            const size_t r1 = (size_t)mo[w0.x] * 256 + w0.y, r2 = (size_t)mo[w0.z] * 256 + w0.w;
            f32x4 v[4];
#pragma unroll
            for (int j = 0; j < 4; ++j) { const int co = 4 * lane + 256 * j;
                v[j] = ld_bf16x4(XN + (size_t)m * D + co) * ALPHA + ld_bf16x4(Y2 + r1 * D + co) * g1 + ld_bf16x4(Y2 + r2 * D + co) * g2; }
            ln_row(v, lg, lb, lane);
            if (L == 0) {
#pragma unroll
                for (int j = 0; j < 4; ++j) st_bf16x4((bf16*)(ws + WS_X2B) + (size_t)m * D + 4 * lane + 256 * j, v[j]);
            } else {
#pragma unroll
                for (int j = 0; j < 4; ++j) *(f32x4*)(args.out + (size_t)m * D + 4 * lane + 256 * j) = v[j];
            }
        }
    }
}

__global__ void __launch_bounds__(512, 2) fwd_kernel(Args args) {
    extern __shared__ __attribute__((aligned(16))) unsigned char lds_raw[];
    Frame F;
    F.lds = (LAS unsigned char*)lds_raw;
    F.tid = threadIdx.x; F.lane = F.tid & 63; F.wave = __builtin_amdgcn_readfirstlane(F.tid >> 6);
    F.G = gridDim.x; { const int bx = blockIdx.x; F.vcu = (F.G % 8 == 0) ? (bx % 8) * (F.G / 8) + bx / 8 : bx; }
    unsigned char* ws = args.ws;
    gu32* ctl = (gu32*)(ws + WS_CTL);
    volatile LAS unsigned* MISC = (volatile LAS unsigned*)(F.lds + MISC_OFF);
    for (int u = F.tid; u < (LDS_BYTES - LDSCTL_OFF) / 4; u += 512) ((LAS unsigned*)(F.lds + LDSCTL_OFF))[u] = 0u;
    __syncthreads();
    XcdBarrier bar; bar.bar = (unsigned*)(ctl + CW_BAR); bar.x = 0; bar.st = nullptr;
    if (MK_N_LAUNCHES == 1) bar = xcd_barrier_post((unsigned*)(ctl + CW_BAR), MISC + 8);
    const int lo = args.ph_lo, hi = args.ph_hi;
    if (IN(0)) { PH_LOCALS
        LAS float* scr = (LAS float*)(F.lds + wave * 16384);
        constexpr int I_IN = (D / 64) * (INP / 32), I_OUT = (DI / 64) * (D / 32);
        for (int it = gw; it < I_IN + I_OUT; it += NGW) {
            if (it < I_IN) transpose_item(args.in[1], D, INP, Wt_in, 0, 0, nullptr, scr, it, lane);
            else transpose_item(args.in[8], DI, D, Wt_out, 0, 0, args.in[7], scr, it - I_IN, lane);
        }
        const size_t n8 = (size_t)T * D / 8, stride = (size_t)F.G * 512; size_t i = (size_t)blockIdx.x * 512 + tid;
        for (; i + 3 * stride < n8; i += 4 * stride) {
            f32x4 a[4], b[4];
#pragma unroll
            for (int u = 0; u < 4; ++u) { a[u] = *(const f32x4*)(x_in + (i + u * stride) * 8); b[u] = *(const f32x4*)(x_in + (i + u * stride) * 8 + 4); }
#pragma unroll
            for (int u = 0; u < 4; ++u) { u32x4 o; o.x = pk2(a[u].x, a[u].y); o.y = pk2(a[u].z, a[u].w); o.z = pk2(b[u].x, b[u].y); o.w = pk2(b[u].z, b[u].w); *(u32x4*)(XB + (i + u * stride) * 8) = o; }
        }
        for (; i < n8; i += stride) { const f32x4 a = *(const f32x4*)(x_in + i * 8), b = *(const f32x4*)(x_in + i * 8 + 4);
            u32x4 o; o.x = pk2(a.x, a.y); o.y = pk2(a.z, a.w); o.z = pk2(b.x, b.y); o.w = pk2(b.z, b.w); *(u32x4*)(XB + i * 8) = o; }
    }
    SEAM(0);

    if (IN(1)) { PH_LOCALS
        pg8::DenseOrder S; S.init(T, NZX, F.G, (int)blockIdx.x, D);
        pg8::EpiInProj E{Zb, XBC};
        pg8::gemm_phase<pg8::EpiInProj, pg8::DenseOrder>(F.lds, XB, Wt_in, D, S, E);
        for (int tile = gw; tile < T / 16; tile += NGW) {
            const int t0 = tile * 16, r = lane & 15, q = lane >> 4;
            const bf16* xp = XB + (size_t)(t0 + r) * D + 8 * q;
            const bf16* w0 = Wt_in + (size_t)(NZX + r) * D + 8 * q; const bf16* w1 = w0 + (size_t)16 * D;
            f32x4 a0 = {0.f, 0.f, 0.f, 0.f}, a1 = {0.f, 0.f, 0.f, 0.f};
#pragma unroll 4
            for (int k0 = 0; k0 < D; k0 += 32) {
                const bf16x8 xv = *(const bf16x8*)(xp + k0), wa = *(const bf16x8*)(w0 + k0), wb = *(const bf16x8*)(w1 + k0);
                a0 = __builtin_amdgcn_mfma_f32_16x16x32_bf16(wa, xv, a0, 0, 0, 0);
                a1 = __builtin_amdgcn_mfma_f32_16x16x32_bf16(wb, xv, a1, 0, 0, 0);
            }
            float* o = DTRAW + (size_t)(t0 + r) * NH + 4 * q;
            *(f32x4*)o = a0; *(f32x4*)(o + 16) = a1;
        }
    }
    SEAM(1);

    if (IN(2)) { PH_LOCALS
        const float* conv_w = args.in[2]; const float* conv_b = args.in[3];
        bf16* BCACT = (bf16*)(ws + WS_BCACT);
        { const float* dt_bias = args.in[4]; const float* a_log = args.in[5]; float* CUMV = (float*)(ws + WS_CUMV); float* DTV = (float*)(ws + WS_DTV);
          for (int it = gw; it < NB * NH * (SEQ / 64); it += NGW) { const int c = it & 63, h = (it >> 6) & 31, b = it >> 11;
              const float rw_ = DTRAW[((size_t)b * SEQ + c * 64 + lane) * NH + h] + dt_bias[h]; const float dtv = rw_ > 15.f ? rw_ : __logf(1.f + __expf(rw_)); float xx = dtv * (-__expf(a_log[h]));
#pragma unroll
              for (int o_ = 1; o_ < 64; o_ <<= 1) { const float vv = __shfl_up(xx, o_); if (lane >= o_) xx += vv; }
              const size_t oi = ((size_t)b * NH + h) * SEQ + c * 64 + lane; CUMV[oi] = xx; DTV[oi] = dtv; } }
        for (int it = blockIdx.x * 512 + tid; it < (T / 8) * 128; it += F.G * 512) {
            const int ch = it & 127, seg = it >> 7, r0 = seg * 8, s0 = r0 & (SEQ - 1), col = DI + 8 * ch;
            u32x4 rw[11];
#pragma unroll
            for (int q = 0; q < 11; ++q) { const int sr = s0 - 3 + q; const int rc = sr < 0 ? 0 : sr; rw[q] = *(const u32x4*)(XBC + (size_t)(r0 - s0 + rc) * CONVD + col); }
#pragma unroll
            for (int q = 0; q < 3; ++q) if (s0 - 3 + q < 0) rw[q] = (u32x4){0u, 0u, 0u, 0u};
#pragma unroll
            for (int hf = 0; hf < 2; ++hf) {
                f32x4 wq[5];
#pragma unroll
                for (int k = 0; k < 4; ++k) wq[k] = *(const f32x4*)(conv_w + k * CONVD + col + 4 * hf);
                wq[4] = *(const f32x4*)(conv_b + col + 4 * hf);
#pragma unroll
                for (int jj = 0; jj < 8; ++jj) { f32x4 aq = wq[4];
#pragma unroll
                    for (int k = 0; k < 4; ++k) { const u32x4 rq = rw[jj + k]; const unsigned a0 = hf ? rq.z : rq.x, a1 = hf ? rq.w : rq.y; aq += wq[k] * (f32x4){bflo(a0), bfhi(a0), bflo(a1), bfhi(a1)}; }
#pragma unroll
                    for (int e = 0; e < 4; ++e) aq[e] = silu_f(aq[e]);
                    u32x2 o_; o_.x = pk2(aq[0], aq[1]); o_.y = pk2(aq[2], aq[3]);
                    *(u32x2*)(BCACT + (size_t)(r0 + jj) * 1024 + 8 * ch + 4 * hf) = o_; }
            }
        }
    }
    SEAM(2);

    if (IN(3)) { PH_LOCALS
#if NAIVE_SCAN
        const float* conv_w = args.in[2]; const float* conv_b = args.in[3]; const float* dt_bias = args.in[4]; const float* a_log = args.in[5]; const float* dsk = args.in[6];
        for (int item = blockIdx.x; item < NB * NH; item += F.G) {
            if (wave >= 2) continue;
            LAS float* sB = (LAS float*)(F.lds + wave * 8192); LAS float* sC = sB + 128; LAS float* cwl = sC + 128;
            const int b = item / NH, h = item % NH, g = h / 8, pp = 32 * wave + (lane & 31), nh = lane >> 5;
            int col[5]; col[0] = h * HP + pp; col[1] = DI + g * NS + lane; col[2] = col[1] + 64; col[3] = DI + NG * NS + g * NS + lane; col[4] = col[3] + 64;
            float hist[5][3];
#pragma unroll
            for (int c = 0; c < 5; ++c) { cwl[(c * 5 + 4) * 64 + lane] = conv_b[col[c]];
#pragma unroll
                for (int k = 0; k < 4; ++k) cwl[(c * 5 + k) * 64 + lane] = conv_w[k * CONVD + col[c]];
#pragma unroll
                for (int k = 0; k < 3; ++k) hist[c][k] = 0.f; }
            LDS_WAIT();
            const float dtb = dt_bias[h], av = -__expf(a_log[h]), dh = dsk[h];
            float hst[64];
#pragma unroll
            for (int n = 0; n < 64; ++n) hst[n] = 0.f;
            for (int t = 0; t < SEQ; ++t) {
                const size_t row = (size_t)b * SEQ + t;
                float v[5];
#pragma unroll
                for (int c = 0; c < 5; ++c) { const float cur = bf2f(XBC[row * CONVD + col[c]]);
                    float a = cwl[(c * 5 + 4) * 64 + lane] + cwl[(c * 5) * 64 + lane] * hist[c][0] + cwl[(c * 5 + 1) * 64 + lane] * hist[c][1] + cwl[(c * 5 + 2) * 64 + lane] * hist[c][2] + cwl[(c * 5 + 3) * 64 + lane] * cur;
                    hist[c][0] = hist[c][1]; hist[c][1] = hist[c][2]; hist[c][2] = cur; v[c] = silu_f(a); }
                const float raw = DTRAW[row * NH + h] + dtb;
                const float dtv = raw > 20.f ? raw : log1pf(__expf(raw));
                const float dA = __expf(dtv * av);
                sB[lane] = v[1]; sB[lane + 64] = v[2]; sC[lane] = v[3]; sC[lane + 64] = v[4];
                LDS_WAIT(); asm volatile("" ::: "memory");
                const float xd = dtv * v[0]; float y = 0.f;
#pragma unroll
                for (int n = 0; n < 64; n += 4) { const f32x4 bb = *(const LAS f32x4*)(sB + 64 * nh + n), cc = *(const LAS f32x4*)(sC + 64 * nh + n);
                    hst[n] = hst[n] * dA + xd * bb.x; y += cc.x * hst[n];
                    hst[n + 1] = hst[n + 1] * dA + xd * bb.y; y += cc.y * hst[n + 1];
                    hst[n + 2] = hst[n + 2] * dA + xd * bb.z; y += cc.z * hst[n + 2];
                    hst[n + 3] = hst[n + 3] * dA + xd * bb.w; y += cc.w * hst[n + 3]; }
                LDS_WAIT(); asm volatile("" ::: "memory");
                y += __shfl_xor(y, 32);
                y += dh * v[0];
                const float zv = bf2f(Zb[row * DI + h * HP + pp]);
                const float yg = y * silu_f(zv);
                float sq = (lane < 32) ? yg * yg : 0.f; sq = wave_sum(sq);
                if (lane < 32) Zb[row * DI + h * HP + pp] = (bf16)f2bf(yg);
                if (lane == 0) SSQ[row * 64 + h * 2 + wave] = sq;
            }
        }
#else
        const float* conv_w = args.in[2]; const float* conv_b = args.in[3]; const float* dt_bias = args.in[4]; const float* a_log = args.in[5]; const float* dsk = args.in[6];
        typedef short v4i16 __attribute__((ext_vector_type(4)));
        constexpr int SXB = 144, SBB = 272;
        constexpr int XS_OFF = 0, XW_OFF = 18432, BM_OFF = 36864, CM_OFF = 71680, WM_OFF = 89088, HB_OFF = 98304, VEC_OFF = 133120, CW_OFF = 134144;
        static_assert(CW_OFF + 5 * 64 * 4 <= LDSCTL_OFF, "scan LDS map");
        LAS unsigned char* Lb = F.lds;
        LAS float* cumL = (LAS float*)(Lb + VEC_OFF);
        LAS float* dtL = cumL + 128;
        LAS float* cwl = (LAS float*)(Lb + CW_OFF);
        const int r16 = lane & 15, q4 = lane >> 4;
#define TR8(dst, base_off, stride, k0, c0) do { const LAS unsigned char* _a = Lb + (base_off) + ((k0) + 8 * q4 + (r16 >> 2)) * (stride) + ((c0) + 4 * (lane & 3)) * 2; \
        const v4i16 _lo = __builtin_amdgcn_ds_read_tr16_b64_v4i16((LAS v4i16*)_a), _hi = __builtin_amdgcn_ds_read_tr16_b64_v4i16((LAS v4i16*)(_a + 4 * (stride))); \
        dst = (bf16x8){_lo[0], _lo[1], _lo[2], _lo[3], _hi[0], _hi[1], _hi[2], _hi[3]}; } while (0)
        if (blockIdx.x < NB * NH) {
            const int item = blockIdx.x; const int b = item / NH, h = item % NH, g = h >> 3;
            __syncthreads();
            for (int i = tid; i < 5 * 64; i += 512) { const int k = i >> 6, cl = i & 63; cwl[i] = k < 4 ? conv_w[k * CONVD + h * HP + cl] : conv_b[h * HP + cl]; }
            for (int i = tid; i < SBB * 64 / 4; i += 512) ((LAS unsigned*)(Lb + HB_OFF))[i] = 0u;
            const float dh = dsk[h];
            const int sj = tid >> 3, sxc = tid & 7;
            const bf16* BCACT = (const bf16*)(ws + WS_BCACT);
            const float* cvp = (const float*)(ws + (tid < 64 ? WS_CUMV : WS_DTV)) + ((size_t)b * NH + h) * SEQ + (tid & 63);
            const size_t row0 = (size_t)b * SEQ;
            f32x4 hacc[4];
#pragma unroll
            for (int i = 0; i < 4; ++i) hacc[i] = (f32x4){0.f, 0.f, 0.f, 0.f};
            u32x4 xrA[4], brA[2], crA[2], xrB[4], brB[2], crB[2]; u32x2 zr[2]; float cv = 0.f;
            const int ti = wave & 3, wh = wave >> 2, irow = 16 * ti + r16;
#define SC_LOAD(c, S) do { _Pragma("unroll") for (int k = 0; k < 4; ++k) { const int rr = (c) * 64 + sj - 3 + k; const int rc = rr < 0 ? 0 : rr; \
                xr##S[k] = *(const u32x4*)(XBC + (row0 + rc) * CONVD + h * HP + 8 * sxc); } \
            _Pragma("unroll") for (int i = 0; i < 2; ++i) { const int idx = tid + 512 * i; const bf16* bp_ = BCACT + (row0 + (c) * 64 + (idx >> 4)) * 1024 + g * NS + 8 * (idx & 15); \
                br##S[i] = *(const u32x4*)bp_; cr##S[i] = *(const u32x4*)(bp_ + 512); } } while (0)
#define SC_LOADZ(c) do { _Pragma("unroll") for (int tt = 0; tt < 2; ++tt) zr[tt] = *(const u32x2*)(Zb + (row0 + (c) * 64 + irow) * DI + h * HP + 16 * (2 * wh + tt) + 4 * q4); } while (0)
#define SC_STAGE(c, S) do { const int pr_ = ((c) & 1) * 64, tb_ = (c) & 1; const float wj = __expf(cumL[pr_ + 63] - cumL[pr_ + sj]) * dtL[pr_ + sj]; \
                _Pragma("unroll") for (int k = 0; k < 3; ++k) if ((c) * 64 + sj - 3 + k < 0) xr##S[k] = (u32x4){0u, 0u, 0u, 0u};     \
                _Pragma("unroll") for (int hf = 0; hf < 2; ++hf) { f32x4 aq = *(const LAS f32x4*)(cwl + 4 * 64 + 8 * sxc + 4 * hf); \
                    _Pragma("unroll") for (int k = 0; k < 4; ++k) { const f32x4 wq = *(const LAS f32x4*)(cwl + k * 64 + 8 * sxc + 4 * hf); const unsigned r0_ = hf ? xr##S[k].z : xr##S[k].x, r1_ = hf ? xr##S[k].w : xr##S[k].y; \
                        aq += wq * (f32x4){bflo(r0_), bfhi(r0_), bflo(r1_), bfhi(r1_)}; } \
                    _Pragma("unroll") for (int e = 0; e < 4; ++e) aq[e] = silu_f(aq[e]); \
                    u32x2 o_; o_.x = pk2(aq[0], aq[1]); o_.y = pk2(aq[2], aq[3]); \
                    *(LAS u32x2*)(Lb + XS_OFF + tb_ * 9216 + sj * SXB + 16 * sxc + 8 * hf) = o_; \
                    o_.x = pk2(aq[0] * wj, aq[1] * wj); o_.y = pk2(aq[2] * wj, aq[3] * wj); \
                    *(LAS u32x2*)(Lb + XW_OFF + tb_ * 9216 + sj * SXB + 16 * sxc + 8 * hf) = o_; } \
                _Pragma("unroll") for (int i = 0; i < 2; ++i) { const int idx = tid + 512 * i; \
                    *(LAS u32x4*)(Lb + BM_OFF + tb_ * 17408 + (idx >> 4) * SBB + 16 * (idx & 15)) = br##S[i]; *(LAS u32x4*)(Lb + CM_OFF + (idx >> 4) * SBB + 16 * (idx & 15)) = cr##S[i]; } } while (0)
            if (tid < 128) { cumL[(tid >> 6) * 128 + (tid & 63)] = cvp[0]; cv = cvp[64]; }
            SC_LOAD(0, A); SC_LOADZ(0);
            __syncthreads();
            SC_STAGE(0, A);
            SC_LOAD(1, B);
            __syncthreads();
            for (int c2 = 0; c2 < SEQ / 64; c2 += 2) {
                { const int c = c2; const int pr = (c & 1) * 64, tb = c & 1; const int hb_cur = HB_OFF + (c & 1) * (SBB * 64), hb_nxt = HB_OFF + ((c & 1) ^ 1) * (SBB * 64);
                  if (tid < 128) { if (c + 1 < SEQ / 64) cumL[(tid >> 6) * 128 + (pr ^ 64) + (tid & 63)] = cv; if (c + 2 < SEQ / 64) cv = cvp[(c + 2) * 64]; }
                  SC_LOAD((c + 2 < SEQ / 64 ? c + 2 : SEQ / 64 - 1), A);
                  bf16x8 cf[4], bfr[2][4];
#pragma unroll
                  for (int ks = 0; ks < 4; ++ks) cf[ks] = *(const LAS bf16x8*)(Lb + CM_OFF + irow * SBB + (32 * ks + 8 * q4) * 2);
#pragma unroll
                  for (int tt = 0; tt < 2; ++tt)
#pragma unroll
                      for (int ks = 0; ks < 4; ++ks) bfr[tt][ks] = *(const LAS bf16x8*)(Lb + BM_OFF + tb * 17408 + (16 * (2 * wh + tt) + r16) * SBB + (32 * ks + 8 * q4) * 2);
                  const float ci = cumL[pr + irow];
                  f32x4 cjv[2], djv[2];
#pragma unroll
                  for (int tt = 0; tt < 2; ++tt) { cjv[tt] = *(const LAS f32x4*)(cumL + pr + 16 * (2 * wh + tt) + 4 * q4); djv[tt] = *(const LAS f32x4*)(dtL + pr + 16 * (2 * wh + tt) + 4 * q4); }
                  f32x4 ga[2] = {{0.f, 0.f, 0.f, 0.f}, {0.f, 0.f, 0.f, 0.f}};
#pragma unroll
                  for (int ks = 0; ks < 4; ++ks)
#pragma unroll
                      for (int tt = 0; tt < 2; ++tt) ga[tt] = __builtin_amdgcn_mfma_f32_16x16x32_bf16(bfr[tt][ks], cf[ks], ga[tt], 0, 0, 0);
#pragma unroll
                  for (int tt = 0; tt < 2; ++tt) { const int j0 = 16 * (2 * wh + tt) + 4 * q4; float wv[4];
#pragma unroll
                      for (int r = 0; r < 4; ++r) { const int j = j0 + r; float v = ga[tt][r] * __expf(ci - cjv[tt][r]) * djv[tt][r]; v = (j <= irow) ? v : 0.f; if (j == irow) v += dh; wv[r] = v; }
                      u32x2 w_; w_.x = pk2(wv[0], wv[1]); w_.y = pk2(wv[2], wv[3]);
                      *(LAS u32x2*)(Lb + WM_OFF + irow * SXB + j0 * 2) = w_; }
                  WG_BAR();
                  if (c + 1 < SEQ / 64) SC_STAGE(c + 1, B);
                  { bf16x8 wf[2], xa[2][2], ha[2][4];
#pragma unroll
                    for (int ks = 0; ks < 2; ++ks) wf[ks] = *(const LAS bf16x8*)(Lb + WM_OFF + irow * SXB + (32 * ks + 8 * q4) * 2);
#pragma unroll
                    for (int tt = 0; tt < 2; ++tt) {
#pragma unroll
                        for (int ks = 0; ks < 2; ++ks) TR8(xa[tt][ks], XS_OFF + tb * 9216, SXB, 32 * ks, 16 * (2 * wh + tt));
#pragma unroll
                        for (int ks = 0; ks < 4; ++ks) ha[tt][ks] = *(const LAS bf16x8*)(Lb + hb_cur + (16 * (2 * wh + tt) + r16) * SBB + (32 * ks + 8 * q4) * 2); }
                    f32x4 yd[2] = {{0.f, 0.f, 0.f, 0.f}, {0.f, 0.f, 0.f, 0.f}}, yo[2] = {{0.f, 0.f, 0.f, 0.f}, {0.f, 0.f, 0.f, 0.f}};
#pragma unroll
                    for (int ks = 0; ks < 4; ++ks)
#pragma unroll
                        for (int tt = 0; tt < 2; ++tt) { yo[tt] = __builtin_amdgcn_mfma_f32_16x16x32_bf16(ha[tt][ks], cf[ks], yo[tt], 0, 0, 0); if (ks < 2) yd[tt] = __builtin_amdgcn_mfma_f32_16x16x32_bf16(xa[tt][ks], wf[ks], yd[tt], 0, 0, 0); }
                    const float ec = __expf(ci); float ssq = 0.f;
#pragma unroll
                    for (int tt = 0; tt < 2; ++tt) { const int tp = 2 * wh + tt;
                        const float z0 = bflo(zr[tt].x), z1 = bfhi(zr[tt].x), z2 = bflo(zr[tt].y), z3 = bfhi(zr[tt].y);
                        const float y0 = (yd[tt][0] + ec * yo[tt][0]) * silu_f(z0), y1 = (yd[tt][1] + ec * yo[tt][1]) * silu_f(z1), y2 = (yd[tt][2] + ec * yo[tt][2]) * silu_f(z2), y3 = (yd[tt][3] + ec * yo[tt][3]) * silu_f(z3);
                        ssq += (y0 * y0 + y1 * y1) + (y2 * y2 + y3 * y3);
                        u32x2 o_; o_.x = pk2(y0, y1); o_.y = pk2(y2, y3);
                        *(u32x2*)(Zb + (row0 + c * 64 + irow) * DI + h * HP + 16 * tp + 4 * q4) = o_; }
                    ssq += __shfl_xor(ssq, 16); ssq += __shfl_xor(ssq, 32);
                    if (q4 == 0) SSQ[(row0 + c * 64 + irow) * 64 + h * 2 + wh] = ssq; }
                  SC_LOADZ((c + 1 < SEQ / 64 ? c + 1 : c));
                  { const float eL = __expf(cumL[pr + 63]);
                    bf16x8 ba[2], xb[2][4];
#pragma unroll
                    for (int ks = 0; ks < 2; ++ks) { TR8(ba[ks], BM_OFF + tb * 17408, SBB, 32 * ks, 16 * wave);
#pragma unroll
                        for (int tp = 0; tp < 4; ++tp) TR8(xb[ks][tp], XW_OFF + tb * 9216, SXB, 32 * ks, 16 * tp); }
#pragma unroll
                    for (int tp = 0; tp < 4; ++tp) hacc[tp] = hacc[tp] * eL;
#pragma unroll
                    for (int ks = 0; ks < 2; ++ks)
#pragma unroll
                        for (int tp = 0; tp < 4; ++tp) hacc[tp] = __builtin_amdgcn_mfma_f32_16x16x32_bf16(ba[ks], xb[ks][tp], hacc[tp], 0, 0, 0);
#pragma unroll
                    for (int tp = 0; tp < 4; ++tp) { u32x2 o_; o_.x = pk2(hacc[tp][0], hacc[tp][1]); o_.y = pk2(hacc[tp][2], hacc[tp][3]);
                        *(LAS u32x2*)(Lb + hb_nxt + (16 * tp + r16) * SBB + (16 * wave + 4 * q4) * 2) = o_; } }
                  WG_BAR();
                }
                { const int c = c2 + 1; const int pr = (c & 1) * 64, tb = c & 1; const int hb_cur = HB_OFF + (c & 1) * (SBB * 64), hb_nxt = HB_OFF + ((c & 1) ^ 1) * (SBB * 64);
                  if (tid < 128) { if (c + 1 < SEQ / 64) cumL[(tid >> 6) * 128 + (pr ^ 64) + (tid & 63)] = cv; if (c + 2 < SEQ / 64) cv = cvp[(c + 2) * 64]; }
                  SC_LOAD((c + 2 < SEQ / 64 ? c + 2 : SEQ / 64 - 1), B);
                  bf16x8 cf[4], bfr[2][4];
#pragma unroll
                  for (int ks = 0; ks < 4; ++ks) cf[ks] = *(const LAS bf16x8*)(Lb + CM_OFF + irow * SBB + (32 * ks + 8 * q4) * 2);
#pragma unroll
                  for (int tt = 0; tt < 2; ++tt)
#pragma unroll
                      for (int ks = 0; ks < 4; ++ks) bfr[tt][ks] = *(const LAS bf16x8*)(Lb + BM_OFF + tb * 17408 + (16 * (2 * wh + tt) + r16) * SBB + (32 * ks + 8 * q4) * 2);
                  const float ci = cumL[pr + irow];
                  f32x4 cjv[2], djv[2];
#pragma unroll
                  for (int tt = 0; tt < 2; ++tt) { cjv[tt] = *(const LAS f32x4*)(cumL + pr + 16 * (2 * wh + tt) + 4 * q4); djv[tt] = *(const LAS f32x4*)(dtL + pr + 16 * (2 * wh + tt) + 4 * q4); }
                  f32x4 ga[2] = {{0.f, 0.f, 0.f, 0.f}, {0.f, 0.f, 0.f, 0.f}};
#pragma unroll
                  for (int ks = 0; ks < 4; ++ks)
#pragma unroll
                      for (int tt = 0; tt < 2; ++tt) ga[tt] = __builtin_amdgcn_mfma_f32_16x16x32_bf16(bfr[tt][ks], cf[ks], ga[tt], 0, 0, 0);
#pragma unroll
                  for (int tt = 0; tt < 2; ++tt) { const int j0 = 16 * (2 * wh + tt) + 4 * q4; float wv[4];
#pragma unroll
                      for (int r = 0; r < 4; ++r) { const int j = j0 + r; float v = ga[tt][r] * __expf(ci - cjv[tt][r]) * djv[tt][r]; v = (j <= irow) ? v : 0.f; if (j == irow) v += dh; wv[r] = v; }
                      u32x2 w_; w_.x = pk2(wv[0], wv[1]); w_.y = pk2(wv[2], wv[3]);
                      *(LAS u32x2*)(Lb + WM_OFF + irow * SXB + j0 * 2) = w_; }
                  WG_BAR();
                  if (c + 1 < SEQ / 64) SC_STAGE(c + 1, A);
                  { bf16x8 wf[2], xa[2][2], ha[2][4];
#pragma unroll
                    for (int ks = 0; ks < 2; ++ks) wf[ks] = *(const LAS bf16x8*)(Lb + WM_OFF + irow * SXB + (32 * ks + 8 * q4) * 2);
#pragma unroll
                    for (int tt = 0; tt < 2; ++tt) {
#pragma unroll
                        for (int ks = 0; ks < 2; ++ks) TR8(xa[tt][ks], XS_OFF + tb * 9216, SXB, 32 * ks, 16 * (2 * wh + tt));
#pragma unroll
                        for (int ks = 0; ks < 4; ++ks) ha[tt][ks] = *(const LAS bf16x8*)(Lb + hb_cur + (16 * (2 * wh + tt) + r16) * SBB + (32 * ks + 8 * q4) * 2); }
                    f32x4 yd[2] = {{0.f, 0.f, 0.f, 0.f}, {0.f, 0.f, 0.f, 0.f}}, yo[2] = {{0.f, 0.f, 0.f, 0.f}, {0.f, 0.f, 0.f, 0.f}};
#pragma unroll
                    for (int ks = 0; ks < 4; ++ks)
#pragma unroll
                        for (int tt = 0; tt < 2; ++tt) { yo[tt] = __builtin_amdgcn_mfma_f32_16x16x32_bf16(ha[tt][ks], cf[ks], yo[tt], 0, 0, 0); if (ks < 2) yd[tt] = __builtin_amdgcn_mfma_f32_16x16x32_bf16(xa[tt][ks], wf[ks], yd[tt], 0, 0, 0); }
                    const float ec = __expf(ci); float ssq = 0.f;
#pragma unroll
                    for (int tt = 0; tt < 2; ++tt) { const int tp = 2 * wh + tt;
                        const float z0 = bflo(zr[tt].x), z1 = bfhi(zr[tt].x), z2 = bflo(zr[tt].y), z3 = bfhi(zr[tt].y);
                        const float y0 = (yd[tt][0] + ec * yo[tt][0]) * silu_f(z0), y1 = (yd[tt][1] + ec * yo[tt][1]) * silu_f(z1), y2 = (yd[tt][2] + ec * yo[tt][2]) * silu_f(z2), y3 = (yd[tt][3] + ec * yo[tt][3]) * silu_f(z3);
                        ssq += (y0 * y0 + y1 * y1) + (y2 * y2 + y3 * y3);
                        u32x2 o_; o_.x = pk2(y0, y1); o_.y = pk2(y2, y3);
                        *(u32x2*)(Zb + (row0 + c * 64 + irow) * DI + h * HP + 16 * tp + 4 * q4) = o_; }
                    ssq += __shfl_xor(ssq, 16); ssq += __shfl_xor(ssq, 32);
                    if (q4 == 0) SSQ[(row0 + c * 64 + irow) * 64 + h * 2 + wh] = ssq; }
                  SC_LOADZ((c + 1 < SEQ / 64 ? c + 1 : c));
                  { const float eL = __expf(cumL[pr + 63]);
                    bf16x8 ba[2], xb[2][4];
#pragma unroll
                    for (int ks = 0; ks < 2; ++ks) { TR8(ba[ks], BM_OFF + tb * 17408, SBB, 32 * ks, 16 * wave);
#pragma unroll
                        for (int tp = 0; tp < 4; ++tp) TR8(xb[ks][tp], XW_OFF + tb * 9216, SXB, 32 * ks, 16 * tp); }
#pragma unroll
                    for (int tp = 0; tp < 4; ++tp) hacc[tp] = hacc[tp] * eL;
#pragma unroll
                    for (int ks = 0; ks < 2; ++ks)
#pragma unroll
                        for (int tp = 0; tp < 4; ++tp) hacc[tp] = __builtin_amdgcn_mfma_f32_16x16x32_bf16(ba[ks], xb[ks][tp], hacc[tp], 0, 0, 0);
#pragma unroll
                    for (int tp = 0; tp < 4; ++tp) { u32x2 o_; o_.x = pk2(hacc[tp][0], hacc[tp][1]); o_.y = pk2(hacc[tp][2], hacc[tp][3]);
                        *(LAS u32x2*)(Lb + hb_nxt + (16 * tp + r16) * SBB + (16 * wave + 4 * q4) * 2) = o_; } }
                  WG_BAR();
                }
            }
        }
#undef SC_LOADZ
#undef TR8
#undef SC_LOAD
#undef SC_STAGE
#endif
    }
    SEAM(3);

    if (IN(4)) { PH_LOCALS
        { float pn = 0.f; u32x4 yn[4];
#define NM_LOAD(mm) do { pn = SSQ[(size_t)(mm) * 64 + lane]; _Pragma("unroll") for (int j = 0; j < 4; ++j) yn[j] = *(const u32x4*)(Zb + (size_t)(mm) * DI + j * 512 + lane * 8); } while (0)
          if (gw < T) NM_LOAD(gw);
          for (int m = gw; m < T; m += NGW) {
            float p = pn; u32x4 yw[4];
#pragma unroll
            for (int j = 0; j < 4; ++j) yw[j] = yn[j];
            NM_LOAD((m + NGW < T ? m + NGW : m));
            p += dpp_mov<0xB1>(p); p += dpp_mov<0x4E>(p); p += dpp_mov<0x141>(p); p += dpp_mov<0x140>(p);
            bf16* yr = Zb + (size_t)m * DI;
#pragma unroll
            for (int j = 0; j < 4; ++j) { const float ss = __builtin_bit_cast(float, __builtin_amdgcn_readlane(__builtin_bit_cast(int, p), 16 * j)); const float rs = 1.f / sqrtf(ss * (1.f / 512.f) + RMS_EPS);
                u32x4 w = yw[j];
                w.x = pk2(bflo(w.x) * rs, bfhi(w.x) * rs); w.y = pk2(bflo(w.y) * rs, bfhi(w.y) * rs); w.z = pk2(bflo(w.z) * rs, bfhi(w.z) * rs); w.w = pk2(bflo(w.w) * rs, bfhi(w.w) * rs);
                *(u32x4*)(yr + j * 512 + lane * 8) = w; }
          }
#undef NM_LOAD
        }
        LAS float* scr = (LAS float*)(F.lds + wave * 16384);
        constexpr int I_QKV = (D / 64) * (3 * D / 32), I_O = (D / 64) * (D / 32), I_G = (D / 64) * (DFF / 32), I_D = (DFF / 64) * (D / 32);
        constexpr int I_MOE = 2 * NE * (2 * I_G + I_D);
        for (int it = gw; it < I_QKV + I_O + I_MOE; it += NGW) {
            int r = it;
            if (r < I_QKV) { transpose_item(args.in[9], D, 3 * D, (bf16*)(ws + WS_WQKV), 0, 0, nullptr, scr, r, lane); continue; } r -= I_QKV;
            if (r < I_O) { transpose_item(args.in[12], D, D, (bf16*)(ws + WS_WO), 0, 0, nullptr, scr, r, lane); continue; } r -= I_O;
            const int le = r / (2 * I_G + I_D), L = le / NE, e = le % NE; r -= le * (2 * I_G + I_D);
            bf16* wgu = (bf16*)(ws + (L ? WS_WGU1 : WS_WGU0)) + (size_t)e * 1024 * D; bf16* wd = (bf16*)(ws + (L ? WS_WD1 : WS_WD0)) + (size_t)e * D * DFF;
            if (r < I_G) { transpose_item(args.in[16] + (size_t)le * D * DFF, D, DFF, wgu, 0, 1, nullptr, scr, r, lane); continue; } r -= I_G;
            if (r < I_G) { transpose_item(args.in[17] + (size_t)le * D * DFF, D, DFF, wgu, 0, 2, nullptr, scr, r, lane); continue; } r -= I_G;
            transpose_item(args.in[18] + (size_t)le * DFF * D, DFF, D, wd, 0, 0, nullptr, scr, r, lane);
        }
    }
    SEAM(4);

    if (IN(5)) { PH_LOCALS
        pg8::DenseOrder S; S.init(T, D, F.G, (int)blockIdx.x, DI);
        pg8::EpiPlain E{(bf16*)(ws + WS_MIX1), D, nullptr, 0, 1.f};
        pg8::gemm_phase<pg8::EpiPlain, pg8::DenseOrder>(F.lds, Zb, Wt_out, DI, S, E);
    }
    SEAM(5);

    layer_tail<0>(args, F, bar, lo, hi);
    SEAM(9);

    if (IN(10)) { PH_LOCALS
        pg8::DenseOrder S; S.init(T, 3 * D, F.G, (int)blockIdx.x, D);
        pg8::EpiPlain E{(bf16*)(ws + WS_QKV), 3 * D, args.in[10], D, 0.125f};
        pg8::gemm_phase<pg8::EpiPlain, pg8::DenseOrder>(F.lds, (const bf16*)(ws + WS_X2B), (const bf16*)(ws + WS_WQKV), D, S, E);
    }
    SEAM(10);
    if (IN(11)) { PH_LOCALS
#if NAIVE_ATTN
        const bf16* QKV = (const bf16*)(ws + WS_QKV); bf16* AO = (bf16*)(ws + WS_AO); const float* rel = args.in[11];
        for (int idx = blockIdx.x * 512 + tid; idx < NB * AH * SEQ; idx += F.G * 512) {
            const int s = idx % SEQ, bh = idx / SEQ, hh = bh % AH, b = bh / AH, c = s / 64;
            const bf16* qp = QKV + ((size_t)b * SEQ + s) * (3 * D) + hh * AD;
            float q[AD], o[AD];
#pragma unroll
            for (int d = 0; d < AD; ++d) { q[d] = bf2f(qp[d]); o[d] = 0.f; }
            float mx = -1e30f, l = 0.f;
            const int k0 = (c - LEFTC) * 64 < 0 ? 0 : (c - LEFTC) * 64, k1 = c * 64 + 64;
            for (int kp = k0; kp < k1; ++kp) {
                const bf16* kr = QKV + ((size_t)b * SEQ + kp) * (3 * D) + D + hh * AD; const bf16* vr = kr + D;
                float sc = 0.f;
#pragma unroll
                for (int d = 0; d < AD; d += 2) { const unsigned w = *(const unsigned*)(kr + d); sc += q[d] * bflo(w) + q[d + 1] * bfhi(w); }
                int dist = s - kp; dist = dist < -MAXREL ? -MAXREL : (dist > MAXREL ? MAXREL : dist);
                sc += rel[(dist + MAXREL) * AH + hh];
                const float mn = fmaxf(mx, sc), f = __expf(mx - mn), p = __expf(sc - mn);
                l = l * f + p; mx = mn;
#pragma unroll
                for (int d = 0; d < AD; d += 2) { const unsigned w = *(const unsigned*)(vr + d); o[d] = o[d] * f + p * bflo(w); o[d + 1] = o[d + 1] * f + p * bfhi(w); }
            }
            const float il = 1.f / l; bf16* op = AO + ((size_t)b * SEQ + s) * D + hh * AD;
#pragma unroll
            for (int d = 0; d < AD; d += 2) *(unsigned*)(op + d) = pk2(o[d] * il, o[d + 1] * il);
        }
#else
        const bf16* QKV = (const bf16*)(ws + WS_QKV); bf16* AO = (bf16*)(ws + WS_AO); const float* rel = args.in[11];
        typedef short v4i16 __attribute__((ext_vector_type(4)));
        constexpr int SKB = 144, KB_OFF = 0, VB_OFF = 36864, TB_OFF = 73728; constexpr float LOG2E = 1.4426950408889634f;
        LAS unsigned char* Lb = F.lds; LAS float* tb = (LAS float*)(Lb + TB_OFF);
        const int r16 = lane & 15, q4 = lane >> 4, wq = wave >> 2;
        const int NU = NB * AH * (SEQ / 128), per = (NU + F.G - 1) / F.G;
        const int u_begin = F.vcu * per, u_end = (u_begin + per < NU) ? u_begin + per : NU;
        const int kr = tid >> 3, pc = tid & 7;
        if (u_begin < u_end) {
            u32x4 kq[3][2], vq[3][2];
#define AT_KTLO(u_) ((2 * ((u_) & 31)) < 8 ? 4 - ((u_) & 31) : 0)
#define AT_ISSUE(slot) do { { const int lu_ = lu < u_end ? lu : u_end - 1, lk_ = lu < u_end ? lkt : 4;        \
                const int b_ = lu_ >> 9, hh_ = (lu_ >> 5) & 15, c0_ = 2 * (lu_ & 31); \
                const bf16* p_ = QKV + ((size_t)b_ * SEQ + (size_t)(c0_ - 8 + 2 * lk_) * 64 + kr) * (3 * D) + D + hh_ * AD + 8 * pc; \
                kq[slot][0] = *(const u32x4*)p_; vq[slot][0] = *(const u32x4*)(p_ + D); kq[slot][1] = *(const u32x4*)(p_ + (size_t)64 * 3 * D); vq[slot][1] = *(const u32x4*)(p_ + (size_t)64 * 3 * D + D); } \
            ++lkt; if (lkt == 5) { ++lu; lkt = AT_KTLO(lu); } } while (0)
#define AT_QLOAD(dst, u_) do { const int b_ = (u_) >> 9, hh_ = ((u_) >> 5) & 15, c0_ = 2 * ((u_) & 31); const int qr_ = 64 * (c0_ + wq) + 16 * (wave & 3) + r16; \
            _Pragma("unroll") for (int ds = 0; ds < 2; ++ds) dst[ds] = *(const bf16x8*)(QKV + ((size_t)b_ * SEQ + qr_) * (3 * D) + hh_ * AD + 32 * ds + 8 * q4); } while (0)
            int lu = u_begin, lkt = AT_KTLO(u_begin);
            int cu = u_begin, ckt = AT_KTLO(u_begin), step = 0;
            int hcur = (cu >> 5) & 15;
            __syncthreads();
            for (int i = tid; i < 384; i += 512) tb[i] = rel[(i < 2 * MAXREL ? i : 2 * MAXREL) * AH + hcur] * LOG2E;
            AT_ISSUE(0); AT_ISSUE(1); AT_ISSUE(2);
            bf16x8 qf[2], qn[2];
            AT_QLOAD(qf, cu);
            qn[0] = qf[0]; qn[1] = qf[1];
            AT_QLOAD(qn, (cu + 1 < u_end ? cu + 1 : cu));
#define AT_PUT(par_, slot) do { _Pragma("unroll") for (int hf = 0; hf < 2; ++hf) { *(LAS u32x4*)(Lb + KB_OFF + (par_) * 18432 + (64 * hf + kr) * SKB + pc * 16) = kq[slot][hf]; *(LAS u32x4*)(Lb + VB_OFF + (par_) * 18432 + (64 * hf + kr) * SKB + pc * 16) = vq[slot][hf]; } } while (0)
            AT_PUT(0, 0);
            f32x4 oacc[4];
#pragma unroll
            for (int i = 0; i < 4; ++i) oacc[i] = (f32x4){0.f, 0.f, 0.f, 0.f};
            float mrun = -1e30f, lrun = 0.f;
            WG_BAR();
#define AT_STEP(J) do { \
            AT_ISSUE(J);                                                                          \
            { const int b = cu >> 9, hh = (cu >> 5) & 15, c0 = 2 * (cu & 31); const int cw = c0 + wq, qrow = 64 * cw + 16 * (wave & 3) + r16, par = step & 1; \
              _Pragma("unroll") for (int hf = 0; hf < 2; ++hf) { const int kt = 2 * ckt + hf, chunk = c0 - 8 + kt; \
              if (kt >= wq && kt <= wq + 8) { \
                const LAS unsigned char* Kb = Lb + KB_OFF + par * 18432 + hf * (64 * SKB); const LAS unsigned char* Vb = Lb + VB_OFF + par * 18432 + hf * (64 * SKB); \
                bf16x8 kf[4][2]; \
                _Pragma("unroll") for (int t = 0; t < 4; ++t) _Pragma("unroll") for (int ds = 0; ds < 2; ++ds) kf[t][ds] = *(const LAS bf16x8*)(Kb + (16 * t + r16) * SKB + (32 * ds + 8 * q4) * 2); \
                f32x4 sc[4]; \
                _Pragma("unroll") for (int t = 0; t < 4; ++t) sc[t] = (f32x4){0.f, 0.f, 0.f, 0.f}; \
                _Pragma("unroll") for (int ds = 0; ds < 2; ++ds) _Pragma("unroll") for (int t = 0; t < 4; ++t) sc[t] = __builtin_amdgcn_mfma_f32_16x16x32_bf16(kf[t][ds], qf[ds], sc[t], 0, 0, 0); \
                bf16x8 vf[4][2]; \
                _Pragma("unroll") for (int dt = 0; dt < 4; ++dt) _Pragma("unroll") for (int kk = 0; kk < 2; ++kk) { const LAS unsigned char* va_ = Vb + (32 * kk + 4 * q4 + (r16 >> 2)) * SKB + (16 * dt + 4 * (lane & 3)) * 2; \
                    const v4i16 lo_ = __builtin_amdgcn_ds_read_tr16_b64_v4i16((LAS v4i16*)va_), hi_ = __builtin_amdgcn_ds_read_tr16_b64_v4i16((LAS v4i16*)(va_ + 16 * SKB)); \
                    vf[dt][kk] = (bf16x8){lo_[0], lo_[1], lo_[2], lo_[3], hi_[0], hi_[1], hi_[2], hi_[3]}; } \
                if (cw - chunk >= 3) { const float bc = tb[2 * MAXREL]; \
                    _Pragma("unroll") for (int t = 0; t < 4; ++t) sc[t] = sc[t] * LOG2E + bc; \
                } else { \
                    const LAS float* tbp = tb + (qrow - 64 * chunk - 4 * q4 + MAXREL);            \
                    _Pragma("unroll") for (int t = 0; t < 4; ++t) _Pragma("unroll") for (int r = 0; r < 4; ++r) sc[t][r] = sc[t][r] * LOG2E + tbp[-(16 * t + r)]; \
                } \
                float mx = fmaxf(fmaxf(sc[0][0], sc[0][1]), fmaxf(sc[0][2], sc[0][3])); \
                _Pragma("unroll") for (int t = 1; t < 4; ++t) mx = fmaxf(mx, fmaxf(fmaxf(sc[t][0], sc[t][1]), fmaxf(sc[t][2], sc[t][3]))); \
                if (__any(mx > mrun + 8.f)) {                                                       \
                    mx = fmaxf(mx, __shfl_xor(mx, 16)); mx = fmaxf(mx, __shfl_xor(mx, 32)); \
                    const float mnew = fmaxf(mrun, mx), alpha = __builtin_amdgcn_exp2f(mrun - mnew); mrun = mnew; lrun *= alpha; \
                    _Pragma("unroll") for (int i = 0; i < 4; ++i) oacc[i] = oacc[i] * alpha; } \
                float ls = 0.f; \
                _Pragma("unroll") for (int t = 0; t < 4; ++t) _Pragma("unroll") for (int r = 0; r < 4; ++r) { sc[t][r] = __builtin_amdgcn_exp2f(sc[t][r] - mrun); ls += sc[t][r]; } \
                lrun += ls; \
                bf16x8 pb[2]; \
                _Pragma("unroll") for (int kk = 0; kk < 2; ++kk) { u32x4 w_; w_.x = pk2(sc[2 * kk][0], sc[2 * kk][1]); w_.y = pk2(sc[2 * kk][2], sc[2 * kk][3]); w_.z = pk2(sc[2 * kk + 1][0], sc[2 * kk + 1][1]); w_.w = pk2(sc[2 * kk + 1][2], sc[2 * kk + 1][3]); pb[kk] = __builtin_bit_cast(bf16x8, w_); } \
                _Pragma("unroll") for (int kk = 0; kk < 2; ++kk) _Pragma("unroll") for (int dt = 0; dt < 4; ++dt) oacc[dt] = __builtin_amdgcn_mfma_f32_16x16x32_bf16(vf[dt][kk], pb[kk], oacc[dt], 0, 0, 0); \
              } } \
              if (ckt == 4) {                                                                     \
                lrun += __shfl_xor(lrun, 16); lrun += __shfl_xor(lrun, 32); \
                const float il = 1.f / lrun; bf16* op = AO + ((size_t)b * SEQ + qrow) * D + hh * AD + 4 * q4; \
                _Pragma("unroll") for (int dt = 0; dt < 4; ++dt) { u32x2 o_; o_.x = pk2(oacc[dt][0] * il, oacc[dt][1] * il); o_.y = pk2(oacc[dt][2] * il, oacc[dt][3] * il); *(u32x2*)(op + 16 * dt) = o_; oacc[dt] = (f32x4){0.f, 0.f, 0.f, 0.f}; } \
                mrun = -1e30f; lrun = 0.f; ++cu; ckt = AT_KTLO(cu); qf[0] = qn[0]; qf[1] = qn[1]; \
                AT_QLOAD(qn, (cu + 1 < u_end ? cu + 1 : u_end - 1)); \
                if (cu < u_end && ((cu >> 5) & 15) != hcur) { hcur = (cu >> 5) & 15; WG_BAR(); for (int i = tid; i < 384; i += 512) tb[i] = rel[(i < 2 * MAXREL ? i : 2 * MAXREL) * AH + hcur] * LOG2E; } \
              } else ++ckt; \
              AT_PUT(par ^ 1, ((J) + 1) % 3); \
              WG_BAR(); ++step; } } while (0)
            while (cu < u_end) { AT_STEP(0); if (cu >= u_end) break; AT_STEP(1); if (cu >= u_end) break; AT_STEP(2); }
#undef AT_STEP
#undef AT_PUT
#undef AT_QLOAD
#undef AT_ISSUE
#undef AT_KTLO
        }
#endif
    }
    SEAM(11);
    if (IN(12)) { PH_LOCALS
        pg8::DenseOrder S; S.init(T, D, F.G, (int)blockIdx.x, D);
        pg8::EpiPlain E{(bf16*)(ws + WS_MIX2), D, args.in[13], 0, 1.f};
        pg8::gemm_phase<pg8::EpiPlain, pg8::DenseOrder>(F.lds, (const bf16*)(ws + WS_AO), (const bf16*)(ws + WS_WO), D, S, E);
    }
    SEAM(12);
    layer_tail<1>(args, F, bar, lo, hi);
#undef IN
#undef SEAM
}

extern "C" void kernel_launch(void* const* d_in, const int* in_sizes, int n_in, void* d_out, int out_size, void* d_ws, size_t ws_size, hipStream_t stream) {
    static int grid = 0;
    if (grid == 0) {
        if (n_in != 23 || in_sizes[0] != T * D || out_size != T * D || ws_size < WS_END) { fprintf(stderr, "kernel_launch: unexpected shapes / workspace (n_in %d, ws %zu); nothing launched\n", n_in, ws_size); grid = -1; return; }
        int dev = 0, cus = 0, per_cu = 0;
        if (hipGetDevice(&dev) != hipSuccess || hipDeviceGetAttribute(&cus, hipDeviceAttributeMultiprocessorCount, dev) != hipSuccess) { grid = -1; return; }
        if (hipFuncSetAttribute((const void*)fwd_kernel, hipFuncAttributeMaxDynamicSharedMemorySize, LDS_BYTES) != hipSuccess) { fprintf(stderr, "kernel_launch: hipFuncSetAttribute failed\n"); grid = -1; return; }
        if (hipOccupancyMaxActiveBlocksPerMultiprocessor(&per_cu, (const void*)fwd_kernel, 512, LDS_BYTES) != hipSuccess || per_cu < 1) fprintf(stderr, "kernel_launch: occupancy query reports %d\n", per_cu);
        (void)hipGetLastError();
        grid = cus;
    }
    if (grid < 0) return;
    if (hipMemsetAsync((char*)d_ws + WS_CTL, 0, CTL_ZERO_BYTES, stream) != hipSuccess) return;
    Args a{};
    for (int i = 0; i < 23; ++i) a.in[i] = (const float*)d_in[i];
    a.out = (float*)d_out; a.ws = (unsigned char*)d_ws;
    if (MK_N_LAUNCHES == 1) { a.ph_lo = 0; a.ph_hi = NPHASE; hipLaunchKernelGGL(fwd_kernel, dim3(grid), dim3(512), LDS_BYTES, stream, a);
#ifdef PROBE_MASK
        for (int p = 0; p < NPHASE; ++p) if ((PROBE_MASK >> p) & 1) { a.ph_lo = p; a.ph_hi = p + 1; hipLaunchKernelGGL(fwd_kernel, dim3(grid), dim3(512), LDS_BYTES, stream, a); }
#endif
    }
    else for (int p = 0; p < NPHASE; ++p) { a.ph_lo = p; a.ph_hi = p + 1; hipLaunchKernelGGL(fwd_kernel, dim3(grid), dim3(512), LDS_BYTES, stream, a); }
}
```
